# Optimizing an MI355X kernel written in HIP

```python
import math
import jax, jax.numpy as jnp
from jax import lax
import numpy as np

D_MODEL = 1024
BATCH = 16
SEQ = 2048
DEPTH = 4

ATTN_WIDTH = D_MODEL // 2
RNN_WIDTH = D_MODEL - ATTN_WIDTH
DIFF_HEAD_DIM = 64
N_DIFF_HEADS = ATTN_WIDTH // (2 * DIFF_HEAD_DIM)
V_HEAD_DIM = 2 * DIFF_HEAD_DIM
ROT_DIM = DIFF_HEAD_DIM // 4
ROPE_THETA = 500000.0
LRU_BLOCK = 64
N_LRU_BLOCKS = RNN_WIDTH // LRU_BLOCK
CONV_WIDTH = 4
LRU_C = 8.0
D_FF = 4 * D_MODEL
PLE_DIM = 256
Q_BLOCK = 128
EPS = 1e-6
IN_WIDTH = 3 * ATTN_WIDTH + 2 * RNN_WIDTH

kernel_name = 'hymba_diffattn_rglru_hybrid'


def rms_norm(x, g):
    xf = x.astype(jnp.float32)
    y = xf * lax.rsqrt(jnp.mean(xf * xf, axis=-1, keepdims=True) + EPS)
    return (y * g.astype(jnp.float32)).astype(x.dtype)


def partial_rope(x, positions):
    half = ROT_DIM // 2
    inv_freq = ROPE_THETA ** (-jnp.arange(half, dtype=jnp.float32) * 2.0 / ROT_DIM)
    ang = positions.astype(jnp.float32)[..., None] * inv_freq
    cos = jnp.cos(ang)[:, :, None, None, :]
    sin = jnp.sin(ang)[:, :, None, None, :]
    xr = x[..., :ROT_DIM].astype(jnp.float32)
    x1, x2 = xr[..., :half], xr[..., half:]
    rot = jnp.concatenate([x1 * cos - x2 * sin, x2 * cos + x1 * sin], axis=-1)
    return jnp.concatenate([rot.astype(x.dtype), x[..., ROT_DIM:]], axis=-1)


def diff_attention(q, k, v, lam):
    B, S = q.shape[0], q.shape[1]
    nb = S // Q_BLOCK
    scale = DIFF_HEAD_DIM ** -0.5
    qb = q.reshape(B, nb, Q_BLOCK, N_DIFF_HEADS, 2, DIFF_HEAD_DIM).transpose(1, 0, 2, 3, 4, 5)
    q_idx = jnp.arange(S).reshape(nb, Q_BLOCK)
    k_idx = jnp.arange(S)

    def block(args):
        q_blk, qi = args
        s = jnp.einsum('bqhcd,bkhcd->bhcqk', q_blk, k).astype(jnp.float32) * scale
        mask = qi[:, None] >= k_idx[None, :]
        s = jnp.where(mask, s, -jnp.inf)
        pr = jax.nn.softmax(s, axis=-1)
        attn = pr[:, :, 0] - lam * pr[:, :, 1]
        return jnp.einsum('bhqk,bkhe->bqhe', attn.astype(v.dtype), v)

    out = lax.map(block, (qb, q_idx))
    return out.transpose(1, 0, 2, 3, 4).reshape(B, S, N_DIFF_HEADS, V_HEAD_DIM)


def causal_depthwise_conv(x, w, b):
    y = lax.conv_general_dilated(
        x, w[:, None, :].astype(x.dtype), window_strides=(1,),
        padding=[(CONV_WIDTH - 1, 0)],
        dimension_numbers=('NWC', 'WIO', 'NWC'),
        feature_group_count=x.shape[-1])
    return y + b


def rg_lru(x, w_a, b_a, w_x, b_x, lam_param):
    B, S, _ = x.shape
    xb = x.reshape(B, S, N_LRU_BLOCKS, LRU_BLOCK)
    r = jax.nn.sigmoid((jnp.einsum('bsgi,gij->bsgj', xb, w_a).reshape(B, S, RNN_WIDTH) + b_a).astype(jnp.float32))
    i = jax.nn.sigmoid((jnp.einsum('bsgi,gij->bsgj', xb, w_x).reshape(B, S, RNN_WIDTH) + b_x).astype(jnp.float32))
    log_a = -LRU_C * r * jax.nn.softplus(-lam_param.astype(jnp.float32))
    a = jnp.exp(log_a)
    b = jnp.sqrt(-jnp.expm1(2.0 * log_a)) * (i * x.astype(jnp.float32))

    def combine(left, right):
        a_l, b_l = left
        a_r, b_r = right
        return a_l * a_r, a_r * b_l + b_r

    _, h = lax.associative_scan(combine, (a, b), axis=1)
    return h.astype(x.dtype)


def setup_inputs(seed: int = 0) -> dict:
    key = jax.random.key(seed)
    ks = jax.random.split(key, 24)
    f32 = jnp.float32
    nrm = lambda k, shape, s: jax.random.normal(k, shape, f32) * s
    gain = lambda k, shape: 1.0 + 0.05 * jax.random.normal(k, shape, f32)
    a0 = jax.random.uniform(ks[15], (DEPTH, RNN_WIDTH), f32, 0.9, 0.999)
    s0 = a0 ** (1.0 / LRU_C)
    lru_lambda = jnp.log(s0) - jnp.log1p(-s0)
    positions = jnp.broadcast_to(jnp.arange(SEQ, dtype=jnp.int32)[None, :], (BATCH, SEQ))
    return {
        'x': nrm(ks[0], (BATCH, SEQ, D_MODEL), 1.0),
        'p': nrm(ks[1], (DEPTH, BATCH, SEQ, PLE_DIM), 1.0),
        'positions': positions,
        'w_in': nrm(ks[2], (DEPTH, D_MODEL, IN_WIDTH), D_MODEL ** -0.5),
        'w_out': nrm(ks[3], (DEPTH, D_MODEL, D_MODEL), D_MODEL ** -0.5),
        'g_mix': gain(ks[4], (DEPTH, D_MODEL)),
        'g_subln': gain(ks[5], (DEPTH, V_HEAD_DIM)),
        'lam_q': nrm(ks[6], (DEPTH, 2, DIFF_HEAD_DIM), 0.1),
        'lam_k': nrm(ks[7], (DEPTH, 2, DIFF_HEAD_DIM), 0.1),
        'conv_w': nrm(ks[8], (DEPTH, CONV_WIDTH, RNN_WIDTH), CONV_WIDTH ** -0.5),
        'conv_b': nrm(ks[9], (DEPTH, RNN_WIDTH), 0.01),
        'w_gate_a': nrm(ks[10], (DEPTH, N_LRU_BLOCKS, LRU_BLOCK, LRU_BLOCK), LRU_BLOCK ** -0.5),
        'b_gate_a': nrm(ks[11], (DEPTH, RNN_WIDTH), 0.01),
        'w_gate_x': nrm(ks[12], (DEPTH, N_LRU_BLOCKS, LRU_BLOCK, LRU_BLOCK), LRU_BLOCK ** -0.5),
        'b_gate_x': nrm(ks[13], (DEPTH, RNN_WIDTH), 0.01),
        'lru_lambda': lru_lambda,
        'g_mlp': gain(ks[14], (DEPTH, D_MODEL)),
        'w_mlp_in': nrm(ks[16], (DEPTH, D_MODEL, D_FF), D_MODEL ** -0.5),
        'w_mlp_out': nrm(ks[17], (DEPTH, D_FF, D_MODEL), D_FF ** -0.5),
        'g_ple': gain(ks[18], (DEPTH, D_MODEL)),
        'w_ple_gate': nrm(ks[19], (DEPTH, D_MODEL, D_MODEL), D_MODEL ** -0.5),
        'w_ple_proj': nrm(ks[20], (DEPTH, PLE_DIM, D_MODEL), PLE_DIM ** -0.5),
        'g_final': gain(ks[21], (D_MODEL,)),
    }


def reference(x, p, positions, w_in, w_out, g_mix, g_subln, lam_q, lam_k, conv_w, conv_b,
              w_gate_a, b_gate_a, w_gate_x, b_gate_x, lru_lambda, g_mlp, w_mlp_in, w_mlp_out,
              g_ple, w_ple_gate, w_ple_proj, g_final):
    B, S, _ = x.shape
    h = x
    A, R = ATTN_WIDTH, RNN_WIDTH
    for l in range(DEPTH):
        hn = rms_norm(h, g_mix[l])
        proj = hn @ w_in[l]
        q, k, v, xr, gr = jnp.split(proj, [A, 2 * A, 3 * A, 3 * A + R], axis=-1)
        q = partial_rope(q.reshape(B, S, N_DIFF_HEADS, 2, DIFF_HEAD_DIM), positions)
        k = partial_rope(k.reshape(B, S, N_DIFF_HEADS, 2, DIFF_HEAD_DIM), positions)
        v = v.reshape(B, S, N_DIFF_HEADS, V_HEAD_DIM)
        lam_init = 0.8 - 0.6 * math.exp(-0.3 * l)
        dots = jnp.sum(lam_q[l].astype(jnp.float32) * lam_k[l].astype(jnp.float32), axis=-1)
        lam = jnp.exp(dots[0]) - jnp.exp(dots[1]) + lam_init
        o = diff_attention(q, k, v, lam)
        o = (rms_norm(o, g_subln[l]) * (1.0 - lam_init)).reshape(B, S, A)
        xc = causal_depthwise_conv(xr, conv_w[l], conv_b[l])
        y = rg_lru(xc, w_gate_a[l], b_gate_a[l], w_gate_x[l], b_gate_x[l], lru_lambda[l])
        y = y * jax.nn.gelu(gr)
        h = h + jnp.concatenate([o, y], axis=-1) @ w_out[l]
        hm = rms_norm(h, g_mlp[l])
        h = h + jnp.square(jax.nn.relu(hm @ w_mlp_in[l])) @ w_mlp_out[l]
        gate = jax.nn.sigmoid(rms_norm(h, g_ple[l]) @ w_ple_gate[l])
        h = h + gate * (p[l] @ w_ple_proj[l])
    return rms_norm(h, g_final)
```

```cpp
#include <hip/hip_runtime.h>
#include <cstdio>
#include <cstdint>
__device__ __forceinline__ int tid_opaque() { int t = threadIdx.x; asm volatile("" : "+v"(t)); return t; }
namespace pg8 {
#define PG8_LAS __attribute__((address_space(3)))
typedef unsigned short bf16_t;
typedef short bf16x8 __attribute__((ext_vector_type(8)));
typedef float f32x4 __attribute__((ext_vector_type(4)));
typedef unsigned u32x4 __attribute__((ext_vector_type(4)));
constexpr int BM = 256, BK = 64, HALF = 128, HTB = HALF * BK * 2  , STAGE_BYTES = 8 * HTB, NXCD = 8, WGM = 8;

__host__ __device__ __forceinline__ int lds_byte(int r, int c) { const int st = (r >> 4) * 2 + (c >> 5), rr = r & 15, cc = c & 31, ob = rr * 64 + cc * 2; return st * 1024 + (ob ^ (((ob >> 9) & 1) << 5)); }
__host__ __device__ __forceinline__ void stage_rc(int b, int& R, int& C) { const int st = b / 1024, sb = b % 1024, swz = sb ^ (((sb >> 9) & 1) << 5); R = (st >> 1) * 16 + swz / 64; C = (st & 1) * 32 + (swz % 64) / 2; }
__host__ __device__ __forceinline__ int perm32(int rho) { const int n = rho >> 4, i = rho & 15; return 8 * (i >> 2) + 4 * n + (i & 3); }

struct Unit { int pm, pn; };
struct Gemm { const bf16_t* A; const bf16_t* Bt; int M, N, K; };

struct StaticOrder {
    int nM, nN, nwg, G, c;
    __host__ __device__ void init(int M, int N, int G_, int c_) { nM = M / BM; nN = N / BM; nwg = nM * nN; G = G_; c = c_; }
    __host__ __device__ bool next(int i, Unit& u) const {
        const long L = (long)i * G + c; if (L >= nwg) return false;
        int wgid = (int)L; { const int q = nwg / NXCD, r = nwg % NXCD, xcd = wgid % NXCD, off = wgid / NXCD; wgid = (xcd < r ? xcd * (q + 1) : r * (q + 1) + (xcd - r) * q) + off; }
        const int nig = WGM * nN, gid = wgid / nig, fm = gid * WGM, gsz = (nM - fm) < WGM ? (nM - fm) : WGM;
        u.pm = fm + ((wgid % nig) % gsz); u.pn = (wgid % nig) / gsz; return true;
    }
    __device__ __forceinline__ void a_ready(const Unit&) const {}
    __device__ __forceinline__ void done(const Unit&) const {}
};

__device__ __forceinline__ unsigned cvt_pk_bf16(float lo, float hi) { unsigned r; asm volatile("v_cvt_pk_bf16_f32 %0, %1, %2" : "=v"(r) : "v"(lo), "v"(hi)); return r; }
__device__ __forceinline__ u32x4 pack8(const f32x4 v0, const f32x4 v1) { u32x4 w; w.x = cvt_pk_bf16(v0[0], v0[1]); w.y = cvt_pk_bf16(v0[2], v0[3]); w.z = cvt_pk_bf16(v1[0], v1[1]); w.w = cvt_pk_bf16(v1[2], v1[3]); return w; }
__device__ __forceinline__ float bf_lo(unsigned w) { return __uint_as_float(w << 16); }
__device__ __forceinline__ float bf_hi(unsigned w) { return __uint_as_float(w & 0xffff0000u); }
constexpr int DMODEL = 1024;
constexpr float RMS_EPS = 1e-6f;
__device__ __forceinline__ float row_rs(const float* ssq, int row) {
    const f32x4* p = (const f32x4*)(ssq + (size_t)row * 16);
    const f32x4 a = p[0], b = p[1], c = p[2], d = p[3];
    const float s = (((a[0] + a[1]) + (a[2] + a[3])) + ((b[0] + b[1]) + (b[2] + b[3]))) + (((c[0] + c[1]) + (c[2] + c[3])) + ((d[0] + d[1]) + (d[2] + d[3])));
    return __builtin_amdgcn_rsqf(s * (1.0f / DMODEL) + RMS_EPS);
}
__device__ __forceinline__ float sumsq8(const f32x4 a, const f32x4 b) { return ((a[0] * a[0] + a[1] * a[1]) + (a[2] * a[2] + a[3] * a[3])) + ((b[0] * b[0] + b[1] * b[1]) + (b[2] * b[2] + b[3] * b[3])); }

struct EpiPlain {
    static constexpr bool PERM = true, AFTER_DRAIN = false;
    bf16_t* O; int ldc;
    __device__ __forceinline__ void operator()(const f32x4 (&acc)[2][2][4][2], const Unit& u, int wr, int wc, int fr, int fq) const {
        const int row0 = u.pm * BM + wr * 64 + fr, col0 = u.pn * BM + wc * 32 + 8 * fq;
#pragma unroll
        for (int ai = 0; ai < 2; ++ai)
#pragma unroll
            for (int m = 0; m < 4; ++m) { bf16_t* rowp = O + (size_t)(row0 + ai * HALF + m * 16) * ldc + col0;
#pragma unroll
                for (int bj = 0; bj < 2; ++bj) *(u32x4*)(rowp + bj * HALF) = pack8(acc[ai][bj][m][0], acc[ai][bj][m][1]); }
    }
};
struct EpiIn {
    static constexpr bool PERM = true, AFTER_DRAIN = false;
    bf16_t* O; int ldc; const float* ssq; const float* cs; float qscale;
    __device__ __forceinline__ void operator()(const f32x4 (&acc)[2][2][4][2], const Unit& u, int wr, int wc, int fr, int fq) const {
        const int row0 = u.pm * BM + wr * 64 + fr, col0 = u.pn * BM + wc * 32 + 8 * fq;
        const bool rope = (u.pn < 4) && !(wc & 1);
        const float sc = (u.pn < 2) ? qscale : 1.f;
        const bool mine = fq < 2; const float sgn = (fq == 0) ? -1.f : 1.f;
#pragma unroll
        for (int ai = 0; ai < 2; ++ai)
#pragma unroll
            for (int m = 0; m < 4; ++m) { const int row = row0 + ai * HALF + m * 16; const float rs = row_rs(ssq, row) * sc;
                bf16_t* rowp = O + (size_t)row * ldc + col0;
                f32x4 c0 = {1.f, 1.f, 1.f, 1.f}, c1 = c0, s0 = {0.f, 0.f, 0.f, 0.f}, s1 = s0;
                if (rope && mine) { const f32x4* cp = (const f32x4*)(cs + (size_t)row * 16); c0 = cp[0]; c1 = cp[1]; s0 = cp[2] * sgn; s1 = cp[3] * sgn; }
#pragma unroll
                for (int bj = 0; bj < 2; ++bj) { f32x4 v0 = acc[ai][bj][m][0] * rs, v1 = acc[ai][bj][m][1] * rs;
                    if (rope) { f32x4 p0, p1;
#pragma unroll
                        for (int e = 0; e < 4; ++e) { p0[e] = __shfl_xor(v0[e], 16); p1[e] = __shfl_xor(v1[e], 16); }
                        v0 = v0 * c0 + p0 * s0; v1 = v1 * c1 + p1 * s1; }
                    *(u32x4*)(rowp + bj * HALF) = pack8(v0, v1); }
                asm volatile("" ::: "memory"); }
    }
};
struct EpiRes {
    static constexpr bool PERM = true, AFTER_DRAIN = false;
    float* H; bf16_t* XB; float* ssq;
    __device__ __forceinline__ void operator()(const f32x4 (&acc)[2][2][4][2], const Unit& u, int wr, int wc, int fr, int fq) const {
        const int row0 = u.pm * BM + wr * 64 + fr, col0 = u.pn * BM + wc * 32 + 8 * fq;
#pragma unroll
        for (int ai = 0; ai < 2; ++ai)
#pragma unroll
            for (int m = 0; m < 4; ++m) { const int row = row0 + ai * HALF + m * 16; float part = 0.f;
#pragma unroll
                for (int bj = 0; bj < 2; ++bj) { float* hp = H + (size_t)row * DMODEL + col0 + bj * HALF;
                    f32x4 h0 = *(const f32x4*)hp, h1 = *(const f32x4*)(hp + 4);
                    h0 = h0 + acc[ai][bj][m][0]; h1 = h1 + acc[ai][bj][m][1];
                    *(f32x4*)hp = h0; *(f32x4*)(hp + 4) = h1; part += sumsq8(h0, h1);
                    *(u32x4*)(XB + (size_t)row * DMODEL + col0 + bj * HALF) = pack8(h0, h1); }
                part += __shfl_xor(part, 16); part += __shfl_xor(part, 32);
                if (fq == 0) ssq[(size_t)row * 16 + u.pn * 4 + wc] = part;
                asm volatile("" ::: "memory"); }
    }
};
struct EpiMlpIn {
    static constexpr bool PERM = true, AFTER_DRAIN = false;
    bf16_t* O; int ldc; const float* ssq;
    __device__ __forceinline__ void operator()(const f32x4 (&acc)[2][2][4][2], const Unit& u, int wr, int wc, int fr, int fq) const {
        const int row0 = u.pm * BM + wr * 64 + fr, col0 = u.pn * BM + wc * 32 + 8 * fq;
#pragma unroll
        for (int ai = 0; ai < 2; ++ai)
#pragma unroll
            for (int m = 0; m < 4; ++m) { const int row = row0 + ai * HALF + m * 16; const float rs = row_rs(ssq, row);
                bf16_t* rowp = O + (size_t)row * ldc + col0;
#pragma unroll
                for (int bj = 0; bj < 2; ++bj) { f32x4 v0 = acc[ai][bj][m][0] * rs, v1 = acc[ai][bj][m][1] * rs;
#pragma unroll
                    for (int e = 0; e < 4; ++e) { const float a = fmaxf(v0[e], 0.f), b = fmaxf(v1[e], 0.f); v0[e] = a * a; v1[e] = b * b; }
                    *(u32x4*)(rowp + bj * HALF) = pack8(v0, v1); }
                asm volatile("" ::: "memory"); }
    }
};
struct EpiPle {
    static constexpr bool PERM = true, AFTER_DRAIN = false;
    float* H; bf16_t* XBo; const float* ssq_in; float* ssq_out; const bf16_t* PP;
    __device__ __forceinline__ void operator()(const f32x4 (&acc)[2][2][4][2], const Unit& u, int wr, int wc, int fr, int fq) const {
        const int row0 = u.pm * BM + wr * 64 + fr, col0 = u.pn * BM + wc * 32 + 8 * fq;
#pragma unroll
        for (int ai = 0; ai < 2; ++ai)
#pragma unroll
            for (int m = 0; m < 4; ++m) { const int row = row0 + ai * HALF + m * 16; const float rs = row_rs(ssq_in, row); float part = 0.f;
#pragma unroll
                for (int bj = 0; bj < 2; ++bj) { float* hp = H + (size_t)row * DMODEL + col0 + bj * HALF;
                    f32x4 h0 = *(const f32x4*)hp, h1 = *(const f32x4*)(hp + 4);
                    const u32x4 pw = *(const u32x4*)(PP + (size_t)row * DMODEL + col0 + bj * HALF);
                    const f32x4 p0 = {bf_lo(pw.x), bf_hi(pw.x), bf_lo(pw.y), bf_hi(pw.y)}, p1 = {bf_lo(pw.z), bf_hi(pw.z), bf_lo(pw.w), bf_hi(pw.w)};
                    f32x4 g0 = acc[ai][bj][m][0] * rs, g1 = acc[ai][bj][m][1] * rs;
#pragma unroll
                    for (int e = 0; e < 4; ++e) { g0[e] = __builtin_amdgcn_rcpf(1.f + __builtin_amdgcn_exp2f(-1.4426950408889634f * g0[e])); g1[e] = __builtin_amdgcn_rcpf(1.f + __builtin_amdgcn_exp2f(-1.4426950408889634f * g1[e])); }
                    h0 = h0 + g0 * p0; h1 = h1 + g1 * p1;
                    *(f32x4*)hp = h0; *(f32x4*)(hp + 4) = h1; part += sumsq8(h0, h1);
                    *(u32x4*)(XBo + (size_t)row * DMODEL + col0 + bj * HALF) = pack8(h0, h1); }
                part += __shfl_xor(part, 16); part += __shfl_xor(part, 32);
                if (fq == 0) ssq_out[(size_t)row * 16 + u.pn * 4 + wc] = part;
                asm volatile("" ::: "memory"); }
    }
};

template <class Epi, class Sched, bool ALIGN_EPI = false, bool SP2 = false>
__device__ __forceinline__ void gemm_phase(PG8_LAS unsigned char* lds, const Gemm g, const Sched& S, const Epi& E) {
    const int tid = tid_opaque(), wid = __builtin_amdgcn_readfirstlane(tid >> 6), lane = tid & 63, wr = wid >> 2, wc = wid & 3, fr = lane & 15, fq = lane >> 4;
    const int K = g.K, nt = K / BK;
    unsigned voffA[2], voffB[2];
#pragma unroll
    for (int i = 0; i < 2; ++i) { int R, C; stage_rc(tid * 16 + i * 8192, R, C); const int Rb = Epi::PERM ? ((R & ~31) + perm32(R & 31)) : R;
        voffA[i] = (unsigned)(R * K + C) * 2u; voffB[i] = (unsigned)(Rb * K + C) * 2u; }
    const size_t kstep = (size_t)(BK * 2);
    const size_t hstep = (size_t)HALF * K * 2;
    const size_t tstep = 2 * hstep;
    const unsigned ldsw = (unsigned)wid * 1024u;
    const int aoff = lds_byte(wr * 64 + fr, fq * 8), boff = lds_byte(wc * 32 + fr, fq * 8);
#define PG8_SA(b, h) (((b) * 2 + (h)) * HTB)
#define PG8_SB(b, h) ((4 + (b) * 2 + (h)) * HTB)
#define PG8_STAGE(bufoff, gbase, voff) do { _Pragma("unroll") for (int _i = 0; _i < 2; ++_i) \
        __builtin_amdgcn_global_load_lds((const unsigned*)((const char*)(gbase) + (voff)[_i]), (PG8_LAS unsigned*)(lds + (bufoff) + ldsw + _i * 8192), 16, 0, 0); } while (0)
#define PG8_LDA(dst, b, h) do { _Pragma("unroll") for (int m = 0; m < 4; ++m) _Pragma("unroll") for (int k = 0; k < 2; ++k) dst[m][k] = *(const PG8_LAS bf16x8*)(lds + PG8_SA(b, h) + aoff + m * 2048 + k * 1024); } while (0)
#define PG8_LDB(dst, b, h) do { _Pragma("unroll") for (int n = 0; n < 2; ++n) _Pragma("unroll") for (int k = 0; k < 2; ++k) dst[n][k] = *(const PG8_LAS bf16x8*)(lds + PG8_SB(b, h) + boff + n * 2048 + k * 1024); } while (0)
#define PG8_MMA(ai, bj, At, Bt) do { __builtin_amdgcn_s_setprio(1); _Pragma("unroll") for (int m = 0; m < 4; ++m) _Pragma("unroll") for (int n = 0; n < 2; ++n) _Pragma("unroll") for (int k = 0; k < 2; ++k) \
        acc[ai][bj][m][n] = __builtin_amdgcn_mfma_f32_16x16x32_bf16(Bt[n][k], At[m][k], acc[ai][bj][m][n], 0, 0, 0); __builtin_amdgcn_s_setprio(0); } while (0)
#define PG8_WAIT_V(n) asm volatile("s_waitcnt vmcnt(" #n ")" ::: "memory")
#define PG8_WAIT_L(n) asm volatile("s_waitcnt lgkmcnt(" #n ")" ::: "memory")
#define PG8_BAR __builtin_amdgcn_s_barrier()
#define PG8_SCHED __builtin_amdgcn_sched_barrier(0)
    Unit cur, nxt; int ui = 0;
    if (!S.next(0, cur)) return;
    f32x4 acc[2][2][4][2];
#pragma unroll
    for (int a = 0; a < 2; ++a)
#pragma unroll
        for (int b = 0; b < 2; ++b)
#pragma unroll
            for (int m = 0; m < 4; ++m)
#pragma unroll
                for (int n = 0; n < 2; ++n) acc[a][b][m][n] = (f32x4){0.f, 0.f, 0.f, 0.f};
    bf16x8 At[4][2], B0[2][2], B1[2][2];
    const char* cA = (const char*)g.A + (size_t)cur.pm * tstep; const char* cB = (const char*)g.Bt + (size_t)cur.pn * tstep;
    S.a_ready(cur);
    if constexpr (SP2) {
        PG8_STAGE(PG8_SB(0, 0), cB, voffB); PG8_STAGE(PG8_SB(0, 1), cB + hstep, voffB); PG8_STAGE(PG8_SA(0, 0), cA, voffA); PG8_STAGE(PG8_SA(0, 1), cA + hstep, voffA);
        if (wr == 1) PG8_BAR;
        PG8_WAIT_V(2); PG8_BAR;
        PG8_STAGE(PG8_SB(1, 0), cB + kstep, voffB); PG8_STAGE(PG8_SA(1, 0), cA + kstep, voffA); PG8_STAGE(PG8_SB(1, 1), cB + hstep + kstep, voffB);
        PG8_WAIT_V(6); PG8_BAR;
    } else {
        PG8_STAGE(PG8_SB(0, 0), cB, voffB); PG8_STAGE(PG8_SA(0, 0), cA, voffA); PG8_STAGE(PG8_SB(0, 1), cB + hstep, voffB); PG8_STAGE(PG8_SA(0, 1), cA + hstep, voffA);
        if (wr == 1) PG8_BAR;
        PG8_WAIT_V(4); PG8_BAR;
        PG8_STAGE(PG8_SB(1, 0), cB + kstep, voffB); PG8_STAGE(PG8_SA(1, 0), cA + kstep, voffA); PG8_STAGE(PG8_SB(1, 1), cB + hstep + kstep, voffB);
        PG8_WAIT_V(6); PG8_BAR;
    }
    for (;;) {
        const bool has_next = S.next(ui + 1, nxt);
        const char* nA = has_next ? (const char*)g.A + (size_t)nxt.pm * tstep : cA; const char* nB = has_next ? (const char*)g.Bt + (size_t)nxt.pn * tstep : cB;
        for (int t = 0; t < nt; t += 2) {
            const bool last = (t == nt - 2);
            const char* a1 = cA + (size_t)(t + 1) * kstep;
            const char* a2 = last ? nA : cA + (size_t)(t + 2) * kstep; const char* b2 = last ? nB : cB + (size_t)(t + 2) * kstep;
            const char* a3 = a2 + kstep; const char* b3 = b2 + kstep;
            if (last && has_next) S.a_ready(nxt);
            if constexpr (SP2) {
            PG8_LDB(B0, 0, 0); PG8_LDB(B1, 0, 1); PG8_SCHED; PG8_LDA(At, 0, 0); PG8_STAGE(PG8_SA(1, 1), a1 + hstep, voffA);
            PG8_WAIT_V(8); PG8_WAIT_L(0); PG8_BAR; PG8_MMA(0, 0, At, B0); PG8_MMA(0, 1, At, B1); PG8_BAR; PG8_SCHED;
            PG8_LDA(At, 0, 1); PG8_STAGE(PG8_SB(0, 0), b2, voffB); PG8_STAGE(PG8_SB(0, 1), b2 + hstep, voffB); PG8_STAGE(PG8_SA(0, 0), a2, voffA);
            PG8_WAIT_V(8); PG8_WAIT_L(0); PG8_BAR; PG8_MMA(1, 0, At, B0); PG8_MMA(1, 1, At, B1); PG8_BAR; PG8_SCHED;
            PG8_LDB(B0, 1, 0); PG8_LDB(B1, 1, 1); PG8_SCHED; PG8_LDA(At, 1, 0); PG8_STAGE(PG8_SA(0, 1), a2 + hstep, voffA);
            PG8_WAIT_V(8); PG8_WAIT_L(0); PG8_BAR; PG8_MMA(0, 0, At, B0); PG8_MMA(0, 1, At, B1); PG8_BAR; PG8_SCHED;
            PG8_LDA(At, 1, 1); PG8_STAGE(PG8_SB(1, 0), b3, voffB); PG8_STAGE(PG8_SB(1, 1), b3 + hstep, voffB); PG8_STAGE(PG8_SA(1, 0), a3, voffA);
            PG8_WAIT_V(8); PG8_WAIT_L(0); PG8_BAR; PG8_MMA(1, 0, At, B0); PG8_MMA(1, 1, At, B1); PG8_BAR; PG8_SCHED;
            } else {
            PG8_LDB(B0, 0, 0); PG8_SCHED; PG8_LDA(At, 0, 0); PG8_STAGE(PG8_SA(1, 1), a1 + hstep, voffA);
            PG8_WAIT_L(8); PG8_BAR; PG8_WAIT_L(0); PG8_MMA(0, 0, At, B0); PG8_BAR; PG8_SCHED;
            PG8_LDB(B1, 0, 1); PG8_STAGE(PG8_SB(0, 0), b2, voffB);
            PG8_BAR; PG8_WAIT_L(0); PG8_MMA(0, 1, At, B1); PG8_BAR;
            PG8_LDA(At, 0, 1); PG8_STAGE(PG8_SA(0, 0), a2, voffA);
            PG8_BAR; PG8_WAIT_L(0); PG8_MMA(1, 0, At, B0); PG8_BAR; PG8_SCHED;
            PG8_STAGE(PG8_SB(0, 1), b2 + hstep, voffB);
            PG8_WAIT_V(6); PG8_BAR; PG8_MMA(1, 1, At, B1); PG8_BAR;
            PG8_LDB(B0, 1, 0); PG8_SCHED; PG8_LDA(At, 1, 0); PG8_STAGE(PG8_SA(0, 1), a2 + hstep, voffA);
            PG8_WAIT_L(8); PG8_BAR; PG8_WAIT_L(0); PG8_MMA(0, 0, At, B0); PG8_BAR; PG8_SCHED;
            PG8_LDB(B1, 1, 1); PG8_STAGE(PG8_SB(1, 0), b3, voffB);
            PG8_BAR; PG8_WAIT_L(0); PG8_MMA(0, 1, At, B1); PG8_BAR;
            PG8_LDA(At, 1, 1); PG8_STAGE(PG8_SA(1, 0), a3, voffA);
            PG8_BAR; PG8_WAIT_L(0); PG8_MMA(1, 0, At, B0); PG8_BAR; PG8_SCHED;
            PG8_STAGE(PG8_SB(1, 1), b3 + hstep, voffB);
            PG8_WAIT_V(6); PG8_BAR; PG8_MMA(1, 1, At, B1); PG8_BAR;
            }
        }
        if constexpr (ALIGN_EPI) { if (wr == 0) PG8_BAR; }
        if constexpr (!Epi::AFTER_DRAIN) { const int t2 = tid_opaque(), w2 = __builtin_amdgcn_readfirstlane(t2 >> 6), l2 = t2 & 63;
            E(acc, cur, w2 >> 2, w2 & 3, l2 & 15, l2 >> 4); S.done(cur); }
        if (!has_next) break;
#pragma unroll
        for (int a = 0; a < 2; ++a)
#pragma unroll
            for (int b = 0; b < 2; ++b)
#pragma unroll
                for (int m = 0; m < 4; ++m)
#pragma unroll
                    for (int n = 0; n < 2; ++n) acc[a][b][m][n] = (f32x4){0.f, 0.f, 0.f, 0.f};
        cur = nxt; cA = nA; cB = nB; ++ui;
        if constexpr (ALIGN_EPI) { if (wr == 1) PG8_BAR; }
    }
    PG8_WAIT_V(0);
    if constexpr (!ALIGN_EPI) { if (wr == 0) PG8_BAR; }
    PG8_BAR;
    if constexpr (Epi::AFTER_DRAIN) { E.fused(acc, cur, wr, wc, fr, fq, lds, wid, lane); S.done(cur); }
#undef PG8_SA
#undef PG8_SB
#undef PG8_STAGE
#undef PG8_LDA
#undef PG8_LDB
#undef PG8_MMA
#undef PG8_WAIT_V
#undef PG8_WAIT_L
#undef PG8_BAR
#undef PG8_SCHED
}
}
#ifndef PG8_SP2
#define PG8_SP2 true
#endif
#include <hip/hip_bf16.h>
#include <cmath>
namespace attn_body {
using bf16=__hip_bfloat16;
using bf16x8=__attribute__((ext_vector_type(8)))short;
using s16x4=__attribute__((ext_vector_type(4)))short;
using f32x16=__attribute__((ext_vector_type(16)))float;
using u32x4=__attribute__((ext_vector_type(4)))unsigned;
constexpr int D=64,PQ=2560,PO=1024;
constexpr int NW=8,QBLK=32,QB=QBLK*NW,KVBLK=64;
constexpr int ATTN_UNIT_ROWS=QB;
__device__ __forceinline__ int crow(int r,int hi){return (r&3)+8*(r>>2)+4*hi;}
#define SBAR() __builtin_amdgcn_sched_barrier(0)
__device__ __forceinline__ void cmask(f32x16&p0,f32x16&p1,int jb,int qrel,int hi){
  const float NEG=-INFINITY; int kb=64*jb+4*hi;
  #pragma unroll
  for(int r=0;r<16;++r){int kv=kb+(r&3)+8*(r>>2); if(kv>qrel)p0[r]=NEG; if(kv+32>qrel)p1[r]=NEG;}
}

constexpr int NSLOT=3, SLOTB=8192;
constexpr int LDS_K=0, LDS_V=NSLOT*SLOTB, LDS_WS=2*NSLOT*SLOTB, LDS_OST=LDS_WS+NW*64*4, LDS_BYTES=LDS_OST+NW*4096;
constexpr float C2=0.125f*1.4426950408889634f;
__device__ __forceinline__ void glds16(const void*gsrc,unsigned lds_dst){unsigned keep;
  asm volatile("s_mov_b32 %0, m0\n\ts_mov_b32 m0, %2\n\ts_nop 0\n\tglobal_load_lds_dwordx4 %1, off\n\ts_mov_b32 m0, %0":"=&s"(keep):"v"(gsrc),"s"(lds_dst):"memory");}
__device__ __forceinline__ float max3f(float a,float b,float c){float r;asm("v_max3_f32 %0, %1, %2, %3":"=v"(r):"v"(a),"v"(b),"v"(c));return r;}
__device__ __forceinline__ float max2f(float a,float b){float r;asm("v_max_f32_e32 %0, %1, %2":"=v"(r):"v"(a),"v"(b));return r;}
__device__ __forceinline__ float fadd_s(float a,float b){float r;asm("v_add_f32_e32 %0, %1, %2":"=v"(r):"v"(a),"v"(b));return r;}
__device__ __forceinline__ float fsub_s(float a,float b){float r;asm("v_sub_f32_e32 %0, %1, %2":"=v"(r):"v"(a),"v"(b));return r;}
typedef float f32x2_t __attribute__((ext_vector_type(2))); typedef __bf16 bf16x2_t __attribute__((ext_vector_type(2)));
__device__ __forceinline__ unsigned cvtpk_s(float lo,float hi){f32x2_t v={lo,hi};bf16x2_t b=__builtin_convertvector(v,bf16x2_t);return __builtin_bit_cast(unsigned,b);}
#define WAIT_BAR(N) asm volatile("s_waitcnt vmcnt(" #N ") lgkmcnt(0)\n\ts_barrier":::"memory")

__device__ __forceinline__ void qkt(f32x16&p0,f32x16&p1,const char*Kslot,const bf16x8*qr,const f32x16&negm,int r32,int hi){
  const char*kb=Kslot+hi*1024+r32*16;
  #pragma unroll
  for(int d0=0;d0<4;++d0){
    const bf16x8 b0=*reinterpret_cast<const bf16x8*>(kb+d0*2048);
    const bf16x8 b1=*reinterpret_cast<const bf16x8*>(kb+d0*2048+512);
    if(d0==0){p0=__builtin_amdgcn_mfma_f32_32x32x16_bf16(b0,qr[0],negm,0,0,0);p1=__builtin_amdgcn_mfma_f32_32x32x16_bf16(b1,qr[0],negm,0,0,0);}
    else{p0=__builtin_amdgcn_mfma_f32_32x32x16_bf16(b0,qr[d0],p0,0,0,0);p1=__builtin_amdgcn_mfma_f32_32x32x16_bf16(b1,qr[d0],p1,0,0,0);}}
}
typedef __attribute__((address_space(3))) const char* lds_cptr;
typedef short v4i16_t __attribute__((ext_vector_type(4)));
__device__ __forceinline__ void kload8(bf16x8*kf,lds_cptr kp){
  kf[0]=*(const __attribute__((address_space(3))) bf16x8*)(kp);      kf[1]=*(const __attribute__((address_space(3))) bf16x8*)(kp+512);
  kf[2]=*(const __attribute__((address_space(3))) bf16x8*)(kp+2048); kf[3]=*(const __attribute__((address_space(3))) bf16x8*)(kp+2560);
  kf[4]=*(const __attribute__((address_space(3))) bf16x8*)(kp+4096); kf[5]=*(const __attribute__((address_space(3))) bf16x8*)(kp+4608);
  kf[6]=*(const __attribute__((address_space(3))) bf16x8*)(kp+6144); kf[7]=*(const __attribute__((address_space(3))) bf16x8*)(kp+6656);
}
__device__ __forceinline__ void kload2(bf16x8*kf,lds_cptr kp,int j){ kf[2*j]=*(const __attribute__((address_space(3))) bf16x8*)(kp+j*2048); kf[2*j+1]=*(const __attribute__((address_space(3))) bf16x8*)(kp+j*2048+512); }
__device__ __forceinline__ s16x4 vtr(lds_cptr p){ return __builtin_bit_cast(s16x4,__builtin_amdgcn_ds_read_tr16_b64_v4i16((__attribute__((address_space(3))) v4i16_t*)p)); }
__device__ __forceinline__ float rowmax(const f32x16&p0,const f32x16&p1){
  float a=max3f(p0[0],p0[1],p1[0]),b=max3f(p0[2],p0[3],p1[1]);a=max3f(a,p1[2],p1[3]);
  #pragma unroll
  for(int r=4;r<16;r+=4){a=max3f(a,p0[r],p0[r+1]);b=max3f(b,p0[r+2],p0[r+3]);a=max3f(a,p1[r],p1[r+1]);b=max3f(b,p1[r+2],p1[r+3]);}
  const float m=max2f(a,b);
  auto rr=__builtin_amdgcn_permlane32_swap(__float_as_uint(m),__float_as_uint(m),false,false);
  return max2f(__uint_as_float(rr[0]),__uint_as_float(rr[1]));
}
__device__ __forceinline__ void pv(f32x16*o,int vb,bf16x8 pa0,bf16x8 pa1,bf16x8 pa2,bf16x8 pa3){
  #pragma unroll
  for(int d0=0;d0<2;++d0){s16x4 lo[4],hi[4];
    #pragma unroll
    for(int ks=0;ks<4;++ks){
      asm volatile("ds_read_b64_tr_b16 %0,%1 offset:%c2":"=&v"(lo[ks]):"v"(vb),"i"(d0*4096+ks*1024):"memory");
      asm volatile("ds_read_b64_tr_b16 %0,%1 offset:%c2":"=&v"(hi[ks]):"v"(vb),"i"(d0*4096+ks*1024+512):"memory");}
    asm volatile("s_waitcnt lgkmcnt(0)":::"memory");SBAR();
    #define PK(k) (bf16x8){lo[k][0],lo[k][1],lo[k][2],lo[k][3],hi[k][0],hi[k][1],hi[k][2],hi[k][3]}
    o[d0]=__builtin_amdgcn_mfma_f32_32x32x16_bf16(pa0,PK(0),o[d0],0,0,0);
    o[d0]=__builtin_amdgcn_mfma_f32_32x32x16_bf16(pa1,PK(1),o[d0],0,0,0);
    o[d0]=__builtin_amdgcn_mfma_f32_32x32x16_bf16(pa2,PK(2),o[d0],0,0,0);
    o[d0]=__builtin_amdgcn_mfma_f32_32x32x16_bf16(pa3,PK(3),o[d0],0,0,0);
    #undef PK
  }
}

#ifndef ATTN_STORE16
#define ATTN_STORE16(p,v) (*(u32x4*)(p)=(v))
#endif
template<int THRL> __device__ __forceinline__ void attn_unit(int qb,const bf16*Qh,const bf16*__restrict__ Kh,const bf16*__restrict__ Vh,bf16*Oh,char*shm){
  const int tid=tid_opaque(),lane=tid&63,r32=lane&31,hi=lane>>5; const int wid=__builtin_amdgcn_readfirstlane(tid>>6);
  const int q0=qb*QB;
  const bf16*Qw=Qh+(long)(q0+wid*QBLK)*PQ;
  const unsigned lds0=(unsigned)(uintptr_t)shm;
  float*wsf=(float*)(shm+LDS_WS)+wid*64;
  const bf16*ksrc=Kh+(long)lane*PQ+wid*8;
  const bf16*vsrc=Vh+(long)(16*(wid&3)+(lane>>2))*PQ+(wid>>2)*32+(lane&3)*8;
  const unsigned kdst=lds0+LDS_K+wid*1024, vdst=lds0+LDS_V+wid*1024;
  #define DMA_K(t,slot) glds16(ksrc+(long)(t)*KVBLK*PQ,(unsigned)__builtin_amdgcn_readfirstlane(kdst+(slot)))
  #define DMA_V(t,slot) glds16(vsrc+(long)(t)*KVBLK*PQ,(unsigned)__builtin_amdgcn_readfirstlane(vdst+(slot)))
  const int vb0=(int)(lds0+LDS_V)+((lane>>4)&1)*32+(lane&3)*8+(4*hi+((lane&15)>>2))*64;
  const char*Kbase=shm+LDS_K; bf16x8 kf[8];
  const lds_cptr shm3=(lds_cptr)shm; const lds_cptr kp0=shm3+LDS_K+hi*1024+r32*16; const lds_cptr vp0=shm3+LDS_V+((lane>>4)&1)*32+(lane&3)*8+(4*hi+((lane&15)>>2))*64;
  const int NT=(q0+QB)/KVBLK;
  DMA_K(0,0);DMA_V(0,0);DMA_K(1,SLOTB);
  bf16x8 qr[4];
  #pragma unroll
  for(int d0=0;d0<4;++d0)qr[d0]=*reinterpret_cast<const bf16x8*>(&Qw[(long)r32*PQ+d0*16+hi*8]);
  float mhat=0.f,l_reg=0.f;f32x16 o[2];o[0]=f32x16{};o[1]=f32x16{};f32x16 negm=f32x16{};asm volatile("":"+v"(negm));
  const int qrel=wid*QBLK+r32;
  #define CMASK(P0,P1,t) do{int jb_=(t)-(NT-4); if(jb_>=0)cmask(P0,P1,jb_,qrel,hi);}while(0)
  bool resc=false;
  #define START(P0,P1) do{ const float rm=rowmax(P0,P1); resc=false; \
    { const float dl=rm; mhat=fadd_s(mhat,dl); \
      _Pragma("unroll") for(int r=0;r<16;++r){P0[r]=fsub_s(P0[r],dl);P1[r]=fsub_s(P1[r],dl);} \
      _Pragma("unroll") for(int r=0;r<16;++r)negm[r]=-mhat; asm volatile("":"+v"(negm)); } \
    _Pragma("unroll") for(int r=0;r<16;++r)P0[r]=__builtin_amdgcn_exp2f(P0[r]); }while(0)
  #define RESC() do{ if(resc){ asm volatile("s_waitcnt lgkmcnt(0)":::"memory"); \
      _Pragma("unroll") for(int d_=0;d_<2;++d_) _Pragma("unroll") for(int r=0;r<16;++r)o[d_][r]*=wsf[crow(r,hi)]; } }while(0)
  f32x16 pA0,pA1,pB0,pB1;
  int sl_prev=0,sl_cur=0,sl_next=SLOTB;
  #define ROT() do{sl_prev=sl_cur;sl_cur=sl_next;sl_next=(sl_next==(NSLOT-1)*SLOTB)?0:sl_next+SLOTB;}while(0)
  DMA_K(2,2*SLOTB);
  WAIT_BAR(3);
  qkt(pA0,pA1,Kbase,qr,negm,r32,hi);asm volatile("s_nop 15\n\ts_nop 7":"+v"(pA0),"+v"(pA1));CMASK(pA0,pA1,0);
  START(pA0,pA1);
  _Pragma("unroll") for(int r=0;r<16;++r)pA1[r]=__builtin_amdgcn_exp2f(pA1[r]);
  WAIT_BAR(0);
  DMA_K(3,0);DMA_V(1,SLOTB);
  ROT();
  kload8(kf,kp0+sl_cur);
  WAIT_BAR(2);
  s16x4 vlo[8],vhi[8]; u32x4 pw0,pw1,pw2,pw3;
  #define PKW(P,B) cvtpk_s(P[B],P[B+1])
  #define PAF(k) __builtin_bit_cast(bf16x8,pw##k)
  #define VFR(i) (bf16x8){vlo[i][0],vlo[i][1],vlo[i][2],vlo[i][3],vhi[i][0],vhi[i][1],vhi[i][2],vhi[i][3]}
  #define PIN(x) asm volatile("":"+v"(x))
  #define MX3(a,b,c) __builtin_fmaxf(__builtin_fmaxf((a),(b)),(c))
  #define GAPA(MF,A0,A1,A2,A3,W0,W1,PW) do{ MF; sacc+=A0; sacc+=A1; sacc+=A2; sacc+=A3; PIN(sacc); W0; W1; PIN(PW); SBAR(); }while(0)
  #define EX(v) __builtin_amdgcn_exp2f(v)
  #define GAPB(MF,X,B) do{ MF; X[B]=EX(X[B]); X[B+1]=EX(X[B+1]); X[B+2]=EX(X[B+2]); X[B+3]=EX(X[B+3]); PIN(X); SBAR(); }while(0)
  #define VRD(i) do{ vlo[i]=vtr(vp_+(((i)>>2)*4096+((i)&3)*1024)); vhi[i]=vtr(vp_+(((i)>>2)*4096+((i)&3)*1024+512)); }while(0)
  #define KRD(G,j) do{ if(G){ kload2(kf,kp0+sl_next,j); SBAR(); } }while(0)
  #define STEP(C0,C1,P0,P1,t,GK,GV,GL) do{ SBAR(); \
    const lds_cptr vp_=vp0+sl_prev; \
    VRD(0); SBAR(); float sacc=(P0[0]+P0[1]); \
    GAPA(C0=__builtin_amdgcn_mfma_f32_32x32x16_bf16(kf[0],qr[0],negm,0,0,0), P0[2],P0[3],P0[4],P0[5],     pw0[0]=PKW(P0,0), pw0[1]=PKW(P0,2), pw0); \
    VRD(4); SBAR(); GAPA(C1=__builtin_amdgcn_mfma_f32_32x32x16_bf16(kf[1],qr[0],negm,0,0,0), P0[6],P0[7],P0[8],P0[9],     pw0[2]=PKW(P0,4), pw0[3]=PKW(P0,6), pw0); \
    VRD(1); SBAR(); GAPA(C0=__builtin_amdgcn_mfma_f32_32x32x16_bf16(kf[2],qr[1],C0,0,0,0),   P0[10],P0[11],P0[12],P0[13], pw1[0]=PKW(P0,8), pw1[1]=PKW(P0,10), pw1); \
    VRD(5); SBAR(); GAPA(C1=__builtin_amdgcn_mfma_f32_32x32x16_bf16(kf[3],qr[1],C1,0,0,0),   P0[14],P0[15],P1[0],P1[1],   pw1[2]=PKW(P0,12),pw1[3]=PKW(P0,14), pw1); \
    VRD(2); SBAR(); GAPA(C0=__builtin_amdgcn_mfma_f32_32x32x16_bf16(kf[4],qr[2],C0,0,0,0),   P1[2],P1[3],P1[4],P1[5],     pw2[0]=PKW(P1,0), pw2[1]=PKW(P1,2), pw2); \
    VRD(6); SBAR(); GAPA(C1=__builtin_amdgcn_mfma_f32_32x32x16_bf16(kf[5],qr[2],C1,0,0,0),   P1[6],P1[7],P1[8],P1[9],     pw2[2]=PKW(P1,4), pw2[3]=PKW(P1,6), pw2); \
    VRD(3); SBAR(); GAPA(C0=__builtin_amdgcn_mfma_f32_32x32x16_bf16(kf[6],qr[3],C0,0,0,0),   P1[10],P1[11],P1[12],P1[13], pw3[0]=PKW(P1,8), pw3[1]=PKW(P1,10), pw3); \
    VRD(7); SBAR(); GAPA(C1=__builtin_amdgcn_mfma_f32_32x32x16_bf16(kf[7],qr[3],C1,0,0,0),   P1[14],P1[15],0.f,0.f,       pw3[2]=PKW(P1,12),pw3[3]=PKW(P1,14), pw3); \
    l_reg+=sacc; \
    if(GK){DMA_K((t)+3,sl_cur);} if(GV){DMA_V((t)+1,sl_next);} \
    CMASK(C0,C1,t); \
    { float a=MX3(C0[0],C0[1],C1[0]),b=MX3(C0[2],C0[3],C1[1]); a=MX3(a,C1[2],C1[3]); \
      _Pragma("unroll") for(int r=4;r<16;r+=4){a=MX3(a,C0[r],C0[r+1]);b=MX3(b,C0[r+2],C0[r+3]);a=MX3(a,C1[r],C1[r+1]);b=MX3(b,C1[r+2],C1[r+3]);} \
      float rm=__builtin_fmaxf(a,b); { auto rr=__builtin_amdgcn_permlane32_swap(__float_as_uint(rm),__float_as_uint(rm),false,false); rm=__builtin_fmaxf(__uint_as_float(rr[0]),__uint_as_float(rr[1])); } \
      resc=false; \
      if(__builtin_expect(__any(rm>(float)THRL),0)){ const float dl=__builtin_fmaxf(rm,0.f); mhat+=dl; \
        _Pragma("unroll") for(int r=0;r<16;++r){C0[r]-=dl;C1[r]-=dl;} \
        _Pragma("unroll") for(int r=0;r<16;++r)negm[r]=-mhat; asm volatile("":"+v"(negm)); \
        const float f=__builtin_amdgcn_exp2f(-dl); l_reg*=f; if(hi==0)wsf[r32]=f; resc=true; } } \
    SBAR(); \
    GAPB(o[0]=__builtin_amdgcn_mfma_f32_32x32x16_bf16(PAF(0),VFR(0),o[0],0,0,0), C0,0); \
    GAPB(o[1]=__builtin_amdgcn_mfma_f32_32x32x16_bf16(PAF(0),VFR(4),o[1],0,0,0), C0,4); \
    KRD(GL,0); GAPB(o[0]=__builtin_amdgcn_mfma_f32_32x32x16_bf16(PAF(1),VFR(1),o[0],0,0,0), C0,8); \
    KRD(GL,1); GAPB(o[1]=__builtin_amdgcn_mfma_f32_32x32x16_bf16(PAF(1),VFR(5),o[1],0,0,0), C0,12); \
    KRD(GL,2); GAPB(o[0]=__builtin_amdgcn_mfma_f32_32x32x16_bf16(PAF(2),VFR(2),o[0],0,0,0), C1,0); \
    KRD(GL,3); GAPB(o[1]=__builtin_amdgcn_mfma_f32_32x32x16_bf16(PAF(2),VFR(6),o[1],0,0,0), C1,4); \
    GAPB(o[0]=__builtin_amdgcn_mfma_f32_32x32x16_bf16(PAF(3),VFR(3),o[0],0,0,0), C1,8); \
    GAPB(o[1]=__builtin_amdgcn_mfma_f32_32x32x16_bf16(PAF(3),VFR(7),o[1],0,0,0), C1,12); \
    }while(0)
  int t=1;
  #undef CMASK
  #define CMASK(P0,P1,t) do{}while(0)
  for(;t+5<NT;t+=2){
    STEP(pB0,pB1,pA0,pA1,t,true,true,true);     WAIT_BAR(2); RESC(); ROT();
    STEP(pA0,pA1,pB0,pB1,t+1,true,true,true);   WAIT_BAR(2); RESC(); ROT();
  }
  #undef CMASK
  #define CMASK(P0,P1,t) do{int jb_=(t)-(NT-4); if(jb_>=0)cmask(P0,P1,jb_,qrel,hi);}while(0)
  #define ENDW(tt) do{ if((tt)+3<NT){WAIT_BAR(2);} else if((tt)+2<NT){WAIT_BAR(1);} else {WAIT_BAR(0);} }while(0)
  for(;t+1<NT;t+=2){
    STEP(pB0,pB1,pA0,pA1,t,(t+3<NT),(t+1<NT),(t+1<NT));       ENDW(t);   RESC(); ROT();
    STEP(pA0,pA1,pB0,pB1,t+1,(t+4<NT),(t+2<NT),(t+2<NT));     ENDW(t+1); RESC(); ROT();
  }
  STEP(pB0,pB1,pA0,pA1,NT-1,false,false,false); RESC();
  { float sacc=pB0[0]+pB0[1]; _Pragma("unroll") for(int r=2;r<16;++r)sacc+=pB0[r]; _Pragma("unroll") for(int r=0;r<16;++r)sacc+=pB1[r]; l_reg+=sacc;
    pw0=(u32x4){PKW(pB0,0),PKW(pB0,2),PKW(pB0,4),PKW(pB0,6)};pw1=(u32x4){PKW(pB0,8),PKW(pB0,10),PKW(pB0,12),PKW(pB0,14)};pw2=(u32x4){PKW(pB1,0),PKW(pB1,2),PKW(pB1,4),PKW(pB1,6)};pw3=(u32x4){PKW(pB1,8),PKW(pB1,10),PKW(pB1,12),PKW(pB1,14)};
    SBAR(); pv(o,vb0+sl_cur,PAF(0),PAF(1),PAF(2),PAF(3)); }
  #undef PKW
  #undef PAF
  #undef VFR
  #undef PIN
  #undef MX3
  #undef GAPA
  #undef GAPB
  #undef EX
  #undef VRD
  #undef KRD
  #undef STEP
  #undef ENDW
  {auto rr=__builtin_amdgcn_permlane32_swap(__float_as_uint(l_reg),__float_as_uint(l_reg),false,false);l_reg=__uint_as_float(rr[0])+__uint_as_float(rr[1]);}
  if(hi==0)wsf[32+r32]=l_reg;asm volatile("s_waitcnt lgkmcnt(0)":::"memory");
  float rli[16];
  #pragma unroll
  for(int r=0;r<16;++r)rli[r]=__builtin_amdgcn_rcpf(wsf[32+crow(r,hi)]);
  bf16*Ow=Oh+(long)(q0+wid*QBLK)*PO;
  { bf16*stg=(bf16*)(shm+LDS_OST)+wid*2048;
    #pragma unroll
    for(int r=0;r<16;++r){const int orow=crow(r,hi);
      #pragma unroll
      for(int d0=0;d0<2;++d0)stg[orow*64+d0*32+r32]=__float2bfloat16(o[d0][r]*rli[r]);}
    asm volatile("s_waitcnt lgkmcnt(0)":::"memory");
    #pragma unroll
    for(int i=0;i<4;++i){const int row=i*8+(lane>>3),ch=lane&7; const u32x4 v=*(const u32x4*)(stg+row*64+ch*8); ATTN_STORE16(Ow+(long)row*PO+ch*8,v);} }
  asm volatile("s_waitcnt lgkmcnt(0)\n\ts_barrier":::"memory");
  #undef DMA_K
  #undef DMA_V
  #undef CMASK
  #undef START
  #undef RESC
  #undef ROT
}
constexpr int ATTN_LDS_BYTES=LDS_BYTES;
#undef SBAR
#undef WAIT_BAR
}
#include <hip/hip_cooperative_groups.h>
namespace cg = cooperative_groups;
constexpr int NWAVES = 8;
constexpr int BATCH = 16, SEQ = 2048, D = 1024, DEPTH = 4, FF = 4096, PLE = 256, INW = 2560, AW = 512, RW = 512;
constexpr int M = BATCH * SEQ;
constexpr size_t MiB = 1u << 20;
constexpr size_t WS_CS = 1 * MiB;
constexpr size_t WS_SSQ0 = 3 * MiB, WS_SSQ1 = 5 * MiB;
constexpr size_t WS_W = 8 * MiB, W_LAYER = 25 * MiB + 512 * 1024;
constexpr size_t WO_IN = 0, WO_OUT = 5 * MiB, WO_W1 = 7 * MiB, WO_W2 = 15 * MiB, WO_PG = 23 * MiB, WO_PP = 25 * MiB;
constexpr size_t WS_P16 = 110 * MiB;
constexpr size_t WS_XB0 = 126 * MiB;
constexpr size_t WS_R = 190 * MiB;
constexpr size_t WS_PROJ = WS_R;
constexpr size_t WS_OV = WS_R + 160 * MiB;
constexpr size_t WS_AO = WS_R + 224 * MiB;
constexpr size_t WS_HB = WS_R;
constexpr size_t WS_PP = WS_R;
constexpr size_t WS_END = WS_R + 288 * MiB;
static_assert(WS_W + DEPTH * W_LAYER <= WS_P16 && WS_P16 + (size_t)M * PLE * 2 <= WS_XB0 && WS_XB0 + (size_t)M * D * 2 <= WS_R && WS_HB + (size_t)M * FF * 2 <= WS_END, "d_ws map");
constexpr int RING_BYTES = 131072;
constexpr int LDS_BYTES = 147456;

#define GAS __attribute__((address_space(1)))
#define LAS __attribute__((address_space(3)))
typedef unsigned short bf16;
typedef unsigned v4u __attribute__((ext_vector_type(4)));
typedef float f32x4 __attribute__((ext_vector_type(4)));
typedef short bf16x8 __attribute__((ext_vector_type(8)));
#define LDS_WAIT() asm volatile("s_waitcnt lgkmcnt(0)" ::: "memory")
#define VM_WAIT() asm volatile("s_waitcnt vmcnt(0)" ::: "memory")
__device__ __forceinline__ unsigned f2bf(float f) { unsigned u = __builtin_bit_cast(unsigned, f); return (u + 0x7fffu + ((u >> 16) & 1u)) >> 16; }
__device__ __forceinline__ unsigned pk2(float lo, float hi) { return f2bf(lo) | (f2bf(hi) << 16); }
__device__ __forceinline__ float bf2f(unsigned short v) { return __uint_as_float((unsigned)v << 16); }
__device__ __forceinline__ float sigmoid_f(float x) { return __builtin_amdgcn_rcpf(1.f + __builtin_amdgcn_exp2f(-1.4426950408889634f * x)); }

struct Frame {
    LAS unsigned char* lds;
    LAS const unsigned long long* tab;
};
struct Who { int tid, lane, wave, vcu, G; };
__device__ __forceinline__ Who who() { Who w; w.tid = tid_opaque(); w.lane = w.tid & 63; w.wave = __builtin_amdgcn_readfirstlane(w.tid >> 6);
    int bx = blockIdx.x, G = gridDim.x; asm volatile("" : "+s"(bx), "+s"(G)); w.G = G; w.vcu = (G % 8 == 0) ? (bx % 8) * (G / 8) + bx / 8 : bx; return w; }
__device__ __forceinline__ int opaque_s(int v) { asm volatile("" : "+s"(v)); return v; }
__device__ __forceinline__ const void* ptab(LAS const unsigned long long* tab, int k) {
    const unsigned long long v = tab[k]; const unsigned lo = __builtin_amdgcn_readfirstlane((unsigned)v), hi = __builtin_amdgcn_readfirstlane((unsigned)(v >> 32));
    return (const void*)(((unsigned long long)hi << 32) | lo);
}
#define FIN(k) ((const float*)ptab(F.tab, (k)))
#define FOUT() ((float*)ptab(F.tab, 23))
#define FWS(off) ((unsigned char*)ptab(F.tab, 24) + (off))
enum { I_X = 0, I_P, I_POS, I_WIN, I_WOUT, I_GMIX, I_GSUBLN, I_LAMQ, I_LAMK, I_CONVW, I_CONVB, I_WGA, I_BGA, I_WGX, I_BGX, I_LRULAM, I_GMLP, I_WMLPIN, I_WMLPOUT, I_GPLE, I_WPLEGATE, I_WPLEPROJ, I_GFINAL };

__device__ __forceinline__ float wave_sum(float v) {
#pragma unroll
    for (int o = 1; o < 64; o <<= 1) v += __shfl_xor(v, o);
    return v;
}
__device__ __forceinline__ void p0_transpose_item(const float* W, const float* gain, int K, int N, bf16* WT, LAS float* scr, int item, int lane) {
    const int nblk = N / 32, kb = item / nblk, nb = item % nblk, k0 = 64 * kb, n0 = 32 * nb;
#pragma unroll 8
    for (int i = 0; i < 32; ++i) { const int kk = 2 * i + (lane >> 5); const float gk = gain ? gain[k0 + kk] : 1.f; scr[kk * 33 + (lane & 31)] = W[(size_t)(k0 + kk) * N + n0 + (lane & 31)] * gk; }
    LDS_WAIT(); asm volatile("" ::: "memory");
    const int c = lane & 7;
#pragma unroll
    for (int j = 0; j < 4; ++j) { const int n = (lane >> 3) + 8 * j; const LAS float* s = scr + (8 * c) * 33 + n;
        v4u o; o.x = pk2(s[0 * 33], s[1 * 33]); o.y = pk2(s[2 * 33], s[3 * 33]); o.z = pk2(s[4 * 33], s[5 * 33]); o.w = pk2(s[6 * 33], s[7 * 33]);
        *(GAS v4u*)(WT + (size_t)(n0 + n) * K + k0 + 8 * c) = o; }
    LDS_WAIT(); asm volatile("" ::: "memory");
}
__device__ __forceinline__ void p0_prologue(Frame& F) {
    const Who W = who();
    LAS float* scr = (LAS float*)(F.lds + W.wave * 16384);
    const int gw = W.vcu * NWAVES + W.wave, NGW = W.G * NWAVES;
    unsigned char* ws = FWS(0);
    const float *w_in = FIN(I_WIN), *w_out = FIN(I_WOUT), *w_mlp_in = FIN(I_WMLPIN), *w_mlp_out = FIN(I_WMLPOUT), *w_ple_gate = FIN(I_WPLEGATE), *w_ple_proj = FIN(I_WPLEPROJ), *g_mix = FIN(I_GMIX), *g_mlp = FIN(I_GMLP), *g_ple = FIN(I_GPLE);
    constexpr int I_IN = (D / 64) * (INW / 32), I_OUT = (D / 64) * (D / 32), I_1 = (D / 64) * (FF / 32), I_2 = (FF / 64) * (D / 32), I_PG = I_OUT, I_PP = (PLE / 64) * (D / 32);
    constexpr int PER_L = I_IN + I_OUT + I_1 + I_2 + I_PG + I_PP;
    for (int it = gw; it < DEPTH * PER_L; it += NGW) {
        const int l = it / PER_L; int r = it % PER_L; bf16* wl = (bf16*)(ws + WS_W + (size_t)l * W_LAYER);
        if (r < I_IN) { p0_transpose_item(w_in + (size_t)l * D * INW, g_mix + l * D, D, INW, (bf16*)((unsigned char*)wl + WO_IN), scr, r, W.lane); continue; } r -= I_IN;
        if (r < I_OUT) { p0_transpose_item(w_out + (size_t)l * D * D, nullptr, D, D, (bf16*)((unsigned char*)wl + WO_OUT), scr, r, W.lane); continue; } r -= I_OUT;
        if (r < I_1) { p0_transpose_item(w_mlp_in + (size_t)l * D * FF, g_mlp + l * D, D, FF, (bf16*)((unsigned char*)wl + WO_W1), scr, r, W.lane); continue; } r -= I_1;
        if (r < I_2) { p0_transpose_item(w_mlp_out + (size_t)l * FF * D, nullptr, FF, D, (bf16*)((unsigned char*)wl + WO_W2), scr, r, W.lane); continue; } r -= I_2;
        if (r < I_PG) { p0_transpose_item(w_ple_gate + (size_t)l * D * D, g_ple + l * D, D, D, (bf16*)((unsigned char*)wl + WO_PG), scr, r, W.lane); continue; } r -= I_PG;
        p0_transpose_item(w_ple_proj + (size_t)l * PLE * D, nullptr, PLE, D, (bf16*)((unsigned char*)wl + WO_PP), scr, r, W.lane);
    }
    const float* x_ = FIN(I_X); float* H_ = FOUT(); bf16* XB1_ = (bf16*)(ws + WS_OV); float* SSQ1_ = (float*)(ws + WS_SSQ1); float* CS_ = (float*)(ws + WS_CS); const int* pos_ = (const int*)FIN(I_POS);
    for (int m = gw; m < M; m += NGW) {
        const GAS f32x4* xr = (const GAS f32x4*)(x_ + (size_t)m * D) + W.lane; GAS f32x4* hr = (GAS f32x4*)(H_ + (size_t)m * D) + W.lane;
        GAS unsigned long long* o8 = (GAS unsigned long long*)(XB1_ + (size_t)m * D) + W.lane; float s = 0.f;
#pragma unroll
        for (int j = 0; j < 4; ++j) { const f32x4 v = xr[64 * j]; hr[64 * j] = v; s += (v.x * v.x + v.y * v.y) + (v.z * v.z + v.w * v.w);
            o8[64 * j] = (unsigned long long)pk2(v.x, v.y) | ((unsigned long long)pk2(v.z, v.w) << 32); }
        s = wave_sum(s);
        if (W.lane < 16) SSQ1_[(size_t)m * 16 + W.lane] = (W.lane == 0) ? s : 0.f;
    }
    for (int e = (W.vcu * NWAVES * 64 + W.tid); e < M * 8; e += W.G * NWAVES * 64) {
        const int m = e >> 3, i = e & 7;
        const float invf = (i == 0) ? 1.0f : (i == 1) ? 0.1939227432012558f : (i == 2) ? 0.03760603070259094f : (i == 3) ? 0.007292664609849453f : (i == 4) ? 0.0014142135623842478f : (i == 5) ? 0.00027424818836152554f : (i == 6) ? 5.3182957344688475e-05f : 1.0313385246263351e-05f;
        const float ang = (float)pos_[m] * invf;
        const double rev = (double)ang * 0.15915494309189535; const double fr = rev - __builtin_rint(rev);
        const float frf = (float)fr;
        CS_[(size_t)m * 16 + i] = __builtin_amdgcn_cosf(frf); CS_[(size_t)m * 16 + 8 + i] = __builtin_amdgcn_sinf(frf);
    }
}
__device__ __forceinline__ void convert_p(Frame& F, int l) {
    const Who W = who();
    const float* src = FIN(I_P) + (size_t)l * M * PLE; bf16* P16_ = (bf16*)FWS(WS_P16);
    for (size_t e = (size_t)W.vcu * NWAVES * 64 + W.tid; e < (size_t)M * PLE / 8; e += (size_t)W.G * NWAVES * 64) {
        const f32x4 a = *(const GAS f32x4*)(src + e * 8), b = *(const GAS f32x4*)(src + e * 8 + 4);
        v4u o; o.x = pk2(a.x, a.y); o.y = pk2(a.z, a.w); o.z = pk2(b.x, b.y); o.w = pk2(b.z, b.w);
        *(GAS v4u*)(P16_ + e * 8) = o; }
}
__device__ __forceinline__ void final_norm(Frame& F) {
    const Who W = who();
    const int gw = W.vcu * NWAVES + W.wave, NGW = W.G * NWAVES;
    const float* SSQ1_ = (const float*)FWS(WS_SSQ1); float* H_ = FOUT(); const float* gf_ = FIN(I_GFINAL);
    for (int m = gw; m < M; m += NGW) {
        const float rs = pg8::row_rs(SSQ1_, m);
        GAS f32x4* hr = (GAS f32x4*)(H_ + (size_t)m * D) + W.lane; const GAS f32x4* gr = (const GAS f32x4*)gf_ + W.lane;
#pragma unroll
        for (int j = 0; j < 4; ++j) { const f32x4 v = hr[64 * j], g = gr[64 * j]; hr[64 * j] = v * rs * g; }
    }
}

__device__ __forceinline__ void lru_item(Frame& F, int l, int item) {
    const int b = item >> 4, g = (item >> 1) & 7, hf = item & 1;
    const int tid_ = tid_opaque(), lane = tid_ & 63, w = __builtin_amdgcn_readfirstlane(tid_ >> 6), r = lane & 15, q = lane >> 4;
    LAS float* xcs = (LAS float*)(F.lds + w * 4352);
    LAS float* car = (LAS float*)(F.lds + 36864);
    const bf16* pj = (const bf16*)FWS(WS_PROJ) + (size_t)b * SEQ * INW;
    bf16* ao = (bf16*)FWS(WS_AO) + (size_t)b * SEQ * D;
    const int cch = g * 64 + lane;
    const float* conv_w = FIN(I_CONVW);
    const float cw0 = conv_w[(l * 4 + 0) * RW + cch], cw1 = conv_w[(l * 4 + 1) * RW + cch], cw2 = conv_w[(l * 4 + 2) * RW + cch], cw3 = conv_w[(l * 4 + 3) * RW + cch], cb = FIN(I_CONVB)[l * RW + cch];
    bf16x8 Bf[2][2][2];
#pragma unroll
    for (int gate = 0; gate < 2; ++gate) { const float* W = (gate ? FIN(I_WGX) : FIN(I_WGA)) + (size_t)(l * 8 + g) * 64 * 64;
#pragma unroll
        for (int n = 0; n < 2; ++n)
#pragma unroll
            for (int kk = 0; kk < 2; ++kk) { const float* wp = W + (size_t)(32 * kk + 8 * q) * 64 + hf * 32 + 16 * n + r; v4u pw;
                pw.x = pk2(wp[0 * 64], wp[1 * 64]); pw.y = pk2(wp[2 * 64], wp[3 * 64]); pw.z = pk2(wp[4 * 64], wp[5 * 64]); pw.w = pk2(wp[6 * 64], wp[7 * 64]);
                Bf[gate][n][kk] = __builtin_bit_cast(bf16x8, pw); } }
    float ba[2], bx[2], sp8[2];
#pragma unroll
    for (int n = 0; n < 2; ++n) { const int ch = l * RW + g * 64 + hf * 32 + 16 * n + r; ba[n] = FIN(I_BGA)[ch]; bx[n] = FIN(I_BGX)[ch];
        const float z = -FIN(I_LRULAM)[ch]; sp8[n] = 8.f * (fmaxf(z, 0.f) + log1pf(__expf(-fabsf(z)))); }
    float hin[2] = {0.f, 0.f};
    const int t0 = w * 256;
    const bf16* xcol = pj + 3 * AW + cch;
    const bf16* gcol = pj + 3 * AW + RW + g * 64 + hf * 32 + r;
    bf16* ycol = ao + AW + g * 64 + hf * 32 + r;
#pragma unroll 1
    for (int pass = 0; pass < 2; ++pass) {
        float h3 = 0.f, h2 = 0.f, h1 = 0.f;
        if (t0 != 0) { h3 = bf2f(xcol[(size_t)(t0 - 3) * INW]); h2 = bf2f(xcol[(size_t)(t0 - 2) * INW]); h1 = bf2f(xcol[(size_t)(t0 - 1) * INW]); }
        float hrun[2] = {pass ? hin[0] : 0.f, pass ? hin[1] : 0.f}, Arun[2] = {1.f, 1.f};
        unsigned short xq[16];
#pragma unroll
        for (int tt = 0; tt < 16; ++tt) xq[tt] = xcol[(size_t)(t0 + tt) * INW];
#pragma unroll 1
        for (int sc = 0; sc < 16; ++sc) {
            const int ts = t0 + sc * 16, tn = (sc < 15) ? ts + 16 : ts;
            unsigned short xn[16];
#pragma unroll
            for (int tt = 0; tt < 16; ++tt) xn[tt] = xcol[(size_t)(tn + tt) * INW];
            unsigned short gq[2][4];
            if (pass) {
#pragma unroll
                for (int n = 0; n < 2; ++n)
#pragma unroll
                    for (int i = 0; i < 4; ++i) gq[n][i] = gcol[(size_t)(ts + 4 * q + i) * INW + 16 * n];
            } else {
#pragma unroll
                for (int n = 0; n < 2; ++n)
#pragma unroll
                    for (int i = 0; i < 4; ++i) gq[n][i] = 0;
            }
#pragma unroll
            for (int tt = 0; tt < 16; ++tt) { const float xv = bf2f(xq[tt]); const float xc = cb + cw0 * h3 + cw1 * h2 + cw2 * h1 + cw3 * xv; h3 = h2; h2 = h1; h1 = xv; xcs[tt * 68 + lane] = xc; }
            asm volatile("s_waitcnt lgkmcnt(0)" ::: "memory");
            bf16x8 Af[2];
#pragma unroll
            for (int kk = 0; kk < 2; ++kk) { const LAS f32x4* ap = (const LAS f32x4*)(xcs + r * 68 + 32 * kk + 8 * q); const f32x4 a0 = ap[0], a1 = ap[1];
                v4u pw; pw.x = pk2(a0.x, a0.y); pw.y = pk2(a0.z, a0.w); pw.z = pk2(a1.x, a1.y); pw.w = pk2(a1.z, a1.w); Af[kk] = __builtin_bit_cast(bf16x8, pw); }
            f32x4 Da[2], Dx[2];
#pragma unroll
            for (int n = 0; n < 2; ++n) { Da[n] = (f32x4){0.f, 0.f, 0.f, 0.f}; Dx[n] = Da[n];
#pragma unroll
                for (int kk = 0; kk < 2; ++kk) { Da[n] = __builtin_amdgcn_mfma_f32_16x16x32_bf16(Af[kk], Bf[0][n][kk], Da[n], 0, 0, 0); Dx[n] = __builtin_amdgcn_mfma_f32_16x16x32_bf16(Af[kk], Bf[1][n][kk], Dx[n], 0, 0, 0); } }
#pragma unroll
            for (int n = 0; n < 2; ++n) {
                float a[4], bb[4];
#pragma unroll
                for (int i = 0; i < 4; ++i) { const float xcv = xcs[(4 * q + i) * 68 + hf * 32 + 16 * n + r];
                    const float ra = sigmoid_f(Da[n][i] + ba[n]), ix = sigmoid_f(Dx[n][i] + bx[n]);
                    const float la = -ra * sp8[n]; const float av = __builtin_amdgcn_exp2f(1.4426950408889634f * la);
                    const float y2 = 2.f * la;
                    const float ser = -y2 * (1.f + y2 * (0.5f + y2 * (0.16666667f + y2 * (0.041666668f + y2 * 0.008333334f))));
                    const float em = (y2 > -0.25f) ? ser : (1.f - av * av);
                    a[i] = av; bb[i] = __builtin_amdgcn_sqrtf(fmaxf(em, 0.f)) * (ix * xcv); }
                const float Al = (a[0] * a[1]) * (a[2] * a[3]);
                const float Hl = ((bb[0] * a[1] + bb[1]) * a[2] + bb[2]) * a[3] + bb[3];
                const float A0 = __shfl(Al, r), A1 = __shfl(Al, r + 16), A2 = __shfl(Al, r + 32), A3 = __shfl(Al, r + 48);
                const float H0 = __shfl(Hl, r), H1 = __shfl(Hl, r + 16), H2 = __shfl(Hl, r + 32), H3 = __shfl(Hl, r + 48);
                const float c0 = hrun[n], c1 = A0 * c0 + H0, c2 = A1 * c1 + H1, c3 = A2 * c2 + H2, c4 = A3 * c3 + H3;
                hrun[n] = c4; Arun[n] *= (A0 * A1) * (A2 * A3);
                if (pass) { float h = (q == 0) ? c0 : (q == 1) ? c1 : (q == 2) ? c2 : c3;
#pragma unroll
                    for (int i = 0; i < 4; ++i) { h = a[i] * h + bb[i]; const float gv = bf2f(gq[n][i]);
                        const float ge = gv * sigmoid_f(1.5957691216057308f * (gv + 0.044715f * gv * gv * gv));
                        ycol[(size_t)(ts + 4 * q + i) * D + 16 * n] = (bf16)f2bf(h * ge); } }
            }
#pragma unroll
            for (int tt = 0; tt < 16; ++tt) xq[tt] = xn[tt];
        }
        if (pass == 0) {
            if (q == 0) {
#pragma unroll
                for (int n = 0; n < 2; ++n) { car[w * 64 + n * 16 + r] = Arun[n]; car[w * 64 + 32 + n * 16 + r] = hrun[n]; } }
            __syncthreads();
#pragma unroll
            for (int n = 0; n < 2; ++n) { float h = 0.f; for (int w2 = 0; w2 < w; ++w2) h = car[w2 * 64 + n * 16 + r] * h + car[w2 * 64 + 32 + n * 16 + r]; hin[n] = h; }
        }
    }
    __syncthreads();
}

__device__ __forceinline__ void attn_post(Frame& F, int l, int b, int h, int qb, float lam, float oscale) {
    const int tid_ = tid_opaque(), lane = tid_ & 63, wave_ = __builtin_amdgcn_readfirstlane(tid_ >> 6), rsub = lane >> 4, e8 = (lane & 15) * 8;
    const float* gs = FIN(I_GSUBLN) + l * 128 + e8; const bf16* OV_ = (const bf16*)FWS(WS_OV); bf16* AO_ = (bf16*)FWS(WS_AO); const f32x4 g0 = *(const f32x4*)gs, g1 = *(const f32x4*)(gs + 4);
    const size_t rowbase = (size_t)b * SEQ + qb * 256 + wave_ * 32;
#pragma unroll 2
    for (int it = 0; it < 8; ++it) { const size_t row = rowbase + it * 4 + rsub;
        const v4u a = *(const GAS v4u*)(OV_ + row * D + h * 256 + e8), c = *(const GAS v4u*)(OV_ + row * D + h * 256 + 128 + e8);
        f32x4 d0 = {pg8::bf_lo(a.x) - lam * pg8::bf_lo(c.x), pg8::bf_hi(a.x) - lam * pg8::bf_hi(c.x), pg8::bf_lo(a.y) - lam * pg8::bf_lo(c.y), pg8::bf_hi(a.y) - lam * pg8::bf_hi(c.y)};
        f32x4 d1 = {pg8::bf_lo(a.z) - lam * pg8::bf_lo(c.z), pg8::bf_hi(a.z) - lam * pg8::bf_hi(c.z), pg8::bf_lo(a.w) - lam * pg8::bf_lo(c.w), pg8::bf_hi(a.w) - lam * pg8::bf_hi(c.w)};
        float ss = pg8::sumsq8(d0, d1);
        ss += __shfl_xor(ss, 1); ss += __shfl_xor(ss, 2); ss += __shfl_xor(ss, 4); ss += __shfl_xor(ss, 8);
        const float rs = __builtin_amdgcn_rsqf(ss * (1.f / 128.f) + 1e-6f) * oscale;
        d0 = d0 * rs * g0; d1 = d1 * rs * g1;
        v4u o; o.x = pk2(d0.x, d0.y); o.y = pk2(d0.z, d0.w); o.z = pk2(d1.x, d1.y); o.w = pk2(d1.z, d1.w);
        *(GAS v4u*)(AO_ + row * D + h * 128 + e8) = o; }
}

struct Args { const void* in[23]; float* out; unsigned char* ws; int ph_lo, ph_hi; };
constexpr int N_PHASES = 2 + 6 * DEPTH;
__global__ void __launch_bounds__(NWAVES * 64, 2) hymba_fwd(Args args) {
    extern __shared__ __attribute__((aligned(16))) unsigned char lds[];
    cg::grid_group grid = cg::this_grid();
    Frame F;
    F.lds = (LAS unsigned char*)lds;
    { LAS unsigned long long* tabw = (LAS unsigned long long*)(F.lds + RING_BYTES + 1024);
      if (threadIdx.x == 0) {
#pragma unroll
          for (int k = 0; k < 23; ++k) tabw[k] = (unsigned long long)args.in[k];
          tabw[23] = (unsigned long long)args.out; tabw[24] = (unsigned long long)args.ws; }
      F.tab = tabw; }
    __syncthreads();
    const int lo = args.ph_lo, hi = args.ph_hi;
#define IN(k) (lo <= (k) && (k) < hi)
#define SEAM(k) do { if (IN(k) && IN((k) + 1)) grid.sync(); } while (0)

    if (IN(0)) { p0_prologue(F); } SEAM(0);

#pragma unroll 1
    for (int l_ = 0; l_ < DEPTH; ++l_) {
        const int pb = 1 + 6 * l_;
        if (IN(pb + 0)) {
            const Who W = who(); const int l = opaque_s(l_);
            unsigned char* ws = FWS(0); const unsigned char* wl = ws + WS_W + (size_t)l * W_LAYER;
            pg8::Gemm g{(const bf16*)(ws + WS_OV), (const bf16*)(wl + WO_IN), M, INW, D}; pg8::StaticOrder S; S.init(M, INW, W.G, opaque_s((int)blockIdx.x));
            pg8::EpiIn E{(bf16*)(ws + WS_PROJ), INW, (const float*)(ws + WS_SSQ1), (const float*)(ws + WS_CS), attn_body::C2};
            pg8::gemm_phase<pg8::EpiIn, pg8::StaticOrder, true, true>(F.lds, g, S, E);
        }
        SEAM(pb + 0);
        if (IN(pb + 1)) {
            const Who W = who(); const int l = opaque_s(l_);
            float lam, oscale;
            { const float* lq = FIN(I_LAMQ) + l * 128; const float* lk = FIN(I_LAMK) + l * 128;
              const float d0 = wave_sum(lq[W.lane] * lk[W.lane]), d1 = wave_sum(lq[64 + W.lane] * lk[64 + W.lane]);
              const float li = 0.8f - 0.6f * __expf(-0.3f * (float)l); lam = __expf(d0) - __expf(d1) + li; oscale = 1.f - li; }
            for (int item = W.vcu; item < 256; item += W.G) {
                const int bh = item >> 2, s = item & 3, b = bh >> 2, h = bh & 3;
                const attn_body::bf16* pj = (const attn_body::bf16*)((const bf16*)FWS(WS_PROJ) + (size_t)b * SEQ * INW); attn_body::bf16* ov = (attn_body::bf16*)((bf16*)FWS(WS_OV) + (size_t)b * SEQ * D);
#pragma unroll 1
                for (int k = 0; k < 2; ++k) { const int qb = k ? 7 - s : s;
#pragma unroll 1
                    for (int j = 0; j < 4; ++j) { const int c = j >> 1, vh = j & 1;
                        attn_body::attn_unit<8>(qb, pj + (h * 2 + c) * 64, pj + AW + (h * 2 + c) * 64, pj + 2 * AW + h * 128 + vh * 64, ov + h * 256 + c * 128 + vh * 64, (char*)lds); }
                    VM_WAIT(); __syncthreads(); __builtin_amdgcn_fence(__ATOMIC_ACQUIRE, "agent"); VM_WAIT();
                    attn_post(F, l, b, h, qb, lam, oscale);
                }
            }
            __syncthreads();
            for (int item = W.vcu; item < 256; item += W.G) lru_item(F, l, item);
        }
        SEAM(pb + 1);
        if (IN(pb + 2)) {
            const Who W = who(); const int l = opaque_s(l_);
            unsigned char* ws = FWS(0); const unsigned char* wl = ws + WS_W + (size_t)l * W_LAYER;
            pg8::Gemm g{(const bf16*)(ws + WS_AO), (const bf16*)(wl + WO_OUT), M, D, D}; pg8::StaticOrder S; S.init(M, D, W.G, opaque_s((int)blockIdx.x));
            pg8::EpiRes E{FOUT(), (bf16*)(ws + WS_XB0), (float*)(ws + WS_SSQ0)};
            pg8::gemm_phase<pg8::EpiRes, pg8::StaticOrder, true, true>(F.lds, g, S, E);
        }
        SEAM(pb + 2);
        if (IN(pb + 3)) {
            const Who W = who(); const int l = opaque_s(l_);
            convert_p(F, l);
            unsigned char* ws = FWS(0); const unsigned char* wl = ws + WS_W + (size_t)l * W_LAYER;
            pg8::Gemm g{(const bf16*)(ws + WS_XB0), (const bf16*)(wl + WO_W1), M, FF, D}; pg8::StaticOrder S; S.init(M, FF, W.G, opaque_s((int)blockIdx.x));
            pg8::EpiMlpIn E{(bf16*)(ws + WS_HB), FF, (const float*)(ws + WS_SSQ0)};
            pg8::gemm_phase<pg8::EpiMlpIn, pg8::StaticOrder, true, true>(F.lds, g, S, E);
        }
        SEAM(pb + 3);
        if (IN(pb + 4)) {
            const Who W = who(); const int l = opaque_s(l_);
            unsigned char* ws = FWS(0); const unsigned char* wl = ws + WS_W + (size_t)l * W_LAYER;
            pg8::Gemm g{(const bf16*)(ws + WS_HB), (const bf16*)(wl + WO_W2), M, D, FF}; pg8::StaticOrder S; S.init(M, D, W.G, opaque_s((int)blockIdx.x));
            pg8::EpiRes E{FOUT(), (bf16*)(ws + WS_XB0), (float*)(ws + WS_SSQ0)};
            pg8::gemm_phase<pg8::EpiRes, pg8::StaticOrder, true, true>(F.lds, g, S, E);
        }
        SEAM(pb + 4);
        if (IN(pb + 5)) {
            const Who W = who(); const int l = opaque_s(l_);
            { unsigned char* ws = FWS(0); const unsigned char* wl = ws + WS_W + (size_t)l * W_LAYER;
              pg8::Gemm g{(const bf16*)(ws + WS_P16), (const bf16*)(wl + WO_PP), M, D, opaque_s(PLE)}; pg8::StaticOrder S; S.init(M, D, W.G, opaque_s((int)blockIdx.x));
              pg8::EpiPlain E{(bf16*)(ws + WS_PP), D};
              pg8::gemm_phase<pg8::EpiPlain, pg8::StaticOrder, true, true>(F.lds, g, S, E); }
            VM_WAIT(); __syncthreads();
            { unsigned char* ws = FWS(0); const unsigned char* wl = ws + WS_W + (size_t)l * W_LAYER;
              pg8::Gemm g{(const bf16*)(ws + WS_XB0), (const bf16*)(wl + WO_PG), M, D, D}; pg8::StaticOrder S; S.init(M, D, W.G, opaque_s((int)blockIdx.x));
              pg8::EpiPle E{FOUT(), (bf16*)(ws + WS_OV), (const float*)(ws + WS_SSQ0), (float*)(ws + WS_SSQ1), (const bf16*)(ws + WS_PP)};
              pg8::gemm_phase<pg8::EpiPle, pg8::StaticOrder, true, true>(F.lds, g, S, E); }
        }
        SEAM(pb + 5);
    }
    if (IN(N_PHASES - 1)) final_norm(F);
#undef IN
#undef SEAM
}

extern "C" void kernel_launch(void* const* d_in, const int* in_sizes, int n_in, void* d_out, int out_size, void* d_ws, size_t ws_size, hipStream_t stream) {
    static int grid = 0;
    if (grid == 0) {
        if (n_in != 23 || in_sizes[0] != M * D || out_size != M * D || ws_size < WS_END) { fprintf(stderr, "kernel_launch: unexpected shapes: n_in %d in0 %d out %d ws %zu (need %zu); nothing launched\n", n_in, n_in > 0 ? in_sizes[0] : -1, out_size, ws_size, (size_t)WS_END); grid = -1; return; }
        int dev = 0, cus = 0, per_cu = 0;
        if (hipGetDevice(&dev) != hipSuccess || hipDeviceGetAttribute(&cus, hipDeviceAttributeMultiprocessorCount, dev) != hipSuccess) { grid = -1; return; }
        if (hipFuncSetAttribute((const void*)hymba_fwd, hipFuncAttributeMaxDynamicSharedMemorySize, LDS_BYTES) != hipSuccess) { fprintf(stderr, "kernel_launch: hipFuncSetAttribute failed\n"); grid = -1; return; }
        if (hipOccupancyMaxActiveBlocksPerMultiprocessor(&per_cu, (const void*)hymba_fwd, NWAVES * 64, LDS_BYTES) != hipSuccess || per_cu < 1) { fprintf(stderr, "kernel_launch: occupancy query reports %d\n", per_cu); per_cu = 1; }
        (void)hipGetLastError();
        grid = cus * per_cu;
    }
    if (grid < 0) return;
    Args a{};
    for (int i = 0; i < 23; ++i) a.in[i] = d_in[i];
    a.out = (float*)d_out; a.ws = (unsigned char*)d_ws;
#ifndef MK_CUTS
    a.ph_lo = 0; a.ph_hi = N_PHASES;
    void* kargs[] = {&a};
    hipError_t e = hipLaunchCooperativeKernel((const void*)hymba_fwd, dim3(grid), dim3(NWAVES * 64), kargs, LDS_BYTES, stream);
    if (e != hipSuccess) fprintf(stderr, "kernel_launch: cooperative launch failed: %s (grid %d)\n", hipGetErrorString(e), grid);
#else
    for (int ph = 0; ph < N_PHASES; ++ph) { a.ph_lo = ph; a.ph_hi = ph + 1; void* kargs[] = {&a};
        hipError_t e = hipLaunchCooperativeKernel((const void*)hymba_fwd, dim3(grid), dim3(NWAVES * 64), kargs, LDS_BYTES, stream);
        if (e != hipSuccess) { fprintf(stderr, "kernel_launch: launch %d failed: %s\n", ph, hipGetErrorString(e)); break; } }
#endif
}
```

```cpp
#include <hip/hip_runtime.h>
#include <cstdio>
#include <cstdint>
__device__ __forceinline__ int tid_opaque() { int t = threadIdx.x; asm volatile("" : "+v"(t)); return t; }
namespace pg8 {
#define PG8_LAS __attribute__((address_space(3)))
typedef unsigned short bf16_t;
typedef short bf16x8 __attribute__((ext_vector_type(8)));
typedef float f32x4 __attribute__((ext_vector_type(4)));
typedef unsigned u32x4 __attribute__((ext_vector_type(4)));
constexpr int BM = 256, BK = 64, HALF = 128, HTB = HALF * BK * 2  , STAGE_BYTES = 8 * HTB, NXCD = 8, WGM = 8;

__host__ __device__ __forceinline__ int lds_byte(int r, int c) { const int st = (r >> 4) * 2 + (c >> 5), rr = r & 15, cc = c & 31, ob = rr * 64 + cc * 2; return st * 1024 + (ob ^ (((ob >> 9) & 1) << 5)); }
__host__ __device__ __forceinline__ void stage_rc(int b, int& R, int& C) { const int st = b / 1024, sb = b % 1024, swz = sb ^ (((sb >> 9) & 1) << 5); R = (st >> 1) * 16 + swz / 64; C = (st & 1) * 32 + (swz % 64) / 2; }
__host__ __device__ __forceinline__ int perm32(int rho) { const int n = rho >> 4, i = rho & 15; return 8 * (i >> 2) + 4 * n + (i & 3); }

struct Unit { int pm, pn; };
struct Gemm { const bf16_t* A; const bf16_t* Bt; int M, N, K; };

struct StaticOrder {
    int nM, nN, nwg, G, c;
    __host__ __device__ void init(int M, int N, int G_, int c_) { nM = M / BM; nN = N / BM; nwg = nM * nN; G = G_; c = c_; }
    __host__ __device__ bool next(int i, Unit& u) const {
        const long L = (long)i * G + c; if (L >= nwg) return false;
        int wgid = (int)L; { const int q = nwg / NXCD, r = nwg % NXCD, xcd = wgid % NXCD, off = wgid / NXCD; wgid = (xcd < r ? xcd * (q + 1) : r * (q + 1) + (xcd - r) * q) + off; }
        const int nig = WGM * nN, gid = wgid / nig, fm = gid * WGM, gsz = (nM - fm) < WGM ? (nM - fm) : WGM;
        u.pm = fm + ((wgid % nig) % gsz); u.pn = (wgid % nig) / gsz; return true;
    }
    __device__ __forceinline__ void a_ready(const Unit&) const {}
    __device__ __forceinline__ void done(const Unit&) const {}
};

__device__ __forceinline__ unsigned cvt_pk_bf16(float lo, float hi) { unsigned r; asm volatile("v_cvt_pk_bf16_f32 %0, %1, %2" : "=v"(r) : "v"(lo), "v"(hi)); return r; }
__device__ __forceinline__ u32x4 pack8(const f32x4 v0, const f32x4 v1) { u32x4 w; w.x = cvt_pk_bf16(v0[0], v0[1]); w.y = cvt_pk_bf16(v0[2], v0[3]); w.z = cvt_pk_bf16(v1[0], v1[1]); w.w = cvt_pk_bf16(v1[2], v1[3]); return w; }
__device__ __forceinline__ float bf_lo(unsigned w) { return __uint_as_float(w << 16); }
__device__ __forceinline__ float bf_hi(unsigned w) { return __uint_as_float(w & 0xffff0000u); }
constexpr int DMODEL = 1024;
constexpr float RMS_EPS = 1e-6f;
__device__ __forceinline__ float row_rs(const float* ssq, int row) {
    const f32x4* p = (const f32x4*)(ssq + (size_t)row * 16);
    const f32x4 a = p[0], b = p[1], c = p[2], d = p[3];
    const float s = (((a[0] + a[1]) + (a[2] + a[3])) + ((b[0] + b[1]) + (b[2] + b[3]))) + (((c[0] + c[1]) + (c[2] + c[3])) + ((d[0] + d[1]) + (d[2] + d[3])));
    return __builtin_amdgcn_rsqf(s * (1.0f / DMODEL) + RMS_EPS);
}
__device__ __forceinline__ float sumsq8(const f32x4 a, const f32x4 b) { return ((a[0] * a[0] + a[1] * a[1]) + (a[2] * a[2] + a[3] * a[3])) + ((b[0] * b[0] + b[1] * b[1]) + (b[2] * b[2] + b[3] * b[3])); }

struct EpiPlain {
    static constexpr bool PERM = true, AFTER_DRAIN = false;
    bf16_t* O; int ldc;
    __device__ __forceinline__ void operator()(const f32x4 (&acc)[2][2][4][2], const Unit& u, int wr, int wc, int fr, int fq) const {
        const int row0 = u.pm * BM + wr * 64 + fr, col0 = u.pn * BM + wc * 32 + 8 * fq;
#pragma unroll
        for (int ai = 0; ai < 2; ++ai)
#pragma unroll
            for (int m = 0; m < 4; ++m) { bf16_t* rowp = O + (size_t)(row0 + ai * HALF + m * 16) * ldc + col0;
#pragma unroll
                for (int bj = 0; bj < 2; ++bj) *(u32x4*)(rowp + bj * HALF) = pack8(acc[ai][bj][m][0], acc[ai][bj][m][1]); }
    }
};
struct EpiIn {
    static constexpr bool PERM = true, AFTER_DRAIN = false;
    bf16_t* O; int ldc; const float* ssq; const float* cs; float qscale;
    __device__ __forceinline__ void operator()(const f32x4 (&acc)[2][2][4][2], const Unit& u, int wr, int wc, int fr, int fq) const {
        const int row0 = u.pm * BM + wr * 64 + fr, col0 = u.pn * BM + wc * 32 + 8 * fq;
        const bool rope = (u.pn < 4) && !(wc & 1);
        const float sc = (u.pn < 2) ? qscale : 1.f;
        const bool mine = fq < 2; const float sgn = (fq == 0) ? -1.f : 1.f;
#pragma unroll
        for (int ai = 0; ai < 2; ++ai)
#pragma unroll
            for (int m = 0; m < 4; ++m) { const int row = row0 + ai * HALF + m * 16; const float rs = row_rs(ssq, row) * sc;
                bf16_t* rowp = O + (size_t)row * ldc + col0;
                f32x4 c0 = {1.f, 1.f, 1.f, 1.f}, c1 = c0, s0 = {0.f, 0.f, 0.f, 0.f}, s1 = s0;
                if (rope && mine) { const f32x4* cp = (const f32x4*)(cs + (size_t)row * 16); c0 = cp[0]; c1 = cp[1]; s0 = cp[2] * sgn; s1 = cp[3] * sgn; }
#pragma unroll
                for (int bj = 0; bj < 2; ++bj) { f32x4 v0 = acc[ai][bj][m][0] * rs, v1 = acc[ai][bj][m][1] * rs;
                    if (rope) { f32x4 p0, p1;
#pragma unroll
                        for (int e = 0; e < 4; ++e) { p0[e] = __shfl_xor(v0[e], 16); p1[e] = __shfl_xor(v1[e], 16); }
                        v0 = v0 * c0 + p0 * s0; v1 = v1 * c1 + p1 * s1; }
                    *(u32x4*)(rowp + bj * HALF) = pack8(v0, v1); }
                asm volatile("" ::: "memory"); }
    }
};
struct EpiRes {
    static constexpr bool PERM = true, AFTER_DRAIN = false;
    float* H; bf16_t* XB; float* ssq;
    __device__ __forceinline__ void operator()(const f32x4 (&acc)[2][2][4][2], const Unit& u, int wr, int wc, int fr, int fq) const {
        const int row0 = u.pm * BM + wr * 64 + fr, col0 = u.pn * BM + wc * 32 + 8 * fq;
#pragma unroll
        for (int ai = 0; ai < 2; ++ai)
#pragma unroll
            for (int m = 0; m < 4; ++m) { const int row = row0 + ai * HALF + m * 16; float part = 0.f;
#pragma unroll
                for (int bj = 0; bj < 2; ++bj) { float* hp = H + (size_t)row * DMODEL + col0 + bj * HALF;
                    f32x4 h0 = *(const f32x4*)hp, h1 = *(const f32x4*)(hp + 4);
                    h0 = h0 + acc[ai][bj][m][0]; h1 = h1 + acc[ai][bj][m][1];
                    *(f32x4*)hp = h0; *(f32x4*)(hp + 4) = h1; part += sumsq8(h0, h1);
                    *(u32x4*)(XB + (size_t)row * DMODEL + col0 + bj * HALF) = pack8(h0, h1); }
                part += __shfl_xor(part, 16); part += __shfl_xor(part, 32);
                if (fq == 0) ssq[(size_t)row * 16 + u.pn * 4 + wc] = part;
                asm volatile("" ::: "memory"); }
    }
};
struct EpiMlpIn {
    static constexpr bool PERM = true, AFTER_DRAIN = false;
    bf16_t* O; int ldc; const float* ssq;
    __device__ __forceinline__ void operator()(const f32x4 (&acc)[2][2][4][2], const Unit& u, int wr, int wc, int fr, int fq) const {
        const int row0 = u.pm * BM + wr * 64 + fr, col0 = u.pn * BM + wc * 32 + 8 * fq;
#pragma unroll
        for (int ai = 0; ai < 2; ++ai)
#pragma unroll
            for (int m = 0; m < 4; ++m) { const int row = row0 + ai * HALF + m * 16; const float rs = row_rs(ssq, row);
                bf16_t* rowp = O + (size_t)row * ldc + col0;
#pragma unroll
                for (int bj = 0; bj < 2; ++bj) { f32x4 v0 = acc[ai][bj][m][0] * rs, v1 = acc[ai][bj][m][1] * rs;
#pragma unroll
                    for (int e = 0; e < 4; ++e) { const float a = fmaxf(v0[e], 0.f), b = fmaxf(v1[e], 0.f); v0[e] = a * a; v1[e] = b * b; }
                    *(u32x4*)(rowp + bj * HALF) = pack8(v0, v1); }
                asm volatile("" ::: "memory"); }
    }
};
struct EpiPle {
    static constexpr bool PERM = true, AFTER_DRAIN = false;
    float* H; bf16_t* XBo; const float* ssq_in; float* ssq_out; const bf16_t* PP;
    __device__ __forceinline__ void operator()(const f32x4 (&acc)[2][2][4][2], const Unit& u, int wr, int wc, int fr, int fq) const {
        const int row0 = u.pm * BM + wr * 64 + fr, col0 = u.pn * BM + wc * 32 + 8 * fq;
#pragma unroll
        for (int ai = 0; ai < 2; ++ai)
#pragma unroll
            for (int m = 0; m < 4; ++m) { const int row = row0 + ai * HALF + m * 16; const float rs = row_rs(ssq_in, row); float part = 0.f;
#pragma unroll
                for (int bj = 0; bj < 2; ++bj) { float* hp = H + (size_t)row * DMODEL + col0 + bj * HALF;
                    f32x4 h0 = *(const f32x4*)hp, h1 = *(const f32x4*)(hp + 4);
                    const u32x4 pw = *(const u32x4*)(PP + (size_t)row * DMODEL + col0 + bj * HALF);
                    const f32x4 p0 = {bf_lo(pw.x), bf_hi(pw.x), bf_lo(pw.y), bf_hi(pw.y)}, p1 = {bf_lo(pw.z), bf_hi(pw.z), bf_lo(pw.w), bf_hi(pw.w)};
                    f32x4 g0 = acc[ai][bj][m][0] * rs, g1 = acc[ai][bj][m][1] * rs;
#pragma unroll
                    for (int e = 0; e < 4; ++e) { g0[e] = __builtin_amdgcn_rcpf(1.f + __builtin_amdgcn_exp2f(-1.4426950408889634f * g0[e])); g1[e] = __builtin_amdgcn_rcpf(1.f + __builtin_amdgcn_exp2f(-1.4426950408889634f * g1[e])); }
                    h0 = h0 + g0 * p0; h1 = h1 + g1 * p1;
                    *(f32x4*)hp = h0; *(f32x4*)(hp + 4) = h1; part += sumsq8(h0, h1);
                    *(u32x4*)(XBo + (size_t)row * DMODEL + col0 + bj * HALF) = pack8(h0, h1); }
                part += __shfl_xor(part, 16); part += __shfl_xor(part, 32);
                if (fq == 0) ssq_out[(size_t)row * 16 + u.pn * 4 + wc] = part;
                asm volatile("" ::: "memory"); }
    }
};

template <class Epi, class Sched, bool ALIGN_EPI = false, bool SP2 = false>
__device__ __forceinline__ void gemm_phase(PG8_LAS unsigned char* lds, const Gemm g, const Sched& S, const Epi& E) {
    const int tid = tid_opaque(), wid = __builtin_amdgcn_readfirstlane(tid >> 6), lane = tid & 63, wr = wid >> 2, wc = wid & 3, fr = lane & 15, fq = lane >> 4;
    const int K = g.K, nt = K / BK;
    unsigned voffA[2], voffB[2];
#pragma unroll
    for (int i = 0; i < 2; ++i) { int R, C; stage_rc(tid * 16 + i * 8192, R, C); const int Rb = Epi::PERM ? ((R & ~31) + perm32(R & 31)) : R;
        voffA[i] = (unsigned)(R * K + C) * 2u; voffB[i] = (unsigned)(Rb * K + C) * 2u; }
    const size_t kstep = (size_t)(BK * 2);
    const size_t hstep = (size_t)HALF * K * 2;
    const size_t tstep = 2 * hstep;
    const unsigned ldsw = (unsigned)wid * 1024u;
    const int aoff = lds_byte(wr * 64 + fr, fq * 8), boff = lds_byte(wc * 32 + fr, fq * 8);
#define PG8_SA(b, h) (((b) * 2 + (h)) * HTB)
#define PG8_SB(b, h) ((4 + (b) * 2 + (h)) * HTB)
#define PG8_STAGE(bufoff, gbase, voff) do { _Pragma("unroll") for (int _i = 0; _i < 2; ++_i) \
        __builtin_amdgcn_global_load_lds((const unsigned*)((const char*)(gbase) + (voff)[_i]), (PG8_LAS unsigned*)(lds + (bufoff) + ldsw + _i * 8192), 16, 0, 0); } while (0)
#define PG8_LDA(dst, b, h) do { _Pragma("unroll") for (int m = 0; m < 4; ++m) _Pragma("unroll") for (int k = 0; k < 2; ++k) dst[m][k] = *(const PG8_LAS bf16x8*)(lds + PG8_SA(b, h) + aoff + m * 2048 + k * 1024); } while (0)
#define PG8_LDB(dst, b, h) do { _Pragma("unroll") for (int n = 0; n < 2; ++n) _Pragma("unroll") for (int k = 0; k < 2; ++k) dst[n][k] = *(const PG8_LAS bf16x8*)(lds + PG8_SB(b, h) + boff + n * 2048 + k * 1024); } while (0)
#define PG8_MMA(ai, bj, At, Bt) do { __builtin_amdgcn_s_setprio(1); _Pragma("unroll") for (int m = 0; m < 4; ++m) _Pragma("unroll") for (int n = 0; n < 2; ++n) _Pragma("unroll") for (int k = 0; k < 2; ++k) \
        acc[ai][bj][m][n] = __builtin_amdgcn_mfma_f32_16x16x32_bf16(Bt[n][k], At[m][k], acc[ai][bj][m][n], 0, 0, 0); __builtin_amdgcn_s_setprio(0); } while (0)
#define PG8_WAIT_V(n) asm volatile("s_waitcnt vmcnt(" #n ")" ::: "memory")
#define PG8_WAIT_L(n) asm volatile("s_waitcnt lgkmcnt(" #n ")" ::: "memory")
#define PG8_BAR __builtin_amdgcn_s_barrier()
#define PG8_SCHED __builtin_amdgcn_sched_barrier(0)
    Unit cur, nxt; int ui = 0;
    if (!S.next(0, cur)) return;
    f32x4 acc[2][2][4][2];
#pragma unroll
    for (int a = 0; a < 2; ++a)
#pragma unroll
        for (int b = 0; b < 2; ++b)
#pragma unroll
            for (int m = 0; m < 4; ++m)
#pragma unroll
                for (int n = 0; n < 2; ++n) acc[a][b][m][n] = (f32x4){0.f, 0.f, 0.f, 0.f};
    bf16x8 At[4][2], B0[2][2], B1[2][2];
    const char* cA = (const char*)g.A + (size_t)cur.pm * tstep; const char* cB = (const char*)g.Bt + (size_t)cur.pn * tstep;
    S.a_ready(cur);
    if constexpr (SP2) {
        PG8_STAGE(PG8_SB(0, 0), cB, voffB); PG8_STAGE(PG8_SB(0, 1), cB + hstep, voffB); PG8_STAGE(PG8_SA(0, 0), cA, voffA); PG8_STAGE(PG8_SA(0, 1), cA + hstep, voffA);
        if (wr == 1) PG8_BAR;
        PG8_WAIT_V(2); PG8_BAR;
        PG8_STAGE(PG8_SB(1, 0), cB + kstep, voffB); PG8_STAGE(PG8_SA(1, 0), cA + kstep, voffA); PG8_STAGE(PG8_SB(1, 1), cB + hstep + kstep, voffB);
        PG8_WAIT_V(6); PG8_BAR;
    } else {
        PG8_STAGE(PG8_SB(0, 0), cB, voffB); PG8_STAGE(PG8_SA(0, 0), cA, voffA); PG8_STAGE(PG8_SB(0, 1), cB + hstep, voffB); PG8_STAGE(PG8_SA(0, 1), cA + hstep, voffA);
        if (wr == 1) PG8_BAR;
        PG8_WAIT_V(4); PG8_BAR;
        PG8_STAGE(PG8_SB(1, 0), cB + kstep, voffB); PG8_STAGE(PG8_SA(1, 0), cA + kstep, voffA); PG8_STAGE(PG8_SB(1, 1), cB + hstep + kstep, voffB);
        PG8_WAIT_V(6); PG8_BAR;
    }
    for (;;) {
        const bool has_next = S.next(ui + 1, nxt);
        const char* nA = has_next ? (const char*)g.A + (size_t)nxt.pm * tstep : cA; const char* nB = has_next ? (const char*)g.Bt + (size_t)nxt.pn * tstep : cB;
        for (int t = 0; t < nt; t += 2) {
            const bool last = (t == nt - 2);
            const char* a1 = cA + (size_t)(t + 1) * kstep;
            const char* a2 = last ? nA : cA + (size_t)(t + 2) * kstep; const char* b2 = last ? nB : cB + (size_t)(t + 2) * kstep;
            const char* a3 = a2 + kstep; const char* b3 = b2 + kstep;
            if (last && has_next) S.a_ready(nxt);
            if constexpr (SP2) {
            PG8_LDB(B0, 0, 0); PG8_LDB(B1, 0, 1); PG8_SCHED; PG8_LDA(At, 0, 0); PG8_STAGE(PG8_SA(1, 1), a1 + hstep, voffA);
            PG8_WAIT_V(8); PG8_WAIT_L(0); PG8_BAR; PG8_MMA(0, 0, At, B0); PG8_MMA(0, 1, At, B1); PG8_BAR; PG8_SCHED;
            PG8_LDA(At, 0, 1); PG8_STAGE(PG8_SB(0, 0), b2, voffB); PG8_STAGE(PG8_SB(0, 1), b2 + hstep, voffB); PG8_STAGE(PG8_SA(0, 0), a2, voffA);
            PG8_WAIT_V(8); PG8_WAIT_L(0); PG8_BAR; PG8_MMA(1, 0, At, B0); PG8_MMA(1, 1, At, B1); PG8_BAR; PG8_SCHED;
            PG8_LDB(B0, 1, 0); PG8_LDB(B1, 1, 1); PG8_SCHED; PG8_LDA(At, 1, 0); PG8_STAGE(PG8_SA(0, 1), a2 + hstep, voffA);
            PG8_WAIT_V(8); PG8_WAIT_L(0); PG8_BAR; PG8_MMA(0, 0, At, B0); PG8_MMA(0, 1, At, B1); PG8_BAR; PG8_SCHED;
            PG8_LDA(At, 1, 1); PG8_STAGE(PG8_SB(1, 0), b3, voffB); PG8_STAGE(PG8_SB(1, 1), b3 + hstep, voffB); PG8_STAGE(PG8_SA(1, 0), a3, voffA);
            PG8_WAIT_V(8); PG8_WAIT_L(0); PG8_BAR; PG8_MMA(1, 0, At, B0); PG8_MMA(1, 1, At, B1); PG8_BAR; PG8_SCHED;
            } else {
            PG8_LDB(B0, 0, 0); PG8_SCHED; PG8_LDA(At, 0, 0); PG8_STAGE(PG8_SA(1, 1), a1 + hstep, voffA);
            PG8_WAIT_L(8); PG8_BAR; PG8_WAIT_L(0); PG8_MMA(0, 0, At, B0); PG8_BAR; PG8_SCHED;
            PG8_LDB(B1, 0, 1); PG8_STAGE(PG8_SB(0, 0), b2, voffB);
            PG8_BAR; PG8_WAIT_L(0); PG8_MMA(0, 1, At, B1); PG8_BAR;
            PG8_LDA(At, 0, 1); PG8_STAGE(PG8_SA(0, 0), a2, voffA);
            PG8_BAR; PG8_WAIT_L(0); PG8_MMA(1, 0, At, B0); PG8_BAR; PG8_SCHED;
            PG8_STAGE(PG8_SB(0, 1), b2 + hstep, voffB);
            PG8_WAIT_V(6); PG8_BAR; PG8_MMA(1, 1, At, B1); PG8_BAR;
            PG8_LDB(B0, 1, 0); PG8_SCHED; PG8_LDA(At, 1, 0); PG8_STAGE(PG8_SA(0, 1), a2 + hstep, voffA);
            PG8_WAIT_L(8); PG8_BAR; PG8_WAIT_L(0); PG8_MMA(0, 0, At, B0); PG8_BAR; PG8_SCHED;
            PG8_LDB(B1, 1, 1); PG8_STAGE(PG8_SB(1, 0), b3, voffB);
            PG8_BAR; PG8_WAIT_L(0); PG8_MMA(0, 1, At, B1); PG8_BAR;
            PG8_LDA(At, 1, 1); PG8_STAGE(PG8_SA(1, 0), a3, voffA);
            PG8_BAR; PG8_WAIT_L(0); PG8_MMA(1, 0, At, B0); PG8_BAR; PG8_SCHED;
            PG8_STAGE(PG8_SB(1, 1), b3 + hstep, voffB);
            PG8_WAIT_V(6); PG8_BAR; PG8_MMA(1, 1, At, B1); PG8_BAR;
            }
        }
        if constexpr (ALIGN_EPI) { if (wr == 0) PG8_BAR; }
        if constexpr (!Epi::AFTER_DRAIN) { const int t2 = tid_opaque(), w2 = __builtin_amdgcn_readfirstlane(t2 >> 6), l2 = t2 & 63;
            E(acc, cur, w2 >> 2, w2 & 3, l2 & 15, l2 >> 4); S.done(cur); }
        if (!has_next) break;
#pragma unroll
        for (int a = 0; a < 2; ++a)
#pragma unroll
            for (int b = 0; b < 2; ++b)
#pragma unroll
                for (int m = 0; m < 4; ++m)
#pragma unroll
                    for (int n = 0; n < 2; ++n) acc[a][b][m][n] = (f32x4){0.f, 0.f, 0.f, 0.f};
        cur = nxt; cA = nA; cB = nB; ++ui;
        if constexpr (ALIGN_EPI) { if (wr == 1) PG8_BAR; }
    }
    PG8_WAIT_V(0);
    if constexpr (!ALIGN_EPI) { if (wr == 0) PG8_BAR; }
    PG8_BAR;
    if constexpr (Epi::AFTER_DRAIN) { E.fused(acc, cur, wr, wc, fr, fq, lds, wid, lane); S.done(cur); }
#undef PG8_SA
#undef PG8_SB
#undef PG8_STAGE
#undef PG8_LDA
#undef PG8_LDB
#undef PG8_MMA
#undef PG8_WAIT_V
#undef PG8_WAIT_L
#undef PG8_BAR
#undef PG8_SCHED
}
}
#ifndef PG8_SP2
#define PG8_SP2 true
#endif
#include <hip/hip_bf16.h>
#include <cmath>
namespace attn_body {
using bf16=__hip_bfloat16;
using bf16x8=__attribute__((ext_vector_type(8)))short;
using s16x4=__attribute__((ext_vector_type(4)))short;
using f32x16=__attribute__((ext_vector_type(16)))float;
using u32x4=__attribute__((ext_vector_type(4)))unsigned;
constexpr int D=64,PQ=2560,PO=1024;
constexpr int NW=8,QBLK=32,QB=QBLK*NW,KVBLK=64;
constexpr int ATTN_UNIT_ROWS=QB;
__device__ __forceinline__ int crow(int r,int hi){return (r&3)+8*(r>>2)+4*hi;}
#define SBAR() __builtin_amdgcn_sched_barrier(0)
__device__ __forceinline__ void cmask(f32x16&p0,f32x16&p1,int jb,int qrel,int hi){
  const float NEG=-INFINITY; int kb=64*jb+4*hi;
  #pragma unroll
  for(int r=0;r<16;++r){int kv=kb+(r&3)+8*(r>>2); if(kv>qrel)p0[r]=NEG; if(kv+32>qrel)p1[r]=NEG;}
}

constexpr int NSLOT=3, SLOTB=8192;
constexpr int LDS_K=0, LDS_V=NSLOT*SLOTB, LDS_WS=2*NSLOT*SLOTB, LDS_OST=LDS_WS+NW*64*4, LDS_BYTES=LDS_OST+NW*4096;
constexpr float C2=0.125f*1.4426950408889634f;
__device__ __forceinline__ void glds16(const void*gsrc,unsigned lds_dst){unsigned keep;
  asm volatile("s_mov_b32 %0, m0\n\ts_mov_b32 m0, %2\n\ts_nop 0\n\tglobal_load_lds_dwordx4 %1, off\n\ts_mov_b32 m0, %0":"=&s"(keep):"v"(gsrc),"s"(lds_dst):"memory");}
__device__ __forceinline__ float max3f(float a,float b,float c){float r;asm("v_max3_f32 %0, %1, %2, %3":"=v"(r):"v"(a),"v"(b),"v"(c));return r;}
__device__ __forceinline__ float max2f(float a,float b){float r;asm("v_max_f32_e32 %0, %1, %2":"=v"(r):"v"(a),"v"(b));return r;}
__device__ __forceinline__ float fadd_s(float a,float b){float r;asm("v_add_f32_e32 %0, %1, %2":"=v"(r):"v"(a),"v"(b));return r;}
__device__ __forceinline__ float fsub_s(float a,float b){float r;asm("v_sub_f32_e32 %0, %1, %2":"=v"(r):"v"(a),"v"(b));return r;}
typedef float f32x2_t __attribute__((ext_vector_type(2))); typedef __bf16 bf16x2_t __attribute__((ext_vector_type(2)));
__device__ __forceinline__ unsigned cvtpk_s(float lo,float hi){f32x2_t v={lo,hi};bf16x2_t b=__builtin_convertvector(v,bf16x2_t);return __builtin_bit_cast(unsigned,b);}
#define WAIT_BAR(N) asm volatile("s_waitcnt vmcnt(" #N ") lgkmcnt(0)\n\ts_barrier":::"memory")

__device__ __forceinline__ void qkt(f32x16&p0,f32x16&p1,const char*Kslot,const bf16x8*qr,const f32x16&negm,int r32,int hi){
  const char*kb=Kslot+hi*1024+r32*16;
  #pragma unroll
  for(int d0=0;d0<4;++d0){
    const bf16x8 b0=*reinterpret_cast<const bf16x8*>(kb+d0*2048);
    const bf16x8 b1=*reinterpret_cast<const bf16x8*>(kb+d0*2048+512);
    if(d0==0){p0=__builtin_amdgcn_mfma_f32_32x32x16_bf16(b0,qr[0],negm,0,0,0);p1=__builtin_amdgcn_mfma_f32_32x32x16_bf16(b1,qr[0],negm,0,0,0);}
    else{p0=__builtin_amdgcn_mfma_f32_32x32x16_bf16(b0,qr[d0],p0,0,0,0);p1=__builtin_amdgcn_mfma_f32_32x32x16_bf16(b1,qr[d0],p1,0,0,0);}}
}
typedef __attribute__((address_space(3))) const char* lds_cptr;
typedef short v4i16_t __attribute__((ext_vector_type(4)));
__device__ __forceinline__ void kload8(bf16x8*kf,lds_cptr kp){
  kf[0]=*(const __attribute__((address_space(3))) bf16x8*)(kp);      kf[1]=*(const __attribute__((address_space(3))) bf16x8*)(kp+512);
  kf[2]=*(const __attribute__((address_space(3))) bf16x8*)(kp+2048); kf[3]=*(const __attribute__((address_space(3))) bf16x8*)(kp+2560);
  kf[4]=*(const __attribute__((address_space(3))) bf16x8*)(kp+4096); kf[5]=*(const __attribute__((address_space(3))) bf16x8*)(kp+4608);
  kf[6]=*(const __attribute__((address_space(3))) bf16x8*)(kp+6144); kf[7]=*(const __attribute__((address_space(3))) bf16x8*)(kp+6656);
}
__device__ __forceinline__ void kload2(bf16x8*kf,lds_cptr kp,int j){ kf[2*j]=*(const __attribute__((address_space(3))) bf16x8*)(kp+j*2048); kf[2*j+1]=*(const __attribute__((address_space(3))) bf16x8*)(kp+j*2048+512); }
__device__ __forceinline__ s16x4 vtr(lds_cptr p){ return __builtin_bit_cast(s16x4,__builtin_amdgcn_ds_read_tr16_b64_v4i16((__attribute__((address_space(3))) v4i16_t*)p)); }
__device__ __forceinline__ float rowmax(const f32x16&p0,const f32x16&p1){
  float a=max3f(p0[0],p0[1],p1[0]),b=max3f(p0[2],p0[3],p1[1]);a=max3f(a,p1[2],p1[3]);
  #pragma unroll
  for(int r=4;r<16;r+=4){a=max3f(a,p0[r],p0[r+1]);b=max3f(b,p0[r+2],p0[r+3]);a=max3f(a,p1[r],p1[r+1]);b=max3f(b,p1[r+2],p1[r+3]);}
  const float m=max2f(a,b);
  auto rr=__builtin_amdgcn_permlane32_swap(__float_as_uint(m),__float_as_uint(m),false,false);
  return max2f(__uint_as_float(rr[0]),__uint_as_float(rr[1]));
}
__device__ __forceinline__ void pv(f32x16*o,int vb,bf16x8 pa0,bf16x8 pa1,bf16x8 pa2,bf16x8 pa3){
  #pragma unroll
  for(int d0=0;d0<2;++d0){s16x4 lo[4],hi[4];
    #pragma unroll
    for(int ks=0;ks<4;++ks){
      asm volatile("ds_read_b64_tr_b16 %0,%1 offset:%c2":"=&v"(lo[ks]):"v"(vb),"i"(d0*4096+ks*1024):"memory");
      asm volatile("ds_read_b64_tr_b16 %0,%1 offset:%c2":"=&v"(hi[ks]):"v"(vb),"i"(d0*4096+ks*1024+512):"memory");}
    asm volatile("s_waitcnt lgkmcnt(0)":::"memory");SBAR();
    #define PK(k) (bf16x8){lo[k][0],lo[k][1],lo[k][2],lo[k][3],hi[k][0],hi[k][1],hi[k][2],hi[k][3]}
    o[d0]=__builtin_amdgcn_mfma_f32_32x32x16_bf16(pa0,PK(0),o[d0],0,0,0);
    o[d0]=__builtin_amdgcn_mfma_f32_32x32x16_bf16(pa1,PK(1),o[d0],0,0,0);
    o[d0]=__builtin_amdgcn_mfma_f32_32x32x16_bf16(pa2,PK(2),o[d0],0,0,0);
    o[d0]=__builtin_amdgcn_mfma_f32_32x32x16_bf16(pa3,PK(3),o[d0],0,0,0);
    #undef PK
  }
}

#ifndef ATTN_STORE16
#define ATTN_STORE16(p,v) (*(u32x4*)(p)=(v))
#endif
template<int THRL> __device__ __forceinline__ void attn_unit(int qb,const bf16*Qh,const bf16*__restrict__ Kh,const bf16*__restrict__ Vh,bf16*Oh,char*shm){
  const int tid=tid_opaque(),lane=tid&63,r32=lane&31,hi=lane>>5; const int wid=__builtin_amdgcn_readfirstlane(tid>>6);
  const int q0=qb*QB;
  const bf16*Qw=Qh+(long)(q0+wid*QBLK)*PQ;
  const unsigned lds0=(unsigned)(uintptr_t)shm;
  float*wsf=(float*)(shm+LDS_WS)+wid*64;
  const bf16*ksrc=Kh+(long)lane*PQ+wid*8;
  const bf16*vsrc=Vh+(long)(16*(wid&3)+(lane>>2))*PQ+(wid>>2)*32+(lane&3)*8;
  const unsigned kdst=lds0+LDS_K+wid*1024, vdst=lds0+LDS_V+wid*1024;
  #define DMA_K(t,slot) glds16(ksrc+(long)(t)*KVBLK*PQ,(unsigned)__builtin_amdgcn_readfirstlane(kdst+(slot)))
  #define DMA_V(t,slot) glds16(vsrc+(long)(t)*KVBLK*PQ,(unsigned)__builtin_amdgcn_readfirstlane(vdst+(slot)))
  const int vb0=(int)(lds0+LDS_V)+((lane>>4)&1)*32+(lane&3)*8+(4*hi+((lane&15)>>2))*64;
  const char*Kbase=shm+LDS_K; bf16x8 kf[8];
  const lds_cptr shm3=(lds_cptr)shm; const lds_cptr kp0=shm3+LDS_K+hi*1024+r32*16; const lds_cptr vp0=shm3+LDS_V+((lane>>4)&1)*32+(lane&3)*8+(4*hi+((lane&15)>>2))*64;
  const int NT=(q0+QB)/KVBLK;
  DMA_K(0,0);DMA_V(0,0);DMA_K(1,SLOTB);
  bf16x8 qr[4];
  #pragma unroll
  for(int d0=0;d0<4;++d0)qr[d0]=*reinterpret_cast<const bf16x8*>(&Qw[(long)r32*PQ+d0*16+hi*8]);
  float mhat=0.f,l_reg=0.f;f32x16 o[2];o[0]=f32x16{};o[1]=f32x16{};f32x16 negm=f32x16{};asm volatile("":"+v"(negm));
  const int qrel=wid*QBLK+r32;
  #define CMASK(P0,P1,t) do{int jb_=(t)-(NT-4); if(jb_>=0)cmask(P0,P1,jb_,qrel,hi);}while(0)
  bool resc=false;
  #define START(P0,P1) do{ const float rm=rowmax(P0,P1); resc=false; \
    { const float dl=rm; mhat=fadd_s(mhat,dl); \
      _Pragma("unroll") for(int r=0;r<16;++r){P0[r]=fsub_s(P0[r],dl);P1[r]=fsub_s(P1[r],dl);} \
      _Pragma("unroll") for(int r=0;r<16;++r)negm[r]=-mhat; asm volatile("":"+v"(negm)); } \
    _Pragma("unroll") for(int r=0;r<16;++r)P0[r]=__builtin_amdgcn_exp2f(P0[r]); }while(0)
  #define RESC() do{ if(resc){ asm volatile("s_waitcnt lgkmcnt(0)":::"memory"); \
      _Pragma("unroll") for(int d_=0;d_<2;++d_) _Pragma("unroll") for(int r=0;r<16;++r)o[d_][r]*=wsf[crow(r,hi)]; } }while(0)
  f32x16 pA0,pA1,pB0,pB1;
  int sl_prev=0,sl_cur=0,sl_next=SLOTB;
  #define ROT() do{sl_prev=sl_cur;sl_cur=sl_next;sl_next=(sl_next==(NSLOT-1)*SLOTB)?0:sl_next+SLOTB;}while(0)
  DMA_K(2,2*SLOTB);
  WAIT_BAR(3);
  qkt(pA0,pA1,Kbase,qr,negm,r32,hi);asm volatile("s_nop 15\n\ts_nop 7":"+v"(pA0),"+v"(pA1));CMASK(pA0,pA1,0);
  START(pA0,pA1);
  _Pragma("unroll") for(int r=0;r<16;++r)pA1[r]=__builtin_amdgcn_exp2f(pA1[r]);
  WAIT_BAR(0);
  DMA_K(3,0);DMA_V(1,SLOTB);
  ROT();
  kload8(kf,kp0+sl_cur);
  WAIT_BAR(2);
  s16x4 vlo[8],vhi[8]; u32x4 pw0,pw1,pw2,pw3;
  #define PKW(P,B) cvtpk_s(P[B],P[B+1])
  #define PAF(k) __builtin_bit_cast(bf16x8,pw##k)
  #define VFR(i) (bf16x8){vlo[i][0],vlo[i][1],vlo[i][2],vlo[i][3],vhi[i][0],vhi[i][1],vhi[i][2],vhi[i][3]}
  #define PIN(x) asm volatile("":"+v"(x))
  #define MX3(a,b,c) __builtin_fmaxf(__builtin_fmaxf((a),(b)),(c))
  #define GAPA(MF,A0,A1,A2,A3,W0,W1,PW) do{ MF; sacc+=A0; sacc+=A1; sacc+=A2; sacc+=A3; PIN(sacc); W0; W1; PIN(PW); SBAR(); }while(0)
  #define EX(v) __builtin_amdgcn_exp2f(v)
  #define GAPB(MF,X,B) do{ MF; X[B]=EX(X[B]); X[B+1]=EX(X[B+1]); X[B+2]=EX(X[B+2]); X[B+3]=EX(X[B+3]); PIN(X); SBAR(); }while(0)
  #define VRD(i) do{ vlo[i]=vtr(vp_+(((i)>>2)*4096+((i)&3)*1024)); vhi[i]=vtr(vp_+(((i)>>2)*4096+((i)&3)*1024+512)); }while(0)
  #define KRD(G,j) do{ if(G){ kload2(kf,kp0+sl_next,j); SBAR(); } }while(0)
  #define STEP(C0,C1,P0,P1,t,GK,GV,GL) do{ SBAR(); \
    const lds_cptr vp_=vp0+sl_prev; \
    VRD(0); SBAR(); float sacc=(P0[0]+P0[1]); \
    GAPA(C0=__builtin_amdgcn_mfma_f32_32x32x16_bf16(kf[0],qr[0],negm,0,0,0), P0[2],P0[3],P0[4],P0[5],     pw0[0]=PKW(P0,0), pw0[1]=PKW(P0,2), pw0); \
    VRD(4); SBAR(); GAPA(C1=__builtin_amdgcn_mfma_f32_32x32x16_bf16(kf[1],qr[0],negm,0,0,0), P0[6],P0[7],P0[8],P0[9],     pw0[2]=PKW(P0,4), pw0[3]=PKW(P0,6), pw0); \
    VRD(1); SBAR(); GAPA(C0=__builtin_amdgcn_mfma_f32_32x32x16_bf16(kf[2],qr[1],C0,0,0,0),   P0[10],P0[11],P0[12],P0[13], pw1[0]=PKW(P0,8), pw1[1]=PKW(P0,10), pw1); \
    VRD(5); SBAR(); GAPA(C1=__builtin_amdgcn_mfma_f32_32x32x16_bf16(kf[3],qr[1],C1,0,0,0),   P0[14],P0[15],P1[0],P1[1],   pw1[2]=PKW(P0,12),pw1[3]=PKW(P0,14), pw1); \
    VRD(2); SBAR(); GAPA(C0=__builtin_amdgcn_mfma_f32_32x32x16_bf16(kf[4],qr[2],C0,0,0,0),   P1[2],P1[3],P1[4],P1[5],     pw2[0]=PKW(P1,0), pw2[1]=PKW(P1,2), pw2); \
    VRD(6); SBAR(); GAPA(C1=__builtin_amdgcn_mfma_f32_32x32x16_bf16(kf[5],qr[2],C1,0,0,0),   P1[6],P1[7],P1[8],P1[9],     pw2[2]=PKW(P1,4), pw2[3]=PKW(P1,6), pw2); \
    VRD(3); SBAR(); GAPA(C0=__builtin_amdgcn_mfma_f32_32x32x16_bf16(kf[6],qr[3],C0,0,0,0),   P1[10],P1[11],P1[12],P1[13], pw3[0]=PKW(P1,8), pw3[1]=PKW(P1,10), pw3); \
    VRD(7); SBAR(); GAPA(C1=__builtin_amdgcn_mfma_f32_32x32x16_bf16(kf[7],qr[3],C1,0,0,0),   P1[14],P1[15],0.f,0.f,       pw3[2]=PKW(P1,12),pw3[3]=PKW(P1,14), pw3); \
    l_reg+=sacc; \
    if(GK){DMA_K((t)+3,sl_cur);} if(GV){DMA_V((t)+1,sl_next);} \
    CMASK(C0,C1,t); \
    { float a=MX3(C0[0],C0[1],C1[0]),b=MX3(C0[2],C0[3],C1[1]); a=MX3(a,C1[2],C1[3]); \
      _Pragma("unroll") for(int r=4;r<16;r+=4){a=MX3(a,C0[r],C0[r+1]);b=MX3(b,C0[r+2],C0[r+3]);a=MX3(a,C1[r],C1[r+1]);b=MX3(b,C1[r+2],C1[r+3]);} \
      float rm=__builtin_fmaxf(a,b); { auto rr=__builtin_amdgcn_permlane32_swap(__float_as_uint(rm),__float_as_uint(rm),false,false); rm=__builtin_fmaxf(__uint_as_float(rr[0]),__uint_as_float(rr[1])); } \
      resc=false; \
      if(__builtin_expect(__any(rm>(float)THRL),0)){ const float dl=__builtin_fmaxf(rm,0.f); mhat+=dl; \
        _Pragma("unroll") for(int r=0;r<16;++r){C0[r]-=dl;C1[r]-=dl;} \
        _Pragma("unroll") for(int r=0;r<16;++r)negm[r]=-mhat; asm volatile("":"+v"(negm)); \
        const float f=__builtin_amdgcn_exp2f(-dl); l_reg*=f; if(hi==0)wsf[r32]=f; resc=true; } } \
    SBAR(); \
    GAPB(o[0]=__builtin_amdgcn_mfma_f32_32x32x16_bf16(PAF(0),VFR(0),o[0],0,0,0), C0,0); \
    GAPB(o[1]=__builtin_amdgcn_mfma_f32_32x32x16_bf16(PAF(0),VFR(4),o[1],0,0,0), C0,4); \
    KRD(GL,0); GAPB(o[0]=__builtin_amdgcn_mfma_f32_32x32x16_bf16(PAF(1),VFR(1),o[0],0,0,0), C0,8); \
    KRD(GL,1); GAPB(o[1]=__builtin_amdgcn_mfma_f32_32x32x16_bf16(PAF(1),VFR(5),o[1],0,0,0), C0,12); \
    KRD(GL,2); GAPB(o[0]=__builtin_amdgcn_mfma_f32_32x32x16_bf16(PAF(2),VFR(2),o[0],0,0,0), C1,0); \
    KRD(GL,3); GAPB(o[1]=__builtin_amdgcn_mfma_f32_32x32x16_bf16(PAF(2),VFR(6),o[1],0,0,0), C1,4); \
    GAPB(o[0]=__builtin_amdgcn_mfma_f32_32x32x16_bf16(PAF(3),VFR(3),o[0],0,0,0), C1,8); \
    GAPB(o[1]=__builtin_amdgcn_mfma_f32_32x32x16_bf16(PAF(3),VFR(7),o[1],0,0,0), C1,12); \
    }while(0)
  int t=1;
  #undef CMASK
  #define CMASK(P0,P1,t) do{}while(0)
  for(;t+5<NT;t+=2){
    STEP(pB0,pB1,pA0,pA1,t,true,true,true);     WAIT_BAR(2); RESC(); ROT();
    STEP(pA0,pA1,pB0,pB1,t+1,true,true,true);   WAIT_BAR(2); RESC(); ROT();
  }
  #undef CMASK
  #define CMASK(P0,P1,t) do{int jb_=(t)-(NT-4); if(jb_>=0)cmask(P0,P1,jb_,qrel,hi);}while(0)
  #define ENDW(tt) do{ if((tt)+3<NT){WAIT_BAR(2);} else if((tt)+2<NT){WAIT_BAR(1);} else {WAIT_BAR(0);} }while(0)
  for(;t+1<NT;t+=2){
    STEP(pB0,pB1,pA0,pA1,t,(t+3<NT),(t+1<NT),(t+1<NT));       ENDW(t);   RESC(); ROT();
    STEP(pA0,pA1,pB0,pB1,t+1,(t+4<NT),(t+2<NT),(t+2<NT));     ENDW(t+1); RESC(); ROT();
  }
  STEP(pB0,pB1,pA0,pA1,NT-1,false,false,false); RESC();
  { float sacc=pB0[0]+pB0[1]; _Pragma("unroll") for(int r=2;r<16;++r)sacc+=pB0[r]; _Pragma("unroll") for(int r=0;r<16;++r)sacc+=pB1[r]; l_reg+=sacc;
    pw0=(u32x4){PKW(pB0,0),PKW(pB0,2),PKW(pB0,4),PKW(pB0,6)};pw1=(u32x4){PKW(pB0,8),PKW(pB0,10),PKW(pB0,12),PKW(pB0,14)};pw2=(u32x4){PKW(pB1,0),PKW(pB1,2),PKW(pB1,4),PKW(pB1,6)};pw3=(u32x4){PKW(pB1,8),PKW(pB1,10),PKW(pB1,12),PKW(pB1,14)};
    SBAR(); pv(o,vb0+sl_cur,PAF(0),PAF(1),PAF(2),PAF(3)); }
  #undef PKW
  #undef PAF
  #undef VFR
  #undef PIN
  #undef MX3
  #undef GAPA
  #undef GAPB
  #undef EX
  #undef VRD
  #undef KRD
  #undef STEP
  #undef ENDW
  {auto rr=__builtin_amdgcn_permlane32_swap(__float_as_uint(l_reg),__float_as_uint(l_reg),false,false);l_reg=__uint_as_float(rr[0])+__uint_as_float(rr[1]);}
  if(hi==0)wsf[32+r32]=l_reg;asm volatile("s_waitcnt lgkmcnt(0)":::"memory");
  float rli[16];
  #pragma unroll
  for(int r=0;r<16;++r)rli[r]=__builtin_amdgcn_rcpf(wsf[32+crow(r,hi)]);
  bf16*Ow=Oh+(long)(q0+wid*QBLK)*PO;
  { bf16*stg=(bf16*)(shm+LDS_OST)+wid*2048;
    #pragma unroll
    for(int r=0;r<16;++r){const int orow=crow(r,hi);
      #pragma unroll
      for(int d0=0;d0<2;++d0)stg[orow*64+d0*32+r32]=__float2bfloat16(o[d0][r]*rli[r]);}
    asm volatile("s_waitcnt lgkmcnt(0)":::"memory");
    #pragma unroll
    for(int i=0;i<4;++i){const int row=i*8+(lane>>3),ch=lane&7; const u32x4 v=*(const u32x4*)(stg+row*64+ch*8); ATTN_STORE16(Ow+(long)row*PO+ch*8,v);} }
  asm volatile("s_waitcnt lgkmcnt(0)\n\ts_barrier":::"memory");
  #undef DMA_K
  #undef DMA_V
  #undef CMASK
  #undef START
  #undef RESC
  #undef ROT
}
constexpr int ATTN_LDS_BYTES=LDS_BYTES;
#undef SBAR
#undef WAIT_BAR
}
#include <hip/hip_cooperative_groups.h>
namespace cg = cooperative_groups;
constexpr int NWAVES = 8;
constexpr int BATCH = 16, SEQ = 2048, D = 1024, DEPTH = 4, FF = 4096, PLE = 256, INW = 2560, AW = 512, RW = 512;
constexpr int M = BATCH * SEQ;
constexpr size_t MiB = 1u << 20;
constexpr size_t WS_CS = 1 * MiB;
constexpr size_t WS_SSQ0 = 3 * MiB, WS_SSQ1 = 5 * MiB;
constexpr size_t WS_W = 8 * MiB, W_LAYER = 25 * MiB + 512 * 1024;
constexpr size_t WO_IN = 0, WO_OUT = 5 * MiB, WO_W1 = 7 * MiB, WO_W2 = 15 * MiB, WO_PG = 23 * MiB, WO_PP = 25 * MiB;
constexpr size_t WS_P16 = 110 * MiB;
constexpr size_t WS_XB0 = 126 * MiB;
constexpr size_t WS_R = 190 * MiB;
constexpr size_t WS_PROJ = WS_R;
constexpr size_t WS_OV = WS_R + 160 * MiB;
constexpr size_t WS_AO = WS_R + 224 * MiB;
constexpr size_t WS_HB = WS_R;
constexpr size_t WS_PP = WS_R;
constexpr size_t WS_END = WS_R + 288 * MiB;
static_assert(WS_W + DEPTH * W_LAYER <= WS_P16 && WS_P16 + (size_t)M * PLE * 2 <= WS_XB0 && WS_XB0 + (size_t)M * D * 2 <= WS_R && WS_HB + (size_t)M * FF * 2 <= WS_END, "d_ws map");
constexpr int RING_BYTES = 131072;
constexpr int LDS_BYTES = 147456;

#define GAS __attribute__((address_space(1)))
#define LAS __attribute__((address_space(3)))
typedef unsigned short bf16;
typedef unsigned v4u __attribute__((ext_vector_type(4)));
typedef float f32x4 __attribute__((ext_vector_type(4)));
typedef short bf16x8 __attribute__((ext_vector_type(8)));
#define LDS_WAIT() asm volatile("s_waitcnt lgkmcnt(0)" ::: "memory")
#define VM_WAIT() asm volatile("s_waitcnt vmcnt(0)" ::: "memory")
__device__ __forceinline__ unsigned f2bf(float f) { unsigned u = __builtin_bit_cast(unsigned, f); return (u + 0x7fffu + ((u >> 16) & 1u)) >> 16; }
__device__ __forceinline__ unsigned pk2(float lo, float hi) { unsigned r; asm("v_cvt_pk_bf16_f32 %0, %1, %2" : "=v"(r) : "v"(lo), "v"(hi)); return r; }
__device__ __forceinline__ float bf2f(unsigned short v) { return __uint_as_float((unsigned)v << 16); }
__device__ __forceinline__ float sigmoid_f(float x) { return __builtin_amdgcn_rcpf(1.f + __builtin_amdgcn_exp2f(-1.4426950408889634f * x)); }

typedef GAS unsigned gu32;
#define RLX_AGENT __ATOMIC_RELAXED, __HIP_MEMORY_SCOPE_AGENT
#define XB_TMO      128
#define XB_XCNT(j)  (256  + 64 * (j))
#define XB_XSUB(j)  (1280 + 64 * (j))
#define XB_XGEN(j)  (2304 + 64 * (j))
#define XB_TOP      3328
#define XB_TOPGEN   3392
#define XCD_BAR_WORDS 3456
#define XB_SPIN_CAP (1u << 18)

__device__ __forceinline__ unsigned xb_ld(unsigned* p)              { return __hip_atomic_load(p, __ATOMIC_RELAXED, __HIP_MEMORY_SCOPE_AGENT); }
__device__ __forceinline__ unsigned xb_add(unsigned* p, unsigned v) { return __hip_atomic_fetch_add(p, v, __ATOMIC_RELAXED, __HIP_MEMORY_SCOPE_AGENT); }
__device__ __forceinline__ unsigned xb_xcc_id() { return (unsigned)__builtin_amdgcn_s_getreg((3 << 11) | 20) & 0xFu; }
#define XB_SPIN(cond, bar) do { unsigned _sp = 0; while (cond) { __builtin_amdgcn_s_sleep(1); \
    if ((++_sp & 255u) == 0u) { if (xb_ld(&(bar)[XB_TMO])) break; if (_sp > XB_SPIN_CAP) { atomicAdd(&(bar)[XB_TMO], 1u); break; } } } } while (0)

struct XcdBarrier {
    unsigned* bar; unsigned x;
    volatile LAS unsigned* st;
};

__device__ __forceinline__ XcdBarrier xcd_barrier_post(unsigned* bar, volatile LAS unsigned* st) {
    XcdBarrier b; b.bar = bar; b.x = xb_xcc_id(); b.st = st;
    if (threadIdx.x == 0) (void)xb_add(&bar[XB_XCNT(b.x)], 1u);
    return b;
}
__device__ __forceinline__ void xcd_barrier_complete(unsigned* bar, unsigned x, unsigned& nloc, unsigned& nx) {
    const unsigned G = gridDim.x * gridDim.y * gridDim.z;
    unsigned sum, cnt, mine, sp = 0u;
    for (;;) {
        sum = 0u; cnt = 0u; mine = 0u;
#pragma unroll
        for (unsigned j = 0; j < 16; ++j) { const unsigned c = xb_ld(&bar[XB_XCNT(j)]); sum += c; cnt += (c > 0u) ? 1u : 0u; mine = (j == x) ? c : mine; }
        if (sum == G) break;
        __builtin_amdgcn_s_sleep(1);
        if ((++sp & 255u) == 0u) { if (xb_ld(&bar[XB_TMO])) break; if (sp > XB_SPIN_CAP) { atomicAdd(&bar[XB_TMO], 1u); break; } }
    }
    nloc = mine > 0u ? mine : 1u; nx = cnt > 0u ? cnt : 1u;
}

__device__ __forceinline__ void xcd_barrier(const XcdBarrier& b) {
    asm volatile("s_waitcnt vmcnt(0)" ::: "memory");
    __syncthreads();
    if (threadIdx.x == 0) {
        unsigned* bar = b.bar;
        __builtin_amdgcn_s_waitcnt(0);
        unsigned nloc = b.st[0], nx = b.st[1];
        if (nloc == 0u) { xcd_barrier_complete(bar, b.x, nloc, nx); b.st[0] = nloc; b.st[1] = nx; }
        const unsigned old = xb_add(&bar[XB_XSUB(b.x)], 1u);
        const unsigned gen = old / nloc;
        if (old + 1u == (gen + 1u) * nloc) {
            __builtin_amdgcn_fence(__ATOMIC_RELEASE, "agent");
            asm volatile("s_waitcnt vmcnt(0)" ::: "memory");
            const unsigned og = xb_add(&bar[XB_TOP], 1u);
            const unsigned tg = og / nx;
            if (og + 1u == (tg + 1u) * nx) xb_add(&bar[XB_TOPGEN], 1u);
            else XB_SPIN(xb_ld(&bar[XB_TOPGEN]) == tg, bar);
            __builtin_amdgcn_fence(__ATOMIC_ACQUIRE, "agent");
            xb_add(&bar[XB_XGEN(b.x)], 1u);
            asm volatile("s_waitcnt vmcnt(0)" ::: "memory");
        } else {
            XB_SPIN(xb_ld(&bar[XB_XGEN(b.x)]) == gen, bar);
            __builtin_amdgcn_fence(__ATOMIC_ACQUIRE, "agent");
            asm volatile("s_waitcnt vmcnt(0)" ::: "memory");
        }
    }
    __syncthreads();
}

struct Frame {
    LAS unsigned char* lds;
    LAS const unsigned long long* tab;
};
struct Who { int tid, lane, wave, vcu, G; };
__device__ __forceinline__ Who who() { Who w; w.tid = tid_opaque(); w.lane = w.tid & 63; w.wave = __builtin_amdgcn_readfirstlane(w.tid >> 6);
    int bx = blockIdx.x, G = gridDim.x; asm volatile("" : "+s"(bx), "+s"(G)); w.G = G; w.vcu = (G % 8 == 0) ? (bx % 8) * (G / 8) + bx / 8 : bx; return w; }
__device__ __forceinline__ int opaque_s(int v) { asm volatile("" : "+s"(v)); return v; }
__device__ __forceinline__ const void* ptab(LAS const unsigned long long* tab, int k) {
    const unsigned long long v = tab[k]; const unsigned lo = __builtin_amdgcn_readfirstlane((unsigned)v), hi = __builtin_amdgcn_readfirstlane((unsigned)(v >> 32));
    return (const void*)(((unsigned long long)hi << 32) | lo);
}
#define FIN(k) ((const float*)ptab(F.tab, (k)))
#define FOUT() ((float*)ptab(F.tab, 23))
#define FWS(off) ((unsigned char*)ptab(F.tab, 24) + (off))
enum { I_X = 0, I_P, I_POS, I_WIN, I_WOUT, I_GMIX, I_GSUBLN, I_LAMQ, I_LAMK, I_CONVW, I_CONVB, I_WGA, I_BGA, I_WGX, I_BGX, I_LRULAM, I_GMLP, I_WMLPIN, I_WMLPOUT, I_GPLE, I_WPLEGATE, I_WPLEPROJ, I_GFINAL };

__device__ __forceinline__ float wave_sum(float v) {
#pragma unroll
    for (int o = 1; o < 64; o <<= 1) v += __shfl_xor(v, o);
    return v;
}
__device__ __forceinline__ void p0_transpose_item(const float* W, const float* gain, int K, int N, bf16* WT, LAS float* scr, int item, int lane) {
    const int nblk = N / 32, kb = item / nblk, nb = item % nblk, k0 = 64 * kb, n0 = 32 * nb;
#pragma unroll 8
    for (int i = 0; i < 32; ++i) { const int kk = 2 * i + (lane >> 5); const float gk = gain ? gain[k0 + kk] : 1.f; scr[kk * 33 + (lane & 31)] = W[(size_t)(k0 + kk) * N + n0 + (lane & 31)] * gk; }
    LDS_WAIT(); asm volatile("" ::: "memory");
    const int c = lane & 7;
#pragma unroll
    for (int j = 0; j < 4; ++j) { const int n = (lane >> 3) + 8 * j; const LAS float* s = scr + (8 * c) * 33 + n;
        v4u o; o.x = pk2(s[0 * 33], s[1 * 33]); o.y = pk2(s[2 * 33], s[3 * 33]); o.z = pk2(s[4 * 33], s[5 * 33]); o.w = pk2(s[6 * 33], s[7 * 33]);
        *(GAS v4u*)(WT + (size_t)(n0 + n) * K + k0 + 8 * c) = o; }
    LDS_WAIT(); asm volatile("" ::: "memory");
}
__device__ __forceinline__ void p0_prologue(Frame& F) {
    const Who W = who();
    LAS float* scr = (LAS float*)(F.lds + W.wave * 16384);
    const int gw = W.vcu * NWAVES + W.wave, NGW = W.G * NWAVES;
    unsigned char* ws = FWS(0);
    const float *w_in = FIN(I_WIN), *w_out = FIN(I_WOUT), *w_mlp_in = FIN(I_WMLPIN), *w_mlp_out = FIN(I_WMLPOUT), *w_ple_gate = FIN(I_WPLEGATE), *w_ple_proj = FIN(I_WPLEPROJ), *g_mix = FIN(I_GMIX), *g_mlp = FIN(I_GMLP), *g_ple = FIN(I_GPLE);
    constexpr int I_IN = (D / 64) * (INW / 32), I_OUT = (D / 64) * (D / 32), I_1 = (D / 64) * (FF / 32), I_2 = (FF / 64) * (D / 32), I_PG = I_OUT, I_PP = (PLE / 64) * (D / 32);
    constexpr int PER_L = I_IN + I_OUT + I_1 + I_2 + I_PG + I_PP;
    for (int it = gw; it < DEPTH * PER_L; it += NGW) {
        const int l = it / PER_L; int r = it % PER_L; bf16* wl = (bf16*)(ws + WS_W + (size_t)l * W_LAYER);
        if (r < I_IN) { p0_transpose_item(w_in + (size_t)l * D * INW, g_mix + l * D, D, INW, (bf16*)((unsigned char*)wl + WO_IN), scr, r, W.lane); continue; } r -= I_IN;
        if (r < I_OUT) { p0_transpose_item(w_out + (size_t)l * D * D, nullptr, D, D, (bf16*)((unsigned char*)wl + WO_OUT), scr, r, W.lane); continue; } r -= I_OUT;
        if (r < I_1) { p0_transpose_item(w_mlp_in + (size_t)l * D * FF, g_mlp + l * D, D, FF, (bf16*)((unsigned char*)wl + WO_W1), scr, r, W.lane); continue; } r -= I_1;
        if (r < I_2) { p0_transpose_item(w_mlp_out + (size_t)l * FF * D, nullptr, FF, D, (bf16*)((unsigned char*)wl + WO_W2), scr, r, W.lane); continue; } r -= I_2;
        if (r < I_PG) { p0_transpose_item(w_ple_gate + (size_t)l * D * D, g_ple + l * D, D, D, (bf16*)((unsigned char*)wl + WO_PG), scr, r, W.lane); continue; } r -= I_PG;
        p0_transpose_item(w_ple_proj + (size_t)l * PLE * D, nullptr, PLE, D, (bf16*)((unsigned char*)wl + WO_PP), scr, r, W.lane);
    }
    const float* x_ = FIN(I_X); float* H_ = FOUT(); bf16* XB1_ = (bf16*)(ws + WS_OV); float* SSQ1_ = (float*)(ws + WS_SSQ1); float* CS_ = (float*)(ws + WS_CS); const int* pos_ = (const int*)FIN(I_POS);
#pragma unroll 2
    for (int m = gw; m < M; m += NGW) {
        const GAS f32x4* xr = (const GAS f32x4*)(x_ + (size_t)m * D) + W.lane; GAS f32x4* hr = (GAS f32x4*)(H_ + (size_t)m * D) + W.lane;
        GAS unsigned long long* o8 = (GAS unsigned long long*)(XB1_ + (size_t)m * D) + W.lane; float s = 0.f;
#pragma unroll
        for (int j = 0; j < 4; ++j) { const f32x4 v = xr[64 * j]; hr[64 * j] = v; s += (v.x * v.x + v.y * v.y) + (v.z * v.z + v.w * v.w);
            o8[64 * j] = (unsigned long long)pk2(v.x, v.y) | ((unsigned long long)pk2(v.z, v.w) << 32); }
        s = wave_sum(s);
        if (W.lane < 16) SSQ1_[(size_t)m * 16 + W.lane] = (W.lane == 0) ? s : 0.f;
    }
    for (int e = (W.vcu * NWAVES * 64 + W.tid); e < M * 8; e += W.G * NWAVES * 64) {
        const int m = e >> 3, i = e & 7;
        const float invf = (i == 0) ? 1.0f : (i == 1) ? 0.1939227432012558f : (i == 2) ? 0.03760603070259094f : (i == 3) ? 0.007292664609849453f : (i == 4) ? 0.0014142135623842478f : (i == 5) ? 0.00027424818836152554f : (i == 6) ? 5.3182957344688475e-05f : 1.0313385246263351e-05f;
        const float ang = (float)pos_[m] * invf;
        const double rev = (double)ang * 0.15915494309189535; const double fr = rev - __builtin_rint(rev);
        const float frf = (float)fr;
        CS_[(size_t)m * 16 + i] = __builtin_amdgcn_cosf(frf); CS_[(size_t)m * 16 + 8 + i] = __builtin_amdgcn_sinf(frf);
    }
}
__device__ __forceinline__ void convert_p(Frame& F, int l) {
    const Who W = who();
    const float* src = FIN(I_P) + (size_t)l * M * PLE; bf16* P16_ = (bf16*)FWS(WS_P16);
#pragma unroll 4
    for (size_t e = (size_t)W.vcu * NWAVES * 64 + W.tid; e < (size_t)M * PLE / 8; e += (size_t)W.G * NWAVES * 64) {
        const f32x4 a = *(const GAS f32x4*)(src + e * 8), b = *(const GAS f32x4*)(src + e * 8 + 4);
        v4u o; o.x = pk2(a.x, a.y); o.y = pk2(a.z, a.w); o.z = pk2(b.x, b.y); o.w = pk2(b.z, b.w);
        *(GAS v4u*)(P16_ + e * 8) = o; }
}
__device__ __forceinline__ void final_norm(Frame& F) {
    const Who W = who();
    const int gw = W.vcu * NWAVES + W.wave, NGW = W.G * NWAVES;
    const float* SSQ1_ = (const float*)FWS(WS_SSQ1); float* H_ = FOUT(); const float* gf_ = FIN(I_GFINAL);
    for (int m = gw; m < M; m += NGW) {
        const float rs = pg8::row_rs(SSQ1_, m);
        GAS f32x4* hr = (GAS f32x4*)(H_ + (size_t)m * D) + W.lane; const GAS f32x4* gr = (const GAS f32x4*)gf_ + W.lane;
#pragma unroll
        for (int j = 0; j < 4; ++j) { const f32x4 v = hr[64 * j], g = gr[64 * j]; hr[64 * j] = v * rs * g; }
    }
}

__device__ __forceinline__ void lru_item(Frame& F, int l, int item) {
    const int b = item >> 4, g = (item >> 1) & 7, hf = item & 1;
    const int tid_ = tid_opaque(), lane = tid_ & 63, w = __builtin_amdgcn_readfirstlane(tid_ >> 6), r = lane & 15, q = lane >> 4;
    LAS float* xcs = (LAS float*)(F.lds + w * 4352);
    LAS float* car = (LAS float*)(F.lds + 36864);
    const bf16* pj = (const bf16*)FWS(WS_PROJ) + (size_t)b * SEQ * INW;
    bf16* ao = (bf16*)FWS(WS_AO) + (size_t)b * SEQ * D;
    const int cch = g * 64 + lane;
    const float* conv_w = FIN(I_CONVW);
    const float cw0 = conv_w[(l * 4 + 0) * RW + cch], cw1 = conv_w[(l * 4 + 1) * RW + cch], cw2 = conv_w[(l * 4 + 2) * RW + cch], cw3 = conv_w[(l * 4 + 3) * RW + cch], cb = FIN(I_CONVB)[l * RW + cch];
    bf16x8 Bf[2][2][2];
#pragma unroll
    for (int gate = 0; gate < 2; ++gate) { const float* W = (gate ? FIN(I_WGX) : FIN(I_WGA)) + (size_t)(l * 8 + g) * 64 * 64;
#pragma unroll
        for (int n = 0; n < 2; ++n)
#pragma unroll
            for (int kk = 0; kk < 2; ++kk) { const float* wp = W + (size_t)(32 * kk + 8 * q) * 64 + hf * 32 + 16 * n + r; v4u pw;
                pw.x = pk2(wp[0 * 64], wp[1 * 64]); pw.y = pk2(wp[2 * 64], wp[3 * 64]); pw.z = pk2(wp[4 * 64], wp[5 * 64]); pw.w = pk2(wp[6 * 64], wp[7 * 64]);
                Bf[gate][n][kk] = __builtin_bit_cast(bf16x8, pw); } }
    float ba[2], bx[2], sp8[2];
#pragma unroll
    for (int n = 0; n < 2; ++n) { const int ch = l * RW + g * 64 + hf * 32 + 16 * n + r; ba[n] = FIN(I_BGA)[ch]; bx[n] = FIN(I_BGX)[ch];
        const float z = -FIN(I_LRULAM)[ch]; sp8[n] = 8.f * (fmaxf(z, 0.f) + log1pf(__expf(-fabsf(z)))); }
    float hin[2] = {0.f, 0.f};
    const int t0 = w * 256;
    const bf16* xcol = pj + 3 * AW + cch;
    const bf16* gcol = pj + 3 * AW + RW + g * 64 + hf * 32 + r;
    bf16* ycol = ao + AW + g * 64 + hf * 32 + r;
#pragma unroll 1
    for (int pass = 0; pass < 2; ++pass) {
        float h3 = 0.f, h2 = 0.f, h1 = 0.f;
        if (t0 != 0) { h3 = bf2f(xcol[(size_t)(t0 - 3) * INW]); h2 = bf2f(xcol[(size_t)(t0 - 2) * INW]); h1 = bf2f(xcol[(size_t)(t0 - 1) * INW]); }
        float hrun[2] = {pass ? hin[0] : 0.f, pass ? hin[1] : 0.f}, Arun[2] = {1.f, 1.f};
        unsigned short xq[16];
#pragma unroll
        for (int tt = 0; tt < 16; ++tt) xq[tt] = xcol[(size_t)(t0 + tt) * INW];
#pragma unroll 1
        for (int sc = 0; sc < 16; ++sc) {
            const int ts = t0 + sc * 16, tn = (sc < 15) ? ts + 16 : ts;
            unsigned short xn[16];
#pragma unroll
            for (int tt = 0; tt < 16; ++tt) xn[tt] = xcol[(size_t)(tn + tt) * INW];
            unsigned short gq[2][4];
            if (pass) {
#pragma unroll
                for (int n = 0; n < 2; ++n)
#pragma unroll
                    for (int i = 0; i < 4; ++i) gq[n][i] = gcol[(size_t)(ts + 4 * q + i) * INW + 16 * n];
            } else {
#pragma unroll
                for (int n = 0; n < 2; ++n)
#pragma unroll
                    for (int i = 0; i < 4; ++i) gq[n][i] = 0;
            }
#pragma unroll
            for (int tt = 0; tt < 16; ++tt) { const float xv = bf2f(xq[tt]); const float xc = cb + cw0 * h3 + cw1 * h2 + cw2 * h1 + cw3 * xv; h3 = h2; h2 = h1; h1 = xv; xcs[tt * 68 + lane] = xc; }
            asm volatile("s_waitcnt lgkmcnt(0)" ::: "memory");
            bf16x8 Af[2];
#pragma unroll
            for (int kk = 0; kk < 2; ++kk) { const LAS f32x4* ap = (const LAS f32x4*)(xcs + r * 68 + 32 * kk + 8 * q); const f32x4 a0 = ap[0], a1 = ap[1];
                v4u pw; pw.x = pk2(a0.x, a0.y); pw.y = pk2(a0.z, a0.w); pw.z = pk2(a1.x, a1.y); pw.w = pk2(a1.z, a1.w); Af[kk] = __builtin_bit_cast(bf16x8, pw); }
            f32x4 Da[2], Dx[2];
#pragma unroll
            for (int n = 0; n < 2; ++n) { Da[n] = (f32x4){0.f, 0.f, 0.f, 0.f}; Dx[n] = Da[n];
#pragma unroll
                for (int kk = 0; kk < 2; ++kk) { Da[n] = __builtin_amdgcn_mfma_f32_16x16x32_bf16(Af[kk], Bf[0][n][kk], Da[n], 0, 0, 0); Dx[n] = __builtin_amdgcn_mfma_f32_16x16x32_bf16(Af[kk], Bf[1][n][kk], Dx[n], 0, 0, 0); } }
#pragma unroll
            for (int n = 0; n < 2; ++n) {
                float a[4], bb[4];
#pragma unroll
                for (int i = 0; i < 4; ++i) { const float xcv = xcs[(4 * q + i) * 68 + hf * 32 + 16 * n + r];
                    const float ra = sigmoid_f(Da[n][i] + ba[n]), ix = sigmoid_f(Dx[n][i] + bx[n]);
                    const float la = -ra * sp8[n]; const float av = __builtin_amdgcn_exp2f(1.4426950408889634f * la);
                    const float y2 = 2.f * la;
                    const float ser = -y2 * (1.f + y2 * (0.5f + y2 * (0.16666667f + y2 * (0.041666668f + y2 * 0.008333334f))));
                    const float em = (y2 > -0.25f) ? ser : (1.f - av * av);
                    a[i] = av; bb[i] = __builtin_amdgcn_sqrtf(fmaxf(em, 0.f)) * (ix * xcv); }
                const float Al = (a[0] * a[1]) * (a[2] * a[3]);
                const float Hl = ((bb[0] * a[1] + bb[1]) * a[2] + bb[2]) * a[3] + bb[3];
                const float A0 = __shfl(Al, r), A1 = __shfl(Al, r + 16), A2 = __shfl(Al, r + 32), A3 = __shfl(Al, r + 48);
                const float H0 = __shfl(Hl, r), H1 = __shfl(Hl, r + 16), H2 = __shfl(Hl, r + 32), H3 = __shfl(Hl, r + 48);
                const float c0 = hrun[n], c1 = A0 * c0 + H0, c2 = A1 * c1 + H1, c3 = A2 * c2 + H2, c4 = A3 * c3 + H3;
                hrun[n] = c4; Arun[n] *= (A0 * A1) * (A2 * A3);
                if (pass) { float h = (q == 0) ? c0 : (q == 1) ? c1 : (q == 2) ? c2 : c3;
#pragma unroll
                    for (int i = 0; i < 4; ++i) { h = a[i] * h + bb[i]; const float gv = bf2f(gq[n][i]);
                        const float ge = gv * sigmoid_f(1.5957691216057308f * (gv + 0.044715f * gv * gv * gv));
                        ycol[(size_t)(ts + 4 * q + i) * D + 16 * n] = (bf16)(pk2(h * ge, 0.f) & 0xffffu); } }
            }
#pragma unroll
            for (int tt = 0; tt < 16; ++tt) xq[tt] = xn[tt];
        }
        if (pass == 0) {
            if (q == 0) {
#pragma unroll
                for (int n = 0; n < 2; ++n) { car[w * 64 + n * 16 + r] = Arun[n]; car[w * 64 + 32 + n * 16 + r] = hrun[n]; } }
            __syncthreads();
#pragma unroll
            for (int n = 0; n < 2; ++n) { float h = 0.f; for (int w2 = 0; w2 < w; ++w2) h = car[w2 * 64 + n * 16 + r] * h + car[w2 * 64 + 32 + n * 16 + r]; hin[n] = h; }
        }
    }
    __syncthreads();
}

__device__ __forceinline__ void attn_post(Frame& F, int l, int b, int h, int qb, float lam, float oscale) {
    const int tid_ = tid_opaque(), lane = tid_ & 63, wave_ = __builtin_amdgcn_readfirstlane(tid_ >> 6), rsub = lane >> 4, e8 = (lane & 15) * 8;
    const float* gs = FIN(I_GSUBLN) + l * 128 + e8; const bf16* OV_ = (const bf16*)FWS(WS_OV); bf16* AO_ = (bf16*)FWS(WS_AO); const f32x4 g0 = *(const f32x4*)gs, g1 = *(const f32x4*)(gs + 4);
    const size_t rowbase = (size_t)b * SEQ + qb * 256 + wave_ * 32;
#pragma unroll 4
    for (int it = 0; it < 8; ++it) { const size_t row = rowbase + it * 4 + rsub;
        const v4u a = *(const GAS v4u*)(OV_ + row * D + h * 256 + e8), c = *(const GAS v4u*)(OV_ + row * D + h * 256 + 128 + e8);
        f32x4 d0 = {pg8::bf_lo(a.x) - lam * pg8::bf_lo(c.x), pg8::bf_hi(a.x) - lam * pg8::bf_hi(c.x), pg8::bf_lo(a.y) - lam * pg8::bf_lo(c.y), pg8::bf_hi(a.y) - lam * pg8::bf_hi(c.y)};
        f32x4 d1 = {pg8::bf_lo(a.z) - lam * pg8::bf_lo(c.z), pg8::bf_hi(a.z) - lam * pg8::bf_hi(c.z), pg8::bf_lo(a.w) - lam * pg8::bf_lo(c.w), pg8::bf_hi(a.w) - lam * pg8::bf_hi(c.w)};
        float ss = pg8::sumsq8(d0, d1);
        ss += __shfl_xor(ss, 1); ss += __shfl_xor(ss, 2); ss += __shfl_xor(ss, 4); ss += __shfl_xor(ss, 8);
        const float rs = __builtin_amdgcn_rsqf(ss * (1.f / 128.f) + 1e-6f) * oscale;
        d0 = d0 * rs * g0; d1 = d1 * rs * g1;
        v4u o; o.x = pk2(d0.x, d0.y); o.y = pk2(d0.z, d0.w); o.z = pk2(d1.x, d1.y); o.w = pk2(d1.z, d1.w);
        *(GAS v4u*)(AO_ + row * D + h * 128 + e8) = o; }
}

struct Args { const void* in[23]; float* out; unsigned char* ws; int ph_lo, ph_hi; };
constexpr int N_PHASES = 2 + 6 * DEPTH;
__global__ void __launch_bounds__(NWAVES * 64, 2) hymba_fwd(Args args) {
    extern __shared__ __attribute__((aligned(16))) unsigned char lds[];
    cg::grid_group grid = cg::this_grid();
    Frame F;
    F.lds = (LAS unsigned char*)lds;
    { LAS unsigned long long* tabw = (LAS unsigned long long*)(F.lds + RING_BYTES + 1024);
      if (threadIdx.x == 0) {
#pragma unroll
          for (int k = 0; k < 23; ++k) tabw[k] = (unsigned long long)args.in[k];
          tabw[23] = (unsigned long long)args.out; tabw[24] = (unsigned long long)args.ws; }
      F.tab = tabw; }
    __syncthreads();
    const int lo = args.ph_lo, hi = args.ph_hi;
#define IN(k) (lo <= (k) && (k) < hi)
#define SEAM(k) do { if (IN(k) && IN((k) + 1)) xcd_barrier(bar); } while (0)

    if (blockIdx.x == 0) { unsigned* bw = (unsigned*)args.ws; for (int u = threadIdx.x; u < XCD_BAR_WORDS; u += NWAVES * 64) bw[u] = 0u; }
    if (threadIdx.x < 2) ((volatile LAS unsigned*)(F.lds + RING_BYTES + 2048))[threadIdx.x] = 0u;
    if (IN(0)) { p0_prologue(F); }
    grid.sync();
    XcdBarrier bar = xcd_barrier_post((unsigned*)args.ws, (volatile LAS unsigned*)(F.lds + RING_BYTES + 2048));

#pragma unroll 1
    for (int l_ = 0; l_ < DEPTH; ++l_) {
        const int pb = 1 + 6 * l_;
        if (IN(pb + 0)) {
            const Who W = who(); const int l = opaque_s(l_);
            unsigned char* ws = FWS(0); const unsigned char* wl = ws + WS_W + (size_t)l * W_LAYER;
            pg8::Gemm g{(const bf16*)(ws + WS_OV), (const bf16*)(wl + WO_IN), M, INW, D}; pg8::StaticOrder S; S.init(M, INW, W.G, opaque_s((int)blockIdx.x));
            pg8::EpiIn E{(bf16*)(ws + WS_PROJ), INW, (const float*)(ws + WS_SSQ1), (const float*)(ws + WS_CS), attn_body::C2};
            pg8::gemm_phase<pg8::EpiIn, pg8::StaticOrder, true, true>(F.lds, g, S, E);
        }
        SEAM(pb + 0);
        if (IN(pb + 1)) {
            const Who W = who(); const int l = opaque_s(l_);
            float lam, oscale;
            { const float* lq = FIN(I_LAMQ) + l * 128; const float* lk = FIN(I_LAMK) + l * 128;
              const float d0 = wave_sum(lq[W.lane] * lk[W.lane]), d1 = wave_sum(lq[64 + W.lane] * lk[64 + W.lane]);
              const float li = 0.8f - 0.6f * __expf(-0.3f * (float)l); lam = __expf(d0) - __expf(d1) + li; oscale = 1.f - li; }
            for (int item = W.vcu; item < 256; item += W.G) {
                const int bh = item >> 2, s = item & 3, b = bh >> 2, h = bh & 3;
                const attn_body::bf16* pj = (const attn_body::bf16*)((const bf16*)FWS(WS_PROJ) + (size_t)b * SEQ * INW); attn_body::bf16* ov = (attn_body::bf16*)((bf16*)FWS(WS_OV) + (size_t)b * SEQ * D);
#pragma unroll 1
                for (int k = 0; k < 2; ++k) { const int qb = k ? 7 - s : s;
#pragma unroll 1
                    for (int j = 0; j < 4; ++j) { const int c = j >> 1, vh = j & 1;
                        attn_body::attn_unit<8>(qb, pj + (h * 2 + c) * 64, pj + AW + (h * 2 + c) * 64, pj + 2 * AW + h * 128 + vh * 64, ov + h * 256 + c * 128 + vh * 64, (char*)lds); }
                    VM_WAIT(); __syncthreads(); __builtin_amdgcn_fence(__ATOMIC_ACQUIRE, "agent"); VM_WAIT();
                    attn_post(F, l, b, h, qb, lam, oscale);
                }
            }
            __syncthreads();
            for (int item = W.vcu; item < 256; item += W.G) lru_item(F, l, item);
        }
        SEAM(pb + 1);
        if (IN(pb + 2)) {
            const Who W = who(); const int l = opaque_s(l_);
            unsigned char* ws = FWS(0); const unsigned char* wl = ws + WS_W + (size_t)l * W_LAYER;
            pg8::Gemm g{(const bf16*)(ws + WS_AO), (const bf16*)(wl + WO_OUT), M, D, D}; pg8::StaticOrder S; S.init(M, D, W.G, opaque_s((int)blockIdx.x));
            pg8::EpiRes E{FOUT(), (bf16*)(ws + WS_XB0), (float*)(ws + WS_SSQ0)};
            pg8::gemm_phase<pg8::EpiRes, pg8::StaticOrder, true, true>(F.lds, g, S, E);
        }
        SEAM(pb + 2);
        if (IN(pb + 3)) {
            const Who W = who(); const int l = opaque_s(l_);
            convert_p(F, l);
            unsigned char* ws = FWS(0); const unsigned char* wl = ws + WS_W + (size_t)l * W_LAYER;
            pg8::Gemm g{(const bf16*)(ws + WS_XB0), (const bf16*)(wl + WO_W1), M, FF, D}; pg8::StaticOrder S; S.init(M, FF, W.G, opaque_s((int)blockIdx.x));
            pg8::EpiMlpIn E{(bf16*)(ws + WS_HB), FF, (const float*)(ws + WS_SSQ0)};
            pg8::gemm_phase<pg8::EpiMlpIn, pg8::StaticOrder, true, true>(F.lds, g, S, E);
        }
        SEAM(pb + 3);
        if (IN(pb + 4)) {
            const Who W = who(); const int l = opaque_s(l_);
            unsigned char* ws = FWS(0); const unsigned char* wl = ws + WS_W + (size_t)l * W_LAYER;
            pg8::Gemm g{(const bf16*)(ws + WS_HB), (const bf16*)(wl + WO_W2), M, D, FF}; pg8::StaticOrder S; S.init(M, D, W.G, opaque_s((int)blockIdx.x));
            pg8::EpiRes E{FOUT(), (bf16*)(ws + WS_XB0), (float*)(ws + WS_SSQ0)};
            pg8::gemm_phase<pg8::EpiRes, pg8::StaticOrder, true, true>(F.lds, g, S, E);
        }
        SEAM(pb + 4);
        if (IN(pb + 5)) {
            const Who W = who(); const int l = opaque_s(l_);
            { unsigned char* ws = FWS(0); const unsigned char* wl = ws + WS_W + (size_t)l * W_LAYER;
              pg8::Gemm g{(const bf16*)(ws + WS_P16), (const bf16*)(wl + WO_PP), M, D, opaque_s(PLE)}; pg8::StaticOrder S; S.init(M, D, W.G, opaque_s((int)blockIdx.x));
              pg8::EpiPlain E{(bf16*)(ws + WS_PP), D};
              pg8::gemm_phase<pg8::EpiPlain, pg8::StaticOrder, true, true>(F.lds, g, S, E); }
            VM_WAIT(); __syncthreads();
            { unsigned char* ws = FWS(0); const unsigned char* wl = ws + WS_W + (size_t)l * W_LAYER;
              pg8::Gemm g{(const bf16*)(ws + WS_XB0), (const bf16*)(wl + WO_PG), M, D, D}; pg8::StaticOrder S; S.init(M, D, W.G, opaque_s((int)blockIdx.x));
              pg8::EpiPle E{FOUT(), (bf16*)(ws + WS_OV), (const float*)(ws + WS_SSQ0), (float*)(ws + WS_SSQ1), (const bf16*)(ws + WS_PP)};
              pg8::gemm_phase<pg8::EpiPle, pg8::StaticOrder, true, true>(F.lds, g, S, E); }
        }
        SEAM(pb + 5);
    }
    if (IN(N_PHASES - 1)) final_norm(F);
#undef IN
#undef SEAM
}

extern "C" void kernel_launch(void* const* d_in, const int* in_sizes, int n_in, void* d_out, int out_size, void* d_ws, size_t ws_size, hipStream_t stream) {
    static int grid = 0;
    if (grid == 0) {
        if (n_in != 23 || in_sizes[0] != M * D || out_size != M * D || ws_size < WS_END) { fprintf(stderr, "kernel_launch: unexpected shapes: n_in %d in0 %d out %d ws %zu (need %zu); nothing launched\n", n_in, n_in > 0 ? in_sizes[0] : -1, out_size, ws_size, (size_t)WS_END); grid = -1; return; }
        int dev = 0, cus = 0, per_cu = 0;
        if (hipGetDevice(&dev) != hipSuccess || hipDeviceGetAttribute(&cus, hipDeviceAttributeMultiprocessorCount, dev) != hipSuccess) { grid = -1; return; }
        if (hipFuncSetAttribute((const void*)hymba_fwd, hipFuncAttributeMaxDynamicSharedMemorySize, LDS_BYTES) != hipSuccess) { fprintf(stderr, "kernel_launch: hipFuncSetAttribute failed\n"); grid = -1; return; }
        if (hipOccupancyMaxActiveBlocksPerMultiprocessor(&per_cu, (const void*)hymba_fwd, NWAVES * 64, LDS_BYTES) != hipSuccess || per_cu < 1) { fprintf(stderr, "kernel_launch: occupancy query reports %d\n", per_cu); per_cu = 1; }
        (void)hipGetLastError();
        grid = cus * per_cu;
    }
    if (grid < 0) return;
    Args a{};
    for (int i = 0; i < 23; ++i) a.in[i] = d_in[i];
    a.out = (float*)d_out; a.ws = (unsigned char*)d_ws;
#ifndef MK_CUTS
    a.ph_lo = 0; a.ph_hi = N_PHASES;
    void* kargs[] = {&a};
    hipError_t e = hipLaunchCooperativeKernel((const void*)hymba_fwd, dim3(grid), dim3(NWAVES * 64), kargs, LDS_BYTES, stream);
    if (e != hipSuccess) fprintf(stderr, "kernel_launch: cooperative launch failed: %s (grid %d)\n", hipGetErrorString(e), grid);
#else
    for (int ph = 0; ph < N_PHASES; ++ph) { a.ph_lo = ph; a.ph_hi = ph + 1; void* kargs[] = {&a};
        hipError_t e = hipLaunchCooperativeKernel((const void*)hymba_fwd, dim3(grid), dim3(NWAVES * 64), kargs, LDS_BYTES, stream);
        if (e != hipSuccess) { fprintf(stderr, "kernel_launch: launch %d failed: %s\n", ph, hipGetErrorString(e)); break; } }
#endif
}
```

```cpp
#include <hip/hip_runtime.h>
#include <cstdio>
#include <cstdint>
__device__ __forceinline__ int tid_opaque() { int t = threadIdx.x; asm volatile("" : "+v"(t)); return t; }
namespace pg8 {
#define PG8_LAS __attribute__((address_space(3)))
typedef unsigned short bf16_t;
typedef short bf16x8 __attribute__((ext_vector_type(8)));
typedef float f32x4 __attribute__((ext_vector_type(4)));
typedef unsigned u32x4 __attribute__((ext_vector_type(4)));
constexpr int BM = 256, BK = 64, HALF = 128, HTB = HALF * BK * 2  , STAGE_BYTES = 8 * HTB, NXCD = 8, WGM = 8;

__host__ __device__ __forceinline__ int lds_byte(int r, int c) { const int st = (r >> 4) * 2 + (c >> 5), rr = r & 15, cc = c & 31, ob = rr * 64 + cc * 2; return st * 1024 + (ob ^ (((ob >> 9) & 1) << 5)); }
__host__ __device__ __forceinline__ void stage_rc(int b, int& R, int& C) { const int st = b / 1024, sb = b % 1024, swz = sb ^ (((sb >> 9) & 1) << 5); R = (st >> 1) * 16 + swz / 64; C = (st & 1) * 32 + (swz % 64) / 2; }
__host__ __device__ __forceinline__ int perm32(int rho) { const int n = rho >> 4, i = rho & 15; return 8 * (i >> 2) + 4 * n + (i & 3); }

struct Unit { int pm, pn; };
struct Gemm { const bf16_t* A; const bf16_t* Bt; int M, N, K; };

struct StaticOrder {
    int nM, nN, nwg, G, c;
    __host__ __device__ void init(int M, int N, int G_, int c_) { nM = M / BM; nN = N / BM; nwg = nM * nN; G = G_; c = c_; }
    __host__ __device__ bool next(int i, Unit& u) const {
        const long L = (long)i * G + c; if (L >= nwg) return false;
        int wgid = (int)L; { const int q = nwg / NXCD, r = nwg % NXCD, xcd = wgid % NXCD, off = wgid / NXCD; wgid = (xcd < r ? xcd * (q + 1) : r * (q + 1) + (xcd - r) * q) + off; }
        const int nig = WGM * nN, gid = wgid / nig, fm = gid * WGM, gsz = (nM - fm) < WGM ? (nM - fm) : WGM;
        u.pm = fm + ((wgid % nig) % gsz); u.pn = (wgid % nig) / gsz; return true;
    }
    __device__ __forceinline__ void a_ready(const Unit&) const {}
    __device__ __forceinline__ void done(const Unit&) const {}
};

__device__ __forceinline__ unsigned cvt_pk_bf16(float lo, float hi) { unsigned r; asm volatile("v_cvt_pk_bf16_f32 %0, %1, %2" : "=v"(r) : "v"(lo), "v"(hi)); return r; }
__device__ __forceinline__ u32x4 pack8(const f32x4 v0, const f32x4 v1) { u32x4 w; w.x = cvt_pk_bf16(v0[0], v0[1]); w.y = cvt_pk_bf16(v0[2], v0[3]); w.z = cvt_pk_bf16(v1[0], v1[1]); w.w = cvt_pk_bf16(v1[2], v1[3]); return w; }
__device__ __forceinline__ float bf_lo(unsigned w) { return __uint_as_float(w << 16); }
__device__ __forceinline__ float bf_hi(unsigned w) { return __uint_as_float(w & 0xffff0000u); }
constexpr int DMODEL = 1024;
constexpr float RMS_EPS = 1e-6f;
__device__ __forceinline__ float row_rs(const float* ssq, int row) {
    const f32x4* p = (const f32x4*)(ssq + (size_t)row * 16);
    const f32x4 a = p[0], b = p[1], c = p[2], d = p[3];
    const float s = (((a[0] + a[1]) + (a[2] + a[3])) + ((b[0] + b[1]) + (b[2] + b[3]))) + (((c[0] + c[1]) + (c[2] + c[3])) + ((d[0] + d[1]) + (d[2] + d[3])));
    return __builtin_amdgcn_rsqf(s * (1.0f / DMODEL) + RMS_EPS);
}
__device__ __forceinline__ float sumsq8(const f32x4 a, const f32x4 b) { return ((a[0] * a[0] + a[1] * a[1]) + (a[2] * a[2] + a[3] * a[3])) + ((b[0] * b[0] + b[1] * b[1]) + (b[2] * b[2] + b[3] * b[3])); }

struct EpiPlain {
    static constexpr bool PERM = true, AFTER_DRAIN = false;
    bf16_t* O; int ldc;
    __device__ __forceinline__ void operator()(const f32x4 (&acc)[2][2][4][2], const Unit& u, int wr, int wc, int fr, int fq) const {
        const int row0 = u.pm * BM + wr * 64 + fr, col0 = u.pn * BM + wc * 32 + 8 * fq;
#pragma unroll
        for (int ai = 0; ai < 2; ++ai)
#pragma unroll
            for (int m = 0; m < 4; ++m) { bf16_t* rowp = O + (size_t)(row0 + ai * HALF + m * 16) * ldc + col0;
#pragma unroll
                for (int bj = 0; bj < 2; ++bj) *(u32x4*)(rowp + bj * HALF) = pack8(acc[ai][bj][m][0], acc[ai][bj][m][1]); }
    }
};
__device__ __forceinline__ void row_rs8(float (&rs)[8], const float* ssq, int row0, int fq) {
    f32x4 p[8];
#pragma unroll
    for (int i = 0; i < 8; ++i) p[i] = *(const f32x4*)(ssq + (size_t)(row0 + (i >> 2) * HALF + (i & 3) * 16) * 16 + 4 * fq);
#pragma unroll
    for (int i = 0; i < 8; ++i) { float s = (p[i][0] + p[i][1]) + (p[i][2] + p[i][3]); s += __shfl_xor(s, 16); s += __shfl_xor(s, 32); rs[i] = __builtin_amdgcn_rsqf(s * (1.0f / DMODEL) + RMS_EPS); }
}
struct EpiIn {
    static constexpr bool PERM = true, AFTER_DRAIN = false;
    bf16_t* O; int ldc; const float* ssq; const int* pos; float qscale;
    __device__ __forceinline__ void operator()(const f32x4 (&acc)[2][2][4][2], const Unit& u, int wr, int wc, int fr, int fq) const {
        const int row0 = u.pm * BM + wr * 64 + fr, col0 = u.pn * BM + wc * 32 + 8 * fq;
        const bool rope = (u.pn < 4) && !(wc & 1);
        const float sc = (u.pn < 2) ? qscale : 1.f;
        float rs[8]; row_rs8(rs, ssq, row0, fq);
        if (rope) {
            int ps[8];
#pragma unroll
            for (int i = 0; i < 8; ++i) ps[i] = pos[row0 + (i >> 2) * HALF + (i & 3) * 16];
            const bool mine = fq < 2; const float sgn = (fq == 0) ? -1.f : 1.f;
            const float invf[8] = {1.0f, 0.1939227432012558f, 0.03760603070259094f, 0.007292664609849453f, 0.0014142135623842478f, 0.00027424818836152554f, 5.3182957344688475e-05f, 1.0313385246263351e-05f};
#pragma unroll
            for (int ai = 0; ai < 2; ++ai)
#pragma unroll
                for (int m = 0; m < 4; ++m) { const int row = row0 + ai * HALF + m * 16; const float r = rs[ai * 4 + m] * sc; const float pf = (float)ps[ai * 4 + m];
                    bf16_t* rowp = O + (size_t)row * ldc + col0;
                    float c[8], sn[8];
#pragma unroll
                    for (int e = 0; e < 8; ++e) { const float rev = __builtin_amdgcn_fractf((pf * invf[e]) * 0.15915494309189535f); c[e] = mine ? __builtin_amdgcn_cosf(rev) : 1.f; sn[e] = mine ? __builtin_amdgcn_sinf(rev) * sgn : 0.f; }
#pragma unroll
                    for (int bj = 0; bj < 2; ++bj) { f32x4 v0 = acc[ai][bj][m][0] * r, v1 = acc[ai][bj][m][1] * r; f32x4 p0, p1;
#pragma unroll
                        for (int e = 0; e < 4; ++e) { p0[e] = __shfl_xor(v0[e], 16); p1[e] = __shfl_xor(v1[e], 16); }
#pragma unroll
                        for (int e = 0; e < 4; ++e) { v0[e] = v0[e] * c[e] + p0[e] * sn[e]; v1[e] = v1[e] * c[4 + e] + p1[e] * sn[4 + e]; }
                        *(u32x4*)(rowp + bj * HALF) = pack8(v0, v1); } }
        } else {
#pragma unroll
            for (int ai = 0; ai < 2; ++ai)
#pragma unroll
                for (int m = 0; m < 4; ++m) { const int row = row0 + ai * HALF + m * 16; const float r = rs[ai * 4 + m] * sc;
                    bf16_t* rowp = O + (size_t)row * ldc + col0;
#pragma unroll
                    for (int bj = 0; bj < 2; ++bj) *(u32x4*)(rowp + bj * HALF) = pack8(acc[ai][bj][m][0] * r, acc[ai][bj][m][1] * r); }
        }
    }
};
struct EpiRes {
    static constexpr bool PERM = true, AFTER_DRAIN = false;
    const float* Hin; float* H; bf16_t* XB; float* ssq;
    __device__ __forceinline__ void operator()(const f32x4 (&acc)[2][2][4][2], const Unit& u, int wr, int wc, int fr, int fq) const {
        const int row0 = u.pm * BM + wr * 64 + fr, col0 = u.pn * BM + wc * 32 + 8 * fq;
#pragma unroll
        for (int ai = 0; ai < 2; ++ai) {
            f32x4 hv[4][2][2];
#pragma unroll
            for (int m = 0; m < 4; ++m)
#pragma unroll
                for (int bj = 0; bj < 2; ++bj) { const float* hp = Hin + (size_t)(row0 + ai * HALF + m * 16) * DMODEL + col0 + bj * HALF; hv[m][bj][0] = *(const f32x4*)hp; hv[m][bj][1] = *(const f32x4*)(hp + 4); }
#pragma unroll
            for (int m = 0; m < 4; ++m) { const int row = row0 + ai * HALF + m * 16; float part = 0.f;
#pragma unroll
                for (int bj = 0; bj < 2; ++bj) { float* hp = H + (size_t)row * DMODEL + col0 + bj * HALF;
                    const f32x4 h0 = hv[m][bj][0] + acc[ai][bj][m][0], h1 = hv[m][bj][1] + acc[ai][bj][m][1];
                    *(f32x4*)hp = h0; *(f32x4*)(hp + 4) = h1; part += sumsq8(h0, h1);
                    *(u32x4*)(XB + (size_t)row * DMODEL + col0 + bj * HALF) = pack8(h0, h1); }
                part += __shfl_xor(part, 16); part += __shfl_xor(part, 32);
                if (fq == 0) ssq[(size_t)row * 16 + u.pn * 4 + wc] = part; }
            asm volatile("" ::: "memory"); }
    }
};
struct EpiMlpIn {
    static constexpr bool PERM = true, AFTER_DRAIN = false;
    bf16_t* O; int ldc; const float* ssq;
    __device__ __forceinline__ void operator()(const f32x4 (&acc)[2][2][4][2], const Unit& u, int wr, int wc, int fr, int fq) const {
        const int row0 = u.pm * BM + wr * 64 + fr, col0 = u.pn * BM + wc * 32 + 8 * fq;
        float rs[8]; row_rs8(rs, ssq, row0, fq);
#pragma unroll
        for (int ai = 0; ai < 2; ++ai)
#pragma unroll
            for (int m = 0; m < 4; ++m) { const int row = row0 + ai * HALF + m * 16; const float r = rs[ai * 4 + m];
                bf16_t* rowp = O + (size_t)row * ldc + col0;
#pragma unroll
                for (int bj = 0; bj < 2; ++bj) { f32x4 v0 = acc[ai][bj][m][0] * r, v1 = acc[ai][bj][m][1] * r;
#pragma unroll
                    for (int e = 0; e < 4; ++e) { const float a = fmaxf(v0[e], 0.f), b = fmaxf(v1[e], 0.f); v0[e] = a * a; v1[e] = b * b; }
                    *(u32x4*)(rowp + bj * HALF) = pack8(v0, v1); } }
    }
};
struct EpiPle {
    static constexpr bool PERM = true, AFTER_DRAIN = false;
    float* H; bf16_t* XBo; const float* ssq_in; float* ssq_out; const bf16_t* PP;
    __device__ __forceinline__ void operator()(const f32x4 (&acc)[2][2][4][2], const Unit& u, int wr, int wc, int fr, int fq) const {
        const int row0 = u.pm * BM + wr * 64 + fr, col0 = u.pn * BM + wc * 32 + 8 * fq;
#pragma unroll
        for (int ai = 0; ai < 2; ++ai) {
          float rs[4];
          { f32x4 p[4];
#pragma unroll
            for (int i = 0; i < 4; ++i) p[i] = *(const f32x4*)(ssq_in + (size_t)(row0 + ai * HALF + i * 16) * 16 + 4 * fq);
#pragma unroll
            for (int i = 0; i < 4; ++i) { float s = (p[i][0] + p[i][1]) + (p[i][2] + p[i][3]); s += __shfl_xor(s, 16); s += __shfl_xor(s, 32); rs[i] = __builtin_amdgcn_rsqf(s * (1.0f / DMODEL) + RMS_EPS); } }
#pragma unroll
          for (int mh = 0; mh < 2; ++mh) {
            f32x4 hv[2][2][2]; u32x4 pw[2][2];
#pragma unroll
            for (int mm = 0; mm < 2; ++mm)
#pragma unroll
                for (int bj = 0; bj < 2; ++bj) { const size_t off = (size_t)(row0 + ai * HALF + (2 * mh + mm) * 16) * DMODEL + col0 + bj * HALF; hv[mm][bj][0] = *(const f32x4*)(H + off); hv[mm][bj][1] = *(const f32x4*)(H + off + 4); pw[mm][bj] = *(const u32x4*)(PP + off); }
#pragma unroll
            for (int mm = 0; mm < 2; ++mm) { const int m = 2 * mh + mm; const int row = row0 + ai * HALF + m * 16; const float r = rs[m]; float part = 0.f;
#pragma unroll
                for (int bj = 0; bj < 2; ++bj) { float* hp = H + (size_t)row * DMODEL + col0 + bj * HALF; const u32x4 w = pw[mm][bj];
                    const f32x4 p0 = {bf_lo(w.x), bf_hi(w.x), bf_lo(w.y), bf_hi(w.y)}, p1 = {bf_lo(w.z), bf_hi(w.z), bf_lo(w.w), bf_hi(w.w)};
                    f32x4 g0 = acc[ai][bj][m][0] * r, g1 = acc[ai][bj][m][1] * r;
#pragma unroll
                    for (int e = 0; e < 4; ++e) { g0[e] = __builtin_amdgcn_rcpf(1.f + __builtin_amdgcn_exp2f(-1.4426950408889634f * g0[e])); g1[e] = __builtin_amdgcn_rcpf(1.f + __builtin_amdgcn_exp2f(-1.4426950408889634f * g1[e])); }
                    const f32x4 h0 = hv[mm][bj][0] + g0 * p0, h1 = hv[mm][bj][1] + g1 * p1;
                    *(f32x4*)hp = h0; *(f32x4*)(hp + 4) = h1; part += sumsq8(h0, h1);
                    *(u32x4*)(XBo + (size_t)row * DMODEL + col0 + bj * HALF) = pack8(h0, h1); }
                part += __shfl_xor(part, 16); part += __shfl_xor(part, 32);
                if (fq == 0) ssq_out[(size_t)row * 16 + u.pn * 4 + wc] = part; }
            asm volatile("" ::: "memory"); } }
    }
};

template <class Epi, class Sched, bool ALIGN_EPI = false, bool SP2 = false>
__device__ __forceinline__ void gemm_phase(PG8_LAS unsigned char* lds, const Gemm g, const Sched& S, const Epi& E) {
    const int tid = tid_opaque(), wid = __builtin_amdgcn_readfirstlane(tid >> 6), lane = tid & 63, wr = wid >> 2, wc = wid & 3, fr = lane & 15, fq = lane >> 4;
    const int K = g.K, nt = K / BK;
    unsigned voffA[2], voffB[2];
#pragma unroll
    for (int i = 0; i < 2; ++i) { int R, C; stage_rc(tid * 16 + i * 8192, R, C); const int Rb = Epi::PERM ? ((R & ~31) + perm32(R & 31)) : R;
        voffA[i] = (unsigned)(R * K + C) * 2u; voffB[i] = (unsigned)(Rb * K + C) * 2u; }
    const size_t kstep = (size_t)(BK * 2);
    const size_t hstep = (size_t)HALF * K * 2;
    const size_t tstep = 2 * hstep;
    const unsigned ldsw = (unsigned)wid * 1024u;
    const int aoff = lds_byte(wr * 64 + fr, fq * 8), boff = lds_byte(wc * 32 + fr, fq * 8);
#define PG8_SA(b, h) (((b) * 2 + (h)) * HTB)
#define PG8_SB(b, h) ((4 + (b) * 2 + (h)) * HTB)
#define PG8_STAGE(bufoff, gbase, voff) do { _Pragma("unroll") for (int _i = 0; _i < 2; ++_i) \
        __builtin_amdgcn_global_load_lds((const unsigned*)((const char*)(gbase) + (voff)[_i]), (PG8_LAS unsigned*)(lds + (bufoff) + ldsw + _i * 8192), 16, 0, 0); } while (0)
#define PG8_LDA(dst, b, h) do { _Pragma("unroll") for (int m = 0; m < 4; ++m) _Pragma("unroll") for (int k = 0; k < 2; ++k) dst[m][k] = *(const PG8_LAS bf16x8*)(lds + PG8_SA(b, h) + aoff + m * 2048 + k * 1024); } while (0)
#define PG8_LDB(dst, b, h) do { _Pragma("unroll") for (int n = 0; n < 2; ++n) _Pragma("unroll") for (int k = 0; k < 2; ++k) dst[n][k] = *(const PG8_LAS bf16x8*)(lds + PG8_SB(b, h) + boff + n * 2048 + k * 1024); } while (0)
#define PG8_MMA(ai, bj, At, Bt) do { __builtin_amdgcn_s_setprio(1); _Pragma("unroll") for (int m = 0; m < 4; ++m) _Pragma("unroll") for (int n = 0; n < 2; ++n) _Pragma("unroll") for (int k = 0; k < 2; ++k) \
        acc[ai][bj][m][n] = __builtin_amdgcn_mfma_f32_16x16x32_bf16(Bt[n][k], At[m][k], acc[ai][bj][m][n], 0, 0, 0); __builtin_amdgcn_s_setprio(0); } while (0)
#define PG8_WAIT_V(n) asm volatile("s_waitcnt vmcnt(" #n ")" ::: "memory")
#define PG8_WAIT_L(n) asm volatile("s_waitcnt lgkmcnt(" #n ")" ::: "memory")
#define PG8_BAR __builtin_amdgcn_s_barrier()
#define PG8_SCHED __builtin_amdgcn_sched_barrier(0)
    Unit cur, nxt; int ui = 0;
    if (!S.next(0, cur)) return;
    f32x4 acc[2][2][4][2];
#pragma unroll
    for (int a = 0; a < 2; ++a)
#pragma unroll
        for (int b = 0; b < 2; ++b)
#pragma unroll
            for (int m = 0; m < 4; ++m)
#pragma unroll
                for (int n = 0; n < 2; ++n) acc[a][b][m][n] = (f32x4){0.f, 0.f, 0.f, 0.f};
    bf16x8 At[4][2], B0[2][2], B1[2][2];
    const char* cA = (const char*)g.A + (size_t)cur.pm * tstep; const char* cB = (const char*)g.Bt + (size_t)cur.pn * tstep;
    S.a_ready(cur);
    if constexpr (SP2) {
        PG8_STAGE(PG8_SB(0, 0), cB, voffB); PG8_STAGE(PG8_SB(0, 1), cB + hstep, voffB); PG8_STAGE(PG8_SA(0, 0), cA, voffA); PG8_STAGE(PG8_SA(0, 1), cA + hstep, voffA);
        if (wr == 1) PG8_BAR;
        PG8_WAIT_V(2); PG8_BAR;
        PG8_STAGE(PG8_SB(1, 0), cB + kstep, voffB); PG8_STAGE(PG8_SA(1, 0), cA + kstep, voffA); PG8_STAGE(PG8_SB(1, 1), cB + hstep + kstep, voffB);
        PG8_WAIT_V(6); PG8_BAR;
    } else {
        PG8_STAGE(PG8_SB(0, 0), cB, voffB); PG8_STAGE(PG8_SA(0, 0), cA, voffA); PG8_STAGE(PG8_SB(0, 1), cB + hstep, voffB); PG8_STAGE(PG8_SA(0, 1), cA + hstep, voffA);
        if (wr == 1) PG8_BAR;
        PG8_WAIT_V(4); PG8_BAR;
        PG8_STAGE(PG8_SB(1, 0), cB + kstep, voffB); PG8_STAGE(PG8_SA(1, 0), cA + kstep, voffA); PG8_STAGE(PG8_SB(1, 1), cB + hstep + kstep, voffB);
        PG8_WAIT_V(6); PG8_BAR;
    }
    for (;;) {
        const bool has_next = S.next(ui + 1, nxt);
        const char* nA = has_next ? (const char*)g.A + (size_t)nxt.pm * tstep : cA; const char* nB = has_next ? (const char*)g.Bt + (size_t)nxt.pn * tstep : cB;
        for (int t = 0; t < nt; t += 2) {
            const bool last = (t == nt - 2);
            const char* a1 = cA + (size_t)(t + 1) * kstep;
            const char* a2 = last ? nA : cA + (size_t)(t + 2) * kstep; const char* b2 = last ? nB : cB + (size_t)(t + 2) * kstep;
            const char* a3 = a2 + kstep; const char* b3 = b2 + kstep;
            if (last && has_next) S.a_ready(nxt);
            if constexpr (SP2) {
            PG8_LDB(B0, 0, 0); PG8_LDB(B1, 0, 1); PG8_SCHED; PG8_LDA(At, 0, 0); PG8_STAGE(PG8_SA(1, 1), a1 + hstep, voffA);
            PG8_WAIT_V(8); PG8_WAIT_L(0); PG8_BAR; PG8_MMA(0, 0, At, B0); PG8_MMA(0, 1, At, B1); PG8_BAR; PG8_SCHED;
            PG8_LDA(At, 0, 1); PG8_STAGE(PG8_SB(0, 0), b2, voffB); PG8_STAGE(PG8_SB(0, 1), b2 + hstep, voffB); PG8_STAGE(PG8_SA(0, 0), a2, voffA);
            PG8_WAIT_V(8); PG8_WAIT_L(0); PG8_BAR; PG8_MMA(1, 0, At, B0); PG8_MMA(1, 1, At, B1); PG8_BAR; PG8_SCHED;
            PG8_LDB(B0, 1, 0); PG8_LDB(B1, 1, 1); PG8_SCHED; PG8_LDA(At, 1, 0); PG8_STAGE(PG8_SA(0, 1), a2 + hstep, voffA);
            PG8_WAIT_V(8); PG8_WAIT_L(0); PG8_BAR; PG8_MMA(0, 0, At, B0); PG8_MMA(0, 1, At, B1); PG8_BAR; PG8_SCHED;
            PG8_LDA(At, 1, 1); PG8_STAGE(PG8_SB(1, 0), b3, voffB); PG8_STAGE(PG8_SB(1, 1), b3 + hstep, voffB); PG8_STAGE(PG8_SA(1, 0), a3, voffA);
            PG8_WAIT_V(8); PG8_WAIT_L(0); PG8_BAR; PG8_MMA(1, 0, At, B0); PG8_MMA(1, 1, At, B1); PG8_BAR; PG8_SCHED;
            } else {
            PG8_LDB(B0, 0, 0); PG8_SCHED; PG8_LDA(At, 0, 0); PG8_STAGE(PG8_SA(1, 1), a1 + hstep, voffA);
            PG8_WAIT_L(8); PG8_BAR; PG8_WAIT_L(0); PG8_MMA(0, 0, At, B0); PG8_BAR; PG8_SCHED;
            PG8_LDB(B1, 0, 1); PG8_STAGE(PG8_SB(0, 0), b2, voffB);
            PG8_BAR; PG8_WAIT_L(0); PG8_MMA(0, 1, At, B1); PG8_BAR;
            PG8_LDA(At, 0, 1); PG8_STAGE(PG8_SA(0, 0), a2, voffA);
            PG8_BAR; PG8_WAIT_L(0); PG8_MMA(1, 0, At, B0); PG8_BAR; PG8_SCHED;
            PG8_STAGE(PG8_SB(0, 1), b2 + hstep, voffB);
            PG8_WAIT_V(6); PG8_BAR; PG8_MMA(1, 1, At, B1); PG8_BAR;
            PG8_LDB(B0, 1, 0); PG8_SCHED; PG8_LDA(At, 1, 0); PG8_STAGE(PG8_SA(0, 1), a2 + hstep, voffA);
            PG8_WAIT_L(8); PG8_BAR; PG8_WAIT_L(0); PG8_MMA(0, 0, At, B0); PG8_BAR; PG8_SCHED;
            PG8_LDB(B1, 1, 1); PG8_STAGE(PG8_SB(1, 0), b3, voffB);
            PG8_BAR; PG8_WAIT_L(0); PG8_MMA(0, 1, At, B1); PG8_BAR;
            PG8_LDA(At, 1, 1); PG8_STAGE(PG8_SA(1, 0), a3, voffA);
            PG8_BAR; PG8_WAIT_L(0); PG8_MMA(1, 0, At, B0); PG8_BAR; PG8_SCHED;
            PG8_STAGE(PG8_SB(1, 1), b3 + hstep, voffB);
            PG8_WAIT_V(6); PG8_BAR; PG8_MMA(1, 1, At, B1); PG8_BAR;
            }
        }
        if constexpr (ALIGN_EPI) { if (wr == 0) PG8_BAR; }
        if constexpr (!Epi::AFTER_DRAIN) { const int t2 = tid_opaque(), w2 = __builtin_amdgcn_readfirstlane(t2 >> 6), l2 = t2 & 63;
            E(acc, cur, w2 >> 2, w2 & 3, l2 & 15, l2 >> 4); S.done(cur); }
        if (!has_next) break;
#pragma unroll
        for (int a = 0; a < 2; ++a)
#pragma unroll
            for (int b = 0; b < 2; ++b)
#pragma unroll
                for (int m = 0; m < 4; ++m)
#pragma unroll
                    for (int n = 0; n < 2; ++n) acc[a][b][m][n] = (f32x4){0.f, 0.f, 0.f, 0.f};
        cur = nxt; cA = nA; cB = nB; ++ui;
        if constexpr (ALIGN_EPI) { if (wr == 1) PG8_BAR; }
    }
    PG8_WAIT_V(0);
    if constexpr (!ALIGN_EPI) { if (wr == 0) PG8_BAR; }
    PG8_BAR;
    if constexpr (Epi::AFTER_DRAIN) { E.fused(acc, cur, wr, wc, fr, fq, lds, wid, lane); S.done(cur); }
#undef PG8_SA
#undef PG8_SB
#undef PG8_STAGE
#undef PG8_LDA
#undef PG8_LDB
#undef PG8_MMA
#undef PG8_WAIT_V
#undef PG8_WAIT_L
#undef PG8_BAR
#undef PG8_SCHED
}
}
#ifndef PG8_SP2
#define PG8_SP2 true
#endif
#include <hip/hip_bf16.h>
#include <cmath>
namespace attn_body {
using bf16=__hip_bfloat16;
using bf16x8=__attribute__((ext_vector_type(8)))short;
using s16x4=__attribute__((ext_vector_type(4)))short;
using f32x16=__attribute__((ext_vector_type(16)))float;
using u32x4=__attribute__((ext_vector_type(4)))unsigned;
constexpr int D=64,PQ=2560,PO=1024;
constexpr int NW=8,QBLK=32,QB=QBLK*NW,KVBLK=64;
constexpr int ATTN_UNIT_ROWS=QB;
__device__ __forceinline__ int crow(int r,int hi){return (r&3)+8*(r>>2)+4*hi;}
#define SBAR() __builtin_amdgcn_sched_barrier(0)
__device__ __forceinline__ void cmask(f32x16&p0,f32x16&p1,int jb,int qrel,int hi){
  const float NEG=-INFINITY; int kb=64*jb+4*hi;
  #pragma unroll
  for(int r=0;r<16;++r){int kv=kb+(r&3)+8*(r>>2); if(kv>qrel)p0[r]=NEG; if(kv+32>qrel)p1[r]=NEG;}
}

constexpr int NSLOT=3, SLOTB=8192;
constexpr int LDS_K=0, LDS_V=NSLOT*SLOTB, LDS_WS=2*NSLOT*SLOTB, LDS_OST=LDS_WS+NW*64*4, LDS_BYTES=LDS_OST+NW*4096;
constexpr float C2=0.125f*1.4426950408889634f;
__device__ __forceinline__ void glds16(const void*gsrc,unsigned lds_dst){unsigned keep;
  asm volatile("s_mov_b32 %0, m0\n\ts_mov_b32 m0, %2\n\ts_nop 0\n\tglobal_load_lds_dwordx4 %1, off\n\ts_mov_b32 m0, %0":"=&s"(keep):"v"(gsrc),"s"(lds_dst):"memory");}
__device__ __forceinline__ float max3f(float a,float b,float c){float r;asm("v_max3_f32 %0, %1, %2, %3":"=v"(r):"v"(a),"v"(b),"v"(c));return r;}
__device__ __forceinline__ float max2f(float a,float b){float r;asm("v_max_f32_e32 %0, %1, %2":"=v"(r):"v"(a),"v"(b));return r;}
__device__ __forceinline__ float fadd_s(float a,float b){float r;asm("v_add_f32_e32 %0, %1, %2":"=v"(r):"v"(a),"v"(b));return r;}
__device__ __forceinline__ float fsub_s(float a,float b){float r;asm("v_sub_f32_e32 %0, %1, %2":"=v"(r):"v"(a),"v"(b));return r;}
typedef float f32x2_t __attribute__((ext_vector_type(2))); typedef __bf16 bf16x2_t __attribute__((ext_vector_type(2)));
__device__ __forceinline__ unsigned cvtpk_s(float lo,float hi){f32x2_t v={lo,hi};bf16x2_t b=__builtin_convertvector(v,bf16x2_t);return __builtin_bit_cast(unsigned,b);}
#define WAIT_BAR(N) asm volatile("s_waitcnt vmcnt(" #N ") lgkmcnt(0)\n\ts_barrier":::"memory")

__device__ __forceinline__ void qkt(f32x16&p0,f32x16&p1,const char*Kslot,const bf16x8*qr,const f32x16&negm,int r32,int hi){
  const char*kb=Kslot+hi*1024+r32*16;
  #pragma unroll
  for(int d0=0;d0<4;++d0){
    const bf16x8 b0=*reinterpret_cast<const bf16x8*>(kb+d0*2048);
    const bf16x8 b1=*reinterpret_cast<const bf16x8*>(kb+d0*2048+512);
    if(d0==0){p0=__builtin_amdgcn_mfma_f32_32x32x16_bf16(b0,qr[0],negm,0,0,0);p1=__builtin_amdgcn_mfma_f32_32x32x16_bf16(b1,qr[0],negm,0,0,0);}
    else{p0=__builtin_amdgcn_mfma_f32_32x32x16_bf16(b0,qr[d0],p0,0,0,0);p1=__builtin_amdgcn_mfma_f32_32x32x16_bf16(b1,qr[d0],p1,0,0,0);}}
}
typedef __attribute__((address_space(3))) const char* lds_cptr;
typedef short v4i16_t __attribute__((ext_vector_type(4)));
__device__ __forceinline__ void kload8(bf16x8*kf,lds_cptr kp){
  kf[0]=*(const __attribute__((address_space(3))) bf16x8*)(kp);      kf[1]=*(const __attribute__((address_space(3))) bf16x8*)(kp+512);
  kf[2]=*(const __attribute__((address_space(3))) bf16x8*)(kp+2048); kf[3]=*(const __attribute__((address_space(3))) bf16x8*)(kp+2560);
  kf[4]=*(const __attribute__((address_space(3))) bf16x8*)(kp+4096); kf[5]=*(const __attribute__((address_space(3))) bf16x8*)(kp+4608);
  kf[6]=*(const __attribute__((address_space(3))) bf16x8*)(kp+6144); kf[7]=*(const __attribute__((address_space(3))) bf16x8*)(kp+6656);
}
__device__ __forceinline__ void kload2(bf16x8*kf,lds_cptr kp,int j){ kf[2*j]=*(const __attribute__((address_space(3))) bf16x8*)(kp+j*2048); kf[2*j+1]=*(const __attribute__((address_space(3))) bf16x8*)(kp+j*2048+512); }
__device__ __forceinline__ s16x4 vtr(lds_cptr p){ return __builtin_bit_cast(s16x4,__builtin_amdgcn_ds_read_tr16_b64_v4i16((__attribute__((address_space(3))) v4i16_t*)p)); }
__device__ __forceinline__ float rowmax(const f32x16&p0,const f32x16&p1){
  float a=max3f(p0[0],p0[1],p1[0]),b=max3f(p0[2],p0[3],p1[1]);a=max3f(a,p1[2],p1[3]);
  #pragma unroll
  for(int r=4;r<16;r+=4){a=max3f(a,p0[r],p0[r+1]);b=max3f(b,p0[r+2],p0[r+3]);a=max3f(a,p1[r],p1[r+1]);b=max3f(b,p1[r+2],p1[r+3]);}
  const float m=max2f(a,b);
  auto rr=__builtin_amdgcn_permlane32_swap(__float_as_uint(m),__float_as_uint(m),false,false);
  return max2f(__uint_as_float(rr[0]),__uint_as_float(rr[1]));
}
__device__ __forceinline__ void pv(f32x16*o,int vb,bf16x8 pa0,bf16x8 pa1,bf16x8 pa2,bf16x8 pa3){
  #pragma unroll
  for(int d0=0;d0<2;++d0){s16x4 lo[4],hi[4];
    #pragma unroll
    for(int ks=0;ks<4;++ks){
      asm volatile("ds_read_b64_tr_b16 %0,%1 offset:%c2":"=&v"(lo[ks]):"v"(vb),"i"(d0*4096+ks*1024):"memory");
      asm volatile("ds_read_b64_tr_b16 %0,%1 offset:%c2":"=&v"(hi[ks]):"v"(vb),"i"(d0*4096+ks*1024+512):"memory");}
    asm volatile("s_waitcnt lgkmcnt(0)":::"memory");SBAR();
    #define PK(k) (bf16x8){lo[k][0],lo[k][1],lo[k][2],lo[k][3],hi[k][0],hi[k][1],hi[k][2],hi[k][3]}
    o[d0]=__builtin_amdgcn_mfma_f32_32x32x16_bf16(pa0,PK(0),o[d0],0,0,0);
    o[d0]=__builtin_amdgcn_mfma_f32_32x32x16_bf16(pa1,PK(1),o[d0],0,0,0);
    o[d0]=__builtin_amdgcn_mfma_f32_32x32x16_bf16(pa2,PK(2),o[d0],0,0,0);
    o[d0]=__builtin_amdgcn_mfma_f32_32x32x16_bf16(pa3,PK(3),o[d0],0,0,0);
    #undef PK
  }
}

#ifndef ATTN_STORE16
#define ATTN_STORE16(p,v) (*(u32x4*)(p)=(v))
#endif
template<int THRL> __device__ __forceinline__ void attn_unit(int qb,const bf16*Qh,const bf16*__restrict__ Kh,const bf16*__restrict__ Vh,bf16*Oh,char*shm){
  const int tid=tid_opaque(),lane=tid&63,r32=lane&31,hi=lane>>5; const int wid=__builtin_amdgcn_readfirstlane(tid>>6);
  const int q0=qb*QB;
  const bf16*Qw=Qh+(long)(q0+wid*QBLK)*PQ;
  const unsigned lds0=(unsigned)(uintptr_t)shm;
  float*wsf=(float*)(shm+LDS_WS)+wid*64;
  const bf16*ksrc=Kh+(long)lane*PQ+wid*8;
  const bf16*vsrc=Vh+(long)(16*(wid&3)+(lane>>2))*PQ+(wid>>2)*32+(lane&3)*8;
  const unsigned kdst=lds0+LDS_K+wid*1024, vdst=lds0+LDS_V+wid*1024;
  #define DMA_K(t,slot) glds16(ksrc+(long)(t)*KVBLK*PQ,(unsigned)__builtin_amdgcn_readfirstlane(kdst+(slot)))
  #define DMA_V(t,slot) glds16(vsrc+(long)(t)*KVBLK*PQ,(unsigned)__builtin_amdgcn_readfirstlane(vdst+(slot)))
  const int vb0=(int)(lds0+LDS_V)+((lane>>4)&1)*32+(lane&3)*8+(4*hi+((lane&15)>>2))*64;
  const char*Kbase=shm+LDS_K; bf16x8 kf[8];
  const lds_cptr shm3=(lds_cptr)shm; const lds_cptr kp0=shm3+LDS_K+hi*1024+r32*16; const lds_cptr vp0=shm3+LDS_V+((lane>>4)&1)*32+(lane&3)*8+(4*hi+((lane&15)>>2))*64;
  const int NT=(q0+QB)/KVBLK;
  DMA_K(0,0);DMA_V(0,0);DMA_K(1,SLOTB);
  bf16x8 qr[4];
  #pragma unroll
  for(int d0=0;d0<4;++d0)qr[d0]=*reinterpret_cast<const bf16x8*>(&Qw[(long)r32*PQ+d0*16+hi*8]);
  float mhat=0.f,l_reg=0.f;f32x16 o[2];o[0]=f32x16{};o[1]=f32x16{};f32x16 negm=f32x16{};asm volatile("":"+v"(negm));
  const int qrel=wid*QBLK+r32;
  #define CMASK(P0,P1,t) do{int jb_=(t)-(NT-4); if(jb_>=0)cmask(P0,P1,jb_,qrel,hi);}while(0)
  bool resc=false;
  #define START(P0,P1) do{ const float rm=rowmax(P0,P1); resc=false; \
    { const float dl=rm; mhat=fadd_s(mhat,dl); \
      _Pragma("unroll") for(int r=0;r<16;++r){P0[r]=fsub_s(P0[r],dl);P1[r]=fsub_s(P1[r],dl);} \
      _Pragma("unroll") for(int r=0;r<16;++r)negm[r]=-mhat; asm volatile("":"+v"(negm)); } \
    _Pragma("unroll") for(int r=0;r<16;++r)P0[r]=__builtin_amdgcn_exp2f(P0[r]); }while(0)
  #define RESC() do{ if(resc){ asm volatile("s_waitcnt lgkmcnt(0)":::"memory"); \
      _Pragma("unroll") for(int d_=0;d_<2;++d_) _Pragma("unroll") for(int r=0;r<16;++r)o[d_][r]*=wsf[crow(r,hi)]; } }while(0)
  f32x16 pA0,pA1,pB0,pB1;
  int sl_prev=0,sl_cur=0,sl_next=SLOTB;
  #define ROT() do{sl_prev=sl_cur;sl_cur=sl_next;sl_next=(sl_next==(NSLOT-1)*SLOTB)?0:sl_next+SLOTB;}while(0)
  DMA_K(2,2*SLOTB);
  WAIT_BAR(3);
  qkt(pA0,pA1,Kbase,qr,negm,r32,hi);asm volatile("s_nop 15\n\ts_nop 7":"+v"(pA0),"+v"(pA1));CMASK(pA0,pA1,0);
  START(pA0,pA1);
  _Pragma("unroll") for(int r=0;r<16;++r)pA1[r]=__builtin_amdgcn_exp2f(pA1[r]);
  WAIT_BAR(0);
  DMA_K(3,0);DMA_V(1,SLOTB);
  ROT();
  kload8(kf,kp0+sl_cur);
  WAIT_BAR(2);
  s16x4 vlo[8],vhi[8]; u32x4 pw0,pw1,pw2,pw3;
  #define PKW(P,B) cvtpk_s(P[B],P[B+1])
  #define PAF(k) __builtin_bit_cast(bf16x8,pw##k)
  #define VFR(i) (bf16x8){vlo[i][0],vlo[i][1],vlo[i][2],vlo[i][3],vhi[i][0],vhi[i][1],vhi[i][2],vhi[i][3]}
  #define PIN(x) asm volatile("":"+v"(x))
  #define MX3(a,b,c) __builtin_fmaxf(__builtin_fmaxf((a),(b)),(c))
  #define GAPA(MF,A0,A1,A2,A3,W0,W1,PW) do{ MF; sacc+=A0; sacc+=A1; sacc+=A2; sacc+=A3; PIN(sacc); W0; W1; PIN(PW); SBAR(); }while(0)
  #define EX(v) __builtin_amdgcn_exp2f(v)
  #define GAPB(MF,X,B) do{ MF; X[B]=EX(X[B]); X[B+1]=EX(X[B+1]); X[B+2]=EX(X[B+2]); X[B+3]=EX(X[B+3]); PIN(X); SBAR(); }while(0)
  #define VRD(i) do{ vlo[i]=vtr(vp_+(((i)>>2)*4096+((i)&3)*1024)); vhi[i]=vtr(vp_+(((i)>>2)*4096+((i)&3)*1024+512)); }while(0)
  #define KRD(G,j) do{ if(G){ kload2(kf,kp0+sl_next,j); SBAR(); } }while(0)
  #define STEP(C0,C1,P0,P1,t,GK,GV,GL) do{ SBAR(); \
    const lds_cptr vp_=vp0+sl_prev; \
    VRD(0); SBAR(); float sacc=(P0[0]+P0[1]); \
    GAPA(C0=__builtin_amdgcn_mfma_f32_32x32x16_bf16(kf[0],qr[0],negm,0,0,0), P0[2],P0[3],P0[4],P0[5],     pw0[0]=PKW(P0,0), pw0[1]=PKW(P0,2), pw0); \
    VRD(4); SBAR(); GAPA(C1=__builtin_amdgcn_mfma_f32_32x32x16_bf16(kf[1],qr[0],negm,0,0,0), P0[6],P0[7],P0[8],P0[9],     pw0[2]=PKW(P0,4), pw0[3]=PKW(P0,6), pw0); \
    VRD(1); SBAR(); GAPA(C0=__builtin_amdgcn_mfma_f32_32x32x16_bf16(kf[2],qr[1],C0,0,0,0),   P0[10],P0[11],P0[12],P0[13], pw1[0]=PKW(P0,8), pw1[1]=PKW(P0,10), pw1); \
    VRD(5); SBAR(); GAPA(C1=__builtin_amdgcn_mfma_f32_32x32x16_bf16(kf[3],qr[1],C1,0,0,0),   P0[14],P0[15],P1[0],P1[1],   pw1[2]=PKW(P0,12),pw1[3]=PKW(P0,14), pw1); \
    VRD(2); SBAR(); GAPA(C0=__builtin_amdgcn_mfma_f32_32x32x16_bf16(kf[4],qr[2],C0,0,0,0),   P1[2],P1[3],P1[4],P1[5],     pw2[0]=PKW(P1,0), pw2[1]=PKW(P1,2), pw2); \
    VRD(6); SBAR(); GAPA(C1=__builtin_amdgcn_mfma_f32_32x32x16_bf16(kf[5],qr[2],C1,0,0,0),   P1[6],P1[7],P1[8],P1[9],     pw2[2]=PKW(P1,4), pw2[3]=PKW(P1,6), pw2); \
    VRD(3); SBAR(); GAPA(C0=__builtin_amdgcn_mfma_f32_32x32x16_bf16(kf[6],qr[3],C0,0,0,0),   P1[10],P1[11],P1[12],P1[13], pw3[0]=PKW(P1,8), pw3[1]=PKW(P1,10), pw3); \
    VRD(7); SBAR(); GAPA(C1=__builtin_amdgcn_mfma_f32_32x32x16_bf16(kf[7],qr[3],C1,0,0,0),   P1[14],P1[15],0.f,0.f,       pw3[2]=PKW(P1,12),pw3[3]=PKW(P1,14), pw3); \
    l_reg+=sacc; \
    if(GK){DMA_K((t)+3,sl_cur);} if(GV){DMA_V((t)+1,sl_next);} \
    CMASK(C0,C1,t); \
    { float a=MX3(C0[0],C0[1],C1[0]),b=MX3(C0[2],C0[3],C1[1]); a=MX3(a,C1[2],C1[3]); \
      _Pragma("unroll") for(int r=4;r<16;r+=4){a=MX3(a,C0[r],C0[r+1]);b=MX3(b,C0[r+2],C0[r+3]);a=MX3(a,C1[r],C1[r+1]);b=MX3(b,C1[r+2],C1[r+3]);} \
      float rm=__builtin_fmaxf(a,b); { auto rr=__builtin_amdgcn_permlane32_swap(__float_as_uint(rm),__float_as_uint(rm),false,false); rm=__builtin_fmaxf(__uint_as_float(rr[0]),__uint_as_float(rr[1])); } \
      resc=false; \
      if(__builtin_expect(__any(rm>(float)THRL),0)){ const float dl=__builtin_fmaxf(rm,0.f); mhat+=dl; \
        _Pragma("unroll") for(int r=0;r<16;++r){C0[r]-=dl;C1[r]-=dl;} \
        _Pragma("unroll") for(int r=0;r<16;++r)negm[r]=-mhat; asm volatile("":"+v"(negm)); \
        const float f=__builtin_amdgcn_exp2f(-dl); l_reg*=f; if(hi==0)wsf[r32]=f; resc=true; } } \
    SBAR(); \
    GAPB(o[0]=__builtin_amdgcn_mfma_f32_32x32x16_bf16(PAF(0),VFR(0),o[0],0,0,0), C0,0); \
    GAPB(o[1]=__builtin_amdgcn_mfma_f32_32x32x16_bf16(PAF(0),VFR(4),o[1],0,0,0), C0,4); \
    KRD(GL,0); GAPB(o[0]=__builtin_amdgcn_mfma_f32_32x32x16_bf16(PAF(1),VFR(1),o[0],0,0,0), C0,8); \
    KRD(GL,1); GAPB(o[1]=__builtin_amdgcn_mfma_f32_32x32x16_bf16(PAF(1),VFR(5),o[1],0,0,0), C0,12); \
    KRD(GL,2); GAPB(o[0]=__builtin_amdgcn_mfma_f32_32x32x16_bf16(PAF(2),VFR(2),o[0],0,0,0), C1,0); \
    KRD(GL,3); GAPB(o[1]=__builtin_amdgcn_mfma_f32_32x32x16_bf16(PAF(2),VFR(6),o[1],0,0,0), C1,4); \
    GAPB(o[0]=__builtin_amdgcn_mfma_f32_32x32x16_bf16(PAF(3),VFR(3),o[0],0,0,0), C1,8); \
    GAPB(o[1]=__builtin_amdgcn_mfma_f32_32x32x16_bf16(PAF(3),VFR(7),o[1],0,0,0), C1,12); \
    }while(0)
  int t=1;
  #undef CMASK
  #define CMASK(P0,P1,t) do{}while(0)
  for(;t+5<NT;t+=2){
    STEP(pB0,pB1,pA0,pA1,t,true,true,true);     WAIT_BAR(2); RESC(); ROT();
    STEP(pA0,pA1,pB0,pB1,t+1,true,true,true);   WAIT_BAR(2); RESC(); ROT();
  }
  #undef CMASK
  #define CMASK(P0,P1,t) do{int jb_=(t)-(NT-4); if(jb_>=0)cmask(P0,P1,jb_,qrel,hi);}while(0)
  #define ENDW(tt) do{ if((tt)+3<NT){WAIT_BAR(2);} else if((tt)+2<NT){WAIT_BAR(1);} else {WAIT_BAR(0);} }while(0)
  for(;t+1<NT;t+=2){
    STEP(pB0,pB1,pA0,pA1,t,(t+3<NT),(t+1<NT),(t+1<NT));       ENDW(t);   RESC(); ROT();
    STEP(pA0,pA1,pB0,pB1,t+1,(t+4<NT),(t+2<NT),(t+2<NT));     ENDW(t+1); RESC(); ROT();
  }
  STEP(pB0,pB1,pA0,pA1,NT-1,false,false,false); RESC();
  { float sacc=pB0[0]+pB0[1]; _Pragma("unroll") for(int r=2;r<16;++r)sacc+=pB0[r]; _Pragma("unroll") for(int r=0;r<16;++r)sacc+=pB1[r]; l_reg+=sacc;
    pw0=(u32x4){PKW(pB0,0),PKW(pB0,2),PKW(pB0,4),PKW(pB0,6)};pw1=(u32x4){PKW(pB0,8),PKW(pB0,10),PKW(pB0,12),PKW(pB0,14)};pw2=(u32x4){PKW(pB1,0),PKW(pB1,2),PKW(pB1,4),PKW(pB1,6)};pw3=(u32x4){PKW(pB1,8),PKW(pB1,10),PKW(pB1,12),PKW(pB1,14)};
    SBAR(); pv(o,vb0+sl_cur,PAF(0),PAF(1),PAF(2),PAF(3)); }
  #undef PKW
  #undef PAF
  #undef VFR
  #undef PIN
  #undef MX3
  #undef GAPA
  #undef GAPB
  #undef EX
  #undef VRD
  #undef KRD
  #undef STEP
  #undef ENDW
  {auto rr=__builtin_amdgcn_permlane32_swap(__float_as_uint(l_reg),__float_as_uint(l_reg),false,false);l_reg=__uint_as_float(rr[0])+__uint_as_float(rr[1]);}
  if(hi==0)wsf[32+r32]=l_reg;asm volatile("s_waitcnt lgkmcnt(0)":::"memory");
  float rli[16];
  #pragma unroll
  for(int r=0;r<16;++r)rli[r]=__builtin_amdgcn_rcpf(wsf[32+crow(r,hi)]);
  bf16*Ow=Oh+(long)(q0+wid*QBLK)*PO;
  { bf16*stg=(bf16*)(shm+LDS_OST)+wid*2048;
    #pragma unroll
    for(int r=0;r<16;++r){const int orow=crow(r,hi);
      #pragma unroll
      for(int d0=0;d0<2;++d0)stg[orow*64+d0*32+r32]=__float2bfloat16(o[d0][r]*rli[r]);}
    asm volatile("s_waitcnt lgkmcnt(0)":::"memory");
    #pragma unroll
    for(int i=0;i<4;++i){const int row=i*8+(lane>>3),ch=lane&7; const u32x4 v=*(const u32x4*)(stg+row*64+ch*8); ATTN_STORE16(Ow+(long)row*PO+ch*8,v);} }
  asm volatile("s_waitcnt lgkmcnt(0)\n\ts_barrier":::"memory");
  #undef DMA_K
  #undef DMA_V
  #undef CMASK
  #undef START
  #undef RESC
  #undef ROT
}
constexpr int ATTN_LDS_BYTES=LDS_BYTES;
#undef SBAR
#undef WAIT_BAR
}
#include <hip/hip_cooperative_groups.h>
namespace cg = cooperative_groups;
constexpr int NWAVES = 8;
constexpr int BATCH = 16, SEQ = 2048, D = 1024, DEPTH = 4, FF = 4096, PLE = 256, INW = 2560, AW = 512, RW = 512;
constexpr int M = BATCH * SEQ;
constexpr size_t MiB = 1u << 20;
constexpr size_t WS_CS = 1 * MiB;
constexpr size_t WS_SSQ0 = 3 * MiB, WS_SSQ1 = 5 * MiB;
constexpr size_t WS_W = 8 * MiB, W_LAYER = 25 * MiB + 512 * 1024;
constexpr size_t WO_IN = 0, WO_OUT = 5 * MiB, WO_W1 = 7 * MiB, WO_W2 = 15 * MiB, WO_PG = 23 * MiB, WO_PP = 25 * MiB;
constexpr size_t WS_P16 = 110 * MiB;
constexpr size_t WS_XB0 = 126 * MiB;
constexpr size_t WS_R = 190 * MiB;
constexpr size_t WS_PROJ = WS_R;
constexpr size_t WS_OV = WS_R + 160 * MiB;
constexpr size_t WS_AO = WS_R + 224 * MiB;
constexpr size_t WS_HB = WS_R;
constexpr size_t WS_PP = WS_R;
constexpr size_t WS_END = WS_R + 288 * MiB;
static_assert(WS_W + DEPTH * W_LAYER <= WS_P16 && WS_P16 + (size_t)M * PLE * 2 <= WS_XB0 && WS_XB0 + (size_t)M * D * 2 <= WS_R && WS_HB + (size_t)M * FF * 2 <= WS_END, "d_ws map");
constexpr int RING_BYTES = 131072;
constexpr int LDS_BYTES = 147456;

#define GAS __attribute__((address_space(1)))
#define LAS __attribute__((address_space(3)))
typedef unsigned short bf16;
typedef unsigned v4u __attribute__((ext_vector_type(4)));
typedef float f32x4 __attribute__((ext_vector_type(4)));
typedef short bf16x8 __attribute__((ext_vector_type(8)));
#define LDS_WAIT() asm volatile("s_waitcnt lgkmcnt(0)" ::: "memory")
#define VM_WAIT() asm volatile("s_waitcnt vmcnt(0)" ::: "memory")
__device__ __forceinline__ unsigned f2bf(float f) { unsigned u = __builtin_bit_cast(unsigned, f); return (u + 0x7fffu + ((u >> 16) & 1u)) >> 16; }
__device__ __forceinline__ unsigned pk2(float lo, float hi) { unsigned r; asm("v_cvt_pk_bf16_f32 %0, %1, %2" : "=v"(r) : "v"(lo), "v"(hi)); return r; }
__device__ __forceinline__ float bf2f(unsigned short v) { return __uint_as_float((unsigned)v << 16); }
__device__ __forceinline__ float sigmoid_f(float x) { return __builtin_amdgcn_rcpf(1.f + __builtin_amdgcn_exp2f(-1.4426950408889634f * x)); }

typedef GAS unsigned gu32;
#define RLX_AGENT __ATOMIC_RELAXED, __HIP_MEMORY_SCOPE_AGENT
#define XB_TMO      128
#define XB_XCNT(j)  (256  + 64 * (j))
#define XB_XSUB(j)  (1280 + 64 * (j))
#define XB_XGEN(j)  (2304 + 64 * (j))
#define XB_TOP      3328
#define XB_TOPGEN   3392
#define XCD_BAR_WORDS 3456
#define XB_SPIN_CAP (1u << 18)

__device__ __forceinline__ unsigned xb_ld(unsigned* p)              { return __hip_atomic_load(p, __ATOMIC_RELAXED, __HIP_MEMORY_SCOPE_AGENT); }
__device__ __forceinline__ unsigned xb_add(unsigned* p, unsigned v) { return __hip_atomic_fetch_add(p, v, __ATOMIC_RELAXED, __HIP_MEMORY_SCOPE_AGENT); }
__device__ __forceinline__ unsigned xb_xcc_id() { return (unsigned)__builtin_amdgcn_s_getreg((3 << 11) | 20) & 0xFu; }
#define XB_SPIN(cond, bar) do { unsigned _sp = 0; while (cond) { __builtin_amdgcn_s_sleep(1); \
    if ((++_sp & 255u) == 0u) { if (xb_ld(&(bar)[XB_TMO])) break; if (_sp > XB_SPIN_CAP) { atomicAdd(&(bar)[XB_TMO], 1u); break; } } } } while (0)

struct XcdBarrier {
    unsigned* bar; unsigned x;
    volatile LAS unsigned* st;
};

__device__ __forceinline__ XcdBarrier xcd_barrier_post(unsigned* bar, volatile LAS unsigned* st) {
    XcdBarrier b; b.bar = bar; b.x = xb_xcc_id(); b.st = st;
    if (threadIdx.x == 0) (void)xb_add(&bar[XB_XCNT(b.x)], 1u);
    return b;
}
__device__ __forceinline__ void xcd_barrier_complete(unsigned* bar, unsigned x, unsigned& nloc, unsigned& nx) {
    const unsigned G = gridDim.x * gridDim.y * gridDim.z;
    unsigned sum, cnt, mine, sp = 0u;
    for (;;) {
        sum = 0u; cnt = 0u; mine = 0u;
#pragma unroll
        for (unsigned j = 0; j < 16; ++j) { const unsigned c = xb_ld(&bar[XB_XCNT(j)]); sum += c; cnt += (c > 0u) ? 1u : 0u; mine = (j == x) ? c : mine; }
        if (sum == G) break;
        __builtin_amdgcn_s_sleep(1);
        if ((++sp & 255u) == 0u) { if (xb_ld(&bar[XB_TMO])) break; if (sp > XB_SPIN_CAP) { atomicAdd(&bar[XB_TMO], 1u); break; } }
    }
    nloc = mine > 0u ? mine : 1u; nx = cnt > 0u ? cnt : 1u;
}

__device__ __forceinline__ void xcd_barrier(const XcdBarrier& b) {
    asm volatile("s_waitcnt vmcnt(0)" ::: "memory");
    __syncthreads();
    if (threadIdx.x == 0) {
        unsigned* bar = b.bar;
        __builtin_amdgcn_s_waitcnt(0);
        unsigned nloc = b.st[0], nx = b.st[1];
        if (nloc == 0u) { xcd_barrier_complete(bar, b.x, nloc, nx); b.st[0] = nloc; b.st[1] = nx; }
        const unsigned old = xb_add(&bar[XB_XSUB(b.x)], 1u);
        const unsigned gen = old / nloc;
        if (old + 1u == (gen + 1u) * nloc) {
            __builtin_amdgcn_fence(__ATOMIC_RELEASE, "agent");
            asm volatile("s_waitcnt vmcnt(0)" ::: "memory");
            const unsigned og = xb_add(&bar[XB_TOP], 1u);
            const unsigned tg = og / nx;
            if (og + 1u == (tg + 1u) * nx) xb_add(&bar[XB_TOPGEN], 1u);
            else XB_SPIN(xb_ld(&bar[XB_TOPGEN]) == tg, bar);
            __builtin_amdgcn_fence(__ATOMIC_ACQUIRE, "agent");
            xb_add(&bar[XB_XGEN(b.x)], 1u);
            asm volatile("s_waitcnt vmcnt(0)" ::: "memory");
        } else {
            XB_SPIN(xb_ld(&bar[XB_XGEN(b.x)]) == gen, bar);
            __builtin_amdgcn_fence(__ATOMIC_ACQUIRE, "agent");
            asm volatile("s_waitcnt vmcnt(0)" ::: "memory");
        }
    }
    __syncthreads();
}

struct Frame {
    LAS unsigned char* lds;
    LAS const unsigned long long* tab;
};
struct Who { int tid, lane, wave, vcu, G; };
__device__ __forceinline__ Who who() { Who w; w.tid = tid_opaque(); w.lane = w.tid & 63; w.wave = __builtin_amdgcn_readfirstlane(w.tid >> 6);
    int bx = blockIdx.x, G = gridDim.x; asm volatile("" : "+s"(bx), "+s"(G)); w.G = G; w.vcu = (G % 8 == 0) ? (bx % 8) * (G / 8) + bx / 8 : bx; return w; }
__device__ __forceinline__ int opaque_s(int v) { asm volatile("" : "+s"(v)); return v; }
__device__ __forceinline__ const void* ptab(LAS const unsigned long long* tab, int k) {
    const unsigned long long v = tab[k]; const unsigned lo = __builtin_amdgcn_readfirstlane((unsigned)v), hi = __builtin_amdgcn_readfirstlane((unsigned)(v >> 32));
    return (const void*)(((unsigned long long)hi << 32) | lo);
}
#define FIN(k) ((const float*)ptab(F.tab, (k)))
#define FOUT() ((float*)ptab(F.tab, 23))
#define FWS(off) ((unsigned char*)ptab(F.tab, 24) + (off))
enum { I_X = 0, I_P, I_POS, I_WIN, I_WOUT, I_GMIX, I_GSUBLN, I_LAMQ, I_LAMK, I_CONVW, I_CONVB, I_WGA, I_BGA, I_WGX, I_BGX, I_LRULAM, I_GMLP, I_WMLPIN, I_WMLPOUT, I_GPLE, I_WPLEGATE, I_WPLEPROJ, I_GFINAL };

__device__ __forceinline__ float wave_sum(float v) {
#pragma unroll
    for (int o = 1; o < 64; o <<= 1) v += __shfl_xor(v, o);
    return v;
}
__device__ __forceinline__ void p0_transpose_item(const float* W, const float* gain, int K, int N, bf16* WT, LAS float* scr, int item, int lane) {
    const int nblk = N / 32, kb = item / nblk, nb = item % nblk, k0 = 64 * kb, n0 = 32 * nb;
#pragma unroll 8
    for (int i = 0; i < 32; ++i) { const int kk = 2 * i + (lane >> 5); const float gk = gain ? gain[k0 + kk] : 1.f; scr[kk * 33 + (lane & 31)] = W[(size_t)(k0 + kk) * N + n0 + (lane & 31)] * gk; }
    LDS_WAIT(); asm volatile("" ::: "memory");
    const int c = lane & 7;
#pragma unroll
    for (int j = 0; j < 4; ++j) { const int n = (lane >> 3) + 8 * j; const LAS float* s = scr + (8 * c) * 33 + n;
        v4u o; o.x = pk2(s[0 * 33], s[1 * 33]); o.y = pk2(s[2 * 33], s[3 * 33]); o.z = pk2(s[4 * 33], s[5 * 33]); o.w = pk2(s[6 * 33], s[7 * 33]);
        *(GAS v4u*)(WT + (size_t)(n0 + n) * K + k0 + 8 * c) = o; }
    LDS_WAIT(); asm volatile("" ::: "memory");
}
__device__ __forceinline__ void p0_prologue(Frame& F) {
    const Who W = who();
    LAS float* scr = (LAS float*)(F.lds + W.wave * 16384);
    const int gw = W.vcu * NWAVES + W.wave, NGW = W.G * NWAVES;
    unsigned char* ws = FWS(0);
    const float *w_in = FIN(I_WIN), *w_out = FIN(I_WOUT), *w_mlp_in = FIN(I_WMLPIN), *w_mlp_out = FIN(I_WMLPOUT), *w_ple_gate = FIN(I_WPLEGATE), *w_ple_proj = FIN(I_WPLEPROJ), *g_mix = FIN(I_GMIX), *g_mlp = FIN(I_GMLP), *g_ple = FIN(I_GPLE);
    constexpr int I_IN = (D / 64) * (INW / 32), I_OUT = (D / 64) * (D / 32), I_1 = (D / 64) * (FF / 32), I_2 = (FF / 64) * (D / 32), I_PG = I_OUT, I_PP = (PLE / 64) * (D / 32);
    constexpr int PER_L = I_IN + I_OUT + I_1 + I_2 + I_PG + I_PP;
    for (int it = gw; it < DEPTH * PER_L; it += NGW) {
        const int l = it / PER_L; int r = it % PER_L; bf16* wl = (bf16*)(ws + WS_W + (size_t)l * W_LAYER);
        if (r < I_IN) { p0_transpose_item(w_in + (size_t)l * D * INW, g_mix + l * D, D, INW, (bf16*)((unsigned char*)wl + WO_IN), scr, r, W.lane); continue; } r -= I_IN;
        if (r < I_OUT) { p0_transpose_item(w_out + (size_t)l * D * D, nullptr, D, D, (bf16*)((unsigned char*)wl + WO_OUT), scr, r, W.lane); continue; } r -= I_OUT;
        if (r < I_1) { p0_transpose_item(w_mlp_in + (size_t)l * D * FF, g_mlp + l * D, D, FF, (bf16*)((unsigned char*)wl + WO_W1), scr, r, W.lane); continue; } r -= I_1;
        if (r < I_2) { p0_transpose_item(w_mlp_out + (size_t)l * FF * D, nullptr, FF, D, (bf16*)((unsigned char*)wl + WO_W2), scr, r, W.lane); continue; } r -= I_2;
        if (r < I_PG) { p0_transpose_item(w_ple_gate + (size_t)l * D * D, g_ple + l * D, D, D, (bf16*)((unsigned char*)wl + WO_PG), scr, r, W.lane); continue; } r -= I_PG;
        p0_transpose_item(w_ple_proj + (size_t)l * PLE * D, nullptr, PLE, D, (bf16*)((unsigned char*)wl + WO_PP), scr, r, W.lane);
    }
    const float* x_ = FIN(I_X); float* H_ = FOUT(); bf16* XB1_ = (bf16*)(ws + WS_OV); float* SSQ1_ = (float*)(ws + WS_SSQ1); float* CS_ = (float*)(ws + WS_CS); const int* pos_ = (const int*)FIN(I_POS);
#pragma unroll 2
    for (int m = gw; m < M; m += NGW) {
        const GAS f32x4* xr = (const GAS f32x4*)(x_ + (size_t)m * D) + W.lane;
        GAS unsigned long long* o8 = (GAS unsigned long long*)(XB1_ + (size_t)m * D) + W.lane; float s = 0.f;
#pragma unroll
        for (int j = 0; j < 4; ++j) { const f32x4 v = xr[64 * j]; s += (v.x * v.x + v.y * v.y) + (v.z * v.z + v.w * v.w);
            o8[64 * j] = (unsigned long long)pk2(v.x, v.y) | ((unsigned long long)pk2(v.z, v.w) << 32); }
        s = wave_sum(s);
        if (W.lane < 16) SSQ1_[(size_t)m * 16 + W.lane] = (W.lane == 0) ? s : 0.f;
    }
}
__device__ __forceinline__ void convert_p(Frame& F, int l) {
    const Who W = who();
    const float* src = FIN(I_P) + (size_t)l * M * PLE; bf16* P16_ = (bf16*)FWS(WS_P16);
#pragma unroll 4
    for (size_t e = (size_t)W.vcu * NWAVES * 64 + W.tid; e < (size_t)M * PLE / 8; e += (size_t)W.G * NWAVES * 64) {
        const f32x4 a = *(const GAS f32x4*)(src + e * 8), b = *(const GAS f32x4*)(src + e * 8 + 4);
        v4u o; o.x = pk2(a.x, a.y); o.y = pk2(a.z, a.w); o.z = pk2(b.x, b.y); o.w = pk2(b.z, b.w);
        *(GAS v4u*)(P16_ + e * 8) = o; }
}
__device__ __forceinline__ void final_norm(Frame& F) {
    const Who W = who();
    const int gw = W.vcu * NWAVES + W.wave, NGW = W.G * NWAVES;
    const float* SSQ1_ = (const float*)FWS(WS_SSQ1); float* H_ = FOUT(); const float* gf_ = FIN(I_GFINAL);
    for (int m = gw; m < M; m += NGW) {
        const float rs = pg8::row_rs(SSQ1_, m);
        GAS f32x4* hr = (GAS f32x4*)(H_ + (size_t)m * D) + W.lane; const GAS f32x4* gr = (const GAS f32x4*)gf_ + W.lane;
#pragma unroll
        for (int j = 0; j < 4; ++j) { const f32x4 v = hr[64 * j], g = gr[64 * j]; hr[64 * j] = v * rs * g; }
    }
}

__device__ __forceinline__ void lru_item(Frame& F, int l, int item) {
    const int b = item >> 4, g = (item >> 1) & 7, hf = item & 1;
    const int tid_ = tid_opaque(), lane = tid_ & 63, w = __builtin_amdgcn_readfirstlane(tid_ >> 6), r = lane & 15, q = lane >> 4;
    LAS float* xcs = (LAS float*)(F.lds + w * 4352);
    LAS float* car = (LAS float*)(F.lds + 36864);
    const bf16* pj = (const bf16*)FWS(WS_PROJ) + (size_t)b * SEQ * INW;
    bf16* ao = (bf16*)FWS(WS_AO) + (size_t)b * SEQ * D;
    const int cch = g * 64 + lane;
    const float* conv_w = FIN(I_CONVW);
    const float cw0 = conv_w[(l * 4 + 0) * RW + cch], cw1 = conv_w[(l * 4 + 1) * RW + cch], cw2 = conv_w[(l * 4 + 2) * RW + cch], cw3 = conv_w[(l * 4 + 3) * RW + cch], cb = FIN(I_CONVB)[l * RW + cch];
    bf16x8 Bf[2][2][2];
#pragma unroll
    for (int gate = 0; gate < 2; ++gate) { const float* W = (gate ? FIN(I_WGX) : FIN(I_WGA)) + (size_t)(l * 8 + g) * 64 * 64;
#pragma unroll
        for (int n = 0; n < 2; ++n)
#pragma unroll
            for (int kk = 0; kk < 2; ++kk) { const float* wp = W + (size_t)(32 * kk + 8 * q) * 64 + hf * 32 + 16 * n + r; v4u pw;
                pw.x = pk2(wp[0 * 64], wp[1 * 64]); pw.y = pk2(wp[2 * 64], wp[3 * 64]); pw.z = pk2(wp[4 * 64], wp[5 * 64]); pw.w = pk2(wp[6 * 64], wp[7 * 64]);
                Bf[gate][n][kk] = __builtin_bit_cast(bf16x8, pw); } }
    float ba[2], bx[2], sp8[2];
#pragma unroll
    for (int n = 0; n < 2; ++n) { const int ch = l * RW + g * 64 + hf * 32 + 16 * n + r; ba[n] = FIN(I_BGA)[ch]; bx[n] = FIN(I_BGX)[ch];
        const float z = -FIN(I_LRULAM)[ch]; sp8[n] = 8.f * (fmaxf(z, 0.f) + log1pf(__expf(-fabsf(z)))); }
    float hin[2] = {0.f, 0.f};
    const int t0 = w * 256;
    const bf16* xcol = pj + 3 * AW + cch;
    const bf16* gcol = pj + 3 * AW + RW + g * 64 + hf * 32 + r;
    bf16* ycol = ao + AW + g * 64 + hf * 32 + r;
#pragma unroll 1
    for (int pass = 0; pass < 2; ++pass) {
        float h3 = 0.f, h2 = 0.f, h1 = 0.f;
        if (t0 != 0) { h3 = bf2f(xcol[(size_t)(t0 - 3) * INW]); h2 = bf2f(xcol[(size_t)(t0 - 2) * INW]); h1 = bf2f(xcol[(size_t)(t0 - 1) * INW]); }
        float hrun[2] = {pass ? hin[0] : 0.f, pass ? hin[1] : 0.f}, Arun[2] = {1.f, 1.f};
        unsigned short xq[16];
#pragma unroll
        for (int tt = 0; tt < 16; ++tt) xq[tt] = xcol[(size_t)(t0 + tt) * INW];
#pragma unroll 1
        for (int sc = 0; sc < 16; ++sc) {
            const int ts = t0 + sc * 16, tn = (sc < 15) ? ts + 16 : ts;
            unsigned short xn[16];
#pragma unroll
            for (int tt = 0; tt < 16; ++tt) xn[tt] = xcol[(size_t)(tn + tt) * INW];
            unsigned short gq[2][4];
            if (pass) {
#pragma unroll
                for (int n = 0; n < 2; ++n)
#pragma unroll
                    for (int i = 0; i < 4; ++i) gq[n][i] = gcol[(size_t)(ts + 4 * q + i) * INW + 16 * n];
            } else {
#pragma unroll
                for (int n = 0; n < 2; ++n)
#pragma unroll
                    for (int i = 0; i < 4; ++i) gq[n][i] = 0;
            }
#pragma unroll
            for (int tt = 0; tt < 16; ++tt) { const float xv = bf2f(xq[tt]); const float xc = cb + cw0 * h3 + cw1 * h2 + cw2 * h1 + cw3 * xv; h3 = h2; h2 = h1; h1 = xv; xcs[tt * 68 + lane] = xc; }
            asm volatile("s_waitcnt lgkmcnt(0)" ::: "memory");
            bf16x8 Af[2];
#pragma unroll
            for (int kk = 0; kk < 2; ++kk) { const LAS f32x4* ap = (const LAS f32x4*)(xcs + r * 68 + 32 * kk + 8 * q); const f32x4 a0 = ap[0], a1 = ap[1];
                v4u pw; pw.x = pk2(a0.x, a0.y); pw.y = pk2(a0.z, a0.w); pw.z = pk2(a1.x, a1.y); pw.w = pk2(a1.z, a1.w); Af[kk] = __builtin_bit_cast(bf16x8, pw); }
            f32x4 Da[2], Dx[2];
#pragma unroll
            for (int n = 0; n < 2; ++n) { Da[n] = (f32x4){0.f, 0.f, 0.f, 0.f}; Dx[n] = Da[n];
#pragma unroll
                for (int kk = 0; kk < 2; ++kk) { Da[n] = __builtin_amdgcn_mfma_f32_16x16x32_bf16(Af[kk], Bf[0][n][kk], Da[n], 0, 0, 0); Dx[n] = __builtin_amdgcn_mfma_f32_16x16x32_bf16(Af[kk], Bf[1][n][kk], Dx[n], 0, 0, 0); } }
#pragma unroll
            for (int n = 0; n < 2; ++n) {
                float a[4], bb[4];
#pragma unroll
                for (int i = 0; i < 4; ++i) { const float xcv = xcs[(4 * q + i) * 68 + hf * 32 + 16 * n + r];
                    const float ra = sigmoid_f(Da[n][i] + ba[n]), ix = sigmoid_f(Dx[n][i] + bx[n]);
                    const float la = -ra * sp8[n]; const float av = __builtin_amdgcn_exp2f(1.4426950408889634f * la);
                    const float y2 = 2.f * la;
                    const float ser = -y2 * (1.f + y2 * (0.5f + y2 * (0.16666667f + y2 * (0.041666668f + y2 * 0.008333334f))));
                    const float em = (y2 > -0.25f) ? ser : (1.f - av * av);
                    a[i] = av; bb[i] = __builtin_amdgcn_sqrtf(fmaxf(em, 0.f)) * (ix * xcv); }
                const float Al = (a[0] * a[1]) * (a[2] * a[3]);
                const float Hl = ((bb[0] * a[1] + bb[1]) * a[2] + bb[2]) * a[3] + bb[3];
                const float A0 = __shfl(Al, r), A1 = __shfl(Al, r + 16), A2 = __shfl(Al, r + 32), A3 = __shfl(Al, r + 48);
                const float H0 = __shfl(Hl, r), H1 = __shfl(Hl, r + 16), H2 = __shfl(Hl, r + 32), H3 = __shfl(Hl, r + 48);
                const float c0 = hrun[n], c1 = A0 * c0 + H0, c2 = A1 * c1 + H1, c3 = A2 * c2 + H2, c4 = A3 * c3 + H3;
                hrun[n] = c4; Arun[n] *= (A0 * A1) * (A2 * A3);
                if (pass) { float h = (q == 0) ? c0 : (q == 1) ? c1 : (q == 2) ? c2 : c3;
#pragma unroll
                    for (int i = 0; i < 4; ++i) { h = a[i] * h + bb[i]; const float gv = bf2f(gq[n][i]);
                        const float ge = gv * sigmoid_f(1.5957691216057308f * (gv + 0.044715f * gv * gv * gv));
                        ycol[(size_t)(ts + 4 * q + i) * D + 16 * n] = (bf16)(pk2(h * ge, 0.f) & 0xffffu); } }
            }
#pragma unroll
            for (int tt = 0; tt < 16; ++tt) xq[tt] = xn[tt];
        }
        if (pass == 0) {
            if (q == 0) {
#pragma unroll
                for (int n = 0; n < 2; ++n) { car[w * 64 + n * 16 + r] = Arun[n]; car[w * 64 + 32 + n * 16 + r] = hrun[n]; } }
            __syncthreads();
#pragma unroll
            for (int n = 0; n < 2; ++n) { float h = 0.f; for (int w2 = 0; w2 < w; ++w2) h = car[w2 * 64 + n * 16 + r] * h + car[w2 * 64 + 32 + n * 16 + r]; hin[n] = h; }
        }
    }
    __syncthreads();
}

__device__ __forceinline__ void attn_post(Frame& F, int l, int b, int h, int qb, float lam, float oscale) {
    const int tid_ = tid_opaque(), lane = tid_ & 63, wave_ = __builtin_amdgcn_readfirstlane(tid_ >> 6), rsub = lane >> 4, e8 = (lane & 15) * 8;
    const float* gs = FIN(I_GSUBLN) + l * 128 + e8; const bf16* OV_ = (const bf16*)FWS(WS_OV); bf16* AO_ = (bf16*)FWS(WS_AO); const f32x4 g0 = *(const f32x4*)gs, g1 = *(const f32x4*)(gs + 4);
    const size_t rowbase = (size_t)b * SEQ + qb * 256 + wave_ * 32;
#pragma unroll 4
    for (int it = 0; it < 8; ++it) { const size_t row = rowbase + it * 4 + rsub;
        const v4u a = *(const GAS v4u*)(OV_ + row * D + h * 256 + e8), c = *(const GAS v4u*)(OV_ + row * D + h * 256 + 128 + e8);
        f32x4 d0 = {pg8::bf_lo(a.x) - lam * pg8::bf_lo(c.x), pg8::bf_hi(a.x) - lam * pg8::bf_hi(c.x), pg8::bf_lo(a.y) - lam * pg8::bf_lo(c.y), pg8::bf_hi(a.y) - lam * pg8::bf_hi(c.y)};
        f32x4 d1 = {pg8::bf_lo(a.z) - lam * pg8::bf_lo(c.z), pg8::bf_hi(a.z) - lam * pg8::bf_hi(c.z), pg8::bf_lo(a.w) - lam * pg8::bf_lo(c.w), pg8::bf_hi(a.w) - lam * pg8::bf_hi(c.w)};
        float ss = pg8::sumsq8(d0, d1);
        ss += __shfl_xor(ss, 1); ss += __shfl_xor(ss, 2); ss += __shfl_xor(ss, 4); ss += __shfl_xor(ss, 8);
        const float rs = __builtin_amdgcn_rsqf(ss * (1.f / 128.f) + 1e-6f) * oscale;
        d0 = d0 * rs * g0; d1 = d1 * rs * g1;
        v4u o; o.x = pk2(d0.x, d0.y); o.y = pk2(d0.z, d0.w); o.z = pk2(d1.x, d1.y); o.w = pk2(d1.z, d1.w);
        *(GAS v4u*)(AO_ + row * D + h * 128 + e8) = o; }
}

struct Args { const void* in[23]; float* out; unsigned char* ws; int ph_lo, ph_hi; };
constexpr int N_PHASES = 2 + 6 * DEPTH;
__global__ void __launch_bounds__(NWAVES * 64, 2) hymba_fwd(Args args) {
    extern __shared__ __attribute__((aligned(16))) unsigned char lds[];
    cg::grid_group grid = cg::this_grid();
    Frame F;
    F.lds = (LAS unsigned char*)lds;
    { LAS unsigned long long* tabw = (LAS unsigned long long*)(F.lds + RING_BYTES + 1024);
      if (threadIdx.x == 0) {
#pragma unroll
          for (int k = 0; k < 23; ++k) tabw[k] = (unsigned long long)args.in[k];
          tabw[23] = (unsigned long long)args.out; tabw[24] = (unsigned long long)args.ws; }
      F.tab = tabw; }
    __syncthreads();
    const int lo = args.ph_lo, hi = args.ph_hi;
#define IN(k) (lo <= (k) && (k) < hi)
#define SEAM(k) do { if (IN(k) && IN((k) + 1)) xcd_barrier(bar); } while (0)

    if (blockIdx.x == 0) { unsigned* bw = (unsigned*)args.ws; for (int u = threadIdx.x; u < XCD_BAR_WORDS; u += NWAVES * 64) bw[u] = 0u; }
    if (threadIdx.x < 2) ((volatile LAS unsigned*)(F.lds + RING_BYTES + 2048))[threadIdx.x] = 0u;
    if (IN(0)) { p0_prologue(F); }
    grid.sync();
    XcdBarrier bar = xcd_barrier_post((unsigned*)args.ws, (volatile LAS unsigned*)(F.lds + RING_BYTES + 2048));

#pragma unroll 1
    for (int l_ = 0; l_ < DEPTH; ++l_) {
        const int pb = 1 + 6 * l_;
        if (IN(pb + 0)) {
            const Who W = who(); const int l = opaque_s(l_);
            unsigned char* ws = FWS(0); const unsigned char* wl = ws + WS_W + (size_t)l * W_LAYER;
            pg8::Gemm g{(const bf16*)(ws + WS_OV), (const bf16*)(wl + WO_IN), M, INW, D}; pg8::StaticOrder S; S.init(M, INW, W.G, opaque_s((int)blockIdx.x));
            pg8::EpiIn E{(bf16*)(ws + WS_PROJ), INW, (const float*)(ws + WS_SSQ1), (const int*)FIN(I_POS), attn_body::C2};
            pg8::gemm_phase<pg8::EpiIn, pg8::StaticOrder, true, true>(F.lds, g, S, E);
        }
        SEAM(pb + 0);
        if (IN(pb + 1)) {
            const Who W = who(); const int l = opaque_s(l_);
            float lam, oscale;
            { const float* lq = FIN(I_LAMQ) + l * 128; const float* lk = FIN(I_LAMK) + l * 128;
              const float d0 = wave_sum(lq[W.lane] * lk[W.lane]), d1 = wave_sum(lq[64 + W.lane] * lk[64 + W.lane]);
              const float li = 0.8f - 0.6f * __expf(-0.3f * (float)l); lam = __expf(d0) - __expf(d1) + li; oscale = 1.f - li; }
#if defined(PROBE_ATTN2)
            for (int rep_ = 0; rep_ < 2; ++rep_)
#endif
            for (int item = W.vcu; item < 256; item += W.G) {
                const int bh = item >> 2, s = item & 3, b = bh >> 2, h = bh & 3;
                const attn_body::bf16* pj = (const attn_body::bf16*)((const bf16*)FWS(WS_PROJ) + (size_t)b * SEQ * INW); attn_body::bf16* ov = (attn_body::bf16*)((bf16*)FWS(WS_OV) + (size_t)b * SEQ * D);
#pragma unroll 1
                for (int k = 0; k < 2; ++k) { const int qb = k ? 7 - s : s;
#pragma unroll 1
                    for (int j = 0; j < 4; ++j) { const int c = j >> 1, vh = j & 1;
                        attn_body::attn_unit<8>(qb, pj + (h * 2 + c) * 64, pj + AW + (h * 2 + c) * 64, pj + 2 * AW + h * 128 + vh * 64, ov + h * 256 + c * 128 + vh * 64, (char*)lds); }
                    VM_WAIT(); __syncthreads(); __builtin_amdgcn_fence(__ATOMIC_ACQUIRE, "agent"); VM_WAIT();
                    attn_post(F, l, b, h, qb, lam, oscale);
                }
            }
            __syncthreads();
#if defined(PROBE_LRU2)
            for (int rep_ = 0; rep_ < 2; ++rep_)
#endif
            for (int item = W.vcu; item < 256; item += W.G) lru_item(F, l, item);
        }
        SEAM(pb + 1);
        if (IN(pb + 2)) {
            const Who W = who(); const int l = opaque_s(l_);
            unsigned char* ws = FWS(0); const unsigned char* wl = ws + WS_W + (size_t)l * W_LAYER;
            pg8::Gemm g{(const bf16*)(ws + WS_AO), (const bf16*)(wl + WO_OUT), M, D, D}; pg8::StaticOrder S; S.init(M, D, W.G, opaque_s((int)blockIdx.x));
            float* Hp = FOUT(); pg8::EpiRes E{l == 0 ? FIN(I_X) : (const float*)Hp, Hp, (bf16*)(ws + WS_XB0), (float*)(ws + WS_SSQ0)};
            pg8::gemm_phase<pg8::EpiRes, pg8::StaticOrder, true, true>(F.lds, g, S, E);
        }
        SEAM(pb + 2);
        if (IN(pb + 3)) {
            const Who W = who(); const int l = opaque_s(l_);
            convert_p(F, l);
            unsigned char* ws = FWS(0); const unsigned char* wl = ws + WS_W + (size_t)l * W_LAYER;
            pg8::Gemm g{(const bf16*)(ws + WS_XB0), (const bf16*)(wl + WO_W1), M, FF, D}; pg8::StaticOrder S; S.init(M, FF, W.G, opaque_s((int)blockIdx.x));
            pg8::EpiMlpIn E{(bf16*)(ws + WS_HB), FF, (const float*)(ws + WS_SSQ0)};
            pg8::gemm_phase<pg8::EpiMlpIn, pg8::StaticOrder, true, true>(F.lds, g, S, E);
        }
        SEAM(pb + 3);
        if (IN(pb + 4)) {
            const Who W = who(); const int l = opaque_s(l_);
            unsigned char* ws = FWS(0); const unsigned char* wl = ws + WS_W + (size_t)l * W_LAYER;
            pg8::Gemm g{(const bf16*)(ws + WS_HB), (const bf16*)(wl + WO_W2), M, D, FF}; pg8::StaticOrder S; S.init(M, D, W.G, opaque_s((int)blockIdx.x));
            float* Hp = FOUT(); pg8::EpiRes E{Hp, Hp, (bf16*)(ws + WS_XB0), (float*)(ws + WS_SSQ0)};
            pg8::gemm_phase<pg8::EpiRes, pg8::StaticOrder, true, true>(F.lds, g, S, E);
        }
        SEAM(pb + 4);
        if (IN(pb + 5)) {
            const Who W = who(); const int l = opaque_s(l_);
            { unsigned char* ws = FWS(0); const unsigned char* wl = ws + WS_W + (size_t)l * W_LAYER;
              pg8::Gemm g{(const bf16*)(ws + WS_P16), (const bf16*)(wl + WO_PP), M, D, opaque_s(PLE)}; pg8::StaticOrder S; S.init(M, D, W.G, opaque_s((int)blockIdx.x));
              pg8::EpiPlain E{(bf16*)(ws + WS_PP), D};
              pg8::gemm_phase<pg8::EpiPlain, pg8::StaticOrder, true, true>(F.lds, g, S, E); }
            VM_WAIT(); __syncthreads();
            { unsigned char* ws = FWS(0); const unsigned char* wl = ws + WS_W + (size_t)l * W_LAYER;
              pg8::Gemm g{(const bf16*)(ws + WS_XB0), (const bf16*)(wl + WO_PG), M, D, D}; pg8::StaticOrder S; S.init(M, D, W.G, opaque_s((int)blockIdx.x));
              pg8::EpiPle E{FOUT(), (bf16*)(ws + WS_OV), (const float*)(ws + WS_SSQ0), (float*)(ws + WS_SSQ1), (const bf16*)(ws + WS_PP)};
              pg8::gemm_phase<pg8::EpiPle, pg8::StaticOrder, true, true>(F.lds, g, S, E); }
        }
        SEAM(pb + 5);
    }
    if (IN(N_PHASES - 1)) final_norm(F);
#undef IN
#undef SEAM
}

extern "C" void kernel_launch(void* const* d_in, const int* in_sizes, int n_in, void* d_out, int out_size, void* d_ws, size_t ws_size, hipStream_t stream) {
    static int grid = 0;
    if (grid == 0) {
        if (n_in != 23 || in_sizes[0] != M * D || out_size != M * D || ws_size < WS_END) { fprintf(stderr, "kernel_launch: unexpected shapes: n_in %d in0 %d out %d ws %zu (need %zu); nothing launched\n", n_in, n_in > 0 ? in_sizes[0] : -1, out_size, ws_size, (size_t)WS_END); grid = -1; return; }
        int dev = 0, cus = 0, per_cu = 0;
        if (hipGetDevice(&dev) != hipSuccess || hipDeviceGetAttribute(&cus, hipDeviceAttributeMultiprocessorCount, dev) != hipSuccess) { grid = -1; return; }
        if (hipFuncSetAttribute((const void*)hymba_fwd, hipFuncAttributeMaxDynamicSharedMemorySize, LDS_BYTES) != hipSuccess) { fprintf(stderr, "kernel_launch: hipFuncSetAttribute failed\n"); grid = -1; return; }
        if (hipOccupancyMaxActiveBlocksPerMultiprocessor(&per_cu, (const void*)hymba_fwd, NWAVES * 64, LDS_BYTES) != hipSuccess || per_cu < 1) { fprintf(stderr, "kernel_launch: occupancy query reports %d\n", per_cu); per_cu = 1; }
        (void)hipGetLastError();
        grid = cus * per_cu;
    }
    if (grid < 0) return;
    Args a{};
    for (int i = 0; i < 23; ++i) a.in[i] = d_in[i];
    a.out = (float*)d_out; a.ws = (unsigned char*)d_ws;
#ifndef MK_CUTS
    a.ph_lo = 0; a.ph_hi = N_PHASES;
    void* kargs[] = {&a};
    hipError_t e = hipLaunchCooperativeKernel((const void*)hymba_fwd, dim3(grid), dim3(NWAVES * 64), kargs, LDS_BYTES, stream);
    if (e != hipSuccess) fprintf(stderr, "kernel_launch: cooperative launch failed: %s (grid %d)\n", hipGetErrorString(e), grid);
#else
    for (int ph = 0; ph < N_PHASES; ++ph) { a.ph_lo = ph; a.ph_hi = ph + 1; void* kargs[] = {&a};
        hipError_t e = hipLaunchCooperativeKernel((const void*)hymba_fwd, dim3(grid), dim3(NWAVES * 64), kargs, LDS_BYTES, stream);
        if (e != hipSuccess) { fprintf(stderr, "kernel_launch: launch %d failed: %s\n", ph, hipGetErrorString(e)); break; } }
#endif
}
```

```cpp
#include <hip/hip_runtime.h>
#include <cstdio>
#include <cstdint>
__device__ __forceinline__ int tid_opaque() { int t = threadIdx.x; asm volatile("" : "+v"(t)); return t; }
namespace pg8 {
#define PG8_LAS __attribute__((address_space(3)))
typedef unsigned short bf16_t;
typedef short bf16x8 __attribute__((ext_vector_type(8)));
typedef float f32x4 __attribute__((ext_vector_type(4)));
typedef unsigned u32x4 __attribute__((ext_vector_type(4)));
constexpr int BM = 256, BK = 64, HALF = 128, HTB = HALF * BK * 2  , STAGE_BYTES = 8 * HTB, NXCD = 8, WGM = 8;

__host__ __device__ __forceinline__ int lds_byte(int r, int c) { const int st = (r >> 4) * 2 + (c >> 5), rr = r & 15, cc = c & 31, ob = rr * 64 + cc * 2; return st * 1024 + (ob ^ (((ob >> 9) & 1) << 5)); }
__host__ __device__ __forceinline__ void stage_rc(int b, int& R, int& C) { const int st = b / 1024, sb = b % 1024, swz = sb ^ (((sb >> 9) & 1) << 5); R = (st >> 1) * 16 + swz / 64; C = (st & 1) * 32 + (swz % 64) / 2; }
__host__ __device__ __forceinline__ int perm32(int rho) { const int n = rho >> 4, i = rho & 15; return 8 * (i >> 2) + 4 * n + (i & 3); }

struct Unit { int pm, pn; };
struct Gemm { const bf16_t* A; const bf16_t* Bt; int M, N, K; };

struct StaticOrder {
    int nM, nN, nwg, G, c;
    __host__ __device__ void init(int M, int N, int G_, int c_) { nM = M / BM; nN = N / BM; nwg = nM * nN; G = G_; c = c_; }
    __host__ __device__ bool next(int i, Unit& u) const {
        const long L = (long)i * G + c; if (L >= nwg) return false;
        int wgid = (int)L; { const int q = nwg / NXCD, r = nwg % NXCD, xcd = wgid % NXCD, off = wgid / NXCD; wgid = (xcd < r ? xcd * (q + 1) : r * (q + 1) + (xcd - r) * q) + off; }
        const int nig = WGM * nN, gid = wgid / nig, fm = gid * WGM, gsz = (nM - fm) < WGM ? (nM - fm) : WGM;
        u.pm = fm + ((wgid % nig) % gsz); u.pn = (wgid % nig) / gsz; return true;
    }
    __device__ __forceinline__ void a_ready(const Unit&) const {}
    __device__ __forceinline__ void done(const Unit&) const {}
};

__device__ __forceinline__ unsigned cvt_pk_bf16(float lo, float hi) { unsigned r; asm volatile("v_cvt_pk_bf16_f32 %0, %1, %2" : "=v"(r) : "v"(lo), "v"(hi)); return r; }
__device__ __forceinline__ u32x4 pack8(const f32x4 v0, const f32x4 v1) { u32x4 w; w.x = cvt_pk_bf16(v0[0], v0[1]); w.y = cvt_pk_bf16(v0[2], v0[3]); w.z = cvt_pk_bf16(v1[0], v1[1]); w.w = cvt_pk_bf16(v1[2], v1[3]); return w; }
__device__ __forceinline__ float bf_lo(unsigned w) { return __uint_as_float(w << 16); }
__device__ __forceinline__ float bf_hi(unsigned w) { return __uint_as_float(w & 0xffff0000u); }
constexpr int DMODEL = 1024;
constexpr float RMS_EPS = 1e-6f;
__device__ __forceinline__ float row_rs(const float* ssq, int row) {
    const f32x4* p = (const f32x4*)(ssq + (size_t)row * 16);
    const f32x4 a = p[0], b = p[1], c = p[2], d = p[3];
    const float s = (((a[0] + a[1]) + (a[2] + a[3])) + ((b[0] + b[1]) + (b[2] + b[3]))) + (((c[0] + c[1]) + (c[2] + c[3])) + ((d[0] + d[1]) + (d[2] + d[3])));
    return __builtin_amdgcn_rsqf(s * (1.0f / DMODEL) + RMS_EPS);
}
__device__ __forceinline__ float sumsq8(const f32x4 a, const f32x4 b) { return ((a[0] * a[0] + a[1] * a[1]) + (a[2] * a[2] + a[3] * a[3])) + ((b[0] * b[0] + b[1] * b[1]) + (b[2] * b[2] + b[3] * b[3])); }

struct EpiPlain {
    static constexpr bool PERM = true, AFTER_DRAIN = false;
    bf16_t* O; int ldc;
    __device__ __forceinline__ void operator()(const f32x4 (&acc)[2][2][4][2], const Unit& u, int wr, int wc, int fr, int fq) const {
        const int row0 = u.pm * BM + wr * 64 + fr, col0 = u.pn * BM + wc * 32 + 8 * fq;
#pragma unroll
        for (int ai = 0; ai < 2; ++ai)
#pragma unroll
            for (int m = 0; m < 4; ++m) { bf16_t* rowp = O + (size_t)(row0 + ai * HALF + m * 16) * ldc + col0;
#pragma unroll
                for (int bj = 0; bj < 2; ++bj) *(u32x4*)(rowp + bj * HALF) = pack8(acc[ai][bj][m][0], acc[ai][bj][m][1]); }
    }
};
__device__ __forceinline__ void row_rs8(float (&rs)[8], const float* ssq, int row0, int fq) {
    f32x4 p[8];
#pragma unroll
    for (int i = 0; i < 8; ++i) p[i] = *(const f32x4*)(ssq + (size_t)(row0 + (i >> 2) * HALF + (i & 3) * 16) * 16 + 4 * fq);
#pragma unroll
    for (int i = 0; i < 8; ++i) { float s = (p[i][0] + p[i][1]) + (p[i][2] + p[i][3]); s += __shfl_xor(s, 16); s += __shfl_xor(s, 32); rs[i] = __builtin_amdgcn_rsqf(s * (1.0f / DMODEL) + RMS_EPS); }
}
struct EpiIn {
    static constexpr bool PERM = true, AFTER_DRAIN = false;
    bf16_t* O; int ldc; const float* ssq; const int* pos; float qscale;
    __device__ __forceinline__ void operator()(const f32x4 (&acc)[2][2][4][2], const Unit& u, int wr, int wc, int fr, int fq) const {
        const int row0 = u.pm * BM + wr * 64 + fr, col0 = u.pn * BM + wc * 32 + 8 * fq;
        const bool rope = (u.pn < 4) && !(wc & 1);
        const float sc = (u.pn < 2) ? qscale : 1.f;
        float rs[8]; row_rs8(rs, ssq, row0, fq);
        if (rope) {
            int ps[8];
#pragma unroll
            for (int i = 0; i < 8; ++i) ps[i] = pos[row0 + (i >> 2) * HALF + (i & 3) * 16];
            const bool mine = fq < 2; const float sgn = (fq == 0) ? -1.f : 1.f;
            const float invf[8] = {1.0f, 0.1939227432012558f, 0.03760603070259094f, 0.007292664609849453f, 0.0014142135623842478f, 0.00027424818836152554f, 5.3182957344688475e-05f, 1.0313385246263351e-05f};
#pragma unroll
            for (int ai = 0; ai < 2; ++ai)
#pragma unroll
                for (int m = 0; m < 4; ++m) { const int row = row0 + ai * HALF + m * 16; const float r = rs[ai * 4 + m] * sc; const float pf = (float)ps[ai * 4 + m];
                    bf16_t* rowp = O + (size_t)row * ldc + col0;
                    float c[8], sn[8];
#pragma unroll
                    for (int e = 0; e < 8; ++e) { const float rev = __builtin_amdgcn_fractf((pf * invf[e]) * 0.15915494309189535f); c[e] = mine ? __builtin_amdgcn_cosf(rev) : 1.f; sn[e] = mine ? __builtin_amdgcn_sinf(rev) * sgn : 0.f; }
#pragma unroll
                    for (int bj = 0; bj < 2; ++bj) { f32x4 v0 = acc[ai][bj][m][0] * r, v1 = acc[ai][bj][m][1] * r; f32x4 p0, p1;
#pragma unroll
                        for (int e = 0; e < 4; ++e) { p0[e] = __shfl_xor(v0[e], 16); p1[e] = __shfl_xor(v1[e], 16); }
#pragma unroll
                        for (int e = 0; e < 4; ++e) { v0[e] = v0[e] * c[e] + p0[e] * sn[e]; v1[e] = v1[e] * c[4 + e] + p1[e] * sn[4 + e]; }
                        *(u32x4*)(rowp + bj * HALF) = pack8(v0, v1); } }
        } else {
#pragma unroll
            for (int ai = 0; ai < 2; ++ai)
#pragma unroll
                for (int m = 0; m < 4; ++m) { const int row = row0 + ai * HALF + m * 16; const float r = rs[ai * 4 + m] * sc;
                    bf16_t* rowp = O + (size_t)row * ldc + col0;
#pragma unroll
                    for (int bj = 0; bj < 2; ++bj) *(u32x4*)(rowp + bj * HALF) = pack8(acc[ai][bj][m][0] * r, acc[ai][bj][m][1] * r); }
        }
    }
};
struct EpiRes {
    static constexpr bool PERM = true, AFTER_DRAIN = false;
    const float* Hin; float* H; bf16_t* XB; float* ssq;
    __device__ __forceinline__ void operator()(const f32x4 (&acc)[2][2][4][2], const Unit& u, int wr, int wc, int fr, int fq) const {
        const int row0 = u.pm * BM + wr * 64 + fr, col0 = u.pn * BM + wc * 32 + 8 * fq;
#pragma unroll
        for (int ai = 0; ai < 2; ++ai) {
            f32x4 hv[4][2][2];
#pragma unroll
            for (int m = 0; m < 4; ++m)
#pragma unroll
                for (int bj = 0; bj < 2; ++bj) { const float* hp = Hin + (size_t)(row0 + ai * HALF + m * 16) * DMODEL + col0 + bj * HALF; hv[m][bj][0] = *(const f32x4*)hp; hv[m][bj][1] = *(const f32x4*)(hp + 4); }
#pragma unroll
            for (int m = 0; m < 4; ++m) { const int row = row0 + ai * HALF + m * 16; float part = 0.f;
#pragma unroll
                for (int bj = 0; bj < 2; ++bj) { float* hp = H + (size_t)row * DMODEL + col0 + bj * HALF;
                    const f32x4 h0 = hv[m][bj][0] + acc[ai][bj][m][0], h1 = hv[m][bj][1] + acc[ai][bj][m][1];
                    *(f32x4*)hp = h0; *(f32x4*)(hp + 4) = h1; part += sumsq8(h0, h1);
                    *(u32x4*)(XB + (size_t)row * DMODEL + col0 + bj * HALF) = pack8(h0, h1); }
                part += __shfl_xor(part, 16); part += __shfl_xor(part, 32);
                if (fq == 0) ssq[(size_t)row * 16 + u.pn * 4 + wc] = part; }
            asm volatile("" ::: "memory"); }
    }
};
struct EpiMlpIn {
    static constexpr bool PERM = true, AFTER_DRAIN = false;
    bf16_t* O; int ldc; const float* ssq;
    __device__ __forceinline__ void operator()(const f32x4 (&acc)[2][2][4][2], const Unit& u, int wr, int wc, int fr, int fq) const {
        const int row0 = u.pm * BM + wr * 64 + fr, col0 = u.pn * BM + wc * 32 + 8 * fq;
        float rs[8]; row_rs8(rs, ssq, row0, fq);
#pragma unroll
        for (int ai = 0; ai < 2; ++ai)
#pragma unroll
            for (int m = 0; m < 4; ++m) { const int row = row0 + ai * HALF + m * 16; const float r = rs[ai * 4 + m];
                bf16_t* rowp = O + (size_t)row * ldc + col0;
#pragma unroll
                for (int bj = 0; bj < 2; ++bj) { f32x4 v0 = acc[ai][bj][m][0] * r, v1 = acc[ai][bj][m][1] * r;
#pragma unroll
                    for (int e = 0; e < 4; ++e) { const float a = fmaxf(v0[e], 0.f), b = fmaxf(v1[e], 0.f); v0[e] = a * a; v1[e] = b * b; }
                    *(u32x4*)(rowp + bj * HALF) = pack8(v0, v1); } }
    }
};
struct EpiPle {
    static constexpr bool PERM = true, AFTER_DRAIN = false;
    float* H; bf16_t* XBo; const float* ssq_in; float* ssq_out; const bf16_t* PP;
    __device__ __forceinline__ void operator()(const f32x4 (&acc)[2][2][4][2], const Unit& u, int wr, int wc, int fr, int fq) const {
        const int row0 = u.pm * BM + wr * 64 + fr, col0 = u.pn * BM + wc * 32 + 8 * fq;
#pragma unroll
        for (int ai = 0; ai < 2; ++ai) {
          float rs[4];
          { f32x4 p[4];
#pragma unroll
            for (int i = 0; i < 4; ++i) p[i] = *(const f32x4*)(ssq_in + (size_t)(row0 + ai * HALF + i * 16) * 16 + 4 * fq);
#pragma unroll
            for (int i = 0; i < 4; ++i) { float s = (p[i][0] + p[i][1]) + (p[i][2] + p[i][3]); s += __shfl_xor(s, 16); s += __shfl_xor(s, 32); rs[i] = __builtin_amdgcn_rsqf(s * (1.0f / DMODEL) + RMS_EPS); } }
#pragma unroll
          for (int mh = 0; mh < 2; ++mh) {
            f32x4 hv[2][2][2]; u32x4 pw[2][2];
#pragma unroll
            for (int mm = 0; mm < 2; ++mm)
#pragma unroll
                for (int bj = 0; bj < 2; ++bj) { const size_t off = (size_t)(row0 + ai * HALF + (2 * mh + mm) * 16) * DMODEL + col0 + bj * HALF; hv[mm][bj][0] = *(const f32x4*)(H + off); hv[mm][bj][1] = *(const f32x4*)(H + off + 4); pw[mm][bj] = *(const u32x4*)(PP + off); }
#pragma unroll
            for (int mm = 0; mm < 2; ++mm) { const int m = 2 * mh + mm; const int row = row0 + ai * HALF + m * 16; const float r = rs[m]; float part = 0.f;
#pragma unroll
                for (int bj = 0; bj < 2; ++bj) { float* hp = H + (size_t)row * DMODEL + col0 + bj * HALF; const u32x4 w = pw[mm][bj];
                    const f32x4 p0 = {bf_lo(w.x), bf_hi(w.x), bf_lo(w.y), bf_hi(w.y)}, p1 = {bf_lo(w.z), bf_hi(w.z), bf_lo(w.w), bf_hi(w.w)};
                    f32x4 g0 = acc[ai][bj][m][0] * r, g1 = acc[ai][bj][m][1] * r;
#pragma unroll
                    for (int e = 0; e < 4; ++e) { g0[e] = __builtin_amdgcn_rcpf(1.f + __builtin_amdgcn_exp2f(-1.4426950408889634f * g0[e])); g1[e] = __builtin_amdgcn_rcpf(1.f + __builtin_amdgcn_exp2f(-1.4426950408889634f * g1[e])); }
                    const f32x4 h0 = hv[mm][bj][0] + g0 * p0, h1 = hv[mm][bj][1] + g1 * p1;
                    *(f32x4*)hp = h0; *(f32x4*)(hp + 4) = h1; part += sumsq8(h0, h1);
                    *(u32x4*)(XBo + (size_t)row * DMODEL + col0 + bj * HALF) = pack8(h0, h1); }
                part += __shfl_xor(part, 16); part += __shfl_xor(part, 32);
                if (fq == 0) ssq_out[(size_t)row * 16 + u.pn * 4 + wc] = part; }
            asm volatile("" ::: "memory"); } }
    }
};

template <class Epi, class Sched, bool ALIGN_EPI = false, bool SP2 = false>
__device__ __forceinline__ void gemm_phase(PG8_LAS unsigned char* lds, const Gemm g, const Sched& S, const Epi& E) {
    const int tid = tid_opaque(), wid = __builtin_amdgcn_readfirstlane(tid >> 6), lane = tid & 63, wr = wid >> 2, wc = wid & 3, fr = lane & 15, fq = lane >> 4;
    const int K = g.K, nt = K / BK;
    unsigned voffA[2], voffB[2];
#pragma unroll
    for (int i = 0; i < 2; ++i) { int R, C; stage_rc(tid * 16 + i * 8192, R, C); const int Rb = Epi::PERM ? ((R & ~31) + perm32(R & 31)) : R;
        voffA[i] = (unsigned)(R * K + C) * 2u; voffB[i] = (unsigned)(Rb * K + C) * 2u; }
    const size_t kstep = (size_t)(BK * 2);
    const size_t hstep = (size_t)HALF * K * 2;
    const size_t tstep = 2 * hstep;
    const unsigned ldsw = (unsigned)wid * 1024u;
    const int aoff = lds_byte(wr * 64 + fr, fq * 8), boff = lds_byte(wc * 32 + fr, fq * 8);
#define PG8_SA(b, h) (((b) * 2 + (h)) * HTB)
#define PG8_SB(b, h) ((4 + (b) * 2 + (h)) * HTB)
#define PG8_STAGE(bufoff, gbase, voff) do { _Pragma("unroll") for (int _i = 0; _i < 2; ++_i) \
        __builtin_amdgcn_global_load_lds((const unsigned*)((const char*)(gbase) + (voff)[_i]), (PG8_LAS unsigned*)(lds + (bufoff) + ldsw + _i * 8192), 16, 0, 0); } while (0)
#define PG8_LDA(dst, b, h) do { _Pragma("unroll") for (int m = 0; m < 4; ++m) _Pragma("unroll") for (int k = 0; k < 2; ++k) dst[m][k] = *(const PG8_LAS bf16x8*)(lds + PG8_SA(b, h) + aoff + m * 2048 + k * 1024); } while (0)
#define PG8_LDB(dst, b, h) do { _Pragma("unroll") for (int n = 0; n < 2; ++n) _Pragma("unroll") for (int k = 0; k < 2; ++k) dst[n][k] = *(const PG8_LAS bf16x8*)(lds + PG8_SB(b, h) + boff + n * 2048 + k * 1024); } while (0)
#define PG8_MMA(ai, bj, At, Bt) do { __builtin_amdgcn_s_setprio(1); _Pragma("unroll") for (int m = 0; m < 4; ++m) _Pragma("unroll") for (int n = 0; n < 2; ++n) _Pragma("unroll") for (int k = 0; k < 2; ++k) \
        acc[ai][bj][m][n] = __builtin_amdgcn_mfma_f32_16x16x32_bf16(Bt[n][k], At[m][k], acc[ai][bj][m][n], 0, 0, 0); __builtin_amdgcn_s_setprio(0); } while (0)
#define PG8_WAIT_V(n) asm volatile("s_waitcnt vmcnt(" #n ")" ::: "memory")
#define PG8_WAIT_L(n) asm volatile("s_waitcnt lgkmcnt(" #n ")" ::: "memory")
#define PG8_BAR __builtin_amdgcn_s_barrier()
#define PG8_SCHED __builtin_amdgcn_sched_barrier(0)
    Unit cur, nxt; int ui = 0;
    if (!S.next(0, cur)) return;
    f32x4 acc[2][2][4][2];
#pragma unroll
    for (int a = 0; a < 2; ++a)
#pragma unroll
        for (int b = 0; b < 2; ++b)
#pragma unroll
            for (int m = 0; m < 4; ++m)
#pragma unroll
                for (int n = 0; n < 2; ++n) acc[a][b][m][n] = (f32x4){0.f, 0.f, 0.f, 0.f};
    bf16x8 At[4][2], B0[2][2], B1[2][2];
    const char* cA = (const char*)g.A + (size_t)cur.pm * tstep; const char* cB = (const char*)g.Bt + (size_t)cur.pn * tstep;
    S.a_ready(cur);
    if constexpr (SP2) {
        PG8_STAGE(PG8_SB(0, 0), cB, voffB); PG8_STAGE(PG8_SB(0, 1), cB + hstep, voffB); PG8_STAGE(PG8_SA(0, 0), cA, voffA); PG8_STAGE(PG8_SA(0, 1), cA + hstep, voffA);
        if (wr == 1) PG8_BAR;
        PG8_WAIT_V(2); PG8_BAR;
        PG8_STAGE(PG8_SB(1, 0), cB + kstep, voffB); PG8_STAGE(PG8_SA(1, 0), cA + kstep, voffA); PG8_STAGE(PG8_SB(1, 1), cB + hstep + kstep, voffB);
        PG8_WAIT_V(6); PG8_BAR;
    } else {
        PG8_STAGE(PG8_SB(0, 0), cB, voffB); PG8_STAGE(PG8_SA(0, 0), cA, voffA); PG8_STAGE(PG8_SB(0, 1), cB + hstep, voffB); PG8_STAGE(PG8_SA(0, 1), cA + hstep, voffA);
        if (wr == 1) PG8_BAR;
        PG8_WAIT_V(4); PG8_BAR;
        PG8_STAGE(PG8_SB(1, 0), cB + kstep, voffB); PG8_STAGE(PG8_SA(1, 0), cA + kstep, voffA); PG8_STAGE(PG8_SB(1, 1), cB + hstep + kstep, voffB);
        PG8_WAIT_V(6); PG8_BAR;
    }
    for (;;) {
        const bool has_next = S.next(ui + 1, nxt);
        const char* nA = has_next ? (const char*)g.A + (size_t)nxt.pm * tstep : cA; const char* nB = has_next ? (const char*)g.Bt + (size_t)nxt.pn * tstep : cB;
        for (int t = 0; t < nt; t += 2) {
            const bool last = (t == nt - 2);
            const char* a1 = cA + (size_t)(t + 1) * kstep;
            const char* a2 = last ? nA : cA + (size_t)(t + 2) * kstep; const char* b2 = last ? nB : cB + (size_t)(t + 2) * kstep;
            const char* a3 = a2 + kstep; const char* b3 = b2 + kstep;
            if (last && has_next) S.a_ready(nxt);
            if constexpr (SP2) {
            PG8_LDB(B0, 0, 0); PG8_LDB(B1, 0, 1); PG8_SCHED; PG8_LDA(At, 0, 0); PG8_STAGE(PG8_SA(1, 1), a1 + hstep, voffA);
            PG8_WAIT_V(8); PG8_WAIT_L(0); PG8_BAR; PG8_MMA(0, 0, At, B0); PG8_MMA(0, 1, At, B1); PG8_BAR; PG8_SCHED;
            PG8_LDA(At, 0, 1); PG8_STAGE(PG8_SB(0, 0), b2, voffB); PG8_STAGE(PG8_SB(0, 1), b2 + hstep, voffB); PG8_STAGE(PG8_SA(0, 0), a2, voffA);
            PG8_WAIT_V(8); PG8_WAIT_L(0); PG8_BAR; PG8_MMA(1, 0, At, B0); PG8_MMA(1, 1, At, B1); PG8_BAR; PG8_SCHED;
            PG8_LDB(B0, 1, 0); PG8_LDB(B1, 1, 1); PG8_SCHED; PG8_LDA(At, 1, 0); PG8_STAGE(PG8_SA(0, 1), a2 + hstep, voffA);
            PG8_WAIT_V(8); PG8_WAIT_L(0); PG8_BAR; PG8_MMA(0, 0, At, B0); PG8_MMA(0, 1, At, B1); PG8_BAR; PG8_SCHED;
            PG8_LDA(At, 1, 1); PG8_STAGE(PG8_SB(1, 0), b3, voffB); PG8_STAGE(PG8_SB(1, 1), b3 + hstep, voffB); PG8_STAGE(PG8_SA(1, 0), a3, voffA);
            PG8_WAIT_V(8); PG8_WAIT_L(0); PG8_BAR; PG8_MMA(1, 0, At, B0); PG8_MMA(1, 1, At, B1); PG8_BAR; PG8_SCHED;
            } else {
            PG8_LDB(B0, 0, 0); PG8_SCHED; PG8_LDA(At, 0, 0); PG8_STAGE(PG8_SA(1, 1), a1 + hstep, voffA);
            PG8_WAIT_L(8); PG8_BAR; PG8_WAIT_L(0); PG8_MMA(0, 0, At, B0); PG8_BAR; PG8_SCHED;
            PG8_LDB(B1, 0, 1); PG8_STAGE(PG8_SB(0, 0), b2, voffB);
            PG8_BAR; PG8_WAIT_L(0); PG8_MMA(0, 1, At, B1); PG8_BAR;
            PG8_LDA(At, 0, 1); PG8_STAGE(PG8_SA(0, 0), a2, voffA);
            PG8_BAR; PG8_WAIT_L(0); PG8_MMA(1, 0, At, B0); PG8_BAR; PG8_SCHED;
            PG8_STAGE(PG8_SB(0, 1), b2 + hstep, voffB);
            PG8_WAIT_V(6); PG8_BAR; PG8_MMA(1, 1, At, B1); PG8_BAR;
            PG8_LDB(B0, 1, 0); PG8_SCHED; PG8_LDA(At, 1, 0); PG8_STAGE(PG8_SA(0, 1), a2 + hstep, voffA);
            PG8_WAIT_L(8); PG8_BAR; PG8_WAIT_L(0); PG8_MMA(0, 0, At, B0); PG8_BAR; PG8_SCHED;
            PG8_LDB(B1, 1, 1); PG8_STAGE(PG8_SB(1, 0), b3, voffB);
            PG8_BAR; PG8_WAIT_L(0); PG8_MMA(0, 1, At, B1); PG8_BAR;
            PG8_LDA(At, 1, 1); PG8_STAGE(PG8_SA(1, 0), a3, voffA);
            PG8_BAR; PG8_WAIT_L(0); PG8_MMA(1, 0, At, B0); PG8_BAR; PG8_SCHED;
            PG8_STAGE(PG8_SB(1, 1), b3 + hstep, voffB);
            PG8_WAIT_V(6); PG8_BAR; PG8_MMA(1, 1, At, B1); PG8_BAR;
            }
        }
        if constexpr (ALIGN_EPI) { if (wr == 0) PG8_BAR; }
        if constexpr (!Epi::AFTER_DRAIN) { const int t2 = tid_opaque(), w2 = __builtin_amdgcn_readfirstlane(t2 >> 6), l2 = t2 & 63;
            E(acc, cur, w2 >> 2, w2 & 3, l2 & 15, l2 >> 4); S.done(cur); }
        if (!has_next) break;
#pragma unroll
        for (int a = 0; a < 2; ++a)
#pragma unroll
            for (int b = 0; b < 2; ++b)
#pragma unroll
                for (int m = 0; m < 4; ++m)
#pragma unroll
                    for (int n = 0; n < 2; ++n) acc[a][b][m][n] = (f32x4){0.f, 0.f, 0.f, 0.f};
        cur = nxt; cA = nA; cB = nB; ++ui;
        if constexpr (ALIGN_EPI) { if (wr == 1) PG8_BAR; }
    }
    PG8_WAIT_V(0);
    if constexpr (!ALIGN_EPI) { if (wr == 0) PG8_BAR; }
    PG8_BAR;
    if constexpr (Epi::AFTER_DRAIN) { E.fused(acc, cur, wr, wc, fr, fq, lds, wid, lane); S.done(cur); }
#undef PG8_SA
#undef PG8_SB
#undef PG8_STAGE
#undef PG8_LDA
#undef PG8_LDB
#undef PG8_MMA
#undef PG8_WAIT_V
#undef PG8_WAIT_L
#undef PG8_BAR
#undef PG8_SCHED
}
}
#ifndef PG8_SP2
#define PG8_SP2 true
#endif
#include <hip/hip_bf16.h>
#include <cmath>
namespace attn_body {
using bf16=__hip_bfloat16;
using bf16x8=__attribute__((ext_vector_type(8)))short;
using s16x4=__attribute__((ext_vector_type(4)))short;
using f32x16=__attribute__((ext_vector_type(16)))float;
using u32x4=__attribute__((ext_vector_type(4)))unsigned;
constexpr int D=64,PQ=2560,PO=1024;
constexpr int NW=8,QBLK=32,QB=QBLK*NW,KVBLK=64;
constexpr int ATTN_UNIT_ROWS=QB;
__device__ __forceinline__ int crow(int r,int hi){return (r&3)+8*(r>>2)+4*hi;}
#define SBAR() __builtin_amdgcn_sched_barrier(0)
__device__ __forceinline__ void cmask(f32x16&p0,f32x16&p1,int jb,int qrel,int hi){
  const float NEG=-INFINITY; int kb=64*jb+4*hi;
  #pragma unroll
  for(int r=0;r<16;++r){int kv=kb+(r&3)+8*(r>>2); if(kv>qrel)p0[r]=NEG; if(kv+32>qrel)p1[r]=NEG;}
}

constexpr int NSLOT=3, SLOTB=8192;
constexpr int LDS_K=0, LDS_V=NSLOT*SLOTB, LDS_WS=2*NSLOT*SLOTB, LDS_OST=LDS_WS+NW*64*4, LDS_BYTES=LDS_OST+NW*4096;
constexpr float C2=0.125f*1.4426950408889634f;
__device__ __forceinline__ void glds16(const void*gsrc,unsigned lds_dst){unsigned keep;
  asm volatile("s_mov_b32 %0, m0\n\ts_mov_b32 m0, %2\n\ts_nop 0\n\tglobal_load_lds_dwordx4 %1, off\n\ts_mov_b32 m0, %0":"=&s"(keep):"v"(gsrc),"s"(lds_dst):"memory");}
__device__ __forceinline__ float max3f(float a,float b,float c){float r;asm("v_max3_f32 %0, %1, %2, %3":"=v"(r):"v"(a),"v"(b),"v"(c));return r;}
__device__ __forceinline__ float max2f(float a,float b){float r;asm("v_max_f32_e32 %0, %1, %2":"=v"(r):"v"(a),"v"(b));return r;}
__device__ __forceinline__ float fadd_s(float a,float b){float r;asm("v_add_f32_e32 %0, %1, %2":"=v"(r):"v"(a),"v"(b));return r;}
__device__ __forceinline__ float fsub_s(float a,float b){float r;asm("v_sub_f32_e32 %0, %1, %2":"=v"(r):"v"(a),"v"(b));return r;}
typedef float f32x2_t __attribute__((ext_vector_type(2))); typedef __bf16 bf16x2_t __attribute__((ext_vector_type(2)));
__device__ __forceinline__ unsigned cvtpk_s(float lo,float hi){f32x2_t v={lo,hi};bf16x2_t b=__builtin_convertvector(v,bf16x2_t);return __builtin_bit_cast(unsigned,b);}
#define WAIT_BAR(N) asm volatile("s_waitcnt vmcnt(" #N ") lgkmcnt(0)\n\ts_barrier":::"memory")

__device__ __forceinline__ void qkt(f32x16&p0,f32x16&p1,const char*Kslot,const bf16x8*qr,const f32x16&negm,int r32,int hi){
  const char*kb=Kslot+hi*1024+r32*16;
  #pragma unroll
  for(int d0=0;d0<4;++d0){
    const bf16x8 b0=*reinterpret_cast<const bf16x8*>(kb+d0*2048);
    const bf16x8 b1=*reinterpret_cast<const bf16x8*>(kb+d0*2048+512);
    if(d0==0){p0=__builtin_amdgcn_mfma_f32_32x32x16_bf16(b0,qr[0],negm,0,0,0);p1=__builtin_amdgcn_mfma_f32_32x32x16_bf16(b1,qr[0],negm,0,0,0);}
    else{p0=__builtin_amdgcn_mfma_f32_32x32x16_bf16(b0,qr[d0],p0,0,0,0);p1=__builtin_amdgcn_mfma_f32_32x32x16_bf16(b1,qr[d0],p1,0,0,0);}}
}
typedef __attribute__((address_space(3))) const char* lds_cptr;
typedef short v4i16_t __attribute__((ext_vector_type(4)));
__device__ __forceinline__ void kload8(bf16x8*kf,lds_cptr kp){
  kf[0]=*(const __attribute__((address_space(3))) bf16x8*)(kp);      kf[1]=*(const __attribute__((address_space(3))) bf16x8*)(kp+512);
  kf[2]=*(const __attribute__((address_space(3))) bf16x8*)(kp+2048); kf[3]=*(const __attribute__((address_space(3))) bf16x8*)(kp+2560);
  kf[4]=*(const __attribute__((address_space(3))) bf16x8*)(kp+4096); kf[5]=*(const __attribute__((address_space(3))) bf16x8*)(kp+4608);
  kf[6]=*(const __attribute__((address_space(3))) bf16x8*)(kp+6144); kf[7]=*(const __attribute__((address_space(3))) bf16x8*)(kp+6656);
}
__device__ __forceinline__ void kload2(bf16x8*kf,lds_cptr kp,int j){ kf[2*j]=*(const __attribute__((address_space(3))) bf16x8*)(kp+j*2048); kf[2*j+1]=*(const __attribute__((address_space(3))) bf16x8*)(kp+j*2048+512); }
__device__ __forceinline__ s16x4 vtr(lds_cptr p){ return __builtin_bit_cast(s16x4,__builtin_amdgcn_ds_read_tr16_b64_v4i16((__attribute__((address_space(3))) v4i16_t*)p)); }
__device__ __forceinline__ float rowmax(const f32x16&p0,const f32x16&p1){
  float a=max3f(p0[0],p0[1],p1[0]),b=max3f(p0[2],p0[3],p1[1]);a=max3f(a,p1[2],p1[3]);
  #pragma unroll
  for(int r=4;r<16;r+=4){a=max3f(a,p0[r],p0[r+1]);b=max3f(b,p0[r+2],p0[r+3]);a=max3f(a,p1[r],p1[r+1]);b=max3f(b,p1[r+2],p1[r+3]);}
  const float m=max2f(a,b);
  auto rr=__builtin_amdgcn_permlane32_swap(__float_as_uint(m),__float_as_uint(m),false,false);
  return max2f(__uint_as_float(rr[0]),__uint_as_float(rr[1]));
}
__device__ __forceinline__ void pv(f32x16*o,int vb,bf16x8 pa0,bf16x8 pa1,bf16x8 pa2,bf16x8 pa3){
  #pragma unroll
  for(int d0=0;d0<2;++d0){s16x4 lo[4],hi[4];
    #pragma unroll
    for(int ks=0;ks<4;++ks){
      asm volatile("ds_read_b64_tr_b16 %0,%1 offset:%c2":"=&v"(lo[ks]):"v"(vb),"i"(d0*4096+ks*1024):"memory");
      asm volatile("ds_read_b64_tr_b16 %0,%1 offset:%c2":"=&v"(hi[ks]):"v"(vb),"i"(d0*4096+ks*1024+512):"memory");}
    asm volatile("s_waitcnt lgkmcnt(0)":::"memory");SBAR();
    #define PK(k) (bf16x8){lo[k][0],lo[k][1],lo[k][2],lo[k][3],hi[k][0],hi[k][1],hi[k][2],hi[k][3]}
    o[d0]=__builtin_amdgcn_mfma_f32_32x32x16_bf16(pa0,PK(0),o[d0],0,0,0);
    o[d0]=__builtin_amdgcn_mfma_f32_32x32x16_bf16(pa1,PK(1),o[d0],0,0,0);
    o[d0]=__builtin_amdgcn_mfma_f32_32x32x16_bf16(pa2,PK(2),o[d0],0,0,0);
    o[d0]=__builtin_amdgcn_mfma_f32_32x32x16_bf16(pa3,PK(3),o[d0],0,0,0);
    #undef PK
  }
}

#ifndef ATTN_STORE16
#define ATTN_STORE16(p,v) (*(u32x4*)(p)=(v))
#endif
template<int THRL> __device__ __forceinline__ void attn_unit(int qb,const bf16*Qh,const bf16*__restrict__ Kh,const bf16*__restrict__ Vh,bf16*Oh,char*shm){
  const int tid=tid_opaque(),lane=tid&63,r32=lane&31,hi=lane>>5; const int wid=__builtin_amdgcn_readfirstlane(tid>>6);
  const int q0=qb*QB;
  const bf16*Qw=Qh+(long)(q0+wid*QBLK)*PQ;
  const unsigned lds0=(unsigned)(uintptr_t)shm;
  float*wsf=(float*)(shm+LDS_WS)+wid*64;
  const bf16*ksrc=Kh+(long)lane*PQ+wid*8;
  const bf16*vsrc=Vh+(long)(16*(wid&3)+(lane>>2))*PQ+(wid>>2)*32+(lane&3)*8;
  const unsigned kdst=lds0+LDS_K+wid*1024, vdst=lds0+LDS_V+wid*1024;
  #define DMA_K(t,slot) glds16(ksrc+(long)(t)*KVBLK*PQ,(unsigned)__builtin_amdgcn_readfirstlane(kdst+(slot)))
  #define DMA_V(t,slot) glds16(vsrc+(long)(t)*KVBLK*PQ,(unsigned)__builtin_amdgcn_readfirstlane(vdst+(slot)))
  const int vb0=(int)(lds0+LDS_V)+((lane>>4)&1)*32+(lane&3)*8+(4*hi+((lane&15)>>2))*64;
  const char*Kbase=shm+LDS_K; bf16x8 kf[8];
  const lds_cptr shm3=(lds_cptr)shm; const lds_cptr kp0=shm3+LDS_K+hi*1024+r32*16; const lds_cptr vp0=shm3+LDS_V+((lane>>4)&1)*32+(lane&3)*8+(4*hi+((lane&15)>>2))*64;
  const int NT=(q0+QB)/KVBLK;
  DMA_K(0,0);DMA_V(0,0);DMA_K(1,SLOTB);
  bf16x8 qr[4];
  #pragma unroll
  for(int d0=0;d0<4;++d0)qr[d0]=*reinterpret_cast<const bf16x8*>(&Qw[(long)r32*PQ+d0*16+hi*8]);
  float mhat=0.f,l_reg=0.f;f32x16 o[2];o[0]=f32x16{};o[1]=f32x16{};f32x16 negm=f32x16{};asm volatile("":"+v"(negm));
  const int qrel=wid*QBLK+r32;
  #define CMASK(P0,P1,t) do{int jb_=(t)-(NT-4); if(jb_>=0)cmask(P0,P1,jb_,qrel,hi);}while(0)
  bool resc=false;
  #define START(P0,P1) do{ const float rm=rowmax(P0,P1); resc=false; \
    { const float dl=rm; mhat=fadd_s(mhat,dl); \
      _Pragma("unroll") for(int r=0;r<16;++r){P0[r]=fsub_s(P0[r],dl);P1[r]=fsub_s(P1[r],dl);} \
      _Pragma("unroll") for(int r=0;r<16;++r)negm[r]=-mhat; asm volatile("":"+v"(negm)); } \
    _Pragma("unroll") for(int r=0;r<16;++r)P0[r]=__builtin_amdgcn_exp2f(P0[r]); }while(0)
  #define RESC() do{ if(resc){ asm volatile("s_waitcnt lgkmcnt(0)":::"memory"); \
      _Pragma("unroll") for(int d_=0;d_<2;++d_) _Pragma("unroll") for(int r=0;r<16;++r)o[d_][r]*=wsf[crow(r,hi)]; } }while(0)
  f32x16 pA0,pA1,pB0,pB1;
  int sl_prev=0,sl_cur=0,sl_next=SLOTB;
  #define ROT() do{sl_prev=sl_cur;sl_cur=sl_next;sl_next=(sl_next==(NSLOT-1)*SLOTB)?0:sl_next+SLOTB;}while(0)
  DMA_K(2,2*SLOTB);
  WAIT_BAR(3);
  qkt(pA0,pA1,Kbase,qr,negm,r32,hi);asm volatile("s_nop 15\n\ts_nop 7":"+v"(pA0),"+v"(pA1));CMASK(pA0,pA1,0);
  START(pA0,pA1);
  _Pragma("unroll") for(int r=0;r<16;++r)pA1[r]=__builtin_amdgcn_exp2f(pA1[r]);
  WAIT_BAR(0);
  DMA_K(3,0);DMA_V(1,SLOTB);
  ROT();
  kload8(kf,kp0+sl_cur);
  WAIT_BAR(2);
  s16x4 vlo[8],vhi[8]; u32x4 pw0,pw1,pw2,pw3;
  #define PKW(P,B) cvtpk_s(P[B],P[B+1])
  #define PAF(k) __builtin_bit_cast(bf16x8,pw##k)
  #define VFR(i) (bf16x8){vlo[i][0],vlo[i][1],vlo[i][2],vlo[i][3],vhi[i][0],vhi[i][1],vhi[i][2],vhi[i][3]}
  #define PIN(x) asm volatile("":"+v"(x))
  #define MX3(a,b,c) __builtin_fmaxf(__builtin_fmaxf((a),(b)),(c))
  #define GAPA(MF,A0,A1,A2,A3,W0,W1,PW) do{ MF; sacc+=A0; sacc+=A1; sacc+=A2; sacc+=A3; PIN(sacc); W0; W1; PIN(PW); SBAR(); }while(0)
  #define EX(v) __builtin_amdgcn_exp2f(v)
  #define GAPB(MF,X,B) do{ MF; X[B]=EX(X[B]); X[B+1]=EX(X[B+1]); X[B+2]=EX(X[B+2]); X[B+3]=EX(X[B+3]); PIN(X); SBAR(); }while(0)
  #define VRD(i) do{ vlo[i]=vtr(vp_+(((i)>>2)*4096+((i)&3)*1024)); vhi[i]=vtr(vp_+(((i)>>2)*4096+((i)&3)*1024+512)); }while(0)
  #define KRD(G,j) do{ if(G){ kload2(kf,kp0+sl_next,j); SBAR(); } }while(0)
  #define STEP(C0,C1,P0,P1,t,GK,GV,GL) do{ SBAR(); \
    const lds_cptr vp_=vp0+sl_prev; \
    VRD(0); SBAR(); float sacc=(P0[0]+P0[1]); \
    GAPA(C0=__builtin_amdgcn_mfma_f32_32x32x16_bf16(kf[0],qr[0],negm,0,0,0), P0[2],P0[3],P0[4],P0[5],     pw0[0]=PKW(P0,0), pw0[1]=PKW(P0,2), pw0); \
    VRD(4); SBAR(); GAPA(C1=__builtin_amdgcn_mfma_f32_32x32x16_bf16(kf[1],qr[0],negm,0,0,0), P0[6],P0[7],P0[8],P0[9],     pw0[2]=PKW(P0,4), pw0[3]=PKW(P0,6), pw0); \
    VRD(1); SBAR(); GAPA(C0=__builtin_amdgcn_mfma_f32_32x32x16_bf16(kf[2],qr[1],C0,0,0,0),   P0[10],P0[11],P0[12],P0[13], pw1[0]=PKW(P0,8), pw1[1]=PKW(P0,10), pw1); \
    VRD(5); SBAR(); GAPA(C1=__builtin_amdgcn_mfma_f32_32x32x16_bf16(kf[3],qr[1],C1,0,0,0),   P0[14],P0[15],P1[0],P1[1],   pw1[2]=PKW(P0,12),pw1[3]=PKW(P0,14), pw1); \
    VRD(2); SBAR(); GAPA(C0=__builtin_amdgcn_mfma_f32_32x32x16_bf16(kf[4],qr[2],C0,0,0,0),   P1[2],P1[3],P1[4],P1[5],     pw2[0]=PKW(P1,0), pw2[1]=PKW(P1,2), pw2); \
    VRD(6); SBAR(); GAPA(C1=__builtin_amdgcn_mfma_f32_32x32x16_bf16(kf[5],qr[2],C1,0,0,0),   P1[6],P1[7],P1[8],P1[9],     pw2[2]=PKW(P1,4), pw2[3]=PKW(P1,6), pw2); \
    VRD(3); SBAR(); GAPA(C0=__builtin_amdgcn_mfma_f32_32x32x16_bf16(kf[6],qr[3],C0,0,0,0),   P1[10],P1[11],P1[12],P1[13], pw3[0]=PKW(P1,8), pw3[1]=PKW(P1,10), pw3); \
    VRD(7); SBAR(); GAPA(C1=__builtin_amdgcn_mfma_f32_32x32x16_bf16(kf[7],qr[3],C1,0,0,0),   P1[14],P1[15],0.f,0.f,       pw3[2]=PKW(P1,12),pw3[3]=PKW(P1,14), pw3); \
    l_reg+=sacc; \
    if(GK){DMA_K((t)+3,sl_cur);} if(GV){DMA_V((t)+1,sl_next);} \
    CMASK(C0,C1,t); \
    { float a=MX3(C0[0],C0[1],C1[0]),b=MX3(C0[2],C0[3],C1[1]); a=MX3(a,C1[2],C1[3]); \
      _Pragma("unroll") for(int r=4;r<16;r+=4){a=MX3(a,C0[r],C0[r+1]);b=MX3(b,C0[r+2],C0[r+3]);a=MX3(a,C1[r],C1[r+1]);b=MX3(b,C1[r+2],C1[r+3]);} \
      float rm=__builtin_fmaxf(a,b); { auto rr=__builtin_amdgcn_permlane32_swap(__float_as_uint(rm),__float_as_uint(rm),false,false); rm=__builtin_fmaxf(__uint_as_float(rr[0]),__uint_as_float(rr[1])); } \
      resc=false; \
      if(__builtin_expect(__any(rm>(float)THRL),0)){ const float dl=__builtin_fmaxf(rm,0.f); mhat+=dl; \
        _Pragma("unroll") for(int r=0;r<16;++r){C0[r]-=dl;C1[r]-=dl;} \
        _Pragma("unroll") for(int r=0;r<16;++r)negm[r]=-mhat; asm volatile("":"+v"(negm)); \
        const float f=__builtin_amdgcn_exp2f(-dl); l_reg*=f; if(hi==0)wsf[r32]=f; resc=true; } } \
    SBAR(); \
    GAPB(o[0]=__builtin_amdgcn_mfma_f32_32x32x16_bf16(PAF(0),VFR(0),o[0],0,0,0), C0,0); \
    GAPB(o[1]=__builtin_amdgcn_mfma_f32_32x32x16_bf16(PAF(0),VFR(4),o[1],0,0,0), C0,4); \
    KRD(GL,0); GAPB(o[0]=__builtin_amdgcn_mfma_f32_32x32x16_bf16(PAF(1),VFR(1),o[0],0,0,0), C0,8); \
    KRD(GL,1); GAPB(o[1]=__builtin_amdgcn_mfma_f32_32x32x16_bf16(PAF(1),VFR(5),o[1],0,0,0), C0,12); \
    KRD(GL,2); GAPB(o[0]=__builtin_amdgcn_mfma_f32_32x32x16_bf16(PAF(2),VFR(2),o[0],0,0,0), C1,0); \
    KRD(GL,3); GAPB(o[1]=__builtin_amdgcn_mfma_f32_32x32x16_bf16(PAF(2),VFR(6),o[1],0,0,0), C1,4); \
    GAPB(o[0]=__builtin_amdgcn_mfma_f32_32x32x16_bf16(PAF(3),VFR(3),o[0],0,0,0), C1,8); \
    GAPB(o[1]=__builtin_amdgcn_mfma_f32_32x32x16_bf16(PAF(3),VFR(7),o[1],0,0,0), C1,12); \
    }while(0)
  int t=1;
  #undef CMASK
  #define CMASK(P0,P1,t) do{}while(0)
  for(;t+5<NT;t+=2){
    STEP(pB0,pB1,pA0,pA1,t,true,true,true);     WAIT_BAR(2); RESC(); ROT();
    STEP(pA0,pA1,pB0,pB1,t+1,true,true,true);   WAIT_BAR(2); RESC(); ROT();
  }
  #undef CMASK
  #define CMASK(P0,P1,t) do{int jb_=(t)-(NT-4); if(jb_>=0)cmask(P0,P1,jb_,qrel,hi);}while(0)
  #define ENDW(tt) do{ if((tt)+3<NT){WAIT_BAR(2);} else if((tt)+2<NT){WAIT_BAR(1);} else {WAIT_BAR(0);} }while(0)
  for(;t+1<NT;t+=2){
    STEP(pB0,pB1,pA0,pA1,t,(t+3<NT),(t+1<NT),(t+1<NT));       ENDW(t);   RESC(); ROT();
    STEP(pA0,pA1,pB0,pB1,t+1,(t+4<NT),(t+2<NT),(t+2<NT));     ENDW(t+1); RESC(); ROT();
  }
  STEP(pB0,pB1,pA0,pA1,NT-1,false,false,false); RESC();
  { float sacc=pB0[0]+pB0[1]; _Pragma("unroll") for(int r=2;r<16;++r)sacc+=pB0[r]; _Pragma("unroll") for(int r=0;r<16;++r)sacc+=pB1[r]; l_reg+=sacc;
    pw0=(u32x4){PKW(pB0,0),PKW(pB0,2),PKW(pB0,4),PKW(pB0,6)};pw1=(u32x4){PKW(pB0,8),PKW(pB0,10),PKW(pB0,12),PKW(pB0,14)};pw2=(u32x4){PKW(pB1,0),PKW(pB1,2),PKW(pB1,4),PKW(pB1,6)};pw3=(u32x4){PKW(pB1,8),PKW(pB1,10),PKW(pB1,12),PKW(pB1,14)};
    SBAR(); pv(o,vb0+sl_cur,PAF(0),PAF(1),PAF(2),PAF(3)); }
  #undef PKW
  #undef PAF
  #undef VFR
  #undef PIN
  #undef MX3
  #undef GAPA
  #undef GAPB
  #undef EX
  #undef VRD
  #undef KRD
  #undef STEP
  #undef ENDW
  {auto rr=__builtin_amdgcn_permlane32_swap(__float_as_uint(l_reg),__float_as_uint(l_reg),false,false);l_reg=__uint_as_float(rr[0])+__uint_as_float(rr[1]);}
  if(hi==0)wsf[32+r32]=l_reg;asm volatile("s_waitcnt lgkmcnt(0)":::"memory");
  float rli[16];
  #pragma unroll
  for(int r=0;r<16;++r)rli[r]=__builtin_amdgcn_rcpf(wsf[32+crow(r,hi)]);
  bf16*Ow=Oh+(long)(q0+wid*QBLK)*PO;
  { bf16*stg=(bf16*)(shm+LDS_OST)+wid*2048;
    #pragma unroll
    for(int r=0;r<16;++r){const int orow=crow(r,hi);
      #pragma unroll
      for(int d0=0;d0<2;++d0)stg[orow*64+d0*32+r32]=__float2bfloat16(o[d0][r]*rli[r]);}
    asm volatile("s_waitcnt lgkmcnt(0)":::"memory");
    #pragma unroll
    for(int i=0;i<4;++i){const int row=i*8+(lane>>3),ch=lane&7; const u32x4 v=*(const u32x4*)(stg+row*64+ch*8); ATTN_STORE16(Ow+(long)row*PO+ch*8,v);} }
  asm volatile("s_waitcnt lgkmcnt(0)\n\ts_barrier":::"memory");
  #undef DMA_K
  #undef DMA_V
  #undef CMASK
  #undef START
  #undef RESC
  #undef ROT
}
constexpr int ATTN_LDS_BYTES=LDS_BYTES;
#undef SBAR
#undef WAIT_BAR
}
#include <hip/hip_cooperative_groups.h>
namespace cg = cooperative_groups;
constexpr int NWAVES = 8;
constexpr int BATCH = 16, SEQ = 2048, D = 1024, DEPTH = 4, FF = 4096, PLE = 256, INW = 2560, AW = 512, RW = 512;
constexpr int M = BATCH * SEQ;
constexpr size_t MiB = 1u << 20;
constexpr size_t WS_CS = 1 * MiB;
constexpr size_t WS_SSQ0 = 3 * MiB, WS_SSQ1 = 5 * MiB;
constexpr size_t WS_W = 8 * MiB, W_LAYER = 25 * MiB + 512 * 1024;
constexpr size_t WO_IN = 0, WO_OUT = 5 * MiB, WO_W1 = 7 * MiB, WO_W2 = 15 * MiB, WO_PG = 23 * MiB, WO_PP = 25 * MiB;
constexpr size_t WS_P16 = 110 * MiB;
constexpr size_t WS_XB0 = 126 * MiB;
constexpr size_t WS_R = 190 * MiB;
constexpr size_t WS_PROJ = WS_R;
constexpr size_t WS_OV = WS_R + 160 * MiB;
constexpr size_t WS_AO = WS_R + 224 * MiB;
constexpr size_t WS_HB = WS_R;
constexpr size_t WS_PP = WS_R;
constexpr size_t WS_END = WS_R + 288 * MiB;
static_assert(WS_W + DEPTH * W_LAYER <= WS_P16 && WS_P16 + (size_t)M * PLE * 2 <= WS_XB0 && WS_XB0 + (size_t)M * D * 2 <= WS_R && WS_HB + (size_t)M * FF * 2 <= WS_END, "d_ws map");
constexpr int RING_BYTES = 131072;
constexpr int LDS_BYTES = 147456;

#define GAS __attribute__((address_space(1)))
#define LAS __attribute__((address_space(3)))
typedef unsigned short bf16;
typedef unsigned v4u __attribute__((ext_vector_type(4)));
typedef float f32x4 __attribute__((ext_vector_type(4)));
typedef short bf16x8 __attribute__((ext_vector_type(8)));
#define LDS_WAIT() asm volatile("s_waitcnt lgkmcnt(0)" ::: "memory")
#define VM_WAIT() asm volatile("s_waitcnt vmcnt(0)" ::: "memory")
__device__ __forceinline__ unsigned f2bf(float f) { unsigned u = __builtin_bit_cast(unsigned, f); return (u + 0x7fffu + ((u >> 16) & 1u)) >> 16; }
__device__ __forceinline__ unsigned pk2(float lo, float hi) { unsigned r; asm("v_cvt_pk_bf16_f32 %0, %1, %2" : "=v"(r) : "v"(lo), "v"(hi)); return r; }
__device__ __forceinline__ float bf2f(unsigned short v) { return __uint_as_float((unsigned)v << 16); }
__device__ __forceinline__ float sigmoid_f(float x) { return __builtin_amdgcn_rcpf(1.f + __builtin_amdgcn_exp2f(-1.4426950408889634f * x)); }

typedef GAS unsigned gu32;
#define RLX_AGENT __ATOMIC_RELAXED, __HIP_MEMORY_SCOPE_AGENT
#define XB_TMO      128
#define XB_XCNT(j)  (256  + 64 * (j))
#define XB_XSUB(j)  (1280 + 64 * (j))
#define XB_XGEN(j)  (2304 + 64 * (j))
#define XB_TOP      3328
#define XB_TOPGEN   3392
#define XCD_BAR_WORDS 3456
#define XB_SPIN_CAP (1u << 18)

__device__ __forceinline__ unsigned xb_ld(unsigned* p)              { return __hip_atomic_load(p, __ATOMIC_RELAXED, __HIP_MEMORY_SCOPE_AGENT); }
__device__ __forceinline__ unsigned xb_add(unsigned* p, unsigned v) { return __hip_atomic_fetch_add(p, v, __ATOMIC_RELAXED, __HIP_MEMORY_SCOPE_AGENT); }
__device__ __forceinline__ unsigned xb_xcc_id() { return (unsigned)__builtin_amdgcn_s_getreg((3 << 11) | 20) & 0xFu; }
#define XB_SPIN(cond, bar) do { unsigned _sp = 0; while (cond) { __builtin_amdgcn_s_sleep(1); \
    if ((++_sp & 255u) == 0u) { if (xb_ld(&(bar)[XB_TMO])) break; if (_sp > XB_SPIN_CAP) { atomicAdd(&(bar)[XB_TMO], 1u); break; } } } } while (0)

struct XcdBarrier {
    unsigned* bar; unsigned x;
    volatile LAS unsigned* st;
};

__device__ __forceinline__ XcdBarrier xcd_barrier_post(unsigned* bar, volatile LAS unsigned* st) {
    XcdBarrier b; b.bar = bar; b.x = xb_xcc_id(); b.st = st;
    if (threadIdx.x == 0) (void)xb_add(&bar[XB_XCNT(b.x)], 1u);
    return b;
}
__device__ __forceinline__ void xcd_barrier_complete(unsigned* bar, unsigned x, unsigned& nloc, unsigned& nx) {
    const unsigned G = gridDim.x * gridDim.y * gridDim.z;
    unsigned sum, cnt, mine, sp = 0u;
    for (;;) {
        sum = 0u; cnt = 0u; mine = 0u;
#pragma unroll
        for (unsigned j = 0; j < 16; ++j) { const unsigned c = xb_ld(&bar[XB_XCNT(j)]); sum += c; cnt += (c > 0u) ? 1u : 0u; mine = (j == x) ? c : mine; }
        if (sum == G) break;
        __builtin_amdgcn_s_sleep(1);
        if ((++sp & 255u) == 0u) { if (xb_ld(&bar[XB_TMO])) break; if (sp > XB_SPIN_CAP) { atomicAdd(&bar[XB_TMO], 1u); break; } }
    }
    nloc = mine > 0u ? mine : 1u; nx = cnt > 0u ? cnt : 1u;
}

__device__ __forceinline__ void xcd_barrier(const XcdBarrier& b) {
    asm volatile("s_waitcnt vmcnt(0)" ::: "memory");
    __syncthreads();
    if (threadIdx.x == 0) {
        unsigned* bar = b.bar;
        __builtin_amdgcn_s_waitcnt(0);
        unsigned nloc = b.st[0], nx = b.st[1];
        if (nloc == 0u) { xcd_barrier_complete(bar, b.x, nloc, nx); b.st[0] = nloc; b.st[1] = nx; }
        const unsigned old = xb_add(&bar[XB_XSUB(b.x)], 1u);
        const unsigned gen = old / nloc;
        if (old + 1u == (gen + 1u) * nloc) {
            __builtin_amdgcn_fence(__ATOMIC_RELEASE, "agent");
            asm volatile("s_waitcnt vmcnt(0)" ::: "memory");
            const unsigned og = xb_add(&bar[XB_TOP], 1u);
            const unsigned tg = og / nx;
            if (og + 1u == (tg + 1u) * nx) xb_add(&bar[XB_TOPGEN], 1u);
            else XB_SPIN(xb_ld(&bar[XB_TOPGEN]) == tg, bar);
            __builtin_amdgcn_fence(__ATOMIC_ACQUIRE, "agent");
            xb_add(&bar[XB_XGEN(b.x)], 1u);
            asm volatile("s_waitcnt vmcnt(0)" ::: "memory");
        } else {
            XB_SPIN(xb_ld(&bar[XB_XGEN(b.x)]) == gen, bar);
            __builtin_amdgcn_fence(__ATOMIC_ACQUIRE, "agent");
            asm volatile("s_waitcnt vmcnt(0)" ::: "memory");
        }
    }
    __syncthreads();
}

struct Frame {
    LAS unsigned char* lds;
    LAS const unsigned long long* tab;
};
struct Who { int tid, lane, wave, vcu, G; };
__device__ __forceinline__ Who who() { Who w; w.tid = tid_opaque(); w.lane = w.tid & 63; w.wave = __builtin_amdgcn_readfirstlane(w.tid >> 6);
    int bx = blockIdx.x, G = gridDim.x; asm volatile("" : "+s"(bx), "+s"(G)); w.G = G; w.vcu = (G % 8 == 0) ? (bx % 8) * (G / 8) + bx / 8 : bx; return w; }
__device__ __forceinline__ int opaque_s(int v) { asm volatile("" : "+s"(v)); return v; }
__device__ __forceinline__ const void* ptab(LAS const unsigned long long* tab, int k) {
    const unsigned long long v = tab[k]; const unsigned lo = __builtin_amdgcn_readfirstlane((unsigned)v), hi = __builtin_amdgcn_readfirstlane((unsigned)(v >> 32));
    return (const void*)(((unsigned long long)hi << 32) | lo);
}
#define FIN(k) ((const float*)ptab(F.tab, (k)))
#define FOUT() ((float*)ptab(F.tab, 23))
#define FWS(off) ((unsigned char*)ptab(F.tab, 24) + (off))
enum { I_X = 0, I_P, I_POS, I_WIN, I_WOUT, I_GMIX, I_GSUBLN, I_LAMQ, I_LAMK, I_CONVW, I_CONVB, I_WGA, I_BGA, I_WGX, I_BGX, I_LRULAM, I_GMLP, I_WMLPIN, I_WMLPOUT, I_GPLE, I_WPLEGATE, I_WPLEPROJ, I_GFINAL };

__device__ __forceinline__ float wave_sum(float v) {
#pragma unroll
    for (int o = 1; o < 64; o <<= 1) v += __shfl_xor(v, o);
    return v;
}
__device__ __forceinline__ void p0_transpose_item(const float* W, const float* gain, int K, int N, bf16* WT, LAS float* scr, int item, int lane) {
    const int nblk = N / 32, kb = item / nblk, nb = item % nblk, k0 = 64 * kb, n0 = 32 * nb;
    const int c = lane & 7;
    float v[32];
#pragma unroll
    for (int i = 0; i < 32; ++i) v[i] = W[(size_t)(k0 + 2 * i + (lane >> 5)) * N + n0 + (lane & 31)];
    f32x4 ga = {1.f, 1.f, 1.f, 1.f}, gb = ga;
    if (gain) { ga = *(const f32x4*)(gain + k0 + 8 * c); gb = *(const f32x4*)(gain + k0 + 8 * c + 4); }
#pragma unroll
    for (int i = 0; i < 32; ++i) scr[(2 * i + (lane >> 5)) * 33 + (lane & 31)] = v[i];
    LDS_WAIT(); asm volatile("" ::: "memory");
#pragma unroll
    for (int j = 0; j < 4; ++j) { const int n = (lane >> 3) + 8 * j; const LAS float* s = scr + (8 * c) * 33 + n;
        v4u o; o.x = pk2(s[0 * 33] * ga.x, s[1 * 33] * ga.y); o.y = pk2(s[2 * 33] * ga.z, s[3 * 33] * ga.w); o.z = pk2(s[4 * 33] * gb.x, s[5 * 33] * gb.y); o.w = pk2(s[6 * 33] * gb.z, s[7 * 33] * gb.w);
        *(GAS v4u*)(WT + (size_t)(n0 + n) * K + k0 + 8 * c) = o; }
    LDS_WAIT(); asm volatile("" ::: "memory");
}
__device__ __forceinline__ void p0_prologue(Frame& F) {
    const Who W = who();
    LAS float* scr = (LAS float*)(F.lds + W.wave * 16384);
    const int gw = W.vcu * NWAVES + W.wave, NGW = W.G * NWAVES;
    unsigned char* ws = FWS(0);
    const float *w_in = FIN(I_WIN), *w_out = FIN(I_WOUT), *w_mlp_in = FIN(I_WMLPIN), *w_mlp_out = FIN(I_WMLPOUT), *w_ple_gate = FIN(I_WPLEGATE), *w_ple_proj = FIN(I_WPLEPROJ), *g_mix = FIN(I_GMIX), *g_mlp = FIN(I_GMLP), *g_ple = FIN(I_GPLE);
    constexpr int I_IN = (D / 64) * (INW / 32), I_OUT = (D / 64) * (D / 32), I_1 = (D / 64) * (FF / 32), I_2 = (FF / 64) * (D / 32), I_PG = I_OUT, I_PP = (PLE / 64) * (D / 32);
    constexpr int PER_L = I_IN + I_OUT + I_1 + I_2 + I_PG + I_PP;
    for (int it = gw; it < DEPTH * PER_L; it += NGW) {
        const int l = it / PER_L; int r = it % PER_L; bf16* wl = (bf16*)(ws + WS_W + (size_t)l * W_LAYER);
        if (r < I_IN) { p0_transpose_item(w_in + (size_t)l * D * INW, g_mix + l * D, D, INW, (bf16*)((unsigned char*)wl + WO_IN), scr, r, W.lane); continue; } r -= I_IN;
        if (r < I_OUT) { p0_transpose_item(w_out + (size_t)l * D * D, nullptr, D, D, (bf16*)((unsigned char*)wl + WO_OUT), scr, r, W.lane); continue; } r -= I_OUT;
        if (r < I_1) { p0_transpose_item(w_mlp_in + (size_t)l * D * FF, g_mlp + l * D, D, FF, (bf16*)((unsigned char*)wl + WO_W1), scr, r, W.lane); continue; } r -= I_1;
        if (r < I_2) { p0_transpose_item(w_mlp_out + (size_t)l * FF * D, nullptr, FF, D, (bf16*)((unsigned char*)wl + WO_W2), scr, r, W.lane); continue; } r -= I_2;
        if (r < I_PG) { p0_transpose_item(w_ple_gate + (size_t)l * D * D, g_ple + l * D, D, D, (bf16*)((unsigned char*)wl + WO_PG), scr, r, W.lane); continue; } r -= I_PG;
        p0_transpose_item(w_ple_proj + (size_t)l * PLE * D, nullptr, PLE, D, (bf16*)((unsigned char*)wl + WO_PP), scr, r, W.lane);
    }
    const float* x_ = FIN(I_X); float* H_ = FOUT(); bf16* XB1_ = (bf16*)(ws + WS_OV); float* SSQ1_ = (float*)(ws + WS_SSQ1); float* CS_ = (float*)(ws + WS_CS); const int* pos_ = (const int*)FIN(I_POS);
#pragma unroll 4
    for (int m = gw; m < M; m += NGW) {
        const GAS f32x4* xr = (const GAS f32x4*)(x_ + (size_t)m * D) + W.lane;
        GAS unsigned long long* o8 = (GAS unsigned long long*)(XB1_ + (size_t)m * D) + W.lane; float s = 0.f;
#pragma unroll
        for (int j = 0; j < 4; ++j) { const f32x4 v = xr[64 * j]; s += (v.x * v.x + v.y * v.y) + (v.z * v.z + v.w * v.w);
            o8[64 * j] = (unsigned long long)pk2(v.x, v.y) | ((unsigned long long)pk2(v.z, v.w) << 32); }
        s = wave_sum(s);
        if (W.lane < 16) SSQ1_[(size_t)m * 16 + W.lane] = (W.lane == 0) ? s : 0.f;
    }
}
__device__ __forceinline__ void convert_p(Frame& F, int l) {
    const Who W = who();
    const float* src = FIN(I_P) + (size_t)l * M * PLE; bf16* P16_ = (bf16*)FWS(WS_P16);
#pragma unroll 4
    for (size_t e = (size_t)W.vcu * NWAVES * 64 + W.tid; e < (size_t)M * PLE / 8; e += (size_t)W.G * NWAVES * 64) {
        const f32x4 a = *(const GAS f32x4*)(src + e * 8), b = *(const GAS f32x4*)(src + e * 8 + 4);
        v4u o; o.x = pk2(a.x, a.y); o.y = pk2(a.z, a.w); o.z = pk2(b.x, b.y); o.w = pk2(b.z, b.w);
        *(GAS v4u*)(P16_ + e * 8) = o; }
}
__device__ __forceinline__ void final_norm(Frame& F) {
    const Who W = who();
    const int gw = W.vcu * NWAVES + W.wave, NGW = W.G * NWAVES;
    const float* SSQ1_ = (const float*)FWS(WS_SSQ1); float* H_ = FOUT(); const float* gf_ = FIN(I_GFINAL);
#pragma unroll 4
    for (int m = gw; m < M; m += NGW) {
        const float rs = pg8::row_rs(SSQ1_, m);
        GAS f32x4* hr = (GAS f32x4*)(H_ + (size_t)m * D) + W.lane; const GAS f32x4* gr = (const GAS f32x4*)gf_ + W.lane;
#pragma unroll
        for (int j = 0; j < 4; ++j) { const f32x4 v = hr[64 * j], g = gr[64 * j]; hr[64 * j] = v * rs * g; }
    }
}

__device__ __forceinline__ void lru_item(Frame& F, int l, int item) {
    const int b = item >> 4, g = (item >> 1) & 7, hf = item & 1;
    const int tid_ = tid_opaque(), lane = tid_ & 63, w = __builtin_amdgcn_readfirstlane(tid_ >> 6), r = lane & 15, q = lane >> 4;
    LAS float* xcs = (LAS float*)(F.lds + w * 4352);
    LAS float* car = (LAS float*)(F.lds + 36864);
    const bf16* pj = (const bf16*)FWS(WS_PROJ) + (size_t)b * SEQ * INW;
    bf16* ao = (bf16*)FWS(WS_AO) + (size_t)b * SEQ * D;
    v4u* lb = (v4u*)FWS(WS_XB0) + ((size_t)item * NWAVES + w) * (16 * 2 * 64) + lane;
    const int t0 = w * 256;
    const bf16* gcol = pj + 3 * AW + RW + g * 64 + hf * 32 + r;
    bf16* ycol = ao + AW + g * 64 + hf * 32 + r;
    float hin[2] = {0.f, 0.f};
    {
        const int cch = g * 64 + lane;
        const float* conv_w = FIN(I_CONVW);
        const float cw0 = conv_w[(l * 4 + 0) * RW + cch], cw1 = conv_w[(l * 4 + 1) * RW + cch], cw2 = conv_w[(l * 4 + 2) * RW + cch], cw3 = conv_w[(l * 4 + 3) * RW + cch], cb = FIN(I_CONVB)[l * RW + cch];
        bf16x8 Bf[2][2][2];
#pragma unroll
        for (int gate = 0; gate < 2; ++gate) { const float* W = (gate ? FIN(I_WGX) : FIN(I_WGA)) + (size_t)(l * 8 + g) * 64 * 64;
#pragma unroll
            for (int n = 0; n < 2; ++n)
#pragma unroll
                for (int kk = 0; kk < 2; ++kk) { const float* wp = W + (size_t)(32 * kk + 8 * q) * 64 + hf * 32 + 16 * n + r; v4u pw;
                    pw.x = pk2(wp[0 * 64], wp[1 * 64]); pw.y = pk2(wp[2 * 64], wp[3 * 64]); pw.z = pk2(wp[4 * 64], wp[5 * 64]); pw.w = pk2(wp[6 * 64], wp[7 * 64]);
                    Bf[gate][n][kk] = __builtin_bit_cast(bf16x8, pw); } }
        float ba[2], bx[2], sp8[2];
#pragma unroll
        for (int n = 0; n < 2; ++n) { const int ch = l * RW + g * 64 + hf * 32 + 16 * n + r; ba[n] = FIN(I_BGA)[ch]; bx[n] = FIN(I_BGX)[ch];
            const float z = -FIN(I_LRULAM)[ch]; sp8[n] = 8.f * (fmaxf(z, 0.f) + log1pf(__expf(-fabsf(z)))); }
        const bf16* xcol = pj + 3 * AW + cch;
        float h3 = 0.f, h2 = 0.f, h1 = 0.f;
        if (t0 != 0) { h3 = bf2f(xcol[(size_t)(t0 - 3) * INW]); h2 = bf2f(xcol[(size_t)(t0 - 2) * INW]); h1 = bf2f(xcol[(size_t)(t0 - 1) * INW]); }
        float hrun[2] = {0.f, 0.f}, Arun[2] = {1.f, 1.f};
        unsigned short xq[16];
#pragma unroll
        for (int tt = 0; tt < 16; ++tt) xq[tt] = xcol[(size_t)(t0 + tt) * INW];
#pragma unroll 1
        for (int sc = 0; sc < 16; ++sc) {
            const int ts = t0 + sc * 16, tn = (sc < 15) ? ts + 16 : ts;
            unsigned short xn[16];
#pragma unroll
            for (int tt = 0; tt < 16; ++tt) xn[tt] = xcol[(size_t)(tn + tt) * INW];
#pragma unroll
            for (int tt = 0; tt < 16; ++tt) { const float xv = bf2f(xq[tt]); const float xc = cb + cw0 * h3 + cw1 * h2 + cw2 * h1 + cw3 * xv; h3 = h2; h2 = h1; h1 = xv; xcs[tt * 68 + lane] = xc; }
            asm volatile("s_waitcnt lgkmcnt(0)" ::: "memory");
            bf16x8 Af[2];
#pragma unroll
            for (int kk = 0; kk < 2; ++kk) { const LAS f32x4* ap = (const LAS f32x4*)(xcs + r * 68 + 32 * kk + 8 * q); const f32x4 a0 = ap[0], a1 = ap[1];
                v4u pw; pw.x = pk2(a0.x, a0.y); pw.y = pk2(a0.z, a0.w); pw.z = pk2(a1.x, a1.y); pw.w = pk2(a1.z, a1.w); Af[kk] = __builtin_bit_cast(bf16x8, pw); }
            f32x4 Da[2], Dx[2];
#pragma unroll
            for (int n = 0; n < 2; ++n) { Da[n] = (f32x4){0.f, 0.f, 0.f, 0.f}; Dx[n] = Da[n];
#pragma unroll
                for (int kk = 0; kk < 2; ++kk) { Da[n] = __builtin_amdgcn_mfma_f32_16x16x32_bf16(Af[kk], Bf[0][n][kk], Da[n], 0, 0, 0); Dx[n] = __builtin_amdgcn_mfma_f32_16x16x32_bf16(Af[kk], Bf[1][n][kk], Dx[n], 0, 0, 0); } }
#pragma unroll
            for (int n = 0; n < 2; ++n) {
                float a[4], bb[4]; v4u st;
#pragma unroll
                for (int i = 0; i < 4; ++i) { const float xcv = xcs[(4 * q + i) * 68 + hf * 32 + 16 * n + r];
                    const float ra = sigmoid_f(Da[n][i] + ba[n]), ix = sigmoid_f(Dx[n][i] + bx[n]);
                    const float la = -ra * sp8[n];
                    const float y2 = 2.f * la;
                    const float ser = -y2 * (1.f + y2 * (0.5f + y2 * (0.16666667f + y2 * (0.041666668f + y2 * 0.008333334f))));
                    const float a2 = __builtin_amdgcn_exp2f(1.4426950408889634f * y2);
                    const float em = (y2 > -0.25f) ? ser : (1.f - a2);
                    const float bv = __builtin_amdgcn_sqrtf(fmaxf(em, 0.f)) * (ix * xcv);
                    const unsigned pr = pk2(la * 1.4426950408889634f, bv); st[i] = pr;
                    a[i] = __builtin_amdgcn_exp2f(bf2f((unsigned short)(pr & 0xffffu))); bb[i] = __uint_as_float(pr & 0xffff0000u); }
                lb[(sc * 2 + n) * 64] = st;
                const float Al = (a[0] * a[1]) * (a[2] * a[3]);
                const float Hl = ((bb[0] * a[1] + bb[1]) * a[2] + bb[2]) * a[3] + bb[3];
                const float A0 = __shfl(Al, r), A1 = __shfl(Al, r + 16), A2 = __shfl(Al, r + 32), A3 = __shfl(Al, r + 48);
                const float H0 = __shfl(Hl, r), H1 = __shfl(Hl, r + 16), H2 = __shfl(Hl, r + 32), H3 = __shfl(Hl, r + 48);
                const float c0 = hrun[n], c1 = A0 * c0 + H0, c2 = A1 * c1 + H1, c3 = A2 * c2 + H2, c4 = A3 * c3 + H3;
                hrun[n] = c4; Arun[n] *= (A0 * A1) * (A2 * A3);
            }
#pragma unroll
            for (int tt = 0; tt < 16; ++tt) xq[tt] = xn[tt];
        }
        if (q == 0) {
#pragma unroll
            for (int n = 0; n < 2; ++n) { car[w * 64 + n * 16 + r] = Arun[n]; car[w * 64 + 32 + n * 16 + r] = hrun[n]; } }
        __syncthreads();
#pragma unroll
        for (int n = 0; n < 2; ++n) { float h = 0.f; for (int w2 = 0; w2 < w; ++w2) h = car[w2 * 64 + n * 16 + r] * h + car[w2 * 64 + 32 + n * 16 + r]; hin[n] = h; }
    }
    {
        VM_WAIT();
        float hrun[2] = {hin[0], hin[1]};
        v4u cur[2]; cur[0] = lb[0]; cur[1] = lb[64];
#pragma unroll 1
        for (int sc = 0; sc < 16; ++sc) {
            const int ts = t0 + sc * 16, scn = (sc < 15) ? sc + 1 : sc;
            v4u nxt[2]; nxt[0] = lb[(scn * 2 + 0) * 64]; nxt[1] = lb[(scn * 2 + 1) * 64];
            unsigned short gq[2][4];
#pragma unroll
            for (int n = 0; n < 2; ++n)
#pragma unroll
                for (int i = 0; i < 4; ++i) gq[n][i] = gcol[(size_t)(ts + 4 * q + i) * INW + 16 * n];
#pragma unroll
            for (int n = 0; n < 2; ++n) {
                float a[4], bb[4];
#pragma unroll
                for (int i = 0; i < 4; ++i) { const unsigned pr = cur[n][i]; a[i] = __builtin_amdgcn_exp2f(__uint_as_float(pr << 16)); bb[i] = __uint_as_float(pr & 0xffff0000u); }
                const float Al = (a[0] * a[1]) * (a[2] * a[3]);
                const float Hl = ((bb[0] * a[1] + bb[1]) * a[2] + bb[2]) * a[3] + bb[3];
                const float A0 = __shfl(Al, r), A1 = __shfl(Al, r + 16), A2 = __shfl(Al, r + 32);
                const float H0 = __shfl(Hl, r), H1 = __shfl(Hl, r + 16), H2 = __shfl(Hl, r + 32), H3 = __shfl(Hl, r + 48), A3 = __shfl(Al, r + 48);
                const float c0 = hrun[n], c1 = A0 * c0 + H0, c2 = A1 * c1 + H1, c3 = A2 * c2 + H2, c4 = A3 * c3 + H3;
                hrun[n] = c4;
                float h = (q == 0) ? c0 : (q == 1) ? c1 : (q == 2) ? c2 : c3;
#pragma unroll
                for (int i = 0; i < 4; ++i) { h = a[i] * h + bb[i]; const float gv = bf2f(gq[n][i]);
                    const float ge = gv * sigmoid_f(1.5957691216057308f * (gv + 0.044715f * gv * gv * gv));
                    ycol[(size_t)(ts + 4 * q + i) * D + 16 * n] = (bf16)(pk2(h * ge, 0.f) & 0xffffu); }
            }
            cur[0] = nxt[0]; cur[1] = nxt[1];
        }
    }
    __syncthreads();
}

__device__ __forceinline__ void attn_post(Frame& F, int l, int b, int h, int qb, float lam, float oscale) {
    const int tid_ = tid_opaque(), lane = tid_ & 63, wave_ = __builtin_amdgcn_readfirstlane(tid_ >> 6), rsub = lane >> 4, e8 = (lane & 15) * 8;
    const float* gs = FIN(I_GSUBLN) + l * 128 + e8; const bf16* OV_ = (const bf16*)FWS(WS_OV); bf16* AO_ = (bf16*)FWS(WS_AO); const f32x4 g0 = *(const f32x4*)gs, g1 = *(const f32x4*)(gs + 4);
    const size_t rowbase = (size_t)b * SEQ + qb * 256 + wave_ * 32;
#pragma unroll 4
    for (int it = 0; it < 8; ++it) { const size_t row = rowbase + it * 4 + rsub;
        const v4u a = *(const GAS v4u*)(OV_ + row * D + h * 256 + e8), c = *(const GAS v4u*)(OV_ + row * D + h * 256 + 128 + e8);
        f32x4 d0 = {pg8::bf_lo(a.x) - lam * pg8::bf_lo(c.x), pg8::bf_hi(a.x) - lam * pg8::bf_hi(c.x), pg8::bf_lo(a.y) - lam * pg8::bf_lo(c.y), pg8::bf_hi(a.y) - lam * pg8::bf_hi(c.y)};
        f32x4 d1 = {pg8::bf_lo(a.z) - lam * pg8::bf_lo(c.z), pg8::bf_hi(a.z) - lam * pg8::bf_hi(c.z), pg8::bf_lo(a.w) - lam * pg8::bf_lo(c.w), pg8::bf_hi(a.w) - lam * pg8::bf_hi(c.w)};
        float ss = pg8::sumsq8(d0, d1);
        ss += __shfl_xor(ss, 1); ss += __shfl_xor(ss, 2); ss += __shfl_xor(ss, 4); ss += __shfl_xor(ss, 8);
        const float rs = __builtin_amdgcn_rsqf(ss * (1.f / 128.f) + 1e-6f) * oscale;
        d0 = d0 * rs * g0; d1 = d1 * rs * g1;
        v4u o; o.x = pk2(d0.x, d0.y); o.y = pk2(d0.z, d0.w); o.z = pk2(d1.x, d1.y); o.w = pk2(d1.z, d1.w);
        *(GAS v4u*)(AO_ + row * D + h * 128 + e8) = o; }
}

struct Args { const void* in[23]; float* out; unsigned char* ws; int ph_lo, ph_hi; };
constexpr int N_PHASES = 2 + 6 * DEPTH;
__global__ void __launch_bounds__(NWAVES * 64, 2) hymba_fwd(Args args) {
    extern __shared__ __attribute__((aligned(16))) unsigned char lds[];
    cg::grid_group grid = cg::this_grid();
    Frame F;
    F.lds = (LAS unsigned char*)lds;
    { LAS unsigned long long* tabw = (LAS unsigned long long*)(F.lds + RING_BYTES + 1024);
      if (threadIdx.x == 0) {
#pragma unroll
          for (int k = 0; k < 23; ++k) tabw[k] = (unsigned long long)args.in[k];
          tabw[23] = (unsigned long long)args.out; tabw[24] = (unsigned long long)args.ws; }
      F.tab = tabw; }
    __syncthreads();
    const int lo = args.ph_lo, hi = args.ph_hi;
#define IN(k) (lo <= (k) && (k) < hi)
#define SEAM(k) do { if (IN(k) && IN((k) + 1)) xcd_barrier(bar); } while (0)

    if (blockIdx.x == 0) { unsigned* bw = (unsigned*)args.ws; for (int u = threadIdx.x; u < XCD_BAR_WORDS; u += NWAVES * 64) bw[u] = 0u; }
    if (threadIdx.x < 2) ((volatile LAS unsigned*)(F.lds + RING_BYTES + 2048))[threadIdx.x] = 0u;
    if (IN(0)) { p0_prologue(F); }
    grid.sync();
    XcdBarrier bar = xcd_barrier_post((unsigned*)args.ws, (volatile LAS unsigned*)(F.lds + RING_BYTES + 2048));

#pragma unroll 1
    for (int l_ = 0; l_ < DEPTH; ++l_) {
        const int pb = 1 + 6 * l_;
        if (IN(pb + 0)) {
            const Who W = who(); const int l = opaque_s(l_);
            unsigned char* ws = FWS(0); const unsigned char* wl = ws + WS_W + (size_t)l * W_LAYER;
            pg8::Gemm g{(const bf16*)(ws + WS_OV), (const bf16*)(wl + WO_IN), M, INW, D}; pg8::StaticOrder S; S.init(M, INW, W.G, opaque_s((int)blockIdx.x));
            pg8::EpiIn E{(bf16*)(ws + WS_PROJ), INW, (const float*)(ws + WS_SSQ1), (const int*)FIN(I_POS), attn_body::C2};
            pg8::gemm_phase<pg8::EpiIn, pg8::StaticOrder, true, true>(F.lds, g, S, E);
        }
        SEAM(pb + 0);
        if (IN(pb + 1)) {
            const Who W = who(); const int l = opaque_s(l_);
            float lam, oscale;
            { const float* lq = FIN(I_LAMQ) + l * 128; const float* lk = FIN(I_LAMK) + l * 128;
              const float d0 = wave_sum(lq[W.lane] * lk[W.lane]), d1 = wave_sum(lq[64 + W.lane] * lk[64 + W.lane]);
              const float li = 0.8f - 0.6f * __expf(-0.3f * (float)l); lam = __expf(d0) - __expf(d1) + li; oscale = 1.f - li; }
#if defined(PROBE_ATTN2)
            for (int rep_ = 0; rep_ < 2; ++rep_)
#endif
            for (int item = W.vcu; item < 256; item += W.G) {
                const int bh = item >> 2, s = item & 3, b = bh >> 2, h = bh & 3;
                const attn_body::bf16* pj = (const attn_body::bf16*)((const bf16*)FWS(WS_PROJ) + (size_t)b * SEQ * INW); attn_body::bf16* ov = (attn_body::bf16*)((bf16*)FWS(WS_OV) + (size_t)b * SEQ * D);
#pragma unroll 1
                for (int k = 0; k < 2; ++k) { const int qb = k ? 7 - s : s;
#pragma unroll 1
                    for (int j = 0; j < 4; ++j) { const int c = j >> 1, vh = j & 1;
                        attn_body::attn_unit<8>(qb, pj + (h * 2 + c) * 64, pj + AW + (h * 2 + c) * 64, pj + 2 * AW + h * 128 + vh * 64, ov + h * 256 + c * 128 + vh * 64, (char*)lds); }
                    VM_WAIT(); __syncthreads(); __builtin_amdgcn_fence(__ATOMIC_ACQUIRE, "agent"); VM_WAIT();
                    attn_post(F, l, b, h, qb, lam, oscale);
                }
            }
            __syncthreads();
#if defined(PROBE_LRU2)
            for (int rep_ = 0; rep_ < 2; ++rep_)
#endif
            for (int item = W.vcu; item < 256; item += W.G) lru_item(F, l, item);
        }
        SEAM(pb + 1);
        if (IN(pb + 2)) {
            const Who W = who(); const int l = opaque_s(l_);
            unsigned char* ws = FWS(0); const unsigned char* wl = ws + WS_W + (size_t)l * W_LAYER;
            pg8::Gemm g{(const bf16*)(ws + WS_AO), (const bf16*)(wl + WO_OUT), M, D, D}; pg8::StaticOrder S; S.init(M, D, W.G, opaque_s((int)blockIdx.x));
            float* Hp = FOUT(); pg8::EpiRes E{l == 0 ? FIN(I_X) : (const float*)Hp, Hp, (bf16*)(ws + WS_XB0), (float*)(ws + WS_SSQ0)};
            pg8::gemm_phase<pg8::EpiRes, pg8::StaticOrder, true, true>(F.lds, g, S, E);
        }
        SEAM(pb + 2);
        if (IN(pb + 3)) {
            const Who W = who(); const int l = opaque_s(l_);
            convert_p(F, l);
            unsigned char* ws = FWS(0); const unsigned char* wl = ws + WS_W + (size_t)l * W_LAYER;
            pg8::Gemm g{(const bf16*)(ws + WS_XB0), (const bf16*)(wl + WO_W1), M, FF, D}; pg8::StaticOrder S; S.init(M, FF, W.G, opaque_s((int)blockIdx.x));
            pg8::EpiMlpIn E{(bf16*)(ws + WS_HB), FF, (const float*)(ws + WS_SSQ0)};
            pg8::gemm_phase<pg8::EpiMlpIn, pg8::StaticOrder, true, true>(F.lds, g, S, E);
        }
        SEAM(pb + 3);
        if (IN(pb + 4)) {
            const Who W = who(); const int l = opaque_s(l_);
            unsigned char* ws = FWS(0); const unsigned char* wl = ws + WS_W + (size_t)l * W_LAYER;
            pg8::Gemm g{(const bf16*)(ws + WS_HB), (const bf16*)(wl + WO_W2), M, D, FF}; pg8::StaticOrder S; S.init(M, D, W.G, opaque_s((int)blockIdx.x));
            float* Hp = FOUT(); pg8::EpiRes E{Hp, Hp, (bf16*)(ws + WS_XB0), (float*)(ws + WS_SSQ0)};
            pg8::gemm_phase<pg8::EpiRes, pg8::StaticOrder, true, true>(F.lds, g, S, E);
        }
        SEAM(pb + 4);
        if (IN(pb + 5)) {
            const Who W = who(); const int l = opaque_s(l_);
            { unsigned char* ws = FWS(0); const unsigned char* wl = ws + WS_W + (size_t)l * W_LAYER;
              pg8::Gemm g{(const bf16*)(ws + WS_P16), (const bf16*)(wl + WO_PP), M, D, opaque_s(PLE)}; pg8::StaticOrder S; S.init(M, D, W.G, opaque_s((int)blockIdx.x));
              pg8::EpiPlain E{(bf16*)(ws + WS_PP), D};
              pg8::gemm_phase<pg8::EpiPlain, pg8::StaticOrder, true, true>(F.lds, g, S, E); }
            VM_WAIT(); __syncthreads();
            { unsigned char* ws = FWS(0); const unsigned char* wl = ws + WS_W + (size_t)l * W_LAYER;
              pg8::Gemm g{(const bf16*)(ws + WS_XB0), (const bf16*)(wl + WO_PG), M, D, D}; pg8::StaticOrder S; S.init(M, D, W.G, opaque_s((int)blockIdx.x));
              pg8::EpiPle E{FOUT(), (bf16*)(ws + WS_OV), (const float*)(ws + WS_SSQ0), (float*)(ws + WS_SSQ1), (const bf16*)(ws + WS_PP)};
              pg8::gemm_phase<pg8::EpiPle, pg8::StaticOrder, true, true>(F.lds, g, S, E); }
        }
        SEAM(pb + 5);
    }
    if (IN(N_PHASES - 1)) final_norm(F);
#undef IN
#undef SEAM
}

extern "C" void kernel_launch(void* const* d_in, const int* in_sizes, int n_in, void* d_out, int out_size, void* d_ws, size_t ws_size, hipStream_t stream) {
    static int grid = 0;
    if (grid == 0) {
        if (n_in != 23 || in_sizes[0] != M * D || out_size != M * D || ws_size < WS_END) { fprintf(stderr, "kernel_launch: unexpected shapes: n_in %d in0 %d out %d ws %zu (need %zu); nothing launched\n", n_in, n_in > 0 ? in_sizes[0] : -1, out_size, ws_size, (size_t)WS_END); grid = -1; return; }
        int dev = 0, cus = 0, per_cu = 0;
        if (hipGetDevice(&dev) != hipSuccess || hipDeviceGetAttribute(&cus, hipDeviceAttributeMultiprocessorCount, dev) != hipSuccess) { grid = -1; return; }
        if (hipFuncSetAttribute((const void*)hymba_fwd, hipFuncAttributeMaxDynamicSharedMemorySize, LDS_BYTES) != hipSuccess) { fprintf(stderr, "kernel_launch: hipFuncSetAttribute failed\n"); grid = -1; return; }
        if (hipOccupancyMaxActiveBlocksPerMultiprocessor(&per_cu, (const void*)hymba_fwd, NWAVES * 64, LDS_BYTES) != hipSuccess || per_cu < 1) { fprintf(stderr, "kernel_launch: occupancy query reports %d\n", per_cu); per_cu = 1; }
        (void)hipGetLastError();
        grid = cus * per_cu;
    }
    if (grid < 0) return;
    Args a{};
    for (int i = 0; i < 23; ++i) a.in[i] = d_in[i];
    a.out = (float*)d_out; a.ws = (unsigned char*)d_ws;
#ifndef MK_CUTS
    a.ph_lo = 0; a.ph_hi = N_PHASES;
    void* kargs[] = {&a};
    hipError_t e = hipLaunchCooperativeKernel((const void*)hymba_fwd, dim3(grid), dim3(NWAVES * 64), kargs, LDS_BYTES, stream);
    if (e != hipSuccess) fprintf(stderr, "kernel_launch: cooperative launch failed: %s (grid %d)\n", hipGetErrorString(e), grid);
#else
    for (int ph = 0; ph < N_PHASES; ++ph) { a.ph_lo = ph; a.ph_hi = ph + 1; void* kargs[] = {&a};
        hipError_t e = hipLaunchCooperativeKernel((const void*)hymba_fwd, dim3(grid), dim3(NWAVES * 64), kargs, LDS_BYTES, stream);
        if (e != hipSuccess) { fprintf(stderr, "kernel_launch: launch %d failed: %s\n", ph, hipGetErrorString(e)); break; } }
#endif
}
```

```cpp
#include <hip/hip_runtime.h>
#include <cstdio>
#include <cstdint>
__device__ __forceinline__ int tid_opaque() { int t = threadIdx.x; asm volatile("" : "+v"(t)); return t; }
namespace pg8 {
#define PG8_LAS __attribute__((address_space(3)))
typedef unsigned short bf16_t;
typedef short bf16x8 __attribute__((ext_vector_type(8)));
typedef float f32x4 __attribute__((ext_vector_type(4)));
typedef unsigned u32x4 __attribute__((ext_vector_type(4)));
constexpr int BM = 256, BK = 64, HALF = 128, HTB = HALF * BK * 2  , STAGE_BYTES = 8 * HTB, NXCD = 8, WGM = 8;

__host__ __device__ __forceinline__ int lds_byte(int r, int c) { const int st = (r >> 4) * 2 + (c >> 5), rr = r & 15, cc = c & 31, ob = rr * 64 + cc * 2; return st * 1024 + (ob ^ (((ob >> 9) & 1) << 5)); }
__host__ __device__ __forceinline__ void stage_rc(int b, int& R, int& C) { const int st = b / 1024, sb = b % 1024, swz = sb ^ (((sb >> 9) & 1) << 5); R = (st >> 1) * 16 + swz / 64; C = (st & 1) * 32 + (swz % 64) / 2; }
__host__ __device__ __forceinline__ int perm32(int rho) { const int n = rho >> 4, i = rho & 15; return 8 * (i >> 2) + 4 * n + (i & 3); }

struct Unit { int pm, pn; };
struct Gemm { const bf16_t* A; const bf16_t* Bt; int M, N, K; };

struct StaticOrder {
    int nM, nN, nwg, G, c;
    __host__ __device__ void init(int M, int N, int G_, int c_) { nM = M / BM; nN = N / BM; nwg = nM * nN; G = G_; c = c_; }
    __host__ __device__ bool next(int i, Unit& u) const {
        const long L = (long)i * G + c; if (L >= nwg) return false;
        int wgid = (int)L; { const int q = nwg / NXCD, r = nwg % NXCD, xcd = wgid % NXCD, off = wgid / NXCD; wgid = (xcd < r ? xcd * (q + 1) : r * (q + 1) + (xcd - r) * q) + off; }
        const int nig = WGM * nN, gid = wgid / nig, fm = gid * WGM, gsz = (nM - fm) < WGM ? (nM - fm) : WGM;
        u.pm = fm + ((wgid % nig) % gsz); u.pn = (wgid % nig) / gsz; return true;
    }
    __device__ __forceinline__ void a_ready(const Unit&) const {}
    __device__ __forceinline__ void done(const Unit&) const {}
};

__device__ __forceinline__ unsigned cvt_pk_bf16(float lo, float hi) { unsigned r; asm volatile("v_cvt_pk_bf16_f32 %0, %1, %2" : "=v"(r) : "v"(lo), "v"(hi)); return r; }
__device__ __forceinline__ u32x4 pack8(const f32x4 v0, const f32x4 v1) { u32x4 w; w.x = cvt_pk_bf16(v0[0], v0[1]); w.y = cvt_pk_bf16(v0[2], v0[3]); w.z = cvt_pk_bf16(v1[0], v1[1]); w.w = cvt_pk_bf16(v1[2], v1[3]); return w; }
__device__ __forceinline__ float bf_lo(unsigned w) { return __uint_as_float(w << 16); }
__device__ __forceinline__ float bf_hi(unsigned w) { return __uint_as_float(w & 0xffff0000u); }
constexpr int DMODEL = 1024;
constexpr float RMS_EPS = 1e-6f;
__device__ __forceinline__ float row_rs(const float* ssq, int row) {
    const f32x4* p = (const f32x4*)(ssq + (size_t)row * 16);
    const f32x4 a = p[0], b = p[1], c = p[2], d = p[3];
    const float s = (((a[0] + a[1]) + (a[2] + a[3])) + ((b[0] + b[1]) + (b[2] + b[3]))) + (((c[0] + c[1]) + (c[2] + c[3])) + ((d[0] + d[1]) + (d[2] + d[3])));
    return __builtin_amdgcn_rsqf(s * (1.0f / DMODEL) + RMS_EPS);
}
__device__ __forceinline__ float sumsq8(const f32x4 a, const f32x4 b) { return ((a[0] * a[0] + a[1] * a[1]) + (a[2] * a[2] + a[3] * a[3])) + ((b[0] * b[0] + b[1] * b[1]) + (b[2] * b[2] + b[3] * b[3])); }

struct EpiPlain {
    static constexpr bool PERM = true, AFTER_DRAIN = false;
    bf16_t* O; int ldc;
    __device__ __forceinline__ void operator()(const f32x4 (&acc)[2][2][4][2], const Unit& u, int wr, int wc, int fr, int fq) const {
        const int row0 = u.pm * BM + wr * 64 + fr, col0 = u.pn * BM + wc * 32 + 8 * fq;
#pragma unroll
        for (int ai = 0; ai < 2; ++ai)
#pragma unroll
            for (int m = 0; m < 4; ++m) { bf16_t* rowp = O + (size_t)(row0 + ai * HALF + m * 16) * ldc + col0;
#pragma unroll
                for (int bj = 0; bj < 2; ++bj) *(u32x4*)(rowp + bj * HALF) = pack8(acc[ai][bj][m][0], acc[ai][bj][m][1]); }
    }
};
__device__ __forceinline__ void row_rs8(float (&rs)[8], const float* ssq, int row0, int fq) {
    f32x4 p[8];
#pragma unroll
    for (int i = 0; i < 8; ++i) p[i] = *(const f32x4*)(ssq + (size_t)(row0 + (i >> 2) * HALF + (i & 3) * 16) * 16 + 4 * fq);
#pragma unroll
    for (int i = 0; i < 8; ++i) { float s = (p[i][0] + p[i][1]) + (p[i][2] + p[i][3]); s += __shfl_xor(s, 16); s += __shfl_xor(s, 32); rs[i] = __builtin_amdgcn_rsqf(s * (1.0f / DMODEL) + RMS_EPS); }
}
struct EpiIn {
    static constexpr bool PERM = true, AFTER_DRAIN = false;
    bf16_t* O; int ldc; const float* ssq; const int* pos; float qscale;
    __device__ __forceinline__ void operator()(const f32x4 (&acc)[2][2][4][2], const Unit& u, int wr, int wc, int fr, int fq) const {
        const int row0 = u.pm * BM + wr * 64 + fr, col0 = u.pn * BM + wc * 32 + 8 * fq;
        const bool rope = (u.pn < 4) && !(wc & 1);
        const float sc = (u.pn < 2) ? qscale : 1.f;
        float rs[8]; row_rs8(rs, ssq, row0, fq);
        if (rope) {
            int ps[8];
#pragma unroll
            for (int i = 0; i < 8; ++i) ps[i] = pos[row0 + (i >> 2) * HALF + (i & 3) * 16];
            const bool mine = fq < 2; const float sgn = (fq == 0) ? -1.f : 1.f;
            const float invf[8] = {1.0f, 0.1939227432012558f, 0.03760603070259094f, 0.007292664609849453f, 0.0014142135623842478f, 0.00027424818836152554f, 5.3182957344688475e-05f, 1.0313385246263351e-05f};
#pragma unroll
            for (int ai = 0; ai < 2; ++ai)
#pragma unroll
                for (int m = 0; m < 4; ++m) { const int row = row0 + ai * HALF + m * 16; const float r = rs[ai * 4 + m] * sc; const float pf = (float)ps[ai * 4 + m];
                    bf16_t* rowp = O + (size_t)row * ldc + col0;
                    float c[8], sn[8];
#pragma unroll
                    for (int e = 0; e < 8; ++e) { const float rev = __builtin_amdgcn_fractf((pf * invf[e]) * 0.15915494309189535f); c[e] = mine ? __builtin_amdgcn_cosf(rev) : 1.f; sn[e] = mine ? __builtin_amdgcn_sinf(rev) * sgn : 0.f; }
#pragma unroll
                    for (int bj = 0; bj < 2; ++bj) { f32x4 v0 = acc[ai][bj][m][0] * r, v1 = acc[ai][bj][m][1] * r; f32x4 p0, p1;
#pragma unroll
                        for (int e = 0; e < 4; ++e) { p0[e] = __shfl_xor(v0[e], 16); p1[e] = __shfl_xor(v1[e], 16); }
#pragma unroll
                        for (int e = 0; e < 4; ++e) { v0[e] = v0[e] * c[e] + p0[e] * sn[e]; v1[e] = v1[e] * c[4 + e] + p1[e] * sn[4 + e]; }
                        *(u32x4*)(rowp + bj * HALF) = pack8(v0, v1); } }
        } else {
#pragma unroll
            for (int ai = 0; ai < 2; ++ai)
#pragma unroll
                for (int m = 0; m < 4; ++m) { const int row = row0 + ai * HALF + m * 16; const float r = rs[ai * 4 + m] * sc;
                    bf16_t* rowp = O + (size_t)row * ldc + col0;
#pragma unroll
                    for (int bj = 0; bj < 2; ++bj) *(u32x4*)(rowp + bj * HALF) = pack8(acc[ai][bj][m][0] * r, acc[ai][bj][m][1] * r); }
        }
    }
};
__device__ __forceinline__ void unpack8(const u32x4 w, f32x4& a, f32x4& b) { a = (f32x4){bf_lo(w.x), bf_hi(w.x), bf_lo(w.y), bf_hi(w.y)}; b = (f32x4){bf_lo(w.z), bf_hi(w.z), bf_lo(w.w), bf_hi(w.w)}; }
struct EpiRes {
    static constexpr bool PERM = true, AFTER_DRAIN = false;
    const bf16_t* Rin; bf16_t* XBo; float* ssq;
    __device__ __forceinline__ void operator()(const f32x4 (&acc)[2][2][4][2], const Unit& u, int wr, int wc, int fr, int fq) const {
        const int row0 = u.pm * BM + wr * 64 + fr, col0 = u.pn * BM + wc * 32 + 8 * fq;
        u32x4 rv[8][2];
#pragma unroll
        for (int i = 0; i < 8; ++i)
#pragma unroll
            for (int bj = 0; bj < 2; ++bj) rv[i][bj] = *(const u32x4*)(Rin + (size_t)(row0 + (i >> 2) * HALF + (i & 3) * 16) * DMODEL + col0 + bj * HALF);
#pragma unroll
        for (int ai = 0; ai < 2; ++ai)
#pragma unroll
            for (int m = 0; m < 4; ++m) { const int row = row0 + ai * HALF + m * 16; float part = 0.f;
#pragma unroll
                for (int bj = 0; bj < 2; ++bj) { f32x4 r0, r1; unpack8(rv[ai * 4 + m][bj], r0, r1);
                    const f32x4 h0 = r0 + acc[ai][bj][m][0], h1 = r1 + acc[ai][bj][m][1]; part += sumsq8(h0, h1);
                    *(u32x4*)(XBo + (size_t)row * DMODEL + col0 + bj * HALF) = pack8(h0, h1); }
                part += __shfl_xor(part, 16); part += __shfl_xor(part, 32);
                if (fq == 0) ssq[(size_t)row * 16 + u.pn * 4 + wc] = part; }
    }
};
struct EpiMlpIn {
    static constexpr bool PERM = true, AFTER_DRAIN = false;
    bf16_t* O; int ldc; const float* ssq;
    __device__ __forceinline__ void operator()(const f32x4 (&acc)[2][2][4][2], const Unit& u, int wr, int wc, int fr, int fq) const {
        const int row0 = u.pm * BM + wr * 64 + fr, col0 = u.pn * BM + wc * 32 + 8 * fq;
        float rs[8]; row_rs8(rs, ssq, row0, fq);
#pragma unroll
        for (int ai = 0; ai < 2; ++ai)
#pragma unroll
            for (int m = 0; m < 4; ++m) { const int row = row0 + ai * HALF + m * 16; const float r = rs[ai * 4 + m];
                bf16_t* rowp = O + (size_t)row * ldc + col0;
#pragma unroll
                for (int bj = 0; bj < 2; ++bj) { f32x4 v0 = acc[ai][bj][m][0] * r, v1 = acc[ai][bj][m][1] * r;
#pragma unroll
                    for (int e = 0; e < 4; ++e) { const float a = fmaxf(v0[e], 0.f), b = fmaxf(v1[e], 0.f); v0[e] = a * a; v1[e] = b * b; }
                    *(u32x4*)(rowp + bj * HALF) = pack8(v0, v1); } }
    }
};
struct EpiPle {
    static constexpr bool PERM = true, AFTER_DRAIN = false;
    const bf16_t* Rin; bf16_t* XBo; const float* ssq_in; float* ssq_out; const bf16_t* PP;
    __device__ __forceinline__ void operator()(const f32x4 (&acc)[2][2][4][2], const Unit& u, int wr, int wc, int fr, int fq) const {
        const int row0 = u.pm * BM + wr * 64 + fr, col0 = u.pn * BM + wc * 32 + 8 * fq;
#pragma unroll
        for (int ai = 0; ai < 2; ++ai)
#pragma unroll
          for (int mh = 0; mh < 2; ++mh) {
            u32x4 rv[2][2], pw[2][2]; f32x4 p[2];
#pragma unroll
            for (int mm = 0; mm < 2; ++mm) { const int rowl = row0 + ai * HALF + (2 * mh + mm) * 16; p[mm] = *(const f32x4*)(ssq_in + (size_t)rowl * 16 + 4 * fq);
#pragma unroll
                for (int bj = 0; bj < 2; ++bj) { const size_t off = (size_t)rowl * DMODEL + col0 + bj * HALF; rv[mm][bj] = *(const u32x4*)(Rin + off); pw[mm][bj] = *(const u32x4*)(PP + off); } }
#pragma unroll
            for (int mm = 0; mm < 2; ++mm) { const int m = 2 * mh + mm; const int row = row0 + ai * HALF + m * 16; float part = 0.f;
                float sr = (p[mm][0] + p[mm][1]) + (p[mm][2] + p[mm][3]); sr += __shfl_xor(sr, 16); sr += __shfl_xor(sr, 32); const float r = __builtin_amdgcn_rsqf(sr * (1.0f / DMODEL) + RMS_EPS);
#pragma unroll
                for (int bj = 0; bj < 2; ++bj) { f32x4 r0, r1, p0, p1; unpack8(rv[mm][bj], r0, r1); unpack8(pw[mm][bj], p0, p1);
                    f32x4 g0 = acc[ai][bj][m][0] * r, g1 = acc[ai][bj][m][1] * r;
#pragma unroll
                    for (int e = 0; e < 4; ++e) { g0[e] = __builtin_amdgcn_rcpf(1.f + __builtin_amdgcn_exp2f(-1.4426950408889634f * g0[e])); g1[e] = __builtin_amdgcn_rcpf(1.f + __builtin_amdgcn_exp2f(-1.4426950408889634f * g1[e])); }
                    const f32x4 h0 = r0 + g0 * p0, h1 = r1 + g1 * p1; part += sumsq8(h0, h1);
                    *(u32x4*)(XBo + (size_t)row * DMODEL + col0 + bj * HALF) = pack8(h0, h1); }
                part += __shfl_xor(part, 16); part += __shfl_xor(part, 32);
                if (fq == 0) ssq_out[(size_t)row * 16 + u.pn * 4 + wc] = part; }
            asm volatile("" ::: "memory"); }
    }
};

template <class Epi, class Sched, bool ALIGN_EPI = false, bool SP2 = false>
__device__ __forceinline__ void gemm_phase(PG8_LAS unsigned char* lds, const Gemm g, const Sched& S, const Epi& E) {
    const int tid = tid_opaque(), wid = __builtin_amdgcn_readfirstlane(tid >> 6), lane = tid & 63, wr = wid >> 2, wc = wid & 3, fr = lane & 15, fq = lane >> 4;
    const int K = g.K, nt = K / BK;
    unsigned voffA[2], voffB[2];
#pragma unroll
    for (int i = 0; i < 2; ++i) { int R, C; stage_rc(tid * 16 + i * 8192, R, C); const int Rb = Epi::PERM ? ((R & ~31) + perm32(R & 31)) : R;
        voffA[i] = (unsigned)(R * K + C) * 2u; voffB[i] = (unsigned)(Rb * K + C) * 2u; }
    const size_t kstep = (size_t)(BK * 2);
    const size_t hstep = (size_t)HALF * K * 2;
    const size_t tstep = 2 * hstep;
    const unsigned ldsw = (unsigned)wid * 1024u;
    const int aoff = lds_byte(wr * 64 + fr, fq * 8), boff = lds_byte(wc * 32 + fr, fq * 8);
#define PG8_SA(b, h) (((b) * 2 + (h)) * HTB)
#define PG8_SB(b, h) ((4 + (b) * 2 + (h)) * HTB)
#define PG8_STAGE(bufoff, gbase, voff) do { _Pragma("unroll") for (int _i = 0; _i < 2; ++_i) \
        __builtin_amdgcn_global_load_lds((const unsigned*)((const char*)(gbase) + (voff)[_i]), (PG8_LAS unsigned*)(lds + (bufoff) + ldsw + _i * 8192), 16, 0, 0); } while (0)
#define PG8_LDA(dst, b, h) do { _Pragma("unroll") for (int m = 0; m < 4; ++m) _Pragma("unroll") for (int k = 0; k < 2; ++k) dst[m][k] = *(const PG8_LAS bf16x8*)(lds + PG8_SA(b, h) + aoff + m * 2048 + k * 1024); } while (0)
#define PG8_LDB(dst, b, h) do { _Pragma("unroll") for (int n = 0; n < 2; ++n) _Pragma("unroll") for (int k = 0; k < 2; ++k) dst[n][k] = *(const PG8_LAS bf16x8*)(lds + PG8_SB(b, h) + boff + n * 2048 + k * 1024); } while (0)
#define PG8_MMA(ai, bj, At, Bt) do { __builtin_amdgcn_s_setprio(1); _Pragma("unroll") for (int m = 0; m < 4; ++m) _Pragma("unroll") for (int n = 0; n < 2; ++n) _Pragma("unroll") for (int k = 0; k < 2; ++k) \
        acc[ai][bj][m][n] = __builtin_amdgcn_mfma_f32_16x16x32_bf16(Bt[n][k], At[m][k], acc[ai][bj][m][n], 0, 0, 0); __builtin_amdgcn_s_setprio(0); } while (0)
#define PG8_WAIT_V(n) asm volatile("s_waitcnt vmcnt(" #n ")" ::: "memory")
#define PG8_WAIT_L(n) asm volatile("s_waitcnt lgkmcnt(" #n ")" ::: "memory")
#define PG8_BAR __builtin_amdgcn_s_barrier()
#define PG8_SCHED __builtin_amdgcn_sched_barrier(0)
    Unit cur, nxt; int ui = 0;
    if (!S.next(0, cur)) return;
    f32x4 acc[2][2][4][2];
#pragma unroll
    for (int a = 0; a < 2; ++a)
#pragma unroll
        for (int b = 0; b < 2; ++b)
#pragma unroll
            for (int m = 0; m < 4; ++m)
#pragma unroll
                for (int n = 0; n < 2; ++n) acc[a][b][m][n] = (f32x4){0.f, 0.f, 0.f, 0.f};
    bf16x8 At[4][2], B0[2][2], B1[2][2];
    const char* cA = (const char*)g.A + (size_t)cur.pm * tstep; const char* cB = (const char*)g.Bt + (size_t)cur.pn * tstep;
    S.a_ready(cur);
    if constexpr (SP2) {
        PG8_STAGE(PG8_SB(0, 0), cB, voffB); PG8_STAGE(PG8_SB(0, 1), cB + hstep, voffB); PG8_STAGE(PG8_SA(0, 0), cA, voffA); PG8_STAGE(PG8_SA(0, 1), cA + hstep, voffA);
        if (wr == 1) PG8_BAR;
        PG8_WAIT_V(2); PG8_BAR;
        PG8_STAGE(PG8_SB(1, 0), cB + kstep, voffB); PG8_STAGE(PG8_SA(1, 0), cA + kstep, voffA); PG8_STAGE(PG8_SB(1, 1), cB + hstep + kstep, voffB);
        PG8_WAIT_V(6); PG8_BAR;
    } else {
        PG8_STAGE(PG8_SB(0, 0), cB, voffB); PG8_STAGE(PG8_SA(0, 0), cA, voffA); PG8_STAGE(PG8_SB(0, 1), cB + hstep, voffB); PG8_STAGE(PG8_SA(0, 1), cA + hstep, voffA);
        if (wr == 1) PG8_BAR;
        PG8_WAIT_V(4); PG8_BAR;
        PG8_STAGE(PG8_SB(1, 0), cB + kstep, voffB); PG8_STAGE(PG8_SA(1, 0), cA + kstep, voffA); PG8_STAGE(PG8_SB(1, 1), cB + hstep + kstep, voffB);
        PG8_WAIT_V(6); PG8_BAR;
    }
    for (;;) {
        const bool has_next = S.next(ui + 1, nxt);
        const char* nA = has_next ? (const char*)g.A + (size_t)nxt.pm * tstep : cA; const char* nB = has_next ? (const char*)g.Bt + (size_t)nxt.pn * tstep : cB;
        for (int t = 0; t < nt; t += 2) {
            const bool last = (t == nt - 2);
            const char* a1 = cA + (size_t)(t + 1) * kstep;
            const char* a2 = last ? nA : cA + (size_t)(t + 2) * kstep; const char* b2 = last ? nB : cB + (size_t)(t + 2) * kstep;
            const char* a3 = a2 + kstep; const char* b3 = b2 + kstep;
            if (last && has_next) S.a_ready(nxt);
            if constexpr (SP2) {
            PG8_LDB(B0, 0, 0); PG8_LDB(B1, 0, 1); PG8_SCHED; PG8_LDA(At, 0, 0); PG8_STAGE(PG8_SA(1, 1), a1 + hstep, voffA);
            PG8_WAIT_V(8); PG8_WAIT_L(0); PG8_BAR; PG8_MMA(0, 0, At, B0); PG8_MMA(0, 1, At, B1); PG8_BAR; PG8_SCHED;
            PG8_LDA(At, 0, 1); PG8_STAGE(PG8_SB(0, 0), b2, voffB); PG8_STAGE(PG8_SB(0, 1), b2 + hstep, voffB); PG8_STAGE(PG8_SA(0, 0), a2, voffA);
            PG8_WAIT_V(8); PG8_WAIT_L(0); PG8_BAR; PG8_MMA(1, 0, At, B0); PG8_MMA(1, 1, At, B1); PG8_BAR; PG8_SCHED;
            PG8_LDB(B0, 1, 0); PG8_LDB(B1, 1, 1); PG8_SCHED; PG8_LDA(At, 1, 0); PG8_STAGE(PG8_SA(0, 1), a2 + hstep, voffA);
            PG8_WAIT_V(8); PG8_WAIT_L(0); PG8_BAR; PG8_MMA(0, 0, At, B0); PG8_MMA(0, 1, At, B1); PG8_BAR; PG8_SCHED;
            PG8_LDA(At, 1, 1); PG8_STAGE(PG8_SB(1, 0), b3, voffB); PG8_STAGE(PG8_SB(1, 1), b3 + hstep, voffB); PG8_STAGE(PG8_SA(1, 0), a3, voffA);
            PG8_WAIT_V(8); PG8_WAIT_L(0); PG8_BAR; PG8_MMA(1, 0, At, B0); PG8_MMA(1, 1, At, B1); PG8_BAR; PG8_SCHED;
            } else {
            PG8_LDB(B0, 0, 0); PG8_SCHED; PG8_LDA(At, 0, 0); PG8_STAGE(PG8_SA(1, 1), a1 + hstep, voffA);
            PG8_WAIT_L(8); PG8_BAR; PG8_WAIT_L(0); PG8_MMA(0, 0, At, B0); PG8_BAR; PG8_SCHED;
            PG8_LDB(B1, 0, 1); PG8_STAGE(PG8_SB(0, 0), b2, voffB);
            PG8_BAR; PG8_WAIT_L(0); PG8_MMA(0, 1, At, B1); PG8_BAR;
            PG8_LDA(At, 0, 1); PG8_STAGE(PG8_SA(0, 0), a2, voffA);
            PG8_BAR; PG8_WAIT_L(0); PG8_MMA(1, 0, At, B0); PG8_BAR; PG8_SCHED;
            PG8_STAGE(PG8_SB(0, 1), b2 + hstep, voffB);
            PG8_WAIT_V(6); PG8_BAR; PG8_MMA(1, 1, At, B1); PG8_BAR;
            PG8_LDB(B0, 1, 0); PG8_SCHED; PG8_LDA(At, 1, 0); PG8_STAGE(PG8_SA(0, 1), a2 + hstep, voffA);
            PG8_WAIT_L(8); PG8_BAR; PG8_WAIT_L(0); PG8_MMA(0, 0, At, B0); PG8_BAR; PG8_SCHED;
            PG8_LDB(B1, 1, 1); PG8_STAGE(PG8_SB(1, 0), b3, voffB);
            PG8_BAR; PG8_WAIT_L(0); PG8_MMA(0, 1, At, B1); PG8_BAR;
            PG8_LDA(At, 1, 1); PG8_STAGE(PG8_SA(1, 0), a3, voffA);
            PG8_BAR; PG8_WAIT_L(0); PG8_MMA(1, 0, At, B0); PG8_BAR; PG8_SCHED;
            PG8_STAGE(PG8_SB(1, 1), b3 + hstep, voffB);
            PG8_WAIT_V(6); PG8_BAR; PG8_MMA(1, 1, At, B1); PG8_BAR;
            }
        }
        if constexpr (ALIGN_EPI) { if (wr == 0) PG8_BAR; }
        if constexpr (!Epi::AFTER_DRAIN) { const int t2 = tid_opaque(), w2 = __builtin_amdgcn_readfirstlane(t2 >> 6), l2 = t2 & 63;
            E(acc, cur, w2 >> 2, w2 & 3, l2 & 15, l2 >> 4); S.done(cur); }
        if (!has_next) break;
#pragma unroll
        for (int a = 0; a < 2; ++a)
#pragma unroll
            for (int b = 0; b < 2; ++b)
#pragma unroll
                for (int m = 0; m < 4; ++m)
#pragma unroll
                    for (int n = 0; n < 2; ++n) acc[a][b][m][n] = (f32x4){0.f, 0.f, 0.f, 0.f};
        cur = nxt; cA = nA; cB = nB; ++ui;
        if constexpr (ALIGN_EPI) { if (wr == 1) PG8_BAR; }
    }
    PG8_WAIT_V(0);
    if constexpr (!ALIGN_EPI) { if (wr == 0) PG8_BAR; }
    PG8_BAR;
    if constexpr (Epi::AFTER_DRAIN) { E.fused(acc, cur, wr, wc, fr, fq, lds, wid, lane); S.done(cur); }
#undef PG8_SA
#undef PG8_SB
#undef PG8_STAGE
#undef PG8_LDA
#undef PG8_LDB
#undef PG8_MMA
#undef PG8_WAIT_V
#undef PG8_WAIT_L
#undef PG8_BAR
#undef PG8_SCHED
}
}
#ifndef PG8_SP2
#define PG8_SP2 true
#endif
#include <hip/hip_bf16.h>
#include <cmath>
namespace attn_body {
using bf16=__hip_bfloat16;
using bf16x8=__attribute__((ext_vector_type(8)))short;
using s16x4=__attribute__((ext_vector_type(4)))short;
using f32x16=__attribute__((ext_vector_type(16)))float;
using u32x4=__attribute__((ext_vector_type(4)))unsigned;
constexpr int D=64,PQ=2560,PO=1024;
constexpr int NW=8,QBLK=32,QB=QBLK*NW,KVBLK=64;
constexpr int ATTN_UNIT_ROWS=QB;
__device__ __forceinline__ int crow(int r,int hi){return (r&3)+8*(r>>2)+4*hi;}
#define SBAR() __builtin_amdgcn_sched_barrier(0)
__device__ __forceinline__ void cmask(f32x16&p0,f32x16&p1,int jb,int qrel,int hi){
  const float NEG=-INFINITY; int kb=64*jb+4*hi;
  #pragma unroll
  for(int r=0;r<16;++r){int kv=kb+(r&3)+8*(r>>2); if(kv>qrel)p0[r]=NEG; if(kv+32>qrel)p1[r]=NEG;}
}

constexpr int NSLOT=3, SLOTB=8192;
constexpr int LDS_K=0, LDS_V=NSLOT*SLOTB, LDS_WS=2*NSLOT*SLOTB, LDS_OST=LDS_WS+NW*64*4, LDS_BYTES=LDS_OST+NW*4096;
constexpr float C2=0.125f*1.4426950408889634f;
__device__ __forceinline__ void glds16(const void*gsrc,unsigned lds_dst){unsigned keep;
  asm volatile("s_mov_b32 %0, m0\n\ts_mov_b32 m0, %2\n\ts_nop 0\n\tglobal_load_lds_dwordx4 %1, off\n\ts_mov_b32 m0, %0":"=&s"(keep):"v"(gsrc),"s"(lds_dst):"memory");}
__device__ __forceinline__ float max3f(float a,float b,float c){float r;asm("v_max3_f32 %0, %1, %2, %3":"=v"(r):"v"(a),"v"(b),"v"(c));return r;}
__device__ __forceinline__ float max2f(float a,float b){float r;asm("v_max_f32_e32 %0, %1, %2":"=v"(r):"v"(a),"v"(b));return r;}
__device__ __forceinline__ float fadd_s(float a,float b){float r;asm("v_add_f32_e32 %0, %1, %2":"=v"(r):"v"(a),"v"(b));return r;}
__device__ __forceinline__ float fsub_s(float a,float b){float r;asm("v_sub_f32_e32 %0, %1, %2":"=v"(r):"v"(a),"v"(b));return r;}
typedef float f32x2_t __attribute__((ext_vector_type(2))); typedef __bf16 bf16x2_t __attribute__((ext_vector_type(2)));
__device__ __forceinline__ unsigned cvtpk_s(float lo,float hi){f32x2_t v={lo,hi};bf16x2_t b=__builtin_convertvector(v,bf16x2_t);return __builtin_bit_cast(unsigned,b);}
#define WAIT_BAR(N) asm volatile("s_waitcnt vmcnt(" #N ") lgkmcnt(0)\n\ts_barrier":::"memory")

__device__ __forceinline__ void qkt(f32x16&p0,f32x16&p1,const char*Kslot,const bf16x8*qr,const f32x16&negm,int r32,int hi){
  const char*kb=Kslot+hi*1024+r32*16;
  #pragma unroll
  for(int d0=0;d0<4;++d0){
    const bf16x8 b0=*reinterpret_cast<const bf16x8*>(kb+d0*2048);
    const bf16x8 b1=*reinterpret_cast<const bf16x8*>(kb+d0*2048+512);
    if(d0==0){p0=__builtin_amdgcn_mfma_f32_32x32x16_bf16(b0,qr[0],negm,0,0,0);p1=__builtin_amdgcn_mfma_f32_32x32x16_bf16(b1,qr[0],negm,0,0,0);}
    else{p0=__builtin_amdgcn_mfma_f32_32x32x16_bf16(b0,qr[d0],p0,0,0,0);p1=__builtin_amdgcn_mfma_f32_32x32x16_bf16(b1,qr[d0],p1,0,0,0);}}
}
typedef __attribute__((address_space(3))) const char* lds_cptr;
typedef short v4i16_t __attribute__((ext_vector_type(4)));
__device__ __forceinline__ void kload8(bf16x8*kf,lds_cptr kp){
  kf[0]=*(const __attribute__((address_space(3))) bf16x8*)(kp);      kf[1]=*(const __attribute__((address_space(3))) bf16x8*)(kp+512);
  kf[2]=*(const __attribute__((address_space(3))) bf16x8*)(kp+2048); kf[3]=*(const __attribute__((address_space(3))) bf16x8*)(kp+2560);
  kf[4]=*(const __attribute__((address_space(3))) bf16x8*)(kp+4096); kf[5]=*(const __attribute__((address_space(3))) bf16x8*)(kp+4608);
  kf[6]=*(const __attribute__((address_space(3))) bf16x8*)(kp+6144); kf[7]=*(const __attribute__((address_space(3))) bf16x8*)(kp+6656);
}
__device__ __forceinline__ void kload2(bf16x8*kf,lds_cptr kp,int j){ kf[2*j]=*(const __attribute__((address_space(3))) bf16x8*)(kp+j*2048); kf[2*j+1]=*(const __attribute__((address_space(3))) bf16x8*)(kp+j*2048+512); }
__device__ __forceinline__ s16x4 vtr(lds_cptr p){ return __builtin_bit_cast(s16x4,__builtin_amdgcn_ds_read_tr16_b64_v4i16((__attribute__((address_space(3))) v4i16_t*)p)); }
__device__ __forceinline__ float rowmax(const f32x16&p0,const f32x16&p1){
  float a=max3f(p0[0],p0[1],p1[0]),b=max3f(p0[2],p0[3],p1[1]);a=max3f(a,p1[2],p1[3]);
  #pragma unroll
  for(int r=4;r<16;r+=4){a=max3f(a,p0[r],p0[r+1]);b=max3f(b,p0[r+2],p0[r+3]);a=max3f(a,p1[r],p1[r+1]);b=max3f(b,p1[r+2],p1[r+3]);}
  const float m=max2f(a,b);
  auto rr=__builtin_amdgcn_permlane32_swap(__float_as_uint(m),__float_as_uint(m),false,false);
  return max2f(__uint_as_float(rr[0]),__uint_as_float(rr[1]));
}
__device__ __forceinline__ void pv(f32x16*o,int vb,bf16x8 pa0,bf16x8 pa1,bf16x8 pa2,bf16x8 pa3){
  #pragma unroll
  for(int d0=0;d0<2;++d0){s16x4 lo[4],hi[4];
    #pragma unroll
    for(int ks=0;ks<4;++ks){
      asm volatile("ds_read_b64_tr_b16 %0,%1 offset:%c2":"=&v"(lo[ks]):"v"(vb),"i"(d0*4096+ks*1024):"memory");
      asm volatile("ds_read_b64_tr_b16 %0,%1 offset:%c2":"=&v"(hi[ks]):"v"(vb),"i"(d0*4096+ks*1024+512):"memory");}
    asm volatile("s_waitcnt lgkmcnt(0)":::"memory");SBAR();
    #define PK(k) (bf16x8){lo[k][0],lo[k][1],lo[k][2],lo[k][3],hi[k][0],hi[k][1],hi[k][2],hi[k][3]}
    o[d0]=__builtin_amdgcn_mfma_f32_32x32x16_bf16(pa0,PK(0),o[d0],0,0,0);
    o[d0]=__builtin_amdgcn_mfma_f32_32x32x16_bf16(pa1,PK(1),o[d0],0,0,0);
    o[d0]=__builtin_amdgcn_mfma_f32_32x32x16_bf16(pa2,PK(2),o[d0],0,0,0);
    o[d0]=__builtin_amdgcn_mfma_f32_32x32x16_bf16(pa3,PK(3),o[d0],0,0,0);
    #undef PK
  }
}

#ifndef ATTN_STORE16
#define ATTN_STORE16(p,v) (*(u32x4*)(p)=(v))
#endif
template<int THRL> __device__ __forceinline__ void attn_unit(int qb,const bf16*Qh,const bf16*__restrict__ Kh,const bf16*__restrict__ Vh,bf16*Oh,char*shm){
  const int tid=tid_opaque(),lane=tid&63,r32=lane&31,hi=lane>>5; const int wid=__builtin_amdgcn_readfirstlane(tid>>6);
  const int q0=qb*QB;
  const bf16*Qw=Qh+(long)(q0+wid*QBLK)*PQ;
  const unsigned lds0=(unsigned)(uintptr_t)shm;
  float*wsf=(float*)(shm+LDS_WS)+wid*64;
  const bf16*ksrc=Kh+(long)lane*PQ+wid*8;
  const bf16*vsrc=Vh+(long)(16*(wid&3)+(lane>>2))*PQ+(wid>>2)*32+(lane&3)*8;
  const unsigned kdst=lds0+LDS_K+wid*1024, vdst=lds0+LDS_V+wid*1024;
  #define DMA_K(t,slot) glds16(ksrc+(long)(t)*KVBLK*PQ,(unsigned)__builtin_amdgcn_readfirstlane(kdst+(slot)))
  #define DMA_V(t,slot) glds16(vsrc+(long)(t)*KVBLK*PQ,(unsigned)__builtin_amdgcn_readfirstlane(vdst+(slot)))
  const int vb0=(int)(lds0+LDS_V)+((lane>>4)&1)*32+(lane&3)*8+(4*hi+((lane&15)>>2))*64;
  const char*Kbase=shm+LDS_K; bf16x8 kf[8];
  const lds_cptr shm3=(lds_cptr)shm; const lds_cptr kp0=shm3+LDS_K+hi*1024+r32*16; const lds_cptr vp0=shm3+LDS_V+((lane>>4)&1)*32+(lane&3)*8+(4*hi+((lane&15)>>2))*64;
  const int NT=(q0+QB)/KVBLK;
  DMA_K(0,0);DMA_V(0,0);DMA_K(1,SLOTB);
  bf16x8 qr[4];
  #pragma unroll
  for(int d0=0;d0<4;++d0)qr[d0]=*reinterpret_cast<const bf16x8*>(&Qw[(long)r32*PQ+d0*16+hi*8]);
  float mhat=0.f,l_reg=0.f;f32x16 o[2];o[0]=f32x16{};o[1]=f32x16{};f32x16 negm=f32x16{};asm volatile("":"+v"(negm));
  const int qrel=wid*QBLK+r32;
  #define CMASK(P0,P1,t) do{int jb_=(t)-(NT-4); if(jb_>=0)cmask(P0,P1,jb_,qrel,hi);}while(0)
  bool resc=false;
  #define START(P0,P1) do{ const float rm=rowmax(P0,P1); resc=false; \
    { const float dl=rm; mhat=fadd_s(mhat,dl); \
      _Pragma("unroll") for(int r=0;r<16;++r){P0[r]=fsub_s(P0[r],dl);P1[r]=fsub_s(P1[r],dl);} \
      _Pragma("unroll") for(int r=0;r<16;++r)negm[r]=-mhat; asm volatile("":"+v"(negm)); } \
    _Pragma("unroll") for(int r=0;r<16;++r)P0[r]=__builtin_amdgcn_exp2f(P0[r]); }while(0)
  #define RESC() do{ if(resc){ asm volatile("s_waitcnt lgkmcnt(0)":::"memory"); \
      _Pragma("unroll") for(int d_=0;d_<2;++d_) _Pragma("unroll") for(int r=0;r<16;++r)o[d_][r]*=wsf[crow(r,hi)]; } }while(0)
  f32x16 pA0,pA1,pB0,pB1;
  int sl_prev=0,sl_cur=0,sl_next=SLOTB;
  #define ROT() do{sl_prev=sl_cur;sl_cur=sl_next;sl_next=(sl_next==(NSLOT-1)*SLOTB)?0:sl_next+SLOTB;}while(0)
  DMA_K(2,2*SLOTB);
  WAIT_BAR(3);
  qkt(pA0,pA1,Kbase,qr,negm,r32,hi);asm volatile("s_nop 15\n\ts_nop 7":"+v"(pA0),"+v"(pA1));CMASK(pA0,pA1,0);
  START(pA0,pA1);
  _Pragma("unroll") for(int r=0;r<16;++r)pA1[r]=__builtin_amdgcn_exp2f(pA1[r]);
  WAIT_BAR(0);
  DMA_K(3,0);DMA_V(1,SLOTB);
  ROT();
  kload8(kf,kp0+sl_cur);
  WAIT_BAR(2);
  s16x4 vlo[8],vhi[8]; u32x4 pw0,pw1,pw2,pw3;
  #define PKW(P,B) cvtpk_s(P[B],P[B+1])
  #define PAF(k) __builtin_bit_cast(bf16x8,pw##k)
  #define VFR(i) (bf16x8){vlo[i][0],vlo[i][1],vlo[i][2],vlo[i][3],vhi[i][0],vhi[i][1],vhi[i][2],vhi[i][3]}
  #define PIN(x) asm volatile("":"+v"(x))
  #define MX3(a,b,c) __builtin_fmaxf(__builtin_fmaxf((a),(b)),(c))
  #define GAPA(MF,A0,A1,A2,A3,W0,W1,PW) do{ MF; sacc+=A0; sacc+=A1; sacc+=A2; sacc+=A3; PIN(sacc); W0; W1; PIN(PW); SBAR(); }while(0)
  #define EX(v) __builtin_amdgcn_exp2f(v)
  #define GAPB(MF,X,B) do{ MF; X[B]=EX(X[B]); X[B+1]=EX(X[B+1]); X[B+2]=EX(X[B+2]); X[B+3]=EX(X[B+3]); PIN(X); SBAR(); }while(0)
  #define VRD(i) do{ vlo[i]=vtr(vp_+(((i)>>2)*4096+((i)&3)*1024)); vhi[i]=vtr(vp_+(((i)>>2)*4096+((i)&3)*1024+512)); }while(0)
  #define KRD(G,j) do{ if(G){ kload2(kf,kp0+sl_next,j); SBAR(); } }while(0)
  #define STEP(C0,C1,P0,P1,t,GK,GV,GL) do{ SBAR(); \
    const lds_cptr vp_=vp0+sl_prev; \
    VRD(0); SBAR(); float sacc=(P0[0]+P0[1]); \
    GAPA(C0=__builtin_amdgcn_mfma_f32_32x32x16_bf16(kf[0],qr[0],negm,0,0,0), P0[2],P0[3],P0[4],P0[5],     pw0[0]=PKW(P0,0), pw0[1]=PKW(P0,2), pw0); \
    VRD(4); SBAR(); GAPA(C1=__builtin_amdgcn_mfma_f32_32x32x16_bf16(kf[1],qr[0],negm,0,0,0), P0[6],P0[7],P0[8],P0[9],     pw0[2]=PKW(P0,4), pw0[3]=PKW(P0,6), pw0); \
    VRD(1); SBAR(); GAPA(C0=__builtin_amdgcn_mfma_f32_32x32x16_bf16(kf[2],qr[1],C0,0,0,0),   P0[10],P0[11],P0[12],P0[13], pw1[0]=PKW(P0,8), pw1[1]=PKW(P0,10), pw1); \
    VRD(5); SBAR(); GAPA(C1=__builtin_amdgcn_mfma_f32_32x32x16_bf16(kf[3],qr[1],C1,0,0,0),   P0[14],P0[15],P1[0],P1[1],   pw1[2]=PKW(P0,12),pw1[3]=PKW(P0,14), pw1); \
    VRD(2); SBAR(); GAPA(C0=__builtin_amdgcn_mfma_f32_32x32x16_bf16(kf[4],qr[2],C0,0,0,0),   P1[2],P1[3],P1[4],P1[5],     pw2[0]=PKW(P1,0), pw2[1]=PKW(P1,2), pw2); \
    VRD(6); SBAR(); GAPA(C1=__builtin_amdgcn_mfma_f32_32x32x16_bf16(kf[5],qr[2],C1,0,0,0),   P1[6],P1[7],P1[8],P1[9],     pw2[2]=PKW(P1,4), pw2[3]=PKW(P1,6), pw2); \
    VRD(3); SBAR(); GAPA(C0=__builtin_amdgcn_mfma_f32_32x32x16_bf16(kf[6],qr[3],C0,0,0,0),   P1[10],P1[11],P1[12],P1[13], pw3[0]=PKW(P1,8), pw3[1]=PKW(P1,10), pw3); \
    VRD(7); SBAR(); GAPA(C1=__builtin_amdgcn_mfma_f32_32x32x16_bf16(kf[7],qr[3],C1,0,0,0),   P1[14],P1[15],0.f,0.f,       pw3[2]=PKW(P1,12),pw3[3]=PKW(P1,14), pw3); \
    l_reg+=sacc; \
    if(GK){DMA_K((t)+3,sl_cur);} if(GV){DMA_V((t)+1,sl_next);} \
    CMASK(C0,C1,t); \
    { float a=MX3(C0[0],C0[1],C1[0]),b=MX3(C0[2],C0[3],C1[1]); a=MX3(a,C1[2],C1[3]); \
      _Pragma("unroll") for(int r=4;r<16;r+=4){a=MX3(a,C0[r],C0[r+1]);b=MX3(b,C0[r+2],C0[r+3]);a=MX3(a,C1[r],C1[r+1]);b=MX3(b,C1[r+2],C1[r+3]);} \
      float rm=__builtin_fmaxf(a,b); { auto rr=__builtin_amdgcn_permlane32_swap(__float_as_uint(rm),__float_as_uint(rm),false,false); rm=__builtin_fmaxf(__uint_as_float(rr[0]),__uint_as_float(rr[1])); } \
      resc=false; \
      if(__builtin_expect(__any(rm>(float)THRL),0)){ const float dl=__builtin_fmaxf(rm,0.f); mhat+=dl; \
        _Pragma("unroll") for(int r=0;r<16;++r){C0[r]-=dl;C1[r]-=dl;} \
        _Pragma("unroll") for(int r=0;r<16;++r)negm[r]=-mhat; asm volatile("":"+v"(negm)); \
        const float f=__builtin_amdgcn_exp2f(-dl); l_reg*=f; if(hi==0)wsf[r32]=f; resc=true; } } \
    SBAR(); \
    GAPB(o[0]=__builtin_amdgcn_mfma_f32_32x32x16_bf16(PAF(0),VFR(0),o[0],0,0,0), C0,0); \
    GAPB(o[1]=__builtin_amdgcn_mfma_f32_32x32x16_bf16(PAF(0),VFR(4),o[1],0,0,0), C0,4); \
    KRD(GL,0); GAPB(o[0]=__builtin_amdgcn_mfma_f32_32x32x16_bf16(PAF(1),VFR(1),o[0],0,0,0), C0,8); \
    KRD(GL,1); GAPB(o[1]=__builtin_amdgcn_mfma_f32_32x32x16_bf16(PAF(1),VFR(5),o[1],0,0,0), C0,12); \
    KRD(GL,2); GAPB(o[0]=__builtin_amdgcn_mfma_f32_32x32x16_bf16(PAF(2),VFR(2),o[0],0,0,0), C1,0); \
    KRD(GL,3); GAPB(o[1]=__builtin_amdgcn_mfma_f32_32x32x16_bf16(PAF(2),VFR(6),o[1],0,0,0), C1,4); \
    GAPB(o[0]=__builtin_amdgcn_mfma_f32_32x32x16_bf16(PAF(3),VFR(3),o[0],0,0,0), C1,8); \
    GAPB(o[1]=__builtin_amdgcn_mfma_f32_32x32x16_bf16(PAF(3),VFR(7),o[1],0,0,0), C1,12); \
    }while(0)
  int t=1;
  #undef CMASK
  #define CMASK(P0,P1,t) do{}while(0)
  for(;t+5<NT;t+=2){
    STEP(pB0,pB1,pA0,pA1,t,true,true,true);     WAIT_BAR(2); RESC(); ROT();
    STEP(pA0,pA1,pB0,pB1,t+1,true,true,true);   WAIT_BAR(2); RESC(); ROT();
  }
  #undef CMASK
  #define CMASK(P0,P1,t) do{int jb_=(t)-(NT-4); if(jb_>=0)cmask(P0,P1,jb_,qrel,hi);}while(0)
  #define ENDW(tt) do{ if((tt)+3<NT){WAIT_BAR(2);} else if((tt)+2<NT){WAIT_BAR(1);} else {WAIT_BAR(0);} }while(0)
  for(;t+1<NT;t+=2){
    STEP(pB0,pB1,pA0,pA1,t,(t+3<NT),(t+1<NT),(t+1<NT));       ENDW(t);   RESC(); ROT();
    STEP(pA0,pA1,pB0,pB1,t+1,(t+4<NT),(t+2<NT),(t+2<NT));     ENDW(t+1); RESC(); ROT();
  }
  STEP(pB0,pB1,pA0,pA1,NT-1,false,false,false); RESC();
  { float sacc=pB0[0]+pB0[1]; _Pragma("unroll") for(int r=2;r<16;++r)sacc+=pB0[r]; _Pragma("unroll") for(int r=0;r<16;++r)sacc+=pB1[r]; l_reg+=sacc;
    pw0=(u32x4){PKW(pB0,0),PKW(pB0,2),PKW(pB0,4),PKW(pB0,6)};pw1=(u32x4){PKW(pB0,8),PKW(pB0,10),PKW(pB0,12),PKW(pB0,14)};pw2=(u32x4){PKW(pB1,0),PKW(pB1,2),PKW(pB1,4),PKW(pB1,6)};pw3=(u32x4){PKW(pB1,8),PKW(pB1,10),PKW(pB1,12),PKW(pB1,14)};
    SBAR(); pv(o,vb0+sl_cur,PAF(0),PAF(1),PAF(2),PAF(3)); }
  #undef PKW
  #undef PAF
  #undef VFR
  #undef PIN
  #undef MX3
  #undef GAPA
  #undef GAPB
  #undef EX
  #undef VRD
  #undef KRD
  #undef STEP
  #undef ENDW
  {auto rr=__builtin_amdgcn_permlane32_swap(__float_as_uint(l_reg),__float_as_uint(l_reg),false,false);l_reg=__uint_as_float(rr[0])+__uint_as_float(rr[1]);}
  if(hi==0)wsf[32+r32]=l_reg;asm volatile("s_waitcnt lgkmcnt(0)":::"memory");
  float rli[16];
  #pragma unroll
  for(int r=0;r<16;++r)rli[r]=__builtin_amdgcn_rcpf(wsf[32+crow(r,hi)]);
  bf16*Ow=Oh+(long)(q0+wid*QBLK)*PO;
  { bf16*stg=(bf16*)(shm+LDS_OST)+wid*2048;
    #pragma unroll
    for(int r=0;r<16;++r){const int orow=crow(r,hi);
      #pragma unroll
      for(int d0=0;d0<2;++d0)stg[orow*64+d0*32+r32]=__float2bfloat16(o[d0][r]*rli[r]);}
    asm volatile("s_waitcnt lgkmcnt(0)":::"memory");
    #pragma unroll
    for(int i=0;i<4;++i){const int row=i*8+(lane>>3),ch=lane&7; const u32x4 v=*(const u32x4*)(stg+row*64+ch*8); ATTN_STORE16(Ow+(long)row*PO+ch*8,v);} }
  asm volatile("s_waitcnt lgkmcnt(0)\n\ts_barrier":::"memory");
  #undef DMA_K
  #undef DMA_V
  #undef CMASK
  #undef START
  #undef RESC
  #undef ROT
}
constexpr int ATTN_LDS_BYTES=LDS_BYTES;
#undef SBAR
#undef WAIT_BAR
}
#include <hip/hip_cooperative_groups.h>
namespace cg = cooperative_groups;
constexpr int NWAVES = 8;
constexpr int BATCH = 16, SEQ = 2048, D = 1024, DEPTH = 4, FF = 4096, PLE = 256, INW = 2560, AW = 512, RW = 512;
constexpr int M = BATCH * SEQ;
constexpr size_t MiB = 1u << 20;
constexpr size_t WS_CS = 1 * MiB;
constexpr size_t WS_SSQ0 = 3 * MiB, WS_SSQ1 = 5 * MiB;
constexpr size_t WS_W = 8 * MiB, W_LAYER = 25 * MiB + 512 * 1024;
constexpr size_t WO_IN = 0, WO_OUT = 5 * MiB, WO_W1 = 7 * MiB, WO_W2 = 15 * MiB, WO_PG = 23 * MiB, WO_PP = 25 * MiB;
constexpr size_t WS_P16 = 110 * MiB;
constexpr size_t WS_XB0 = 126 * MiB;
constexpr size_t WS_R = 190 * MiB;
constexpr size_t WS_PROJ = WS_R;
constexpr size_t WS_OV = WS_R + 160 * MiB;
constexpr size_t WS_AO = WS_R + 224 * MiB;
constexpr size_t WS_HB = WS_R;
constexpr size_t WS_XBF = WS_R + 64 * MiB;
constexpr size_t WS_PP = WS_R;
constexpr size_t WS_END = WS_R + 288 * MiB;
static_assert(WS_W + DEPTH * W_LAYER <= WS_P16 && WS_P16 + (size_t)M * PLE * 2 <= WS_XB0 && WS_XB0 + (size_t)M * D * 2 <= WS_R && WS_HB + (size_t)M * FF * 2 <= WS_END, "d_ws map");
constexpr int RING_BYTES = 131072;
constexpr int LDS_BYTES = 147456;

#define GAS __attribute__((address_space(1)))
#define LAS __attribute__((address_space(3)))
typedef unsigned short bf16;
typedef unsigned v4u __attribute__((ext_vector_type(4)));
typedef float f32x4 __attribute__((ext_vector_type(4)));
typedef short bf16x8 __attribute__((ext_vector_type(8)));
#define LDS_WAIT() asm volatile("s_waitcnt lgkmcnt(0)" ::: "memory")
#define VM_WAIT() asm volatile("s_waitcnt vmcnt(0)" ::: "memory")
__device__ __forceinline__ unsigned f2bf(float f) { unsigned u = __builtin_bit_cast(unsigned, f); return (u + 0x7fffu + ((u >> 16) & 1u)) >> 16; }
__device__ __forceinline__ unsigned pk2(float lo, float hi) { unsigned r; asm("v_cvt_pk_bf16_f32 %0, %1, %2" : "=v"(r) : "v"(lo), "v"(hi)); return r; }
__device__ __forceinline__ float bf2f(unsigned short v) { return __uint_as_float((unsigned)v << 16); }
__device__ __forceinline__ float sigmoid_f(float x) { return __builtin_amdgcn_rcpf(1.f + __builtin_amdgcn_exp2f(-1.4426950408889634f * x)); }

typedef GAS unsigned gu32;
#define RLX_AGENT __ATOMIC_RELAXED, __HIP_MEMORY_SCOPE_AGENT
#define XB_TMO      128
#define XB_XCNT(j)  (256  + 64 * (j))
#define XB_XSUB(j)  (1280 + 64 * (j))
#define XB_XGEN(j)  (2304 + 64 * (j))
#define XB_TOP      3328
#define XB_TOPGEN   3392
#define XCD_BAR_WORDS 3456
#define XB_SPIN_CAP (1u << 18)

__device__ __forceinline__ unsigned xb_ld(unsigned* p)              { return __hip_atomic_load(p, __ATOMIC_RELAXED, __HIP_MEMORY_SCOPE_AGENT); }
__device__ __forceinline__ unsigned xb_add(unsigned* p, unsigned v) { return __hip_atomic_fetch_add(p, v, __ATOMIC_RELAXED, __HIP_MEMORY_SCOPE_AGENT); }
__device__ __forceinline__ unsigned xb_xcc_id() { return (unsigned)__builtin_amdgcn_s_getreg((3 << 11) | 20) & 0xFu; }
#define XB_SPIN(cond, bar) do { unsigned _sp = 0; while (cond) { __builtin_amdgcn_s_sleep(1); \
    if ((++_sp & 255u) == 0u) { if (xb_ld(&(bar)[XB_TMO])) break; if (_sp > XB_SPIN_CAP) { atomicAdd(&(bar)[XB_TMO], 1u); break; } } } } while (0)

struct XcdBarrier {
    unsigned* bar; unsigned x;
    volatile LAS unsigned* st;
};

__device__ __forceinline__ XcdBarrier xcd_barrier_post(unsigned* bar, volatile LAS unsigned* st) {
    XcdBarrier b; b.bar = bar; b.x = xb_xcc_id(); b.st = st;
    if (threadIdx.x == 0) (void)xb_add(&bar[XB_XCNT(b.x)], 1u);
    return b;
}
__device__ __forceinline__ void xcd_barrier_complete(unsigned* bar, unsigned x, unsigned& nloc, unsigned& nx) {
    const unsigned G = gridDim.x * gridDim.y * gridDim.z;
    unsigned sum, cnt, mine, sp = 0u;
    for (;;) {
        sum = 0u; cnt = 0u; mine = 0u;
#pragma unroll
        for (unsigned j = 0; j < 16; ++j) { const unsigned c = xb_ld(&bar[XB_XCNT(j)]); sum += c; cnt += (c > 0u) ? 1u : 0u; mine = (j == x) ? c : mine; }
        if (sum == G) break;
        __builtin_amdgcn_s_sleep(1);
        if ((++sp & 255u) == 0u) { if (xb_ld(&bar[XB_TMO])) break; if (sp > XB_SPIN_CAP) { atomicAdd(&bar[XB_TMO], 1u); break; } }
    }
    nloc = mine > 0u ? mine : 1u; nx = cnt > 0u ? cnt : 1u;
}

__device__ __forceinline__ void xcd_barrier(const XcdBarrier& b) {
    asm volatile("s_waitcnt vmcnt(0)" ::: "memory");
    __syncthreads();
    if (threadIdx.x == 0) {
        unsigned* bar = b.bar;
        __builtin_amdgcn_s_waitcnt(0);
        unsigned nloc = b.st[0], nx = b.st[1];
        if (nloc == 0u) { xcd_barrier_complete(bar, b.x, nloc, nx); b.st[0] = nloc; b.st[1] = nx; }
        const unsigned old = xb_add(&bar[XB_XSUB(b.x)], 1u);
        const unsigned gen = old / nloc;
        if (old + 1u == (gen + 1u) * nloc) {
            __builtin_amdgcn_fence(__ATOMIC_RELEASE, "agent");
            asm volatile("s_waitcnt vmcnt(0)" ::: "memory");
            const unsigned og = xb_add(&bar[XB_TOP], 1u);
            const unsigned tg = og / nx;
            if (og + 1u == (tg + 1u) * nx) xb_add(&bar[XB_TOPGEN], 1u);
            else XB_SPIN(xb_ld(&bar[XB_TOPGEN]) == tg, bar);
            __builtin_amdgcn_fence(__ATOMIC_ACQUIRE, "agent");
            xb_add(&bar[XB_XGEN(b.x)], 1u);
            asm volatile("s_waitcnt vmcnt(0)" ::: "memory");
        } else {
            XB_SPIN(xb_ld(&bar[XB_XGEN(b.x)]) == gen, bar);
            __builtin_amdgcn_fence(__ATOMIC_ACQUIRE, "agent");
            asm volatile("s_waitcnt vmcnt(0)" ::: "memory");
        }
    }
    __syncthreads();
}

struct Frame {
    LAS unsigned char* lds;
    LAS const unsigned long long* tab;
};
struct Who { int tid, lane, wave, vcu, G; };
__device__ __forceinline__ Who who() { Who w; w.tid = tid_opaque(); w.lane = w.tid & 63; w.wave = __builtin_amdgcn_readfirstlane(w.tid >> 6);
    int bx = blockIdx.x, G = gridDim.x; asm volatile("" : "+s"(bx), "+s"(G)); w.G = G; w.vcu = (G % 8 == 0) ? (bx % 8) * (G / 8) + bx / 8 : bx; return w; }
__device__ __forceinline__ int opaque_s(int v) { asm volatile("" : "+s"(v)); return v; }
__device__ __forceinline__ const void* ptab(LAS const unsigned long long* tab, int k) {
    const unsigned long long v = tab[k]; const unsigned lo = __builtin_amdgcn_readfirstlane((unsigned)v), hi = __builtin_amdgcn_readfirstlane((unsigned)(v >> 32));
    return (const void*)(((unsigned long long)hi << 32) | lo);
}
#define FIN(k) ((const float*)ptab(F.tab, (k)))
#define FOUT() ((float*)ptab(F.tab, 23))
#define FWS(off) ((unsigned char*)ptab(F.tab, 24) + (off))
enum { I_X = 0, I_P, I_POS, I_WIN, I_WOUT, I_GMIX, I_GSUBLN, I_LAMQ, I_LAMK, I_CONVW, I_CONVB, I_WGA, I_BGA, I_WGX, I_BGX, I_LRULAM, I_GMLP, I_WMLPIN, I_WMLPOUT, I_GPLE, I_WPLEGATE, I_WPLEPROJ, I_GFINAL };

__device__ __forceinline__ float wave_sum(float v) {
#pragma unroll
    for (int o = 1; o < 64; o <<= 1) v += __shfl_xor(v, o);
    return v;
}
__device__ __forceinline__ void p0_transpose_item(const float* W, const float* gain, int K, int N, bf16* WT, LAS float* scr, int item, int lane) {
    const int nblk = N / 32, kb = item / nblk, nb = item % nblk, k0 = 64 * kb, n0 = 32 * nb;
    const int c = lane & 7;
    float v[32];
#pragma unroll
    for (int i = 0; i < 32; ++i) v[i] = W[(size_t)(k0 + 2 * i + (lane >> 5)) * N + n0 + (lane & 31)];
    f32x4 ga = {1.f, 1.f, 1.f, 1.f}, gb = ga;
    if (gain) { ga = *(const f32x4*)(gain + k0 + 8 * c); gb = *(const f32x4*)(gain + k0 + 8 * c + 4); }
#pragma unroll
    for (int i = 0; i < 32; ++i) scr[(2 * i + (lane >> 5)) * 33 + (lane & 31)] = v[i];
    LDS_WAIT(); asm volatile("" ::: "memory");
#pragma unroll
    for (int j = 0; j < 4; ++j) { const int n = (lane >> 3) + 8 * j; const LAS float* s = scr + (8 * c) * 33 + n;
        v4u o; o.x = pk2(s[0 * 33] * ga.x, s[1 * 33] * ga.y); o.y = pk2(s[2 * 33] * ga.z, s[3 * 33] * ga.w); o.z = pk2(s[4 * 33] * gb.x, s[5 * 33] * gb.y); o.w = pk2(s[6 * 33] * gb.z, s[7 * 33] * gb.w);
        *(GAS v4u*)(WT + (size_t)(n0 + n) * K + k0 + 8 * c) = o; }
    LDS_WAIT(); asm volatile("" ::: "memory");
}
__device__ __forceinline__ void p0_prologue(Frame& F) {
    const Who W = who();
    LAS float* scr = (LAS float*)(F.lds + W.wave * 16384);
    const int gw = W.vcu * NWAVES + W.wave, NGW = W.G * NWAVES;
    unsigned char* ws = FWS(0);
    const float *w_in = FIN(I_WIN), *w_out = FIN(I_WOUT), *w_mlp_in = FIN(I_WMLPIN), *w_mlp_out = FIN(I_WMLPOUT), *w_ple_gate = FIN(I_WPLEGATE), *w_ple_proj = FIN(I_WPLEPROJ), *g_mix = FIN(I_GMIX), *g_mlp = FIN(I_GMLP), *g_ple = FIN(I_GPLE);
    constexpr int I_IN = (D / 64) * (INW / 32), I_OUT = (D / 64) * (D / 32), I_1 = (D / 64) * (FF / 32), I_2 = (FF / 64) * (D / 32), I_PG = I_OUT, I_PP = (PLE / 64) * (D / 32);
    constexpr int PER_L = I_IN + I_OUT + I_1 + I_2 + I_PG + I_PP;
    for (int it = gw; it < DEPTH * PER_L; it += NGW) {
        const int l = it / PER_L; int r = it % PER_L; bf16* wl = (bf16*)(ws + WS_W + (size_t)l * W_LAYER);
        if (r < I_IN) { p0_transpose_item(w_in + (size_t)l * D * INW, g_mix + l * D, D, INW, (bf16*)((unsigned char*)wl + WO_IN), scr, r, W.lane); continue; } r -= I_IN;
        if (r < I_OUT) { p0_transpose_item(w_out + (size_t)l * D * D, nullptr, D, D, (bf16*)((unsigned char*)wl + WO_OUT), scr, r, W.lane); continue; } r -= I_OUT;
        if (r < I_1) { p0_transpose_item(w_mlp_in + (size_t)l * D * FF, g_mlp + l * D, D, FF, (bf16*)((unsigned char*)wl + WO_W1), scr, r, W.lane); continue; } r -= I_1;
        if (r < I_2) { p0_transpose_item(w_mlp_out + (size_t)l * FF * D, nullptr, FF, D, (bf16*)((unsigned char*)wl + WO_W2), scr, r, W.lane); continue; } r -= I_2;
        if (r < I_PG) { p0_transpose_item(w_ple_gate + (size_t)l * D * D, g_ple + l * D, D, D, (bf16*)((unsigned char*)wl + WO_PG), scr, r, W.lane); continue; } r -= I_PG;
        p0_transpose_item(w_ple_proj + (size_t)l * PLE * D, nullptr, PLE, D, (bf16*)((unsigned char*)wl + WO_PP), scr, r, W.lane);
    }
    const float* x_ = FIN(I_X); bf16* XB1_ = (bf16*)FOUT(); float* SSQ1_ = (float*)(ws + WS_SSQ1); float* CS_ = (float*)(ws + WS_CS); const int* pos_ = (const int*)FIN(I_POS);
#pragma unroll 4
    for (int m = gw; m < M; m += NGW) {
        const GAS f32x4* xr = (const GAS f32x4*)(x_ + (size_t)m * D) + W.lane;
        GAS unsigned long long* o8 = (GAS unsigned long long*)(XB1_ + (size_t)m * D) + W.lane; float s = 0.f;
#pragma unroll
        for (int j = 0; j < 4; ++j) { const f32x4 v = xr[64 * j]; s += (v.x * v.x + v.y * v.y) + (v.z * v.z + v.w * v.w);
            o8[64 * j] = (unsigned long long)pk2(v.x, v.y) | ((unsigned long long)pk2(v.z, v.w) << 32); }
        s = wave_sum(s);
        if (W.lane < 16) SSQ1_[(size_t)m * 16 + W.lane] = (W.lane == 0) ? s : 0.f;
    }
}
__device__ __forceinline__ void convert_p(Frame& F, int l) {
    const Who W = who();
    const float* src = FIN(I_P) + (size_t)l * M * PLE; bf16* P16_ = (bf16*)FWS(WS_P16);
#pragma unroll 4
    for (size_t e = (size_t)W.vcu * NWAVES * 64 + W.tid; e < (size_t)M * PLE / 8; e += (size_t)W.G * NWAVES * 64) {
        const f32x4 a = *(const GAS f32x4*)(src + e * 8), b = *(const GAS f32x4*)(src + e * 8 + 4);
        v4u o; o.x = pk2(a.x, a.y); o.y = pk2(a.z, a.w); o.z = pk2(b.x, b.y); o.w = pk2(b.z, b.w);
        *(GAS v4u*)(P16_ + e * 8) = o; }
}
__device__ __forceinline__ void final_norm(Frame& F) {
    const Who W = who();
    const int gw = W.vcu * NWAVES + W.wave, NGW = W.G * NWAVES;
    const float* SSQ1_ = (const float*)FWS(WS_SSQ1); float* O_ = FOUT(); const float* gf_ = FIN(I_GFINAL); const bf16* XBF_ = (const bf16*)FWS(WS_XBF);
#pragma unroll 4
    for (int m = gw; m < M; m += NGW) {
        const float rs = pg8::row_rs(SSQ1_, m);
        const GAS unsigned long long* hr = (const GAS unsigned long long*)(XBF_ + (size_t)m * D) + W.lane; GAS f32x4* orow = (GAS f32x4*)(O_ + (size_t)m * D) + W.lane; const GAS f32x4* gr = (const GAS f32x4*)gf_ + W.lane;
#pragma unroll
        for (int j = 0; j < 4; ++j) { const unsigned long long w8 = hr[64 * j]; const unsigned lo = (unsigned)w8, hi = (unsigned)(w8 >> 32); const f32x4 g = gr[64 * j];
            const f32x4 v = {pg8::bf_lo(lo), pg8::bf_hi(lo), pg8::bf_lo(hi), pg8::bf_hi(hi)}; orow[64 * j] = v * rs * g; }
    }
}

__device__ __forceinline__ void lru_item(Frame& F, int l, int item) {
    const int b = item >> 4, g = (item >> 1) & 7, hf = item & 1;
    const int tid_ = tid_opaque(), lane = tid_ & 63, w = __builtin_amdgcn_readfirstlane(tid_ >> 6), r = lane & 15, q = lane >> 4;
    LAS float* xcs = (LAS float*)(F.lds + w * 4352);
    LAS float* car = (LAS float*)(F.lds + 36864);
    const bf16* pj = (const bf16*)FWS(WS_PROJ) + (size_t)b * SEQ * INW;
    bf16* ao = (bf16*)FWS(WS_AO) + (size_t)b * SEQ * D;
    v4u* lb = (v4u*)FWS(WS_XB0) + ((size_t)item * NWAVES + w) * (16 * 2 * 64) + lane;
    const int t0 = w * 256;
    const bf16* gcol = pj + 3 * AW + RW + g * 64 + hf * 32 + r;
    bf16* ycol = ao + AW + g * 64 + hf * 32 + r;
    float hin[2] = {0.f, 0.f};
    {
        const int cch = g * 64 + lane;
        const float* conv_w = FIN(I_CONVW);
        const float cw0 = conv_w[(l * 4 + 0) * RW + cch], cw1 = conv_w[(l * 4 + 1) * RW + cch], cw2 = conv_w[(l * 4 + 2) * RW + cch], cw3 = conv_w[(l * 4 + 3) * RW + cch], cb = FIN(I_CONVB)[l * RW + cch];
        bf16x8 Bf[2][2][2];
#pragma unroll
        for (int gate = 0; gate < 2; ++gate) { const float* W = (gate ? FIN(I_WGX) : FIN(I_WGA)) + (size_t)(l * 8 + g) * 64 * 64;
#pragma unroll
            for (int n = 0; n < 2; ++n)
#pragma unroll
                for (int kk = 0; kk < 2; ++kk) { const float* wp = W + (size_t)(32 * kk + 8 * q) * 64 + hf * 32 + 16 * n + r; v4u pw;
                    pw.x = pk2(wp[0 * 64], wp[1 * 64]); pw.y = pk2(wp[2 * 64], wp[3 * 64]); pw.z = pk2(wp[4 * 64], wp[5 * 64]); pw.w = pk2(wp[6 * 64], wp[7 * 64]);
                    Bf[gate][n][kk] = __builtin_bit_cast(bf16x8, pw); } }
        float ba[2], bx[2], sp8[2];
#pragma unroll
        for (int n = 0; n < 2; ++n) { const int ch = l * RW + g * 64 + hf * 32 + 16 * n + r; ba[n] = FIN(I_BGA)[ch]; bx[n] = FIN(I_BGX)[ch];
            const float z = -FIN(I_LRULAM)[ch]; sp8[n] = 8.f * (fmaxf(z, 0.f) + log1pf(__expf(-fabsf(z)))); }
        const bf16* xcol = pj + 3 * AW + cch;
        float h3 = 0.f, h2 = 0.f, h1 = 0.f;
        if (t0 != 0) { h3 = bf2f(xcol[(size_t)(t0 - 3) * INW]); h2 = bf2f(xcol[(size_t)(t0 - 2) * INW]); h1 = bf2f(xcol[(size_t)(t0 - 1) * INW]); }
        float hrun[2] = {0.f, 0.f}, Arun[2] = {1.f, 1.f};
        unsigned short xq[16];
#pragma unroll
        for (int tt = 0; tt < 16; ++tt) xq[tt] = xcol[(size_t)(t0 + tt) * INW];
#pragma unroll 1
        for (int sc = 0; sc < 16; ++sc) {
            const int ts = t0 + sc * 16, tn = (sc < 15) ? ts + 16 : ts;
            unsigned short xn[16];
#pragma unroll
            for (int tt = 0; tt < 16; ++tt) xn[tt] = xcol[(size_t)(tn + tt) * INW];
#pragma unroll
            for (int tt = 0; tt < 16; ++tt) { const float xv = bf2f(xq[tt]); const float xc = cb + cw0 * h3 + cw1 * h2 + cw2 * h1 + cw3 * xv; h3 = h2; h2 = h1; h1 = xv; xcs[tt * 68 + lane] = xc; }
            asm volatile("s_waitcnt lgkmcnt(0)" ::: "memory");
            bf16x8 Af[2];
#pragma unroll
            for (int kk = 0; kk < 2; ++kk) { const LAS f32x4* ap = (const LAS f32x4*)(xcs + r * 68 + 32 * kk + 8 * q); const f32x4 a0 = ap[0], a1 = ap[1];
                v4u pw; pw.x = pk2(a0.x, a0.y); pw.y = pk2(a0.z, a0.w); pw.z = pk2(a1.x, a1.y); pw.w = pk2(a1.z, a1.w); Af[kk] = __builtin_bit_cast(bf16x8, pw); }
            f32x4 Da[2], Dx[2];
#pragma unroll
            for (int n = 0; n < 2; ++n) { Da[n] = (f32x4){0.f, 0.f, 0.f, 0.f}; Dx[n] = Da[n];
#pragma unroll
                for (int kk = 0; kk < 2; ++kk) { Da[n] = __builtin_amdgcn_mfma_f32_16x16x32_bf16(Af[kk], Bf[0][n][kk], Da[n], 0, 0, 0); Dx[n] = __builtin_amdgcn_mfma_f32_16x16x32_bf16(Af[kk], Bf[1][n][kk], Dx[n], 0, 0, 0); } }
#pragma unroll
            for (int n = 0; n < 2; ++n) {
                float a[4], bb[4]; v4u st;
#pragma unroll
                for (int i = 0; i < 4; ++i) { const float xcv = xcs[(4 * q + i) * 68 + hf * 32 + 16 * n + r];
                    const float ra = sigmoid_f(Da[n][i] + ba[n]), ix = sigmoid_f(Dx[n][i] + bx[n]);
                    const float la = -ra * sp8[n];
                    const float y2 = 2.f * la;
                    const float ser = -y2 * (1.f + y2 * (0.5f + y2 * (0.16666667f + y2 * (0.041666668f + y2 * 0.008333334f))));
                    const float a2 = __builtin_amdgcn_exp2f(1.4426950408889634f * y2);
                    const float em = (y2 > -0.25f) ? ser : (1.f - a2);
                    const float bv = __builtin_amdgcn_sqrtf(fmaxf(em, 0.f)) * (ix * xcv);
                    const unsigned pr = pk2(la * 1.4426950408889634f, bv); st[i] = pr;
                    a[i] = __builtin_amdgcn_exp2f(bf2f((unsigned short)(pr & 0xffffu))); bb[i] = __uint_as_float(pr & 0xffff0000u); }
                lb[(sc * 2 + n) * 64] = st;
                const float Al = (a[0] * a[1]) * (a[2] * a[3]);
                const float Hl = ((bb[0] * a[1] + bb[1]) * a[2] + bb[2]) * a[3] + bb[3];
                const float A0 = __shfl(Al, r), A1 = __shfl(Al, r + 16), A2 = __shfl(Al, r + 32), A3 = __shfl(Al, r + 48);
                const float H0 = __shfl(Hl, r), H1 = __shfl(Hl, r + 16), H2 = __shfl(Hl, r + 32), H3 = __shfl(Hl, r + 48);
                const float c0 = hrun[n], c1 = A0 * c0 + H0, c2 = A1 * c1 + H1, c3 = A2 * c2 + H2, c4 = A3 * c3 + H3;
                hrun[n] = c4; Arun[n] *= (A0 * A1) * (A2 * A3);
            }
#pragma unroll
            for (int tt = 0; tt < 16; ++tt) xq[tt] = xn[tt];
        }
        if (q == 0) {
#pragma unroll
            for (int n = 0; n < 2; ++n) { car[w * 64 + n * 16 + r] = Arun[n]; car[w * 64 + 32 + n * 16 + r] = hrun[n]; } }
        __syncthreads();
#pragma unroll
        for (int n = 0; n < 2; ++n) { float h = 0.f; for (int w2 = 0; w2 < w; ++w2) h = car[w2 * 64 + n * 16 + r] * h + car[w2 * 64 + 32 + n * 16 + r]; hin[n] = h; }
    }
    {
        VM_WAIT();
        float hrun[2] = {hin[0], hin[1]};
        v4u cur[2]; cur[0] = lb[0]; cur[1] = lb[64];
#pragma unroll 1
        for (int sc = 0; sc < 16; ++sc) {
            const int ts = t0 + sc * 16, scn = (sc < 15) ? sc + 1 : sc;
            v4u nxt[2]; nxt[0] = lb[(scn * 2 + 0) * 64]; nxt[1] = lb[(scn * 2 + 1) * 64];
            unsigned short gq[2][4];
#pragma unroll
            for (int n = 0; n < 2; ++n)
#pragma unroll
                for (int i = 0; i < 4; ++i) gq[n][i] = gcol[(size_t)(ts + 4 * q + i) * INW + 16 * n];
#pragma unroll
            for (int n = 0; n < 2; ++n) {
                float a[4], bb[4];
#pragma unroll
                for (int i = 0; i < 4; ++i) { const unsigned pr = cur[n][i]; a[i] = __builtin_amdgcn_exp2f(__uint_as_float(pr << 16)); bb[i] = __uint_as_float(pr & 0xffff0000u); }
                const float Al = (a[0] * a[1]) * (a[2] * a[3]);
                const float Hl = ((bb[0] * a[1] + bb[1]) * a[2] + bb[2]) * a[3] + bb[3];
                const float A0 = __shfl(Al, r), A1 = __shfl(Al, r + 16), A2 = __shfl(Al, r + 32);
                const float H0 = __shfl(Hl, r), H1 = __shfl(Hl, r + 16), H2 = __shfl(Hl, r + 32), H3 = __shfl(Hl, r + 48), A3 = __shfl(Al, r + 48);
                const float c0 = hrun[n], c1 = A0 * c0 + H0, c2 = A1 * c1 + H1, c3 = A2 * c2 + H2, c4 = A3 * c3 + H3;
                hrun[n] = c4;
                float h = (q == 0) ? c0 : (q == 1) ? c1 : (q == 2) ? c2 : c3;
#pragma unroll
                for (int i = 0; i < 4; ++i) { h = a[i] * h + bb[i]; const float gv = bf2f(gq[n][i]);
                    const float ge = gv * sigmoid_f(1.5957691216057308f * (gv + 0.044715f * gv * gv * gv));
                    ycol[(size_t)(ts + 4 * q + i) * D + 16 * n] = (bf16)(pk2(h * ge, 0.f) & 0xffffu); }
            }
            cur[0] = nxt[0]; cur[1] = nxt[1];
        }
    }
    __syncthreads();
}

__device__ __forceinline__ void attn_post(Frame& F, int l, int b, int h, int qb, float lam, float oscale) {
    const int tid_ = tid_opaque(), lane = tid_ & 63, wave_ = __builtin_amdgcn_readfirstlane(tid_ >> 6), rsub = lane >> 4, e8 = (lane & 15) * 8;
    const float* gs = FIN(I_GSUBLN) + l * 128 + e8; const bf16* OV_ = (const bf16*)FWS(WS_OV); bf16* AO_ = (bf16*)FWS(WS_AO); const f32x4 g0 = *(const f32x4*)gs, g1 = *(const f32x4*)(gs + 4);
    const size_t rowbase = (size_t)b * SEQ + qb * 256 + wave_ * 32;
#pragma unroll 4
    for (int it = 0; it < 8; ++it) { const size_t row = rowbase + it * 4 + rsub;
        const v4u a = *(const GAS v4u*)(OV_ + row * D + h * 256 + e8), c = *(const GAS v4u*)(OV_ + row * D + h * 256 + 128 + e8);
        f32x4 d0 = {pg8::bf_lo(a.x) - lam * pg8::bf_lo(c.x), pg8::bf_hi(a.x) - lam * pg8::bf_hi(c.x), pg8::bf_lo(a.y) - lam * pg8::bf_lo(c.y), pg8::bf_hi(a.y) - lam * pg8::bf_hi(c.y)};
        f32x4 d1 = {pg8::bf_lo(a.z) - lam * pg8::bf_lo(c.z), pg8::bf_hi(a.z) - lam * pg8::bf_hi(c.z), pg8::bf_lo(a.w) - lam * pg8::bf_lo(c.w), pg8::bf_hi(a.w) - lam * pg8::bf_hi(c.w)};
        float ss = pg8::sumsq8(d0, d1);
        ss += __shfl_xor(ss, 1); ss += __shfl_xor(ss, 2); ss += __shfl_xor(ss, 4); ss += __shfl_xor(ss, 8);
        const float rs = __builtin_amdgcn_rsqf(ss * (1.f / 128.f) + 1e-6f) * oscale;
        d0 = d0 * rs * g0; d1 = d1 * rs * g1;
        v4u o; o.x = pk2(d0.x, d0.y); o.y = pk2(d0.z, d0.w); o.z = pk2(d1.x, d1.y); o.w = pk2(d1.z, d1.w);
        *(GAS v4u*)(AO_ + row * D + h * 128 + e8) = o; }
}

struct Args { const void* in[23]; float* out; unsigned char* ws; int ph_lo, ph_hi; };
constexpr int N_PHASES = 2 + 6 * DEPTH;
__global__ void __launch_bounds__(NWAVES * 64, 2) hymba_fwd(Args args) {
    extern __shared__ __attribute__((aligned(16))) unsigned char lds[];
    cg::grid_group grid = cg::this_grid();
    Frame F;
    F.lds = (LAS unsigned char*)lds;
    { LAS unsigned long long* tabw = (LAS unsigned long long*)(F.lds + RING_BYTES + 1024);
      if (threadIdx.x == 0) {
#pragma unroll
          for (int k = 0; k < 23; ++k) tabw[k] = (unsigned long long)args.in[k];
          tabw[23] = (unsigned long long)args.out; tabw[24] = (unsigned long long)args.ws; }
      F.tab = tabw; }
    __syncthreads();
    const int lo = args.ph_lo, hi = args.ph_hi;
#define IN(k) (lo <= (k) && (k) < hi)
#define SEAM(k) do { if (IN(k) && IN((k) + 1)) xcd_barrier(bar); } while (0)

    if (blockIdx.x == 0) { unsigned* bw = (unsigned*)args.ws; for (int u = threadIdx.x; u < XCD_BAR_WORDS; u += NWAVES * 64) bw[u] = 0u; }
    if (threadIdx.x < 2) ((volatile LAS unsigned*)(F.lds + RING_BYTES + 2048))[threadIdx.x] = 0u;
    if (IN(0)) { p0_prologue(F); }
    grid.sync();
    XcdBarrier bar = xcd_barrier_post((unsigned*)args.ws, (volatile LAS unsigned*)(F.lds + RING_BYTES + 2048));

#pragma unroll 1
    for (int l_ = 0; l_ < DEPTH; ++l_) {
        const int pb = 1 + 6 * l_;
        if (IN(pb + 0)) {
            const Who W = who(); const int l = opaque_s(l_);
            unsigned char* ws = FWS(0); const unsigned char* wl = ws + WS_W + (size_t)l * W_LAYER;
            pg8::Gemm g{(const bf16*)FOUT(), (const bf16*)(wl + WO_IN), M, INW, D}; pg8::StaticOrder S; S.init(M, INW, W.G, opaque_s((int)blockIdx.x));
            pg8::EpiIn E{(bf16*)(ws + WS_PROJ), INW, (const float*)(ws + WS_SSQ1), (const int*)FIN(I_POS), attn_body::C2};
            pg8::gemm_phase<pg8::EpiIn, pg8::StaticOrder, true, true>(F.lds, g, S, E);
        }
        SEAM(pb + 0);
        if (IN(pb + 1)) {
            const Who W = who(); const int l = opaque_s(l_);
            float lam, oscale;
            { const float* lq = FIN(I_LAMQ) + l * 128; const float* lk = FIN(I_LAMK) + l * 128;
              const float d0 = wave_sum(lq[W.lane] * lk[W.lane]), d1 = wave_sum(lq[64 + W.lane] * lk[64 + W.lane]);
              const float li = 0.8f - 0.6f * __expf(-0.3f * (float)l); lam = __expf(d0) - __expf(d1) + li; oscale = 1.f - li; }
#if defined(PROBE_ATTN2)
            for (int rep_ = 0; rep_ < 2; ++rep_)
#endif
            for (int item = W.vcu; item < 256; item += W.G) {
                const int bh = item >> 2, s = item & 3, b = bh >> 2, h = bh & 3;
                const attn_body::bf16* pj = (const attn_body::bf16*)((const bf16*)FWS(WS_PROJ) + (size_t)b * SEQ * INW); attn_body::bf16* ov = (attn_body::bf16*)((bf16*)FWS(WS_OV) + (size_t)b * SEQ * D);
#pragma unroll 1
                for (int k = 0; k < 2; ++k) { const int qb = k ? 7 - s : s;
#pragma unroll 1
                    for (int j = 0; j < 4; ++j) { const int c = j >> 1, vh = j & 1;
                        attn_body::attn_unit<8>(qb, pj + (h * 2 + c) * 64, pj + AW + (h * 2 + c) * 64, pj + 2 * AW + h * 128 + vh * 64, ov + h * 256 + c * 128 + vh * 64, (char*)lds); }
                    VM_WAIT(); __syncthreads(); __builtin_amdgcn_fence(__ATOMIC_ACQUIRE, "agent"); VM_WAIT();
                    attn_post(F, l, b, h, qb, lam, oscale);
                }
            }
            __syncthreads();
#if defined(PROBE_LRU2)
            for (int rep_ = 0; rep_ < 2; ++rep_)
#endif
            for (int item = W.vcu; item < 256; item += W.G) lru_item(F, l, item);
        }
        SEAM(pb + 1);
        if (IN(pb + 2)) {
            const Who W = who(); const int l = opaque_s(l_);
            unsigned char* ws = FWS(0); const unsigned char* wl = ws + WS_W + (size_t)l * W_LAYER;
            pg8::Gemm g{(const bf16*)(ws + WS_AO), (const bf16*)(wl + WO_OUT), M, D, D}; pg8::StaticOrder S; S.init(M, D, W.G, opaque_s((int)blockIdx.x));
            pg8::EpiRes E{(const bf16*)FOUT(), (bf16*)(ws + WS_XB0), (float*)(ws + WS_SSQ0)};
            pg8::gemm_phase<pg8::EpiRes, pg8::StaticOrder, true, true>(F.lds, g, S, E);
        }
        SEAM(pb + 2);
        if (IN(pb + 3)) {
            const Who W = who(); const int l = opaque_s(l_);
            convert_p(F, l);
            unsigned char* ws = FWS(0); const unsigned char* wl = ws + WS_W + (size_t)l * W_LAYER;
            pg8::Gemm g{(const bf16*)(ws + WS_XB0), (const bf16*)(wl + WO_W1), M, FF, D}; pg8::StaticOrder S; S.init(M, FF, W.G, opaque_s((int)blockIdx.x));
            pg8::EpiMlpIn E{(bf16*)(ws + WS_HB), FF, (const float*)(ws + WS_SSQ0)};
            pg8::gemm_phase<pg8::EpiMlpIn, pg8::StaticOrder, true, true>(F.lds, g, S, E);
        }
        SEAM(pb + 3);
        if (IN(pb + 4)) {
            const Who W = who(); const int l = opaque_s(l_);
            unsigned char* ws = FWS(0); const unsigned char* wl = ws + WS_W + (size_t)l * W_LAYER;
            pg8::Gemm g{(const bf16*)(ws + WS_HB), (const bf16*)(wl + WO_W2), M, D, FF}; pg8::StaticOrder S; S.init(M, D, W.G, opaque_s((int)blockIdx.x));
            pg8::EpiRes E{(const bf16*)(ws + WS_XB0), (bf16*)(ws + WS_XB0), (float*)(ws + WS_SSQ0)};
            pg8::gemm_phase<pg8::EpiRes, pg8::StaticOrder, true, true>(F.lds, g, S, E);
        }
        SEAM(pb + 4);
        if (IN(pb + 5)) {
            const Who W = who(); const int l = opaque_s(l_);
            { unsigned char* ws = FWS(0); const unsigned char* wl = ws + WS_W + (size_t)l * W_LAYER;
              pg8::Gemm g{(const bf16*)(ws + WS_P16), (const bf16*)(wl + WO_PP), M, D, opaque_s(PLE)}; pg8::StaticOrder S; S.init(M, D, W.G, opaque_s((int)blockIdx.x));
              pg8::EpiPlain E{(bf16*)(ws + WS_PP), D};
              pg8::gemm_phase<pg8::EpiPlain, pg8::StaticOrder, true, true>(F.lds, g, S, E); }
            VM_WAIT(); __syncthreads();
            { unsigned char* ws = FWS(0); const unsigned char* wl = ws + WS_W + (size_t)l * W_LAYER;
              pg8::Gemm g{(const bf16*)(ws + WS_XB0), (const bf16*)(wl + WO_PG), M, D, D}; pg8::StaticOrder S; S.init(M, D, W.G, opaque_s((int)blockIdx.x));
              pg8::EpiPle E{(const bf16*)(ws + WS_XB0), (l == DEPTH - 1) ? (bf16*)(ws + WS_XBF) : (bf16*)FOUT(), (const float*)(ws + WS_SSQ0), (float*)(ws + WS_SSQ1), (const bf16*)(ws + WS_PP)};
              pg8::gemm_phase<pg8::EpiPle, pg8::StaticOrder, true, true>(F.lds, g, S, E); }
        }
        SEAM(pb + 5);
    }
    if (IN(N_PHASES - 1)) final_norm(F);
#undef IN
#undef SEAM
}

extern "C" void kernel_launch(void* const* d_in, const int* in_sizes, int n_in, void* d_out, int out_size, void* d_ws, size_t ws_size, hipStream_t stream) {
    static int grid = 0;
    if (grid == 0) {
        if (n_in != 23 || in_sizes[0] != M * D || out_size != M * D || ws_size < WS_END) { fprintf(stderr, "kernel_launch: unexpected shapes: n_in %d in0 %d out %d ws %zu (need %zu); nothing launched\n", n_in, n_in > 0 ? in_sizes[0] : -1, out_size, ws_size, (size_t)WS_END); grid = -1; return; }
        int dev = 0, cus = 0, per_cu = 0;
        if (hipGetDevice(&dev) != hipSuccess || hipDeviceGetAttribute(&cus, hipDeviceAttributeMultiprocessorCount, dev) != hipSuccess) { grid = -1; return; }
        if (hipFuncSetAttribute((const void*)hymba_fwd, hipFuncAttributeMaxDynamicSharedMemorySize, LDS_BYTES) != hipSuccess) { fprintf(stderr, "kernel_launch: hipFuncSetAttribute failed\n"); grid = -1; return; }
        if (hipOccupancyMaxActiveBlocksPerMultiprocessor(&per_cu, (const void*)hymba_fwd, NWAVES * 64, LDS_BYTES) != hipSuccess || per_cu < 1) { fprintf(stderr, "kernel_launch: occupancy query reports %d\n", per_cu); per_cu = 1; }
        (void)hipGetLastError();
        grid = cus * per_cu;
    }
    if (grid < 0) return;
    Args a{};
    for (int i = 0; i < 23; ++i) a.in[i] = d_in[i];
    a.out = (float*)d_out; a.ws = (unsigned char*)d_ws;
#ifndef MK_CUTS
    a.ph_lo = 0; a.ph_hi = N_PHASES;
    void* kargs[] = {&a};
    hipError_t e = hipLaunchCooperativeKernel((const void*)hymba_fwd, dim3(grid), dim3(NWAVES * 64), kargs, LDS_BYTES, stream);
    if (e != hipSuccess) fprintf(stderr, "kernel_launch: cooperative launch failed: %s (grid %d)\n", hipGetErrorString(e), grid);
#else
    for (int ph = 0; ph < N_PHASES; ++ph) { a.ph_lo = ph; a.ph_hi = ph + 1; void* kargs[] = {&a};
        hipError_t e = hipLaunchCooperativeKernel((const void*)hymba_fwd, dim3(grid), dim3(NWAVES * 64), kargs, LDS_BYTES, stream);
        if (e != hipSuccess) { fprintf(stderr, "kernel_launch: launch %d failed: %s\n", ph, hipGetErrorString(e)); break; } }
#endif
}
```

```cpp
#include <hip/hip_runtime.h>
#include <cstdio>
#include <cstdint>
__device__ __forceinline__ int tid_opaque() { int t = threadIdx.x; asm volatile("" : "+v"(t)); return t; }
namespace pg8 {
#define PG8_LAS __attribute__((address_space(3)))
typedef unsigned short bf16_t;
typedef short bf16x8 __attribute__((ext_vector_type(8)));
typedef float f32x4 __attribute__((ext_vector_type(4)));
typedef unsigned u32x4 __attribute__((ext_vector_type(4)));
constexpr int BM = 256, BK = 64, HALF = 128, HTB = HALF * BK * 2  , STAGE_BYTES = 8 * HTB, NXCD = 8, WGM = 8;

__host__ __device__ __forceinline__ int lds_byte(int r, int c) { const int st = (r >> 4) * 2 + (c >> 5), rr = r & 15, cc = c & 31, ob = rr * 64 + cc * 2; return st * 1024 + (ob ^ (((ob >> 9) & 1) << 5)); }
__host__ __device__ __forceinline__ void stage_rc(int b, int& R, int& C) { const int st = b / 1024, sb = b % 1024, swz = sb ^ (((sb >> 9) & 1) << 5); R = (st >> 1) * 16 + swz / 64; C = (st & 1) * 32 + (swz % 64) / 2; }
__host__ __device__ __forceinline__ int perm32(int rho) { const int n = rho >> 4, i = rho & 15; return 8 * (i >> 2) + 4 * n + (i & 3); }

struct Unit { int pm, pn; };
struct Gemm { const bf16_t* A; const bf16_t* Bt; int M, N, K; };

struct StaticOrder {
    int nM, nN, nwg, G, c;
    __host__ __device__ void init(int M, int N, int G_, int c_) { nM = M / BM; nN = N / BM; nwg = nM * nN; G = G_; c = c_; }
    __host__ __device__ bool next(int i, Unit& u) const {
        const long L = (long)i * G + c; if (L >= nwg) return false;
        int wgid = (int)L; { const int q = nwg / NXCD, r = nwg % NXCD, xcd = wgid % NXCD, off = wgid / NXCD; wgid = (xcd < r ? xcd * (q + 1) : r * (q + 1) + (xcd - r) * q) + off; }
        const int nig = WGM * nN, gid = wgid / nig, fm = gid * WGM, gsz = (nM - fm) < WGM ? (nM - fm) : WGM;
        u.pm = fm + ((wgid % nig) % gsz); u.pn = (wgid % nig) / gsz; return true;
    }
    __device__ __forceinline__ void a_ready(const Unit&) const {}
    __device__ __forceinline__ void done(const Unit&) const {}
};

__device__ __forceinline__ unsigned cvt_pk_bf16(float lo, float hi) { unsigned r; asm volatile("v_cvt_pk_bf16_f32 %0, %1, %2" : "=v"(r) : "v"(lo), "v"(hi)); return r; }
__device__ __forceinline__ u32x4 pack8(const f32x4 v0, const f32x4 v1) { u32x4 w; w.x = cvt_pk_bf16(v0[0], v0[1]); w.y = cvt_pk_bf16(v0[2], v0[3]); w.z = cvt_pk_bf16(v1[0], v1[1]); w.w = cvt_pk_bf16(v1[2], v1[3]); return w; }
__device__ __forceinline__ float bf_lo(unsigned w) { return __uint_as_float(w << 16); }
__device__ __forceinline__ float bf_hi(unsigned w) { return __uint_as_float(w & 0xffff0000u); }
constexpr int DMODEL = 1024;
constexpr float RMS_EPS = 1e-6f;
__device__ __forceinline__ float row_rs(const float* ssq, int row) {
    const f32x4* p = (const f32x4*)(ssq + (size_t)row * 16);
    const f32x4 a = p[0], b = p[1], c = p[2], d = p[3];
    const float s = (((a[0] + a[1]) + (a[2] + a[3])) + ((b[0] + b[1]) + (b[2] + b[3]))) + (((c[0] + c[1]) + (c[2] + c[3])) + ((d[0] + d[1]) + (d[2] + d[3])));
    return __builtin_amdgcn_rsqf(s * (1.0f / DMODEL) + RMS_EPS);
}
__device__ __forceinline__ float sumsq8(const f32x4 a, const f32x4 b) { return ((a[0] * a[0] + a[1] * a[1]) + (a[2] * a[2] + a[3] * a[3])) + ((b[0] * b[0] + b[1] * b[1]) + (b[2] * b[2] + b[3] * b[3])); }

struct EpiPlain {
    static constexpr bool PERM = true, AFTER_DRAIN = false;
    bf16_t* O; int ldc;
    __device__ __forceinline__ void operator()(const f32x4 (&acc)[2][2][4][2], const Unit& u, int wr, int wc, int fr, int fq) const {
        const int row0 = u.pm * BM + wr * 64 + fr, col0 = u.pn * BM + wc * 32 + 8 * fq;
#pragma unroll
        for (int ai = 0; ai < 2; ++ai)
#pragma unroll
            for (int m = 0; m < 4; ++m) { bf16_t* rowp = O + (size_t)(row0 + ai * HALF + m * 16) * ldc + col0;
#pragma unroll
                for (int bj = 0; bj < 2; ++bj) *(u32x4*)(rowp + bj * HALF) = pack8(acc[ai][bj][m][0], acc[ai][bj][m][1]); }
    }
};
__device__ __forceinline__ void row_rs8(float (&rs)[8], const float* ssq, int row0, int fq) {
    f32x4 p[8];
#pragma unroll
    for (int i = 0; i < 8; ++i) p[i] = *(const f32x4*)(ssq + (size_t)(row0 + (i >> 2) * HALF + (i & 3) * 16) * 16 + 4 * fq);
#pragma unroll
    for (int i = 0; i < 8; ++i) { float s = (p[i][0] + p[i][1]) + (p[i][2] + p[i][3]); s += __shfl_xor(s, 16); s += __shfl_xor(s, 32); rs[i] = __builtin_amdgcn_rsqf(s * (1.0f / DMODEL) + RMS_EPS); }
}
struct EpiIn {
    static constexpr bool PERM = true, AFTER_DRAIN = false;
    bf16_t* O; int ldc; const float* ssq; const int* pos; float qscale;
    __device__ __forceinline__ void operator()(const f32x4 (&acc)[2][2][4][2], const Unit& u, int wr, int wc, int fr, int fq) const {
        const int row0 = u.pm * BM + wr * 64 + fr, col0 = u.pn * BM + wc * 32 + 8 * fq;
        const bool rope = (u.pn < 4) && !(wc & 1);
        const float sc = (u.pn < 2) ? qscale : 1.f;
        float rs[8]; row_rs8(rs, ssq, row0, fq);
        if (rope) {
            int ps[8];
#pragma unroll
            for (int i = 0; i < 8; ++i) ps[i] = pos[row0 + (i >> 2) * HALF + (i & 3) * 16];
            const bool mine = fq < 2; const float sgn = (fq == 0) ? -1.f : 1.f;
            const float invf[8] = {1.0f, 0.1939227432012558f, 0.03760603070259094f, 0.007292664609849453f, 0.0014142135623842478f, 0.00027424818836152554f, 5.3182957344688475e-05f, 1.0313385246263351e-05f};
#pragma unroll
            for (int ai = 0; ai < 2; ++ai)
#pragma unroll
                for (int m = 0; m < 4; ++m) { const int row = row0 + ai * HALF + m * 16; const float r = rs[ai * 4 + m] * sc; const float pf = (float)ps[ai * 4 + m];
                    bf16_t* rowp = O + (size_t)row * ldc + col0;
                    float c[8], sn[8];
#pragma unroll
                    for (int e = 0; e < 8; ++e) { const float rev = __builtin_amdgcn_fractf((pf * invf[e]) * 0.15915494309189535f); c[e] = mine ? __builtin_amdgcn_cosf(rev) : 1.f; sn[e] = mine ? __builtin_amdgcn_sinf(rev) * sgn : 0.f; }
#pragma unroll
                    for (int bj = 0; bj < 2; ++bj) { f32x4 v0 = acc[ai][bj][m][0] * r, v1 = acc[ai][bj][m][1] * r; f32x4 p0, p1;
#pragma unroll
                        for (int e = 0; e < 4; ++e) { p0[e] = __shfl_xor(v0[e], 16); p1[e] = __shfl_xor(v1[e], 16); }
#pragma unroll
                        for (int e = 0; e < 4; ++e) { v0[e] = v0[e] * c[e] + p0[e] * sn[e]; v1[e] = v1[e] * c[4 + e] + p1[e] * sn[4 + e]; }
                        *(u32x4*)(rowp + bj * HALF) = pack8(v0, v1); } }
        } else {
#pragma unroll
            for (int ai = 0; ai < 2; ++ai)
#pragma unroll
                for (int m = 0; m < 4; ++m) { const int row = row0 + ai * HALF + m * 16; const float r = rs[ai * 4 + m] * sc;
                    bf16_t* rowp = O + (size_t)row * ldc + col0;
#pragma unroll
                    for (int bj = 0; bj < 2; ++bj) *(u32x4*)(rowp + bj * HALF) = pack8(acc[ai][bj][m][0] * r, acc[ai][bj][m][1] * r); }
        }
    }
};
__device__ __forceinline__ void unpack8(const u32x4 w, f32x4& a, f32x4& b) { a = (f32x4){bf_lo(w.x), bf_hi(w.x), bf_lo(w.y), bf_hi(w.y)}; b = (f32x4){bf_lo(w.z), bf_hi(w.z), bf_lo(w.w), bf_hi(w.w)}; }
struct EpiRes {
    static constexpr bool PERM = true, AFTER_DRAIN = false;
    const bf16_t* Rin; bf16_t* XBo; float* ssq;
    __device__ __forceinline__ void operator()(const f32x4 (&acc)[2][2][4][2], const Unit& u, int wr, int wc, int fr, int fq) const {
        const int row0 = u.pm * BM + wr * 64 + fr, col0 = u.pn * BM + wc * 32 + 8 * fq;
        u32x4 rv[8][2];
#pragma unroll
        for (int i = 0; i < 8; ++i)
#pragma unroll
            for (int bj = 0; bj < 2; ++bj) rv[i][bj] = *(const u32x4*)(Rin + (size_t)(row0 + (i >> 2) * HALF + (i & 3) * 16) * DMODEL + col0 + bj * HALF);
#pragma unroll
        for (int ai = 0; ai < 2; ++ai)
#pragma unroll
            for (int m = 0; m < 4; ++m) { const int row = row0 + ai * HALF + m * 16; float part = 0.f;
#pragma unroll
                for (int bj = 0; bj < 2; ++bj) { f32x4 r0, r1; unpack8(rv[ai * 4 + m][bj], r0, r1);
                    const f32x4 h0 = r0 + acc[ai][bj][m][0], h1 = r1 + acc[ai][bj][m][1]; part += sumsq8(h0, h1);
                    *(u32x4*)(XBo + (size_t)row * DMODEL + col0 + bj * HALF) = pack8(h0, h1); }
                part += __shfl_xor(part, 16); part += __shfl_xor(part, 32);
                if (fq == 0) ssq[(size_t)row * 16 + u.pn * 4 + wc] = part; }
    }
};
struct EpiMlpIn {
    static constexpr bool PERM = true, AFTER_DRAIN = false;
    bf16_t* O; int ldc; const float* ssq;
    __device__ __forceinline__ void operator()(const f32x4 (&acc)[2][2][4][2], const Unit& u, int wr, int wc, int fr, int fq) const {
        const int row0 = u.pm * BM + wr * 64 + fr, col0 = u.pn * BM + wc * 32 + 8 * fq;
        float rs[8]; row_rs8(rs, ssq, row0, fq);
#pragma unroll
        for (int ai = 0; ai < 2; ++ai)
#pragma unroll
            for (int m = 0; m < 4; ++m) { const int row = row0 + ai * HALF + m * 16; const float r = rs[ai * 4 + m];
                bf16_t* rowp = O + (size_t)row * ldc + col0;
#pragma unroll
                for (int bj = 0; bj < 2; ++bj) { f32x4 v0 = acc[ai][bj][m][0] * r, v1 = acc[ai][bj][m][1] * r;
#pragma unroll
                    for (int e = 0; e < 4; ++e) { const float a = fmaxf(v0[e], 0.f), b = fmaxf(v1[e], 0.f); v0[e] = a * a; v1[e] = b * b; }
                    *(u32x4*)(rowp + bj * HALF) = pack8(v0, v1); } }
    }
};
struct EpiPle {
    static constexpr bool PERM = true, AFTER_DRAIN = false;
    const bf16_t* Rin; bf16_t* XBo; const float* ssq_in; float* ssq_out; const bf16_t* PP;
    __device__ __forceinline__ void operator()(const f32x4 (&acc)[2][2][4][2], const Unit& u, int wr, int wc, int fr, int fq) const {
        const int row0 = u.pm * BM + wr * 64 + fr, col0 = u.pn * BM + wc * 32 + 8 * fq;
#pragma unroll
        for (int ai = 0; ai < 2; ++ai)
#pragma unroll
          for (int mh = 0; mh < 2; ++mh) {
            u32x4 rv[2][2], pw[2][2]; f32x4 p[2];
#pragma unroll
            for (int mm = 0; mm < 2; ++mm) { const int rowl = row0 + ai * HALF + (2 * mh + mm) * 16; p[mm] = *(const f32x4*)(ssq_in + (size_t)rowl * 16 + 4 * fq);
#pragma unroll
                for (int bj = 0; bj < 2; ++bj) { const size_t off = (size_t)rowl * DMODEL + col0 + bj * HALF; rv[mm][bj] = *(const u32x4*)(Rin + off); pw[mm][bj] = *(const u32x4*)(PP + off); } }
#pragma unroll
            for (int mm = 0; mm < 2; ++mm) { const int m = 2 * mh + mm; const int row = row0 + ai * HALF + m * 16; float part = 0.f;
                float sr = (p[mm][0] + p[mm][1]) + (p[mm][2] + p[mm][3]); sr += __shfl_xor(sr, 16); sr += __shfl_xor(sr, 32); const float r = __builtin_amdgcn_rsqf(sr * (1.0f / DMODEL) + RMS_EPS);
#pragma unroll
                for (int bj = 0; bj < 2; ++bj) { f32x4 r0, r1, p0, p1; unpack8(rv[mm][bj], r0, r1); unpack8(pw[mm][bj], p0, p1);
                    f32x4 g0 = acc[ai][bj][m][0] * r, g1 = acc[ai][bj][m][1] * r;
#pragma unroll
                    for (int e = 0; e < 4; ++e) { g0[e] = __builtin_amdgcn_rcpf(1.f + __builtin_amdgcn_exp2f(-1.4426950408889634f * g0[e])); g1[e] = __builtin_amdgcn_rcpf(1.f + __builtin_amdgcn_exp2f(-1.4426950408889634f * g1[e])); }
                    const f32x4 h0 = r0 + g0 * p0, h1 = r1 + g1 * p1; part += sumsq8(h0, h1);
                    *(u32x4*)(XBo + (size_t)row * DMODEL + col0 + bj * HALF) = pack8(h0, h1); }
                part += __shfl_xor(part, 16); part += __shfl_xor(part, 32);
                if (fq == 0) ssq_out[(size_t)row * 16 + u.pn * 4 + wc] = part; }
            asm volatile("" ::: "memory"); }
    }
};

template <class Epi, class Sched, bool ALIGN_EPI = false, bool SP2 = false>
__device__ __forceinline__ void gemm_phase(PG8_LAS unsigned char* lds, const Gemm g, const Sched& S, const Epi& E) {
    const int tid = tid_opaque(), wid = __builtin_amdgcn_readfirstlane(tid >> 6), lane = tid & 63, wr = wid >> 2, wc = wid & 3, fr = lane & 15, fq = lane >> 4;
    const int K = g.K, nt = K / BK;
    unsigned voffA[2], voffB[2];
#pragma unroll
    for (int i = 0; i < 2; ++i) { int R, C; stage_rc(tid * 16 + i * 8192, R, C); const int Rb = Epi::PERM ? ((R & ~31) + perm32(R & 31)) : R;
        voffA[i] = (unsigned)(R * K + C) * 2u; voffB[i] = (unsigned)(Rb * K + C) * 2u; }
    const size_t kstep = (size_t)(BK * 2);
    const size_t hstep = (size_t)HALF * K * 2;
    const size_t tstep = 2 * hstep;
    const unsigned ldsw = (unsigned)wid * 1024u;
    const int aoff = lds_byte(wr * 64 + fr, fq * 8), boff = lds_byte(wc * 32 + fr, fq * 8);
#define PG8_SA(b, h) (((b) * 2 + (h)) * HTB)
#define PG8_SB(b, h) ((4 + (b) * 2 + (h)) * HTB)
#define PG8_STAGE(bufoff, gbase, voff) do { _Pragma("unroll") for (int _i = 0; _i < 2; ++_i) \
        __builtin_amdgcn_global_load_lds((const unsigned*)((const char*)(gbase) + (voff)[_i]), (PG8_LAS unsigned*)(lds + (bufoff) + ldsw + _i * 8192), 16, 0, 0); } while (0)
#define PG8_LDA(dst, b, h) do { _Pragma("unroll") for (int m = 0; m < 4; ++m) _Pragma("unroll") for (int k = 0; k < 2; ++k) dst[m][k] = *(const PG8_LAS bf16x8*)(lds + PG8_SA(b, h) + aoff + m * 2048 + k * 1024); } while (0)
#define PG8_LDB(dst, b, h) do { _Pragma("unroll") for (int n = 0; n < 2; ++n) _Pragma("unroll") for (int k = 0; k < 2; ++k) dst[n][k] = *(const PG8_LAS bf16x8*)(lds + PG8_SB(b, h) + boff + n * 2048 + k * 1024); } while (0)
#define PG8_MMA(ai, bj, At, Bt) do { __builtin_amdgcn_s_setprio(1); _Pragma("unroll") for (int m = 0; m < 4; ++m) _Pragma("unroll") for (int n = 0; n < 2; ++n) _Pragma("unroll") for (int k = 0; k < 2; ++k) \
        acc[ai][bj][m][n] = __builtin_amdgcn_mfma_f32_16x16x32_bf16(Bt[n][k], At[m][k], acc[ai][bj][m][n], 0, 0, 0); __builtin_amdgcn_s_setprio(0); } while (0)
#define PG8_WAIT_V(n) asm volatile("s_waitcnt vmcnt(" #n ")" ::: "memory")
#define PG8_WAIT_L(n) asm volatile("s_waitcnt lgkmcnt(" #n ")" ::: "memory")
#define PG8_BAR __builtin_amdgcn_s_barrier()
#define PG8_SCHED __builtin_amdgcn_sched_barrier(0)
    Unit cur, nxt; int ui = 0;
    if (!S.next(0, cur)) return;
    f32x4 acc[2][2][4][2];
#pragma unroll
    for (int a = 0; a < 2; ++a)
#pragma unroll
        for (int b = 0; b < 2; ++b)
#pragma unroll
            for (int m = 0; m < 4; ++m)
#pragma unroll
                for (int n = 0; n < 2; ++n) acc[a][b][m][n] = (f32x4){0.f, 0.f, 0.f, 0.f};
    bf16x8 At[4][2], B0[2][2], B1[2][2];
    const char* cA = (const char*)g.A + (size_t)cur.pm * tstep; const char* cB = (const char*)g.Bt + (size_t)cur.pn * tstep;
    S.a_ready(cur);
    if constexpr (SP2) {
        PG8_STAGE(PG8_SB(0, 0), cB, voffB); PG8_STAGE(PG8_SB(0, 1), cB + hstep, voffB); PG8_STAGE(PG8_SA(0, 0), cA, voffA); PG8_STAGE(PG8_SA(0, 1), cA + hstep, voffA);
        if (wr == 1) PG8_BAR;
        PG8_WAIT_V(2); PG8_BAR;
        PG8_STAGE(PG8_SB(1, 0), cB + kstep, voffB); PG8_STAGE(PG8_SA(1, 0), cA + kstep, voffA); PG8_STAGE(PG8_SB(1, 1), cB + hstep + kstep, voffB);
        PG8_WAIT_V(6); PG8_BAR;
    } else {
        PG8_STAGE(PG8_SB(0, 0), cB, voffB); PG8_STAGE(PG8_SA(0, 0), cA, voffA); PG8_STAGE(PG8_SB(0, 1), cB + hstep, voffB); PG8_STAGE(PG8_SA(0, 1), cA + hstep, voffA);
        if (wr == 1) PG8_BAR;
        PG8_WAIT_V(4); PG8_BAR;
        PG8_STAGE(PG8_SB(1, 0), cB + kstep, voffB); PG8_STAGE(PG8_SA(1, 0), cA + kstep, voffA); PG8_STAGE(PG8_SB(1, 1), cB + hstep + kstep, voffB);
        PG8_WAIT_V(6); PG8_BAR;
    }
    for (;;) {
        const bool has_next = S.next(ui + 1, nxt);
        const char* nA = has_next ? (const char*)g.A + (size_t)nxt.pm * tstep : cA; const char* nB = has_next ? (const char*)g.Bt + (size_t)nxt.pn * tstep : cB;
        for (int t = 0; t < nt; t += 2) {
            const bool last = (t == nt - 2);
            const char* a1 = cA + (size_t)(t + 1) * kstep;
            const char* a2 = last ? nA : cA + (size_t)(t + 2) * kstep; const char* b2 = last ? nB : cB + (size_t)(t + 2) * kstep;
            const char* a3 = a2 + kstep; const char* b3 = b2 + kstep;
            if (last && has_next) S.a_ready(nxt);
            if constexpr (SP2) {
            PG8_LDB(B0, 0, 0); PG8_LDB(B1, 0, 1); PG8_SCHED; PG8_LDA(At, 0, 0); PG8_STAGE(PG8_SA(1, 1), a1 + hstep, voffA);
            PG8_WAIT_V(8); PG8_WAIT_L(0); PG8_BAR; PG8_MMA(0, 0, At, B0); PG8_MMA(0, 1, At, B1); PG8_BAR; PG8_SCHED;
            PG8_LDA(At, 0, 1); PG8_STAGE(PG8_SB(0, 0), b2, voffB); PG8_STAGE(PG8_SB(0, 1), b2 + hstep, voffB); PG8_STAGE(PG8_SA(0, 0), a2, voffA);
            PG8_WAIT_V(8); PG8_WAIT_L(0); PG8_BAR; PG8_MMA(1, 0, At, B0); PG8_MMA(1, 1, At, B1); PG8_BAR; PG8_SCHED;
            PG8_LDB(B0, 1, 0); PG8_LDB(B1, 1, 1); PG8_SCHED; PG8_LDA(At, 1, 0); PG8_STAGE(PG8_SA(0, 1), a2 + hstep, voffA);
            PG8_WAIT_V(8); PG8_WAIT_L(0); PG8_BAR; PG8_MMA(0, 0, At, B0); PG8_MMA(0, 1, At, B1); PG8_BAR; PG8_SCHED;
            PG8_LDA(At, 1, 1); PG8_STAGE(PG8_SB(1, 0), b3, voffB); PG8_STAGE(PG8_SB(1, 1), b3 + hstep, voffB); PG8_STAGE(PG8_SA(1, 0), a3, voffA);
            PG8_WAIT_V(8); PG8_WAIT_L(0); PG8_BAR; PG8_MMA(1, 0, At, B0); PG8_MMA(1, 1, At, B1); PG8_BAR; PG8_SCHED;
            } else {
            PG8_LDB(B0, 0, 0); PG8_SCHED; PG8_LDA(At, 0, 0); PG8_STAGE(PG8_SA(1, 1), a1 + hstep, voffA);
            PG8_WAIT_L(8); PG8_BAR; PG8_WAIT_L(0); PG8_MMA(0, 0, At, B0); PG8_BAR; PG8_SCHED;
            PG8_LDB(B1, 0, 1); PG8_STAGE(PG8_SB(0, 0), b2, voffB);
            PG8_BAR; PG8_WAIT_L(0); PG8_MMA(0, 1, At, B1); PG8_BAR;
            PG8_LDA(At, 0, 1); PG8_STAGE(PG8_SA(0, 0), a2, voffA);
            PG8_BAR; PG8_WAIT_L(0); PG8_MMA(1, 0, At, B0); PG8_BAR; PG8_SCHED;
            PG8_STAGE(PG8_SB(0, 1), b2 + hstep, voffB);
            PG8_WAIT_V(6); PG8_BAR; PG8_MMA(1, 1, At, B1); PG8_BAR;
            PG8_LDB(B0, 1, 0); PG8_SCHED; PG8_LDA(At, 1, 0); PG8_STAGE(PG8_SA(0, 1), a2 + hstep, voffA);
            PG8_WAIT_L(8); PG8_BAR; PG8_WAIT_L(0); PG8_MMA(0, 0, At, B0); PG8_BAR; PG8_SCHED;
            PG8_LDB(B1, 1, 1); PG8_STAGE(PG8_SB(1, 0), b3, voffB);
            PG8_BAR; PG8_WAIT_L(0); PG8_MMA(0, 1, At, B1); PG8_BAR;
            PG8_LDA(At, 1, 1); PG8_STAGE(PG8_SA(1, 0), a3, voffA);
            PG8_BAR; PG8_WAIT_L(0); PG8_MMA(1, 0, At, B0); PG8_BAR; PG8_SCHED;
            PG8_STAGE(PG8_SB(1, 1), b3 + hstep, voffB);
            PG8_WAIT_V(6); PG8_BAR; PG8_MMA(1, 1, At, B1); PG8_BAR;
            }
        }
        if constexpr (ALIGN_EPI) { if (wr == 0) PG8_BAR; }
        if constexpr (!Epi::AFTER_DRAIN) { const int t2 = tid_opaque(), w2 = __builtin_amdgcn_readfirstlane(t2 >> 6), l2 = t2 & 63;
            E(acc, cur, w2 >> 2, w2 & 3, l2 & 15, l2 >> 4); S.done(cur); }
        if (!has_next) break;
#pragma unroll
        for (int a = 0; a < 2; ++a)
#pragma unroll
            for (int b = 0; b < 2; ++b)
#pragma unroll
                for (int m = 0; m < 4; ++m)
#pragma unroll
                    for (int n = 0; n < 2; ++n) acc[a][b][m][n] = (f32x4){0.f, 0.f, 0.f, 0.f};
        cur = nxt; cA = nA; cB = nB; ++ui;
        if constexpr (ALIGN_EPI) { if (wr == 1) PG8_BAR; }
    }
    PG8_WAIT_V(0);
    if constexpr (!ALIGN_EPI) { if (wr == 0) PG8_BAR; }
    PG8_BAR;
    if constexpr (Epi::AFTER_DRAIN) { E.fused(acc, cur, wr, wc, fr, fq, lds, wid, lane); S.done(cur); }
#undef PG8_SA
#undef PG8_SB
#undef PG8_STAGE
#undef PG8_LDA
#undef PG8_LDB
#undef PG8_MMA
#undef PG8_WAIT_V
#undef PG8_WAIT_L
#undef PG8_BAR
#undef PG8_SCHED
}
}
#ifndef PG8_SP2
#define PG8_SP2 true
#endif
#include <hip/hip_bf16.h>
#include <cmath>
namespace attn_body {
using bf16=__hip_bfloat16;
using bf16x8=__attribute__((ext_vector_type(8)))short;
using s16x4=__attribute__((ext_vector_type(4)))short;
using f32x16=__attribute__((ext_vector_type(16)))float;
using u32x4=__attribute__((ext_vector_type(4)))unsigned;
constexpr int D=64,PQ=2560,PO=1024;
constexpr int NW=8,QBLK=32,QB=QBLK*NW,KVBLK=64;
constexpr int ATTN_UNIT_ROWS=QB;
__device__ __forceinline__ int crow(int r,int hi){return (r&3)+8*(r>>2)+4*hi;}
#define SBAR() __builtin_amdgcn_sched_barrier(0)
__device__ __forceinline__ void cmask(f32x16&p0,f32x16&p1,int jb,int qrel,int hi){
  const float NEG=-INFINITY; int kb=64*jb+4*hi;
  #pragma unroll
  for(int r=0;r<16;++r){int kv=kb+(r&3)+8*(r>>2); if(kv>qrel)p0[r]=NEG; if(kv+32>qrel)p1[r]=NEG;}
}

constexpr int NSLOT=3, SLOTB=8192;
constexpr int LDS_K=0, LDS_V=NSLOT*SLOTB, LDS_WS=2*NSLOT*SLOTB, LDS_OST=LDS_WS+NW*64*4, LDS_BYTES=LDS_OST+NW*4096;
constexpr float C2=0.125f*1.4426950408889634f;
__device__ __forceinline__ void glds16(const void*gsrc,unsigned lds_dst){unsigned keep;
  asm volatile("s_mov_b32 %0, m0\n\ts_mov_b32 m0, %2\n\ts_nop 0\n\tglobal_load_lds_dwordx4 %1, off\n\ts_mov_b32 m0, %0":"=&s"(keep):"v"(gsrc),"s"(lds_dst):"memory");}
__device__ __forceinline__ float max3f(float a,float b,float c){float r;asm("v_max3_f32 %0, %1, %2, %3":"=v"(r):"v"(a),"v"(b),"v"(c));return r;}
__device__ __forceinline__ float max2f(float a,float b){float r;asm("v_max_f32_e32 %0, %1, %2":"=v"(r):"v"(a),"v"(b));return r;}
__device__ __forceinline__ float fadd_s(float a,float b){float r;asm("v_add_f32_e32 %0, %1, %2":"=v"(r):"v"(a),"v"(b));return r;}
__device__ __forceinline__ float fsub_s(float a,float b){float r;asm("v_sub_f32_e32 %0, %1, %2":"=v"(r):"v"(a),"v"(b));return r;}
typedef float f32x2_t __attribute__((ext_vector_type(2))); typedef __bf16 bf16x2_t __attribute__((ext_vector_type(2)));
__device__ __forceinline__ unsigned cvtpk_s(float lo,float hi){f32x2_t v={lo,hi};bf16x2_t b=__builtin_convertvector(v,bf16x2_t);return __builtin_bit_cast(unsigned,b);}
#define WAIT_BAR(N) asm volatile("s_waitcnt vmcnt(" #N ") lgkmcnt(0)\n\ts_barrier":::"memory")

__device__ __forceinline__ void qkt(f32x16&p0,f32x16&p1,const char*Kslot,const bf16x8*qr,const f32x16&negm,int r32,int hi){
  const char*kb=Kslot+hi*1024+r32*16;
  #pragma unroll
  for(int d0=0;d0<4;++d0){
    const bf16x8 b0=*reinterpret_cast<const bf16x8*>(kb+d0*2048);
    const bf16x8 b1=*reinterpret_cast<const bf16x8*>(kb+d0*2048+512);
    if(d0==0){p0=__builtin_amdgcn_mfma_f32_32x32x16_bf16(b0,qr[0],negm,0,0,0);p1=__builtin_amdgcn_mfma_f32_32x32x16_bf16(b1,qr[0],negm,0,0,0);}
    else{p0=__builtin_amdgcn_mfma_f32_32x32x16_bf16(b0,qr[d0],p0,0,0,0);p1=__builtin_amdgcn_mfma_f32_32x32x16_bf16(b1,qr[d0],p1,0,0,0);}}
}
typedef __attribute__((address_space(3))) const char* lds_cptr;
typedef short v4i16_t __attribute__((ext_vector_type(4)));
__device__ __forceinline__ void kload8(bf16x8*kf,lds_cptr kp){
  kf[0]=*(const __attribute__((address_space(3))) bf16x8*)(kp);      kf[1]=*(const __attribute__((address_space(3))) bf16x8*)(kp+512);
  kf[2]=*(const __attribute__((address_space(3))) bf16x8*)(kp+2048); kf[3]=*(const __attribute__((address_space(3))) bf16x8*)(kp+2560);
  kf[4]=*(const __attribute__((address_space(3))) bf16x8*)(kp+4096); kf[5]=*(const __attribute__((address_space(3))) bf16x8*)(kp+4608);
  kf[6]=*(const __attribute__((address_space(3))) bf16x8*)(kp+6144); kf[7]=*(const __attribute__((address_space(3))) bf16x8*)(kp+6656);
}
__device__ __forceinline__ void kload2(bf16x8*kf,lds_cptr kp,int j){ kf[2*j]=*(const __attribute__((address_space(3))) bf16x8*)(kp+j*2048); kf[2*j+1]=*(const __attribute__((address_space(3))) bf16x8*)(kp+j*2048+512); }
__device__ __forceinline__ s16x4 vtr(lds_cptr p){ return __builtin_bit_cast(s16x4,__builtin_amdgcn_ds_read_tr16_b64_v4i16((__attribute__((address_space(3))) v4i16_t*)p)); }
__device__ __forceinline__ float rowmax(const f32x16&p0,const f32x16&p1){
  float a=max3f(p0[0],p0[1],p1[0]),b=max3f(p0[2],p0[3],p1[1]);a=max3f(a,p1[2],p1[3]);
  #pragma unroll
  for(int r=4;r<16;r+=4){a=max3f(a,p0[r],p0[r+1]);b=max3f(b,p0[r+2],p0[r+3]);a=max3f(a,p1[r],p1[r+1]);b=max3f(b,p1[r+2],p1[r+3]);}
  const float m=max2f(a,b);
  auto rr=__builtin_amdgcn_permlane32_swap(__float_as_uint(m),__float_as_uint(m),false,false);
  return max2f(__uint_as_float(rr[0]),__uint_as_float(rr[1]));
}
__device__ __forceinline__ void pv(f32x16*o,int vb,bf16x8 pa0,bf16x8 pa1,bf16x8 pa2,bf16x8 pa3){
  #pragma unroll
  for(int d0=0;d0<2;++d0){s16x4 lo[4],hi[4];
    #pragma unroll
    for(int ks=0;ks<4;++ks){
      asm volatile("ds_read_b64_tr_b16 %0,%1 offset:%c2":"=&v"(lo[ks]):"v"(vb),"i"(d0*4096+ks*1024):"memory");
      asm volatile("ds_read_b64_tr_b16 %0,%1 offset:%c2":"=&v"(hi[ks]):"v"(vb),"i"(d0*4096+ks*1024+512):"memory");}
    asm volatile("s_waitcnt lgkmcnt(0)":::"memory");SBAR();
    #define PK(k) (bf16x8){lo[k][0],lo[k][1],lo[k][2],lo[k][3],hi[k][0],hi[k][1],hi[k][2],hi[k][3]}
    o[d0]=__builtin_amdgcn_mfma_f32_32x32x16_bf16(pa0,PK(0),o[d0],0,0,0);
    o[d0]=__builtin_amdgcn_mfma_f32_32x32x16_bf16(pa1,PK(1),o[d0],0,0,0);
    o[d0]=__builtin_amdgcn_mfma_f32_32x32x16_bf16(pa2,PK(2),o[d0],0,0,0);
    o[d0]=__builtin_amdgcn_mfma_f32_32x32x16_bf16(pa3,PK(3),o[d0],0,0,0);
    #undef PK
  }
}

#ifndef ATTN_STORE16
#define ATTN_STORE16(p,v) (*(u32x4*)(p)=(v))
#endif
template<int THRL> __device__ __forceinline__ void attn_unit(int qb,const bf16*Qh,const bf16*__restrict__ Kh,const bf16*__restrict__ Vh,bf16*Oh,char*shm){
  const int tid=tid_opaque(),lane=tid&63,r32=lane&31,hi=lane>>5; const int wid=__builtin_amdgcn_readfirstlane(tid>>6);
  const int q0=qb*QB;
  const bf16*Qw=Qh+(long)(q0+wid*QBLK)*PQ;
  const unsigned lds0=(unsigned)(uintptr_t)shm;
  float*wsf=(float*)(shm+LDS_WS)+wid*64;
  const bf16*ksrc=Kh+(long)lane*PQ+wid*8;
  const bf16*vsrc=Vh+(long)(16*(wid&3)+(lane>>2))*PQ+(wid>>2)*32+(lane&3)*8;
  const unsigned kdst=lds0+LDS_K+wid*1024, vdst=lds0+LDS_V+wid*1024;
  #define DMA_K(t,slot) glds16(ksrc+(long)(t)*KVBLK*PQ,(unsigned)__builtin_amdgcn_readfirstlane(kdst+(slot)))
  #define DMA_V(t,slot) glds16(vsrc+(long)(t)*KVBLK*PQ,(unsigned)__builtin_amdgcn_readfirstlane(vdst+(slot)))
  const int vb0=(int)(lds0+LDS_V)+((lane>>4)&1)*32+(lane&3)*8+(4*hi+((lane&15)>>2))*64;
  const char*Kbase=shm+LDS_K; bf16x8 kf[8];
  const lds_cptr shm3=(lds_cptr)shm; const lds_cptr kp0=shm3+LDS_K+hi*1024+r32*16; const lds_cptr vp0=shm3+LDS_V+((lane>>4)&1)*32+(lane&3)*8+(4*hi+((lane&15)>>2))*64;
  const int NT=(q0+QB)/KVBLK;
  DMA_K(0,0);DMA_V(0,0);DMA_K(1,SLOTB);
  bf16x8 qr[4];
  #pragma unroll
  for(int d0=0;d0<4;++d0)qr[d0]=*reinterpret_cast<const bf16x8*>(&Qw[(long)r32*PQ+d0*16+hi*8]);
  float mhat=0.f,l_reg=0.f;f32x16 o[2];o[0]=f32x16{};o[1]=f32x16{};f32x16 negm=f32x16{};asm volatile("":"+v"(negm));
  const int qrel=wid*QBLK+r32;
  #define CMASK(P0,P1,t) do{int jb_=(t)-(NT-4); if(jb_>=0)cmask(P0,P1,jb_,qrel,hi);}while(0)
  bool resc=false;
  #define START(P0,P1) do{ const float rm=rowmax(P0,P1); resc=false; \
    { const float dl=rm; mhat=fadd_s(mhat,dl); \
      _Pragma("unroll") for(int r=0;r<16;++r){P0[r]=fsub_s(P0[r],dl);P1[r]=fsub_s(P1[r],dl);} \
      _Pragma("unroll") for(int r=0;r<16;++r)negm[r]=-mhat; asm volatile("":"+v"(negm)); } \
    _Pragma("unroll") for(int r=0;r<16;++r)P0[r]=__builtin_amdgcn_exp2f(P0[r]); }while(0)
  #define RESC() do{ if(resc){ asm volatile("s_waitcnt lgkmcnt(0)":::"memory"); \
      _Pragma("unroll") for(int d_=0;d_<2;++d_) _Pragma("unroll") for(int r=0;r<16;++r)o[d_][r]*=wsf[crow(r,hi)]; } }while(0)
  f32x16 pA0,pA1,pB0,pB1;
  int sl_prev=0,sl_cur=0,sl_next=SLOTB;
  #define ROT() do{sl_prev=sl_cur;sl_cur=sl_next;sl_next=(sl_next==(NSLOT-1)*SLOTB)?0:sl_next+SLOTB;}while(0)
  DMA_K(2,2*SLOTB);
  WAIT_BAR(3);
  qkt(pA0,pA1,Kbase,qr,negm,r32,hi);asm volatile("s_nop 15\n\ts_nop 7":"+v"(pA0),"+v"(pA1));CMASK(pA0,pA1,0);
  START(pA0,pA1);
  _Pragma("unroll") for(int r=0;r<16;++r)pA1[r]=__builtin_amdgcn_exp2f(pA1[r]);
  WAIT_BAR(0);
  DMA_K(3,0);DMA_V(1,SLOTB);
  ROT();
  kload8(kf,kp0+sl_cur);
  WAIT_BAR(2);
  s16x4 vlo[8],vhi[8]; u32x4 pw0,pw1,pw2,pw3;
  #define PKW(P,B) cvtpk_s(P[B],P[B+1])
  #define PAF(k) __builtin_bit_cast(bf16x8,pw##k)
  #define VFR(i) (bf16x8){vlo[i][0],vlo[i][1],vlo[i][2],vlo[i][3],vhi[i][0],vhi[i][1],vhi[i][2],vhi[i][3]}
  #define PIN(x) asm volatile("":"+v"(x))
  #define MX3(a,b,c) __builtin_fmaxf(__builtin_fmaxf((a),(b)),(c))
  #define GAPA(MF,A0,A1,A2,A3,W0,W1,PW) do{ MF; sacc+=A0; sacc+=A1; sacc+=A2; sacc+=A3; PIN(sacc); W0; W1; PIN(PW); SBAR(); }while(0)
  #define EX(v) __builtin_amdgcn_exp2f(v)
  #define GAPB(MF,X,B) do{ MF; X[B]=EX(X[B]); X[B+1]=EX(X[B+1]); X[B+2]=EX(X[B+2]); X[B+3]=EX(X[B+3]); PIN(X); SBAR(); }while(0)
  #define VRD(i) do{ vlo[i]=vtr(vp_+(((i)>>2)*4096+((i)&3)*1024)); vhi[i]=vtr(vp_+(((i)>>2)*4096+((i)&3)*1024+512)); }while(0)
  #define KRD(G,j) do{ if(G){ kload2(kf,kp0+sl_next,j); SBAR(); } }while(0)
  #define STEP(C0,C1,P0,P1,t,GK,GV,GL) do{ SBAR(); \
    const lds_cptr vp_=vp0+sl_prev; \
    VRD(0); SBAR(); float sacc=(P0[0]+P0[1]); \
    GAPA(C0=__builtin_amdgcn_mfma_f32_32x32x16_bf16(kf[0],qr[0],negm,0,0,0), P0[2],P0[3],P0[4],P0[5],     pw0[0]=PKW(P0,0), pw0[1]=PKW(P0,2), pw0); \
    VRD(4); SBAR(); GAPA(C1=__builtin_amdgcn_mfma_f32_32x32x16_bf16(kf[1],qr[0],negm,0,0,0), P0[6],P0[7],P0[8],P0[9],     pw0[2]=PKW(P0,4), pw0[3]=PKW(P0,6), pw0); \
    VRD(1); SBAR(); GAPA(C0=__builtin_amdgcn_mfma_f32_32x32x16_bf16(kf[2],qr[1],C0,0,0,0),   P0[10],P0[11],P0[12],P0[13], pw1[0]=PKW(P0,8), pw1[1]=PKW(P0,10), pw1); \
    VRD(5); SBAR(); GAPA(C1=__builtin_amdgcn_mfma_f32_32x32x16_bf16(kf[3],qr[1],C1,0,0,0),   P0[14],P0[15],P1[0],P1[1],   pw1[2]=PKW(P0,12),pw1[3]=PKW(P0,14), pw1); \
    VRD(2); SBAR(); GAPA(C0=__builtin_amdgcn_mfma_f32_32x32x16_bf16(kf[4],qr[2],C0,0,0,0),   P1[2],P1[3],P1[4],P1[5],     pw2[0]=PKW(P1,0), pw2[1]=PKW(P1,2), pw2); \
    VRD(6); SBAR(); GAPA(C1=__builtin_amdgcn_mfma_f32_32x32x16_bf16(kf[5],qr[2],C1,0,0,0),   P1[6],P1[7],P1[8],P1[9],     pw2[2]=PKW(P1,4), pw2[3]=PKW(P1,6), pw2); \
    VRD(3); SBAR(); GAPA(C0=__builtin_amdgcn_mfma_f32_32x32x16_bf16(kf[6],qr[3],C0,0,0,0),   P1[10],P1[11],P1[12],P1[13], pw3[0]=PKW(P1,8), pw3[1]=PKW(P1,10), pw3); \
    VRD(7); SBAR(); GAPA(C1=__builtin_amdgcn_mfma_f32_32x32x16_bf16(kf[7],qr[3],C1,0,0,0),   P1[14],P1[15],0.f,0.f,       pw3[2]=PKW(P1,12),pw3[3]=PKW(P1,14), pw3); \
    l_reg+=sacc; \
    if(GK){DMA_K((t)+3,sl_cur);} if(GV){DMA_V((t)+1,sl_next);} \
    CMASK(C0,C1,t); \
    { float a=MX3(C0[0],C0[1],C1[0]),b=MX3(C0[2],C0[3],C1[1]); a=MX3(a,C1[2],C1[3]); \
      _Pragma("unroll") for(int r=4;r<16;r+=4){a=MX3(a,C0[r],C0[r+1]);b=MX3(b,C0[r+2],C0[r+3]);a=MX3(a,C1[r],C1[r+1]);b=MX3(b,C1[r+2],C1[r+3]);} \
      float rm=__builtin_fmaxf(a,b); { auto rr=__builtin_amdgcn_permlane32_swap(__float_as_uint(rm),__float_as_uint(rm),false,false); rm=__builtin_fmaxf(__uint_as_float(rr[0]),__uint_as_float(rr[1])); } \
      resc=false; \
      if(__builtin_expect(__any(rm>(float)THRL),0)){ const float dl=__builtin_fmaxf(rm,0.f); mhat+=dl; \
        _Pragma("unroll") for(int r=0;r<16;++r){C0[r]-=dl;C1[r]-=dl;} \
        _Pragma("unroll") for(int r=0;r<16;++r)negm[r]=-mhat; asm volatile("":"+v"(negm)); \
        const float f=__builtin_amdgcn_exp2f(-dl); l_reg*=f; if(hi==0)wsf[r32]=f; resc=true; } } \
    SBAR(); \
    GAPB(o[0]=__builtin_amdgcn_mfma_f32_32x32x16_bf16(PAF(0),VFR(0),o[0],0,0,0), C0,0); \
    GAPB(o[1]=__builtin_amdgcn_mfma_f32_32x32x16_bf16(PAF(0),VFR(4),o[1],0,0,0), C0,4); \
    KRD(GL,0); GAPB(o[0]=__builtin_amdgcn_mfma_f32_32x32x16_bf16(PAF(1),VFR(1),o[0],0,0,0), C0,8); \
    KRD(GL,1); GAPB(o[1]=__builtin_amdgcn_mfma_f32_32x32x16_bf16(PAF(1),VFR(5),o[1],0,0,0), C0,12); \
    KRD(GL,2); GAPB(o[0]=__builtin_amdgcn_mfma_f32_32x32x16_bf16(PAF(2),VFR(2),o[0],0,0,0), C1,0); \
    KRD(GL,3); GAPB(o[1]=__builtin_amdgcn_mfma_f32_32x32x16_bf16(PAF(2),VFR(6),o[1],0,0,0), C1,4); \
    GAPB(o[0]=__builtin_amdgcn_mfma_f32_32x32x16_bf16(PAF(3),VFR(3),o[0],0,0,0), C1,8); \
    GAPB(o[1]=__builtin_amdgcn_mfma_f32_32x32x16_bf16(PAF(3),VFR(7),o[1],0,0,0), C1,12); \
    }while(0)
  int t=1;
  #undef CMASK
  #define CMASK(P0,P1,t) do{}while(0)
  for(;t+5<NT;t+=2){
    STEP(pB0,pB1,pA0,pA1,t,true,true,true);     WAIT_BAR(2); RESC(); ROT();
    STEP(pA0,pA1,pB0,pB1,t+1,true,true,true);   WAIT_BAR(2); RESC(); ROT();
  }
  #undef CMASK
  #define CMASK(P0,P1,t) do{int jb_=(t)-(NT-4); if(jb_>=0)cmask(P0,P1,jb_,qrel,hi);}while(0)
  #define ENDW(tt) do{ if((tt)+3<NT){WAIT_BAR(2);} else if((tt)+2<NT){WAIT_BAR(1);} else {WAIT_BAR(0);} }while(0)
  for(;t+1<NT;t+=2){
    STEP(pB0,pB1,pA0,pA1,t,(t+3<NT),(t+1<NT),(t+1<NT));       ENDW(t);   RESC(); ROT();
    STEP(pA0,pA1,pB0,pB1,t+1,(t+4<NT),(t+2<NT),(t+2<NT));     ENDW(t+1); RESC(); ROT();
  }
  STEP(pB0,pB1,pA0,pA1,NT-1,false,false,false); RESC();
  { float sacc=pB0[0]+pB0[1]; _Pragma("unroll") for(int r=2;r<16;++r)sacc+=pB0[r]; _Pragma("unroll") for(int r=0;r<16;++r)sacc+=pB1[r]; l_reg+=sacc;
    pw0=(u32x4){PKW(pB0,0),PKW(pB0,2),PKW(pB0,4),PKW(pB0,6)};pw1=(u32x4){PKW(pB0,8),PKW(pB0,10),PKW(pB0,12),PKW(pB0,14)};pw2=(u32x4){PKW(pB1,0),PKW(pB1,2),PKW(pB1,4),PKW(pB1,6)};pw3=(u32x4){PKW(pB1,8),PKW(pB1,10),PKW(pB1,12),PKW(pB1,14)};
    SBAR(); pv(o,vb0+sl_cur,PAF(0),PAF(1),PAF(2),PAF(3)); }
  #undef PKW
  #undef PAF
  #undef VFR
  #undef PIN
  #undef MX3
  #undef GAPA
  #undef GAPB
  #undef EX
  #undef VRD
  #undef KRD
  #undef STEP
  #undef ENDW
  {auto rr=__builtin_amdgcn_permlane32_swap(__float_as_uint(l_reg),__float_as_uint(l_reg),false,false);l_reg=__uint_as_float(rr[0])+__uint_as_float(rr[1]);}
  if(hi==0)wsf[32+r32]=l_reg;asm volatile("s_waitcnt lgkmcnt(0)":::"memory");
  float rli[16];
  #pragma unroll
  for(int r=0;r<16;++r)rli[r]=__builtin_amdgcn_rcpf(wsf[32+crow(r,hi)]);
  bf16*Ow=Oh+(long)(q0+wid*QBLK)*PO;
  { bf16*stg=(bf16*)(shm+LDS_OST)+wid*2048;
    #pragma unroll
    for(int r=0;r<16;++r){const int orow=crow(r,hi);
      #pragma unroll
      for(int d0=0;d0<2;++d0)stg[orow*64+d0*32+r32]=__float2bfloat16(o[d0][r]*rli[r]);}
    asm volatile("s_waitcnt lgkmcnt(0)":::"memory");
    #pragma unroll
    for(int i=0;i<4;++i){const int row=i*8+(lane>>3),ch=lane&7; const u32x4 v=*(const u32x4*)(stg+row*64+ch*8); ATTN_STORE16(Ow+(long)row*PO+ch*8,v);} }
  asm volatile("s_waitcnt lgkmcnt(0)\n\ts_barrier":::"memory");
  #undef DMA_K
  #undef DMA_V
  #undef CMASK
  #undef START
  #undef RESC
  #undef ROT
}
constexpr int ATTN_LDS_BYTES=LDS_BYTES;
#undef SBAR
#undef WAIT_BAR
}
namespace attn2 {
using namespace attn_body;
constexpr int KSLOT=8192, VSLOT=16384;
constexpr int L_K=0, L_V=3*KSLOT, L_WS=L_V+3*VSLOT, L_Q=L_WS+NW*64*4, L_END=L_Q+NW*4096;
#define SBAR() __builtin_amdgcn_sched_barrier(0)
#define WAIT_BAR(N) asm volatile("s_waitcnt vmcnt(" #N ") lgkmcnt(0)\n\ts_barrier":::"memory")
__device__ __forceinline__ void pv4(f32x16*o,int vb,bf16x8 pa0,bf16x8 pa1,bf16x8 pa2,bf16x8 pa3){
  #pragma unroll
  for(int d0=0;d0<4;++d0){s16x4 lo[4],hi[4];
    #pragma unroll
    for(int ks=0;ks<4;++ks){
      asm volatile("ds_read_b64_tr_b16 %0,%1 offset:%c2":"=&v"(lo[ks]):"v"(vb),"i"(d0*4096+ks*1024):"memory");
      asm volatile("ds_read_b64_tr_b16 %0,%1 offset:%c2":"=&v"(hi[ks]):"v"(vb),"i"(d0*4096+ks*1024+512):"memory");}
    asm volatile("s_waitcnt lgkmcnt(0)":::"memory");SBAR();
    #define PK(k) (bf16x8){lo[k][0],lo[k][1],lo[k][2],lo[k][3],hi[k][0],hi[k][1],hi[k][2],hi[k][3]}
    o[d0]=__builtin_amdgcn_mfma_f32_32x32x16_bf16(pa0,PK(0),o[d0],0,0,0);
    o[d0]=__builtin_amdgcn_mfma_f32_32x32x16_bf16(pa1,PK(1),o[d0],0,0,0);
    o[d0]=__builtin_amdgcn_mfma_f32_32x32x16_bf16(pa2,PK(2),o[d0],0,0,0);
    o[d0]=__builtin_amdgcn_mfma_f32_32x32x16_bf16(pa3,PK(3),o[d0],0,0,0);
    #undef PK
  }
}
template<int THRL> __device__ __forceinline__ void attn_unit128(int qb,const bf16*Qh,const bf16*__restrict__ Kh,const bf16*__restrict__ Vh,bf16*Oh,char*shm){
  const int tid=tid_opaque(),lane=tid&63,r32=lane&31,hi=lane>>5; const int wid=__builtin_amdgcn_readfirstlane(tid>>6);
  const int q0=qb*QB;
  const bf16*Qw=Qh+(long)(q0+wid*QBLK)*PQ;
  const unsigned lds0=(unsigned)(uintptr_t)shm;
  float*wsf=(float*)(shm+L_WS)+wid*64;
  const bf16*ksrc=Kh+(long)lane*PQ+wid*8;
  const bf16*vsrc=Vh+(long)(16*(wid&3)+(lane>>2))*PQ+(wid>>2)*32+(lane&3)*8;
  const unsigned kdst=lds0+L_K+wid*1024, vdst=lds0+L_V+wid*1024, qdst=lds0+L_Q+wid*4096;
  #define DMA_K(t,slot) glds16(ksrc+(long)(t)*KVBLK*PQ,(unsigned)__builtin_amdgcn_readfirstlane(kdst+(slot)))
  #define DMA_V(t,slot) do{ glds16(vsrc+(long)(t)*KVBLK*PQ,(unsigned)__builtin_amdgcn_readfirstlane(vdst+2*(slot))); glds16(vsrc+(long)(t)*KVBLK*PQ+64,(unsigned)__builtin_amdgcn_readfirstlane(vdst+2*(slot)+8192)); }while(0)
  const int vb0=(int)(lds0+L_V)+((lane>>4)&1)*32+(lane&3)*8+(4*hi+((lane&15)>>2))*64;
  const char*Kbase=shm+L_K; bf16x8 kf[8];
  const lds_cptr shm3=(lds_cptr)shm; const lds_cptr kp0=shm3+L_K+hi*1024+r32*16; const lds_cptr vp0=shm3+L_V+((lane>>4)&1)*32+(lane&3)*8+(4*hi+((lane&15)>>2))*64;
  const lds_cptr qp=shm3+L_Q+wid*4096+lane*16;
  #define QLD(d) (*(const __attribute__((address_space(3))) bf16x8*)(qp+(d)*1024))
  const int NT=(q0+QB)/KVBLK;
  DMA_K(0,0);DMA_V(0,0);DMA_K(1,KSLOT);
  #pragma unroll
  for(int d0=0;d0<4;++d0)glds16(&Qw[(long)r32*PQ+d0*16+hi*8],(unsigned)__builtin_amdgcn_readfirstlane(qdst+d0*1024));
  float mhat=0.f,l_reg=0.f;f32x16 o[4];o[0]=f32x16{};o[1]=f32x16{};o[2]=f32x16{};o[3]=f32x16{};
  const f32x16 zero16=f32x16{};
  const int qrel=wid*QBLK+r32;
  #define CMASK(P0,P1,t) do{int jb_=(t)-(NT-4); if(jb_>=0)cmask(P0,P1,jb_,qrel,hi);}while(0)
  bool resc=false;
  #define START(P0,P1) do{ const float rm=rowmax(P0,P1); resc=false; \
    { const float dl=rm; mhat=fadd_s(mhat,dl); \
      _Pragma("unroll") for(int r=0;r<16;++r){P0[r]=fsub_s(P0[r],dl);P1[r]=fsub_s(P1[r],dl);} } \
    _Pragma("unroll") for(int r=0;r<16;++r)P0[r]=__builtin_amdgcn_exp2f(P0[r]); }while(0)
  #define RESC() do{ if(resc){ asm volatile("s_waitcnt lgkmcnt(0)":::"memory"); \
      _Pragma("unroll") for(int d_=0;d_<4;++d_) _Pragma("unroll") for(int r=0;r<16;++r)o[d_][r]*=wsf[crow(r,hi)]; } }while(0)
  f32x16 pA0,pA1,pB0,pB1;
  int sl_prev=0,sl_cur=0,sl_next=KSLOT;
  #define ROT() do{sl_prev=sl_cur;sl_cur=sl_next;sl_next=(sl_next==(NSLOT-1)*KSLOT)?0:sl_next+KSLOT;}while(0)
  DMA_K(2,2*KSLOT);
  WAIT_BAR(1);
  { bf16x8 q4[4];
    #pragma unroll
    for(int d0=0;d0<4;++d0)q4[d0]=QLD(d0);
    qkt(pA0,pA1,Kbase,q4,zero16,r32,hi); }
  asm volatile("s_nop 15\n\ts_nop 7":"+v"(pA0),"+v"(pA1));CMASK(pA0,pA1,0);
  START(pA0,pA1);
  _Pragma("unroll") for(int r=0;r<16;++r)pA1[r]=__builtin_amdgcn_exp2f(pA1[r]);
  WAIT_BAR(0);
  DMA_K(3,0);DMA_V(1,KSLOT);
  ROT();
  kload8(kf,kp0+sl_cur);
  WAIT_BAR(3);
  s16x4 vlo[16],vhi[16]; u32x4 pw0,pw1,pw2,pw3;
  #define PKW(P,B) cvtpk_s(P[B],P[B+1])
  #define PAF(k) __builtin_bit_cast(bf16x8,pw##k)
  #define VFR(i) (bf16x8){vlo[i][0],vlo[i][1],vlo[i][2],vlo[i][3],vhi[i][0],vhi[i][1],vhi[i][2],vhi[i][3]}
  #define PIN(x) asm volatile("":"+v"(x))
  #define MX3(a,b,c) __builtin_fmaxf(__builtin_fmaxf((a),(b)),(c))
  #define GAPA(MF,A0,A1,A2,A3,W0,W1,PW) do{ MF; sacc+=A0; sacc+=A1; sacc+=A2; sacc+=A3; PIN(sacc); W0; W1; PIN(PW); SBAR(); }while(0)
  #define EX(v) __builtin_amdgcn_exp2f((v)-mhat)
  #define GAPB(MF,X,B) do{ MF; X[B]=EX(X[B]); X[B+1]=EX(X[B+1]); PIN(X); SBAR(); }while(0)
  #define VRD(i) do{ vlo[i]=vtr(vp_+(((i)>>2)*4096+((i)&3)*1024)); vhi[i]=vtr(vp_+(((i)>>2)*4096+((i)&3)*1024+512)); }while(0)
  #define KRD(G,j) do{ if(G){ kload2(kf,kp0+sl_next,j); SBAR(); } }while(0)
  #define PVM(d,ks) o[d]=__builtin_amdgcn_mfma_f32_32x32x16_bf16(PAF(ks),VFR((d)*4+(ks)),o[d],0,0,0)
  #define STEP(C0,C1,P0,P1,t,GK,GV,GL) do{ SBAR(); \
    const lds_cptr vp_=vp0+2*sl_prev; \
    const bf16x8 q0_=QLD(0),q1_=QLD(1),q2_=QLD(2),q3_=QLD(3); \
    VRD(0); SBAR(); float sacc=(P0[0]+P0[1]); \
    GAPA(C0=__builtin_amdgcn_mfma_f32_32x32x16_bf16(kf[0],q0_,zero16,0,0,0), P0[2],P0[3],P0[4],P0[5],     pw0[0]=PKW(P0,0), pw0[1]=PKW(P0,2), pw0); \
    VRD(4); SBAR(); GAPA(C1=__builtin_amdgcn_mfma_f32_32x32x16_bf16(kf[1],q0_,zero16,0,0,0), P0[6],P0[7],P0[8],P0[9],     pw0[2]=PKW(P0,4), pw0[3]=PKW(P0,6), pw0); \
    VRD(8); SBAR(); GAPA(C0=__builtin_amdgcn_mfma_f32_32x32x16_bf16(kf[2],q1_,C0,0,0,0),   P0[10],P0[11],P0[12],P0[13], pw1[0]=PKW(P0,8), pw1[1]=PKW(P0,10), pw1); \
    VRD(12); SBAR(); GAPA(C1=__builtin_amdgcn_mfma_f32_32x32x16_bf16(kf[3],q1_,C1,0,0,0),   P0[14],P0[15],P1[0],P1[1],   pw1[2]=PKW(P0,12),pw1[3]=PKW(P0,14), pw1); \
    VRD(1); SBAR(); GAPA(C0=__builtin_amdgcn_mfma_f32_32x32x16_bf16(kf[4],q2_,C0,0,0,0),   P1[2],P1[3],P1[4],P1[5],     pw2[0]=PKW(P1,0), pw2[1]=PKW(P1,2), pw2); \
    VRD(5); SBAR(); GAPA(C1=__builtin_amdgcn_mfma_f32_32x32x16_bf16(kf[5],q2_,C1,0,0,0),   P1[6],P1[7],P1[8],P1[9],     pw2[2]=PKW(P1,4), pw2[3]=PKW(P1,6), pw2); \
    VRD(9); SBAR(); GAPA(C0=__builtin_amdgcn_mfma_f32_32x32x16_bf16(kf[6],q3_,C0,0,0,0),   P1[10],P1[11],P1[12],P1[13], pw3[0]=PKW(P1,8), pw3[1]=PKW(P1,10), pw3); \
    VRD(13); SBAR(); GAPA(C1=__builtin_amdgcn_mfma_f32_32x32x16_bf16(kf[7],q3_,C1,0,0,0),   P1[14],P1[15],0.f,0.f,       pw3[2]=PKW(P1,12),pw3[3]=PKW(P1,14), pw3); \
    l_reg+=sacc; \
    if(GK){DMA_K((t)+3,sl_cur);} if(GV){DMA_V((t)+1,sl_next);} \
    CMASK(C0,C1,t); \
    { float a=MX3(C0[0],C0[1],C1[0]),b=MX3(C0[2],C0[3],C1[1]); a=MX3(a,C1[2],C1[3]); \
      _Pragma("unroll") for(int r=4;r<16;r+=4){a=MX3(a,C0[r],C0[r+1]);b=MX3(b,C0[r+2],C0[r+3]);a=MX3(a,C1[r],C1[r+1]);b=MX3(b,C1[r+2],C1[r+3]);} \
      float rm=__builtin_fmaxf(a,b); { auto rr=__builtin_amdgcn_permlane32_swap(__float_as_uint(rm),__float_as_uint(rm),false,false); rm=__builtin_fmaxf(__uint_as_float(rr[0]),__uint_as_float(rr[1])); } \
      rm-=mhat; resc=false; \
      if(__builtin_expect(__any(rm>(float)THRL),0)){ const float dl=__builtin_fmaxf(rm,0.f); mhat+=dl; \
        const float f=__builtin_amdgcn_exp2f(-dl); l_reg*=f; if(hi==0)wsf[r32]=f; resc=true; } } \
    SBAR(); \
    GAPB(PVM(0,0), C0,0);  VRD(2);  SBAR(); \
    GAPB(PVM(1,0), C0,2);  VRD(6);  SBAR(); \
    GAPB(PVM(2,0), C0,4);  VRD(10); SBAR(); \
    GAPB(PVM(3,0), C0,6);  VRD(14); SBAR(); \
    GAPB(PVM(0,1), C0,8);  VRD(3);  SBAR(); \
    GAPB(PVM(1,1), C0,10); VRD(7);  SBAR(); \
    GAPB(PVM(2,1), C0,12); VRD(11); SBAR(); \
    GAPB(PVM(3,1), C0,14); VRD(15); SBAR(); \
    KRD(GL,0); GAPB(PVM(0,2), C1,0); \
    GAPB(PVM(1,2), C1,2); \
    KRD(GL,1); GAPB(PVM(2,2), C1,4); \
    GAPB(PVM(3,2), C1,6); \
    KRD(GL,2); GAPB(PVM(0,3), C1,8); \
    GAPB(PVM(1,3), C1,10); \
    KRD(GL,3); GAPB(PVM(2,3), C1,12); \
    GAPB(PVM(3,3), C1,14); \
    }while(0)
  int t=1;
  #undef CMASK
  #define CMASK(P0,P1,t) do{}while(0)
  for(;t+5<NT;t+=2){
    STEP(pB0,pB1,pA0,pA1,t,true,true,true);     WAIT_BAR(3); RESC(); ROT();
    STEP(pA0,pA1,pB0,pB1,t+1,true,true,true);   WAIT_BAR(3); RESC(); ROT();
  }
  #undef CMASK
  #define CMASK(P0,P1,t) do{int jb_=(t)-(NT-4); if(jb_>=0)cmask(P0,P1,jb_,qrel,hi);}while(0)
  #define ENDW(tt) do{ if((tt)+3<NT){WAIT_BAR(3);} else if((tt)+2<NT){WAIT_BAR(2);} else {WAIT_BAR(0);} }while(0)
  for(;t+1<NT;t+=2){
    STEP(pB0,pB1,pA0,pA1,t,(t+3<NT),(t+1<NT),(t+1<NT));       ENDW(t);   RESC(); ROT();
    STEP(pA0,pA1,pB0,pB1,t+1,(t+4<NT),(t+2<NT),(t+2<NT));     ENDW(t+1); RESC(); ROT();
  }
  STEP(pB0,pB1,pA0,pA1,NT-1,false,false,false); RESC();
  { float sacc=pB0[0]+pB0[1]; _Pragma("unroll") for(int r=2;r<16;++r)sacc+=pB0[r]; _Pragma("unroll") for(int r=0;r<16;++r)sacc+=pB1[r]; l_reg+=sacc;
    pw0=(u32x4){PKW(pB0,0),PKW(pB0,2),PKW(pB0,4),PKW(pB0,6)};pw1=(u32x4){PKW(pB0,8),PKW(pB0,10),PKW(pB0,12),PKW(pB0,14)};pw2=(u32x4){PKW(pB1,0),PKW(pB1,2),PKW(pB1,4),PKW(pB1,6)};pw3=(u32x4){PKW(pB1,8),PKW(pB1,10),PKW(pB1,12),PKW(pB1,14)};
    SBAR(); pv4(o,vb0+2*sl_cur,PAF(0),PAF(1),PAF(2),PAF(3)); }
  #undef PKW
  #undef PAF
  #undef VFR
  #undef PIN
  #undef MX3
  #undef GAPA
  #undef GAPB
  #undef EX
  #undef VRD
  #undef KRD
  #undef PVM
  #undef STEP
  #undef ENDW
  {auto rr=__builtin_amdgcn_permlane32_swap(__float_as_uint(l_reg),__float_as_uint(l_reg),false,false);l_reg=__uint_as_float(rr[0])+__uint_as_float(rr[1]);}
  if(hi==0)wsf[32+r32]=l_reg;asm volatile("s_waitcnt lgkmcnt(0)":::"memory");
  float rli[16];
  #pragma unroll
  for(int r=0;r<16;++r)rli[r]=__builtin_amdgcn_rcpf(wsf[32+crow(r,hi)]);
  bf16*Ow=Oh+(long)(q0+wid*QBLK)*PO;
  { bf16*stg=(bf16*)(shm+L_Q)+wid*2048;
    #pragma unroll
    for(int hf=0;hf<2;++hf){
      #pragma unroll
      for(int r=0;r<16;++r){const int orow=crow(r,hi);
        #pragma unroll
        for(int d0=0;d0<2;++d0)stg[orow*64+d0*32+r32]=__float2bfloat16(o[2*hf+d0][r]*rli[r]);}
      asm volatile("s_waitcnt lgkmcnt(0)":::"memory");
      #pragma unroll
      for(int i=0;i<4;++i){const int row=i*8+(lane>>3),ch=lane&7; const u32x4 v=*(const u32x4*)(stg+row*64+ch*8); ATTN_STORE16(Ow+(long)row*PO+hf*64+ch*8,v);}
      asm volatile("s_waitcnt lgkmcnt(0)":::"memory"); } }
  asm volatile("s_waitcnt lgkmcnt(0)\n\ts_barrier":::"memory");
  #undef DMA_K
  #undef DMA_V
  #undef QLD
  #undef CMASK
  #undef START
  #undef RESC
  #undef ROT
}
#undef SBAR
#undef WAIT_BAR
}
#include <hip/hip_cooperative_groups.h>
namespace cg = cooperative_groups;
constexpr int NWAVES = 8;
constexpr int BATCH = 16, SEQ = 2048, D = 1024, DEPTH = 4, FF = 4096, PLE = 256, INW = 2560, AW = 512, RW = 512;
constexpr int M = BATCH * SEQ;
constexpr size_t MiB = 1u << 20;
constexpr size_t WS_CS = 1 * MiB;
constexpr size_t WS_SSQ0 = 3 * MiB, WS_SSQ1 = 5 * MiB;
constexpr size_t WS_W = 8 * MiB, W_LAYER = 25 * MiB + 512 * 1024;
constexpr size_t WO_IN = 0, WO_OUT = 5 * MiB, WO_W1 = 7 * MiB, WO_W2 = 15 * MiB, WO_PG = 23 * MiB, WO_PP = 25 * MiB;
constexpr size_t WS_P16 = 110 * MiB;
constexpr size_t WS_XB0 = 126 * MiB;
constexpr size_t WS_R = 190 * MiB;
constexpr size_t WS_PROJ = WS_R;
constexpr size_t WS_OV = WS_R + 160 * MiB;
constexpr size_t WS_AO = WS_R + 224 * MiB;
constexpr size_t WS_HB = WS_R;
constexpr size_t WS_XBF = WS_R + 64 * MiB;
constexpr size_t WS_PP = WS_R;
constexpr size_t WS_END = WS_R + 288 * MiB;
static_assert(WS_W + DEPTH * W_LAYER <= WS_P16 && WS_P16 + (size_t)M * PLE * 2 <= WS_XB0 && WS_XB0 + (size_t)M * D * 2 <= WS_R && WS_HB + (size_t)M * FF * 2 <= WS_END, "d_ws map");
constexpr int RING_BYTES = 131072;
constexpr int LDS_BYTES = 147456;

#define GAS __attribute__((address_space(1)))
#define LAS __attribute__((address_space(3)))
typedef unsigned short bf16;
typedef unsigned v4u __attribute__((ext_vector_type(4)));
typedef float f32x4 __attribute__((ext_vector_type(4)));
typedef short bf16x8 __attribute__((ext_vector_type(8)));
#define LDS_WAIT() asm volatile("s_waitcnt lgkmcnt(0)" ::: "memory")
#define VM_WAIT() asm volatile("s_waitcnt vmcnt(0)" ::: "memory")
__device__ __forceinline__ unsigned f2bf(float f) { unsigned u = __builtin_bit_cast(unsigned, f); return (u + 0x7fffu + ((u >> 16) & 1u)) >> 16; }
__device__ __forceinline__ unsigned pk2(float lo, float hi) { unsigned r; asm("v_cvt_pk_bf16_f32 %0, %1, %2" : "=v"(r) : "v"(lo), "v"(hi)); return r; }
__device__ __forceinline__ float bf2f(unsigned short v) { return __uint_as_float((unsigned)v << 16); }
__device__ __forceinline__ float sigmoid_f(float x) { return __builtin_amdgcn_rcpf(1.f + __builtin_amdgcn_exp2f(-1.4426950408889634f * x)); }

typedef GAS unsigned gu32;
#define RLX_AGENT __ATOMIC_RELAXED, __HIP_MEMORY_SCOPE_AGENT
#define XB_TMO      128
#define XB_XCNT(j)  (256  + 64 * (j))
#define XB_XSUB(j)  (1280 + 64 * (j))
#define XB_XGEN(j)  (2304 + 64 * (j))
#define XB_TOP      3328
#define XB_TOPGEN   3392
#define XCD_BAR_WORDS 3456
#define XB_SPIN_CAP (1u << 18)

__device__ __forceinline__ unsigned xb_ld(unsigned* p)              { return __hip_atomic_load(p, __ATOMIC_RELAXED, __HIP_MEMORY_SCOPE_AGENT); }
__device__ __forceinline__ unsigned xb_add(unsigned* p, unsigned v) { return __hip_atomic_fetch_add(p, v, __ATOMIC_RELAXED, __HIP_MEMORY_SCOPE_AGENT); }
__device__ __forceinline__ unsigned xb_xcc_id() { return (unsigned)__builtin_amdgcn_s_getreg((3 << 11) | 20) & 0xFu; }
#define XB_SPIN(cond, bar) do { unsigned _sp = 0; while (cond) { __builtin_amdgcn_s_sleep(1); \
    if ((++_sp & 255u) == 0u) { if (xb_ld(&(bar)[XB_TMO])) break; if (_sp > XB_SPIN_CAP) { atomicAdd(&(bar)[XB_TMO], 1u); break; } } } } while (0)

struct XcdBarrier {
    unsigned* bar; unsigned x;
    volatile LAS unsigned* st;
};

__device__ __forceinline__ XcdBarrier xcd_barrier_post(unsigned* bar, volatile LAS unsigned* st) {
    XcdBarrier b; b.bar = bar; b.x = xb_xcc_id(); b.st = st;
    if (threadIdx.x == 0) (void)xb_add(&bar[XB_XCNT(b.x)], 1u);
    return b;
}
__device__ __forceinline__ void xcd_barrier_complete(unsigned* bar, unsigned x, unsigned& nloc, unsigned& nx) {
    const unsigned G = gridDim.x * gridDim.y * gridDim.z;
    unsigned sum, cnt, mine, sp = 0u;
    for (;;) {
        sum = 0u; cnt = 0u; mine = 0u;
#pragma unroll
        for (unsigned j = 0; j < 16; ++j) { const unsigned c = xb_ld(&bar[XB_XCNT(j)]); sum += c; cnt += (c > 0u) ? 1u : 0u; mine = (j == x) ? c : mine; }
        if (sum == G) break;
        __builtin_amdgcn_s_sleep(1);
        if ((++sp & 255u) == 0u) { if (xb_ld(&bar[XB_TMO])) break; if (sp > XB_SPIN_CAP) { atomicAdd(&bar[XB_TMO], 1u); break; } }
    }
    nloc = mine > 0u ? mine : 1u; nx = cnt > 0u ? cnt : 1u;
}

__device__ __forceinline__ void xcd_barrier(const XcdBarrier& b) {
    asm volatile("s_waitcnt vmcnt(0)" ::: "memory");
    __syncthreads();
    if (threadIdx.x == 0) {
        unsigned* bar = b.bar;
        __builtin_amdgcn_s_waitcnt(0);
        unsigned nloc = b.st[0], nx = b.st[1];
        if (nloc == 0u) { xcd_barrier_complete(bar, b.x, nloc, nx); b.st[0] = nloc; b.st[1] = nx; }
        const unsigned old = xb_add(&bar[XB_XSUB(b.x)], 1u);
        const unsigned gen = old / nloc;
        if (old + 1u == (gen + 1u) * nloc) {
            __builtin_amdgcn_fence(__ATOMIC_RELEASE, "agent");
            asm volatile("s_waitcnt vmcnt(0)" ::: "memory");
            const unsigned og = xb_add(&bar[XB_TOP], 1u);
            const unsigned tg = og / nx;
            if (og + 1u == (tg + 1u) * nx) xb_add(&bar[XB_TOPGEN], 1u);
            else XB_SPIN(xb_ld(&bar[XB_TOPGEN]) == tg, bar);
            __builtin_amdgcn_fence(__ATOMIC_ACQUIRE, "agent");
            xb_add(&bar[XB_XGEN(b.x)], 1u);
            asm volatile("s_waitcnt vmcnt(0)" ::: "memory");
        } else {
            XB_SPIN(xb_ld(&bar[XB_XGEN(b.x)]) == gen, bar);
            __builtin_amdgcn_fence(__ATOMIC_ACQUIRE, "agent");
            asm volatile("s_waitcnt vmcnt(0)" ::: "memory");
        }
    }
    __syncthreads();
}

struct Frame {
    LAS unsigned char* lds;
    LAS const unsigned long long* tab;
};
struct Who { int tid, lane, wave, vcu, G; };
__device__ __forceinline__ Who who() { Who w; w.tid = tid_opaque(); w.lane = w.tid & 63; w.wave = __builtin_amdgcn_readfirstlane(w.tid >> 6);
    int bx = blockIdx.x, G = gridDim.x; asm volatile("" : "+s"(bx), "+s"(G)); w.G = G; w.vcu = (G % 8 == 0) ? (bx % 8) * (G / 8) + bx / 8 : bx; return w; }
__device__ __forceinline__ int opaque_s(int v) { asm volatile("" : "+s"(v)); return v; }
__device__ __forceinline__ const void* ptab(LAS const unsigned long long* tab, int k) {
    const unsigned long long v = tab[k]; const unsigned lo = __builtin_amdgcn_readfirstlane((unsigned)v), hi = __builtin_amdgcn_readfirstlane((unsigned)(v >> 32));
    GAS const char* g = (GAS const char*)(((unsigned long long)hi << 32) | lo);
    return (const void*)g;
}
#define FIN(k) ((const float*)ptab(F.tab, (k)))
#define FOUT() ((float*)ptab(F.tab, 23))
#define FWS(off) ((unsigned char*)ptab(F.tab, 24) + (off))
enum { I_X = 0, I_P, I_POS, I_WIN, I_WOUT, I_GMIX, I_GSUBLN, I_LAMQ, I_LAMK, I_CONVW, I_CONVB, I_WGA, I_BGA, I_WGX, I_BGX, I_LRULAM, I_GMLP, I_WMLPIN, I_WMLPOUT, I_GPLE, I_WPLEGATE, I_WPLEPROJ, I_GFINAL };

__device__ __forceinline__ float wave_sum(float v) {
#pragma unroll
    for (int o = 1; o < 64; o <<= 1) v += __shfl_xor(v, o);
    return v;
}
__device__ __forceinline__ void p0_transpose_item(const float* W, const float* gain, int K, int N, bf16* WT, LAS float* scr, int item, int lane) {
    const int nblk = N / 32, kb = item / nblk, nb = item % nblk, k0 = 64 * kb, n0 = 32 * nb;
    const int c = lane & 7;
    float v[32];
#pragma unroll
    for (int i = 0; i < 32; ++i) v[i] = W[(size_t)(k0 + 2 * i + (lane >> 5)) * N + n0 + (lane & 31)];
    f32x4 ga = {1.f, 1.f, 1.f, 1.f}, gb = ga;
    if (gain) { ga = *(const f32x4*)(gain + k0 + 8 * c); gb = *(const f32x4*)(gain + k0 + 8 * c + 4); }
#pragma unroll
    for (int i = 0; i < 32; ++i) scr[(2 * i + (lane >> 5)) * 33 + (lane & 31)] = v[i];
    LDS_WAIT(); asm volatile("" ::: "memory");
#pragma unroll
    for (int j = 0; j < 4; ++j) { const int n = (lane >> 3) + 8 * j; const LAS float* s = scr + (8 * c) * 33 + n;
        v4u o; o.x = pk2(s[0 * 33] * ga.x, s[1 * 33] * ga.y); o.y = pk2(s[2 * 33] * ga.z, s[3 * 33] * ga.w); o.z = pk2(s[4 * 33] * gb.x, s[5 * 33] * gb.y); o.w = pk2(s[6 * 33] * gb.z, s[7 * 33] * gb.w);
        *(GAS v4u*)(WT + (size_t)(n0 + n) * K + k0 + 8 * c) = o; }
    LDS_WAIT(); asm volatile("" ::: "memory");
}
__device__ __forceinline__ void p0_prologue(Frame& F) {
    const Who W = who();
    LAS float* scr = (LAS float*)(F.lds + W.wave * 16384);
    const int gw = W.vcu * NWAVES + W.wave, NGW = W.G * NWAVES;
    unsigned char* ws = FWS(0);
    const float *w_in = FIN(I_WIN), *w_out = FIN(I_WOUT), *w_mlp_in = FIN(I_WMLPIN), *w_mlp_out = FIN(I_WMLPOUT), *w_ple_gate = FIN(I_WPLEGATE), *w_ple_proj = FIN(I_WPLEPROJ), *g_mix = FIN(I_GMIX), *g_mlp = FIN(I_GMLP), *g_ple = FIN(I_GPLE);
    constexpr int I_IN = (D / 64) * (INW / 32), I_OUT = (D / 64) * (D / 32), I_1 = (D / 64) * (FF / 32), I_2 = (FF / 64) * (D / 32), I_PG = I_OUT, I_PP = (PLE / 64) * (D / 32);
    constexpr int PER_L = I_IN + I_OUT + I_1 + I_2 + I_PG + I_PP;
    for (int it = gw; it < DEPTH * PER_L; it += NGW) {
        const int l = it / PER_L; int r = it % PER_L; bf16* wl = (bf16*)(ws + WS_W + (size_t)l * W_LAYER);
        if (r < I_IN) { p0_transpose_item(w_in + (size_t)l * D * INW, g_mix + l * D, D, INW, (bf16*)((unsigned char*)wl + WO_IN), scr, r, W.lane); continue; } r -= I_IN;
        if (r < I_OUT) { p0_transpose_item(w_out + (size_t)l * D * D, nullptr, D, D, (bf16*)((unsigned char*)wl + WO_OUT), scr, r, W.lane); continue; } r -= I_OUT;
        if (r < I_1) { p0_transpose_item(w_mlp_in + (size_t)l * D * FF, g_mlp + l * D, D, FF, (bf16*)((unsigned char*)wl + WO_W1), scr, r, W.lane); continue; } r -= I_1;
        if (r < I_2) { p0_transpose_item(w_mlp_out + (size_t)l * FF * D, nullptr, FF, D, (bf16*)((unsigned char*)wl + WO_W2), scr, r, W.lane); continue; } r -= I_2;
        if (r < I_PG) { p0_transpose_item(w_ple_gate + (size_t)l * D * D, g_ple + l * D, D, D, (bf16*)((unsigned char*)wl + WO_PG), scr, r, W.lane); continue; } r -= I_PG;
        p0_transpose_item(w_ple_proj + (size_t)l * PLE * D, nullptr, PLE, D, (bf16*)((unsigned char*)wl + WO_PP), scr, r, W.lane);
    }
    const float* x_ = FIN(I_X); bf16* XB1_ = (bf16*)FOUT(); float* SSQ1_ = (float*)(ws + WS_SSQ1); float* CS_ = (float*)(ws + WS_CS); const int* pos_ = (const int*)FIN(I_POS);
#pragma unroll 4
    for (int m = gw; m < M; m += NGW) {
        const GAS f32x4* xr = (const GAS f32x4*)(x_ + (size_t)m * D) + W.lane;
        GAS unsigned long long* o8 = (GAS unsigned long long*)(XB1_ + (size_t)m * D) + W.lane; float s = 0.f;
#pragma unroll
        for (int j = 0; j < 4; ++j) { const f32x4 v = xr[64 * j]; s += (v.x * v.x + v.y * v.y) + (v.z * v.z + v.w * v.w);
            o8[64 * j] = (unsigned long long)pk2(v.x, v.y) | ((unsigned long long)pk2(v.z, v.w) << 32); }
        s = wave_sum(s);
        if (W.lane < 16) SSQ1_[(size_t)m * 16 + W.lane] = (W.lane == 0) ? s : 0.f;
    }
}
__device__ __forceinline__ void convert_p(Frame& F, int l) {
    const Who W = who();
    const float* src = FIN(I_P) + (size_t)l * M * PLE; bf16* P16_ = (bf16*)FWS(WS_P16);
#pragma unroll 4
    for (size_t e = (size_t)W.vcu * NWAVES * 64 + W.tid; e < (size_t)M * PLE / 8; e += (size_t)W.G * NWAVES * 64) {
        const f32x4 a = *(const GAS f32x4*)(src + e * 8), b = *(const GAS f32x4*)(src + e * 8 + 4);
        v4u o; o.x = pk2(a.x, a.y); o.y = pk2(a.z, a.w); o.z = pk2(b.x, b.y); o.w = pk2(b.z, b.w);
        *(GAS v4u*)(P16_ + e * 8) = o; }
}
__device__ __forceinline__ void final_norm(Frame& F) {
    const Who W = who();
    const int gw = W.vcu * NWAVES + W.wave, NGW = W.G * NWAVES;
    const float* SSQ1_ = (const float*)FWS(WS_SSQ1); float* O_ = FOUT(); const float* gf_ = FIN(I_GFINAL); const bf16* XBF_ = (const bf16*)FWS(WS_XBF);
#pragma unroll 4
    for (int m = gw; m < M; m += NGW) {
        const float rs = pg8::row_rs(SSQ1_, m);
        const GAS unsigned long long* hr = (const GAS unsigned long long*)(XBF_ + (size_t)m * D) + W.lane; GAS f32x4* orow = (GAS f32x4*)(O_ + (size_t)m * D) + W.lane; const GAS f32x4* gr = (const GAS f32x4*)gf_ + W.lane;
#pragma unroll
        for (int j = 0; j < 4; ++j) { const unsigned long long w8 = hr[64 * j]; const unsigned lo = (unsigned)w8, hi = (unsigned)(w8 >> 32); const f32x4 g = gr[64 * j];
            const f32x4 v = {pg8::bf_lo(lo), pg8::bf_hi(lo), pg8::bf_lo(hi), pg8::bf_hi(hi)}; orow[64 * j] = v * rs * g; }
    }
}

__device__ __forceinline__ void lru_item(Frame& F, int l, int item) {
    const int b = item >> 4, g = (item >> 1) & 7, hf = item & 1;
    const int tid_ = tid_opaque(), lane = tid_ & 63, w = __builtin_amdgcn_readfirstlane(tid_ >> 6), r = lane & 15, q = lane >> 4;
    LAS float* xcs = (LAS float*)(F.lds + w * 4352);
    LAS float* car = (LAS float*)(F.lds + 36864);
    const bf16* pj = (const bf16*)FWS(WS_PROJ) + (size_t)b * SEQ * INW;
    bf16* ao = (bf16*)FWS(WS_AO) + (size_t)b * SEQ * D;
    v4u* lb = (v4u*)FWS(WS_XB0) + ((size_t)item * NWAVES + w) * (16 * 2 * 64) + lane;
    const int t0 = w * 256;
    const bf16* gcol = pj + 3 * AW + RW + g * 64 + hf * 32 + r;
    bf16* ycol = ao + AW + g * 64 + hf * 32 + r;
    float hin[2] = {0.f, 0.f};
    {
        const int cch = g * 64 + lane;
        const float* conv_w = FIN(I_CONVW);
        const float cw0 = conv_w[(l * 4 + 0) * RW + cch], cw1 = conv_w[(l * 4 + 1) * RW + cch], cw2 = conv_w[(l * 4 + 2) * RW + cch], cw3 = conv_w[(l * 4 + 3) * RW + cch], cb = FIN(I_CONVB)[l * RW + cch];
        bf16x8 Bf[2][2][2];
#pragma unroll
        for (int gate = 0; gate < 2; ++gate) { const float* W = (gate ? FIN(I_WGX) : FIN(I_WGA)) + (size_t)(l * 8 + g) * 64 * 64;
#pragma unroll
            for (int n = 0; n < 2; ++n)
#pragma unroll
                for (int kk = 0; kk < 2; ++kk) { const float* wp = W + (size_t)(32 * kk + 8 * q) * 64 + hf * 32 + 16 * n + r; v4u pw;
                    pw.x = pk2(wp[0 * 64], wp[1 * 64]); pw.y = pk2(wp[2 * 64], wp[3 * 64]); pw.z = pk2(wp[4 * 64], wp[5 * 64]); pw.w = pk2(wp[6 * 64], wp[7 * 64]);
                    Bf[gate][n][kk] = __builtin_bit_cast(bf16x8, pw); } }
        float ba[2], bx[2], sp8[2];
#pragma unroll
        for (int n = 0; n < 2; ++n) { const int ch = l * RW + g * 64 + hf * 32 + 16 * n + r; ba[n] = FIN(I_BGA)[ch]; bx[n] = FIN(I_BGX)[ch];
            const float z = -FIN(I_LRULAM)[ch]; sp8[n] = 8.f * (fmaxf(z, 0.f) + log1pf(__expf(-fabsf(z)))); }
        const bf16* xcol = pj + 3 * AW + cch;
        float h3 = 0.f, h2 = 0.f, h1 = 0.f;
        if (t0 != 0) { h3 = bf2f(xcol[(size_t)(t0 - 3) * INW]); h2 = bf2f(xcol[(size_t)(t0 - 2) * INW]); h1 = bf2f(xcol[(size_t)(t0 - 1) * INW]); }
        float hrun[2] = {0.f, 0.f}, Arun[2] = {1.f, 1.f};
        unsigned short xq[16];
#pragma unroll
        for (int tt = 0; tt < 16; ++tt) xq[tt] = xcol[(size_t)(t0 + tt) * INW];
#pragma unroll 1
        for (int sc = 0; sc < 16; ++sc) {
            const int ts = t0 + sc * 16, tn = (sc < 15) ? ts + 16 : ts;
            unsigned short xn[16];
#pragma unroll
            for (int tt = 0; tt < 16; ++tt) xn[tt] = xcol[(size_t)(tn + tt) * INW];
#pragma unroll
            for (int tt = 0; tt < 16; ++tt) { const float xv = bf2f(xq[tt]); const float xc = cb + cw0 * h3 + cw1 * h2 + cw2 * h1 + cw3 * xv; h3 = h2; h2 = h1; h1 = xv; xcs[tt * 68 + lane] = xc; }
            asm volatile("s_waitcnt lgkmcnt(0)" ::: "memory");
            bf16x8 Af[2];
#pragma unroll
            for (int kk = 0; kk < 2; ++kk) { const LAS f32x4* ap = (const LAS f32x4*)(xcs + r * 68 + 32 * kk + 8 * q); const f32x4 a0 = ap[0], a1 = ap[1];
                v4u pw; pw.x = pk2(a0.x, a0.y); pw.y = pk2(a0.z, a0.w); pw.z = pk2(a1.x, a1.y); pw.w = pk2(a1.z, a1.w); Af[kk] = __builtin_bit_cast(bf16x8, pw); }
            f32x4 Da[2], Dx[2];
#pragma unroll
            for (int n = 0; n < 2; ++n) { Da[n] = (f32x4){0.f, 0.f, 0.f, 0.f}; Dx[n] = Da[n];
#pragma unroll
                for (int kk = 0; kk < 2; ++kk) { Da[n] = __builtin_amdgcn_mfma_f32_16x16x32_bf16(Af[kk], Bf[0][n][kk], Da[n], 0, 0, 0); Dx[n] = __builtin_amdgcn_mfma_f32_16x16x32_bf16(Af[kk], Bf[1][n][kk], Dx[n], 0, 0, 0); } }
#pragma unroll
            for (int n = 0; n < 2; ++n) {
                float a[4], bb[4]; v4u st;
#pragma unroll
                for (int i = 0; i < 4; ++i) { const float xcv = xcs[(4 * q + i) * 68 + hf * 32 + 16 * n + r];
                    const float ra = sigmoid_f(Da[n][i] + ba[n]), ix = sigmoid_f(Dx[n][i] + bx[n]);
                    const float la = -ra * sp8[n];
                    const float y2 = 2.f * la;
                    const float ser = -y2 * (1.f + y2 * (0.5f + y2 * (0.16666667f + y2 * (0.041666668f + y2 * 0.008333334f))));
                    const float a2 = __builtin_amdgcn_exp2f(1.4426950408889634f * y2);
                    const float em = (y2 > -0.25f) ? ser : (1.f - a2);
                    const float bv = __builtin_amdgcn_sqrtf(fmaxf(em, 0.f)) * (ix * xcv);
                    const unsigned pr = pk2(la * 1.4426950408889634f, bv); st[i] = pr;
                    a[i] = __builtin_amdgcn_exp2f(bf2f((unsigned short)(pr & 0xffffu))); bb[i] = __uint_as_float(pr & 0xffff0000u); }
                lb[(sc * 2 + n) * 64] = st;
                const float Al = (a[0] * a[1]) * (a[2] * a[3]);
                const float Hl = ((bb[0] * a[1] + bb[1]) * a[2] + bb[2]) * a[3] + bb[3];
                const float A0 = __shfl(Al, r), A1 = __shfl(Al, r + 16), A2 = __shfl(Al, r + 32), A3 = __shfl(Al, r + 48);
                const float H0 = __shfl(Hl, r), H1 = __shfl(Hl, r + 16), H2 = __shfl(Hl, r + 32), H3 = __shfl(Hl, r + 48);
                const float c0 = hrun[n], c1 = A0 * c0 + H0, c2 = A1 * c1 + H1, c3 = A2 * c2 + H2, c4 = A3 * c3 + H3;
                hrun[n] = c4; Arun[n] *= (A0 * A1) * (A2 * A3);
            }
#pragma unroll
            for (int tt = 0; tt < 16; ++tt) xq[tt] = xn[tt];
        }
        if (q == 0) {
#pragma unroll
            for (int n = 0; n < 2; ++n) { car[w * 64 + n * 16 + r] = Arun[n]; car[w * 64 + 32 + n * 16 + r] = hrun[n]; } }
        __syncthreads();
#pragma unroll
        for (int n = 0; n < 2; ++n) { float h = 0.f; for (int w2 = 0; w2 < w; ++w2) h = car[w2 * 64 + n * 16 + r] * h + car[w2 * 64 + 32 + n * 16 + r]; hin[n] = h; }
    }
    {
        VM_WAIT();
        float hrun[2] = {hin[0], hin[1]};
        v4u cur[2]; cur[0] = lb[0]; cur[1] = lb[64];
#pragma unroll 1
        for (int sc = 0; sc < 16; ++sc) {
            const int ts = t0 + sc * 16, scn = (sc < 15) ? sc + 1 : sc;
            v4u nxt[2]; nxt[0] = lb[(scn * 2 + 0) * 64]; nxt[1] = lb[(scn * 2 + 1) * 64];
            unsigned short gq[2][4];
#pragma unroll
            for (int n = 0; n < 2; ++n)
#pragma unroll
                for (int i = 0; i < 4; ++i) gq[n][i] = gcol[(size_t)(ts + 4 * q + i) * INW + 16 * n];
#pragma unroll
            for (int n = 0; n < 2; ++n) {
                float a[4], bb[4];
#pragma unroll
                for (int i = 0; i < 4; ++i) { const unsigned pr = cur[n][i]; a[i] = __builtin_amdgcn_exp2f(__uint_as_float(pr << 16)); bb[i] = __uint_as_float(pr & 0xffff0000u); }
                const float Al = (a[0] * a[1]) * (a[2] * a[3]);
                const float Hl = ((bb[0] * a[1] + bb[1]) * a[2] + bb[2]) * a[3] + bb[3];
                const float A0 = __shfl(Al, r), A1 = __shfl(Al, r + 16), A2 = __shfl(Al, r + 32);
                const float H0 = __shfl(Hl, r), H1 = __shfl(Hl, r + 16), H2 = __shfl(Hl, r + 32), H3 = __shfl(Hl, r + 48), A3 = __shfl(Al, r + 48);
                const float c0 = hrun[n], c1 = A0 * c0 + H0, c2 = A1 * c1 + H1, c3 = A2 * c2 + H2, c4 = A3 * c3 + H3;
                hrun[n] = c4;
                float h = (q == 0) ? c0 : (q == 1) ? c1 : (q == 2) ? c2 : c3;
#pragma unroll
                for (int i = 0; i < 4; ++i) { h = a[i] * h + bb[i]; const float gv = bf2f(gq[n][i]);
                    const float ge = gv * sigmoid_f(1.5957691216057308f * (gv + 0.044715f * gv * gv * gv));
                    ycol[(size_t)(ts + 4 * q + i) * D + 16 * n] = (bf16)(pk2(h * ge, 0.f) & 0xffffu); }
            }
            cur[0] = nxt[0]; cur[1] = nxt[1];
        }
    }
    __syncthreads();
}

__device__ __forceinline__ void attn_post(Frame& F, int l, int b, int h, int qb, float lam, float oscale) {
    const int tid_ = tid_opaque(), lane = tid_ & 63, wave_ = __builtin_amdgcn_readfirstlane(tid_ >> 6), rsub = lane >> 4, e8 = (lane & 15) * 8;
    const float* gs = FIN(I_GSUBLN) + l * 128 + e8; const bf16* OV_ = (const bf16*)FWS(WS_OV); bf16* AO_ = (bf16*)FWS(WS_AO); const f32x4 g0 = *(const f32x4*)gs, g1 = *(const f32x4*)(gs + 4);
    const size_t rowbase = (size_t)b * SEQ + qb * 256 + wave_ * 32;
#pragma unroll 4
    for (int it = 0; it < 8; ++it) { const size_t row = rowbase + it * 4 + rsub;
        const v4u a = *(const GAS v4u*)(OV_ + row * D + h * 256 + e8), c = *(const GAS v4u*)(OV_ + row * D + h * 256 + 128 + e8);
        f32x4 d0 = {pg8::bf_lo(a.x) - lam * pg8::bf_lo(c.x), pg8::bf_hi(a.x) - lam * pg8::bf_hi(c.x), pg8::bf_lo(a.y) - lam * pg8::bf_lo(c.y), pg8::bf_hi(a.y) - lam * pg8::bf_hi(c.y)};
        f32x4 d1 = {pg8::bf_lo(a.z) - lam * pg8::bf_lo(c.z), pg8::bf_hi(a.z) - lam * pg8::bf_hi(c.z), pg8::bf_lo(a.w) - lam * pg8::bf_lo(c.w), pg8::bf_hi(a.w) - lam * pg8::bf_hi(c.w)};
        float ss = pg8::sumsq8(d0, d1);
        ss += __shfl_xor(ss, 1); ss += __shfl_xor(ss, 2); ss += __shfl_xor(ss, 4); ss += __shfl_xor(ss, 8);
        const float rs = __builtin_amdgcn_rsqf(ss * (1.f / 128.f) + 1e-6f) * oscale;
        d0 = d0 * rs * g0; d1 = d1 * rs * g1;
        v4u o; o.x = pk2(d0.x, d0.y); o.y = pk2(d0.z, d0.w); o.z = pk2(d1.x, d1.y); o.w = pk2(d1.z, d1.w);
        *(GAS v4u*)(AO_ + row * D + h * 128 + e8) = o; }
}

struct Args { const void* in[23]; float* out; unsigned char* ws; int ph_lo, ph_hi; };
constexpr int N_PHASES = 2 + 6 * DEPTH;
__global__ void __launch_bounds__(NWAVES * 64, 2) hymba_fwd(Args args) {
    extern __shared__ __attribute__((aligned(16))) unsigned char lds[];
    cg::grid_group grid = cg::this_grid();
    Frame F;
    F.lds = (LAS unsigned char*)lds;
    { LAS unsigned long long* tabw = (LAS unsigned long long*)(F.lds + RING_BYTES + 1024);
      if (threadIdx.x == 0) {
#pragma unroll
          for (int k = 0; k < 23; ++k) tabw[k] = (unsigned long long)args.in[k];
          tabw[23] = (unsigned long long)args.out; tabw[24] = (unsigned long long)args.ws; }
      F.tab = tabw; }
    __syncthreads();
    const int lo = args.ph_lo, hi = args.ph_hi;
#define IN(k) (lo <= (k) && (k) < hi)
#define SEAM(k) do { if (IN(k) && IN((k) + 1)) xcd_barrier(bar); } while (0)

    if (blockIdx.x == 0) { unsigned* bw = (unsigned*)args.ws; for (int u = threadIdx.x; u < XCD_BAR_WORDS; u += NWAVES * 64) bw[u] = 0u; }
    if (threadIdx.x < 2) ((volatile LAS unsigned*)(F.lds + RING_BYTES + 2048))[threadIdx.x] = 0u;
    if (IN(0)) { p0_prologue(F); }
    grid.sync();
    XcdBarrier bar = xcd_barrier_post((unsigned*)args.ws, (volatile LAS unsigned*)(F.lds + RING_BYTES + 2048));

#pragma unroll 1
    for (int l_ = 0; l_ < DEPTH; ++l_) {
        const int pb = 1 + 6 * l_;
        if (IN(pb + 0)) {
            const Who W = who(); const int l = opaque_s(l_);
            unsigned char* ws = FWS(0); const unsigned char* wl = ws + WS_W + (size_t)l * W_LAYER;
            pg8::Gemm g{(const bf16*)FOUT(), (const bf16*)(wl + WO_IN), M, INW, D}; pg8::StaticOrder S; S.init(M, INW, W.G, opaque_s((int)blockIdx.x));
            pg8::EpiIn E{(bf16*)(ws + WS_PROJ), INW, (const float*)(ws + WS_SSQ1), (const int*)FIN(I_POS), attn_body::C2};
            pg8::gemm_phase<pg8::EpiIn, pg8::StaticOrder, true, true>(F.lds, g, S, E);
        }
        SEAM(pb + 0);
        if (IN(pb + 1)) {
            const Who W = who(); const int l = opaque_s(l_);
            float lam, oscale;
            { const float* lq = FIN(I_LAMQ) + l * 128; const float* lk = FIN(I_LAMK) + l * 128;
              const float d0 = wave_sum(lq[W.lane] * lk[W.lane]), d1 = wave_sum(lq[64 + W.lane] * lk[64 + W.lane]);
              const float li = 0.8f - 0.6f * __expf(-0.3f * (float)l); lam = __expf(d0) - __expf(d1) + li; oscale = 1.f - li; }
#if defined(PROBE_ATTN2)
            for (int rep_ = 0; rep_ < 2; ++rep_)
#endif
            for (int item = W.vcu; item < 256; item += W.G) {
                const int bh = item >> 2, s = item & 3, b = bh >> 2, h = bh & 3;
                const attn_body::bf16* pj = (const attn_body::bf16*)((const bf16*)FWS(WS_PROJ) + (size_t)b * SEQ * INW); attn_body::bf16* ov = (attn_body::bf16*)((bf16*)FWS(WS_OV) + (size_t)b * SEQ * D);
#pragma unroll 1
                for (int k = 0; k < 2; ++k) { const int qb = k ? 7 - s : s;
#pragma unroll 1
                    for (int c = 0; c < 2; ++c)
                        attn2::attn_unit128<8>(qb, pj + (h * 2 + c) * 64, pj + AW + (h * 2 + c) * 64, pj + 2 * AW + h * 128, ov + h * 256 + c * 128, (char*)lds);
                    VM_WAIT(); __syncthreads(); __builtin_amdgcn_fence(__ATOMIC_ACQUIRE, "agent"); VM_WAIT();
                    attn_post(F, l, b, h, qb, lam, oscale);
                }
            }
            __syncthreads();
#if defined(PROBE_LRU2)
            for (int rep_ = 0; rep_ < 2; ++rep_)
#endif
            for (int item = W.vcu; item < 256; item += W.G) lru_item(F, l, item);
        }
        SEAM(pb + 1);
        if (IN(pb + 2)) {
            const Who W = who(); const int l = opaque_s(l_);
            unsigned char* ws = FWS(0); const unsigned char* wl = ws + WS_W + (size_t)l * W_LAYER;
            pg8::Gemm g{(const bf16*)(ws + WS_AO), (const bf16*)(wl + WO_OUT), M, D, D}; pg8::StaticOrder S; S.init(M, D, W.G, opaque_s((int)blockIdx.x));
            pg8::EpiRes E{(const bf16*)FOUT(), (bf16*)(ws + WS_XB0), (float*)(ws + WS_SSQ0)};
            pg8::gemm_phase<pg8::EpiRes, pg8::StaticOrder, true, true>(F.lds, g, S, E);
        }
        SEAM(pb + 2);
        if (IN(pb + 3)) {
            const Who W = who(); const int l = opaque_s(l_);
            convert_p(F, l);
            unsigned char* ws = FWS(0); const unsigned char* wl = ws + WS_W + (size_t)l * W_LAYER;
            pg8::Gemm g{(const bf16*)(ws + WS_XB0), (const bf16*)(wl + WO_W1), M, FF, D}; pg8::StaticOrder S; S.init(M, FF, W.G, opaque_s((int)blockIdx.x));
            pg8::EpiMlpIn E{(bf16*)(ws + WS_HB), FF, (const float*)(ws + WS_SSQ0)};
            pg8::gemm_phase<pg8::EpiMlpIn, pg8::StaticOrder, true, true>(F.lds, g, S, E);
        }
        SEAM(pb + 3);
        if (IN(pb + 4)) {
            const Who W = who(); const int l = opaque_s(l_);
            unsigned char* ws = FWS(0); const unsigned char* wl = ws + WS_W + (size_t)l * W_LAYER;
            pg8::Gemm g{(const bf16*)(ws + WS_HB), (const bf16*)(wl + WO_W2), M, D, FF}; pg8::StaticOrder S; S.init(M, D, W.G, opaque_s((int)blockIdx.x));
            pg8::EpiRes E{(const bf16*)(ws + WS_XB0), (bf16*)(ws + WS_XB0), (float*)(ws + WS_SSQ0)};
            pg8::gemm_phase<pg8::EpiRes, pg8::StaticOrder, true, true>(F.lds, g, S, E);
        }
        SEAM(pb + 4);
        if (IN(pb + 5)) {
            const Who W = who(); const int l = opaque_s(l_);
            { unsigned char* ws = FWS(0); const unsigned char* wl = ws + WS_W + (size_t)l * W_LAYER;
              pg8::Gemm g{(const bf16*)(ws + WS_P16), (const bf16*)(wl + WO_PP), M, D, opaque_s(PLE)}; pg8::StaticOrder S; S.init(M, D, W.G, opaque_s((int)blockIdx.x));
              pg8::EpiPlain E{(bf16*)(ws + WS_PP), D};
              pg8::gemm_phase<pg8::EpiPlain, pg8::StaticOrder, true, true>(F.lds, g, S, E); }
            VM_WAIT(); __syncthreads();
            { unsigned char* ws = FWS(0); const unsigned char* wl = ws + WS_W + (size_t)l * W_LAYER;
              pg8::Gemm g{(const bf16*)(ws + WS_XB0), (const bf16*)(wl + WO_PG), M, D, D}; pg8::StaticOrder S; S.init(M, D, W.G, opaque_s((int)blockIdx.x));
              pg8::EpiPle E{(const bf16*)(ws + WS_XB0), (l == DEPTH - 1) ? (bf16*)(ws + WS_XBF) : (bf16*)FOUT(), (const float*)(ws + WS_SSQ0), (float*)(ws + WS_SSQ1), (const bf16*)(ws + WS_PP)};
              pg8::gemm_phase<pg8::EpiPle, pg8::StaticOrder, true, true>(F.lds, g, S, E); }
        }
        SEAM(pb + 5);
    }
    if (IN(N_PHASES - 1)) final_norm(F);
#undef IN
#undef SEAM
}

extern "C" void kernel_launch(void* const* d_in, const int* in_sizes, int n_in, void* d_out, int out_size, void* d_ws, size_t ws_size, hipStream_t stream) {
    static int grid = 0;
    if (grid == 0) {
        if (n_in != 23 || in_sizes[0] != M * D || out_size != M * D || ws_size < WS_END) { fprintf(stderr, "kernel_launch: unexpected shapes: n_in %d in0 %d out %d ws %zu (need %zu); nothing launched\n", n_in, n_in > 0 ? in_sizes[0] : -1, out_size, ws_size, (size_t)WS_END); grid = -1; return; }
        int dev = 0, cus = 0, per_cu = 0;
        if (hipGetDevice(&dev) != hipSuccess || hipDeviceGetAttribute(&cus, hipDeviceAttributeMultiprocessorCount, dev) != hipSuccess) { grid = -1; return; }
        if (hipFuncSetAttribute((const void*)hymba_fwd, hipFuncAttributeMaxDynamicSharedMemorySize, LDS_BYTES) != hipSuccess) { fprintf(stderr, "kernel_launch: hipFuncSetAttribute failed\n"); grid = -1; return; }
        if (hipOccupancyMaxActiveBlocksPerMultiprocessor(&per_cu, (const void*)hymba_fwd, NWAVES * 64, LDS_BYTES) != hipSuccess || per_cu < 1) { fprintf(stderr, "kernel_launch: occupancy query reports %d\n", per_cu); per_cu = 1; }
        (void)hipGetLastError();
        grid = cus * per_cu;
    }
    if (grid < 0) return;
    Args a{};
    for (int i = 0; i < 23; ++i) a.in[i] = d_in[i];
    a.out = (float*)d_out; a.ws = (unsigned char*)d_ws;
#ifndef MK_CUTS
    a.ph_lo = 0; a.ph_hi = N_PHASES;
    void* kargs[] = {&a};
    hipError_t e = hipLaunchCooperativeKernel((const void*)hymba_fwd, dim3(grid), dim3(NWAVES * 64), kargs, LDS_BYTES, stream);
    if (e != hipSuccess) fprintf(stderr, "kernel_launch: cooperative launch failed: %s (grid %d)\n", hipGetErrorString(e), grid);
#else
    for (int ph = 0; ph < N_PHASES; ++ph) { a.ph_lo = ph; a.ph_hi = ph + 1; void* kargs[] = {&a};
        hipError_t e = hipLaunchCooperativeKernel((const void*)hymba_fwd, dim3(grid), dim3(NWAVES * 64), kargs, LDS_BYTES, stream);
        if (e != hipSuccess) { fprintf(stderr, "kernel_launch: launch %d failed: %s\n", ph, hipGetErrorString(e)); break; } }
#endif
}
```

```cpp
#include <hip/hip_runtime.h>
#include <cstdio>
#include <cstdint>
__device__ __forceinline__ int tid_opaque() { int t = threadIdx.x; asm volatile("" : "+v"(t)); return t; }
namespace pg8 {
#define PG8_LAS __attribute__((address_space(3)))
typedef unsigned short bf16_t;
typedef short bf16x8 __attribute__((ext_vector_type(8)));
typedef float f32x4 __attribute__((ext_vector_type(4)));
typedef unsigned u32x4 __attribute__((ext_vector_type(4)));
constexpr int BM = 256, BK = 64, HALF = 128, HTB = HALF * BK * 2  , STAGE_BYTES = 8 * HTB, NXCD = 8, WGM = 8;

__host__ __device__ __forceinline__ int lds_byte(int r, int c) { const int st = (r >> 4) * 2 + (c >> 5), rr = r & 15, cc = c & 31, ob = rr * 64 + cc * 2; return st * 1024 + (ob ^ (((ob >> 9) & 1) << 5)); }
__host__ __device__ __forceinline__ void stage_rc(int b, int& R, int& C) { const int st = b / 1024, sb = b % 1024, swz = sb ^ (((sb >> 9) & 1) << 5); R = (st >> 1) * 16 + swz / 64; C = (st & 1) * 32 + (swz % 64) / 2; }
__host__ __device__ __forceinline__ int perm32(int rho) { const int n = rho >> 4, i = rho & 15; return 8 * (i >> 2) + 4 * n + (i & 3); }

struct Unit { int pm, pn; };
struct Gemm { const bf16_t* A; const bf16_t* Bt; int M, N, K; };

struct StaticOrder {
    int nM, nN, nwg, G, c;
    __host__ __device__ void init(int M, int N, int G_, int c_) { nM = M / BM; nN = N / BM; nwg = nM * nN; G = G_; c = c_; }
    __host__ __device__ bool next(int i, Unit& u) const {
        const long L = (long)i * G + c; if (L >= nwg) return false;
        int wgid = (int)L; { const int q = nwg / NXCD, r = nwg % NXCD, xcd = wgid % NXCD, off = wgid / NXCD; wgid = (xcd < r ? xcd * (q + 1) : r * (q + 1) + (xcd - r) * q) + off; }
        const int nig = WGM * nN, gid = wgid / nig, fm = gid * WGM, gsz = (nM - fm) < WGM ? (nM - fm) : WGM;
        u.pm = fm + ((wgid % nig) % gsz); u.pn = (wgid % nig) / gsz; return true;
    }
    __device__ __forceinline__ void a_ready(const Unit&) const {}
    __device__ __forceinline__ void done(const Unit&) const {}
};

__device__ __forceinline__ unsigned cvt_pk_bf16(float lo, float hi) { unsigned r; asm volatile("v_cvt_pk_bf16_f32 %0, %1, %2" : "=v"(r) : "v"(lo), "v"(hi)); return r; }
__device__ __forceinline__ u32x4 pack8(const f32x4 v0, const f32x4 v1) { u32x4 w; w.x = cvt_pk_bf16(v0[0], v0[1]); w.y = cvt_pk_bf16(v0[2], v0[3]); w.z = cvt_pk_bf16(v1[0], v1[1]); w.w = cvt_pk_bf16(v1[2], v1[3]); return w; }
__device__ __forceinline__ float bf_lo(unsigned w) { return __uint_as_float(w << 16); }
__device__ __forceinline__ float bf_hi(unsigned w) { return __uint_as_float(w & 0xffff0000u); }
constexpr int DMODEL = 1024;
constexpr float RMS_EPS = 1e-6f;
__device__ __forceinline__ float row_rs(const float* ssq, int row) {
    const f32x4* p = (const f32x4*)(ssq + (size_t)row * 16);
    const f32x4 a = p[0], b = p[1], c = p[2], d = p[3];
    const float s = (((a[0] + a[1]) + (a[2] + a[3])) + ((b[0] + b[1]) + (b[2] + b[3]))) + (((c[0] + c[1]) + (c[2] + c[3])) + ((d[0] + d[1]) + (d[2] + d[3])));
    return __builtin_amdgcn_rsqf(s * (1.0f / DMODEL) + RMS_EPS);
}
__device__ __forceinline__ float sumsq8(const f32x4 a, const f32x4 b) { return ((a[0] * a[0] + a[1] * a[1]) + (a[2] * a[2] + a[3] * a[3])) + ((b[0] * b[0] + b[1] * b[1]) + (b[2] * b[2] + b[3] * b[3])); }

struct EpiPlain {
    static constexpr bool PERM = true, AFTER_DRAIN = false;
    bf16_t* O; int ldc;
    __device__ __forceinline__ void operator()(const f32x4 (&acc)[2][2][4][2], const Unit& u, int wr, int wc, int fr, int fq) const {
        const int row0 = u.pm * BM + wr * 64 + fr, col0 = u.pn * BM + wc * 32 + 8 * fq;
#pragma unroll
        for (int ai = 0; ai < 2; ++ai)
#pragma unroll
            for (int m = 0; m < 4; ++m) { bf16_t* rowp = O + (size_t)(row0 + ai * HALF + m * 16) * ldc + col0;
#pragma unroll
                for (int bj = 0; bj < 2; ++bj) *(u32x4*)(rowp + bj * HALF) = pack8(acc[ai][bj][m][0], acc[ai][bj][m][1]); }
    }
};
__device__ __forceinline__ void row_rs8(float (&rs)[8], const float* ssq, int row0, int fq) {
    f32x4 p[8];
#pragma unroll
    for (int i = 0; i < 8; ++i) p[i] = *(const f32x4*)(ssq + (size_t)(row0 + (i >> 2) * HALF + (i & 3) * 16) * 16 + 4 * fq);
#pragma unroll
    for (int i = 0; i < 8; ++i) { float s = (p[i][0] + p[i][1]) + (p[i][2] + p[i][3]); s += __shfl_xor(s, 16); s += __shfl_xor(s, 32); rs[i] = __builtin_amdgcn_rsqf(s * (1.0f / DMODEL) + RMS_EPS); }
}
struct EpiIn {
    static constexpr bool PERM = true, AFTER_DRAIN = false;
    bf16_t* O; int ldc; const float* ssq; const int* pos; float qscale;
    __device__ __forceinline__ void operator()(const f32x4 (&acc)[2][2][4][2], const Unit& u, int wr, int wc, int fr, int fq) const {
        const int row0 = u.pm * BM + wr * 64 + fr, col0 = u.pn * BM + wc * 32 + 8 * fq;
        const bool rope = (u.pn < 4) && !(wc & 1);
        const float sc = (u.pn < 2) ? qscale : 1.f;
        float rs[8]; row_rs8(rs, ssq, row0, fq);
        if (rope) {
            int ps[8];
#pragma unroll
            for (int i = 0; i < 8; ++i) ps[i] = pos[row0 + (i >> 2) * HALF + (i & 3) * 16];
            const bool mine = fq < 2; const float sgn = (fq == 0) ? -1.f : 1.f;
            const float invf[8] = {1.0f, 0.1939227432012558f, 0.03760603070259094f, 0.007292664609849453f, 0.0014142135623842478f, 0.00027424818836152554f, 5.3182957344688475e-05f, 1.0313385246263351e-05f};
#pragma unroll
            for (int ai = 0; ai < 2; ++ai)
#pragma unroll
                for (int m = 0; m < 4; ++m) { const int row = row0 + ai * HALF + m * 16; const float r = rs[ai * 4 + m] * sc; const float pf = (float)ps[ai * 4 + m];
                    bf16_t* rowp = O + (size_t)row * ldc + col0;
                    float c[8], sn[8];
#pragma unroll
                    for (int e = 0; e < 8; ++e) { const float rev = __builtin_amdgcn_fractf((pf * invf[e]) * 0.15915494309189535f); c[e] = mine ? __builtin_amdgcn_cosf(rev) : 1.f; sn[e] = mine ? __builtin_amdgcn_sinf(rev) * sgn : 0.f; }
#pragma unroll
                    for (int bj = 0; bj < 2; ++bj) { f32x4 v0 = acc[ai][bj][m][0] * r, v1 = acc[ai][bj][m][1] * r; f32x4 p0, p1;
#pragma unroll
                        for (int e = 0; e < 4; ++e) { p0[e] = __shfl_xor(v0[e], 16); p1[e] = __shfl_xor(v1[e], 16); }
#pragma unroll
                        for (int e = 0; e < 4; ++e) { v0[e] = v0[e] * c[e] + p0[e] * sn[e]; v1[e] = v1[e] * c[4 + e] + p1[e] * sn[4 + e]; }
                        *(u32x4*)(rowp + bj * HALF) = pack8(v0, v1); } }
        } else {
#pragma unroll
            for (int ai = 0; ai < 2; ++ai)
#pragma unroll
                for (int m = 0; m < 4; ++m) { const int row = row0 + ai * HALF + m * 16; const float r = rs[ai * 4 + m] * sc;
                    bf16_t* rowp = O + (size_t)row * ldc + col0;
#pragma unroll
                    for (int bj = 0; bj < 2; ++bj) *(u32x4*)(rowp + bj * HALF) = pack8(acc[ai][bj][m][0] * r, acc[ai][bj][m][1] * r); }
        }
    }
};
__device__ __forceinline__ void unpack8(const u32x4 w, f32x4& a, f32x4& b) { a = (f32x4){bf_lo(w.x), bf_hi(w.x), bf_lo(w.y), bf_hi(w.y)}; b = (f32x4){bf_lo(w.z), bf_hi(w.z), bf_lo(w.w), bf_hi(w.w)}; }
struct EpiRes {
    static constexpr bool PERM = true, AFTER_DRAIN = false;
    const bf16_t* Rin; bf16_t* XBo; float* ssq;
    __device__ __forceinline__ void operator()(const f32x4 (&acc)[2][2][4][2], const Unit& u, int wr, int wc, int fr, int fq) const {
        const int row0 = u.pm * BM + wr * 64 + fr, col0 = u.pn * BM + wc * 32 + 8 * fq;
        u32x4 rv[8][2];
#pragma unroll
        for (int i = 0; i < 8; ++i)
#pragma unroll
            for (int bj = 0; bj < 2; ++bj) rv[i][bj] = *(const u32x4*)(Rin + (size_t)(row0 + (i >> 2) * HALF + (i & 3) * 16) * DMODEL + col0 + bj * HALF);
#pragma unroll
        for (int ai = 0; ai < 2; ++ai)
#pragma unroll
            for (int m = 0; m < 4; ++m) { const int row = row0 + ai * HALF + m * 16; float part = 0.f;
#pragma unroll
                for (int bj = 0; bj < 2; ++bj) { f32x4 r0, r1; unpack8(rv[ai * 4 + m][bj], r0, r1);
                    const f32x4 h0 = r0 + acc[ai][bj][m][0], h1 = r1 + acc[ai][bj][m][1]; part += sumsq8(h0, h1);
                    *(u32x4*)(XBo + (size_t)row * DMODEL + col0 + bj * HALF) = pack8(h0, h1); }
                part += __shfl_xor(part, 16); part += __shfl_xor(part, 32);
                if (fq == 0) ssq[(size_t)row * 16 + u.pn * 4 + wc] = part; }
    }
};
struct EpiMlpIn {
    static constexpr bool PERM = true, AFTER_DRAIN = false;
    bf16_t* O; int ldc; const float* ssq;
    __device__ __forceinline__ void operator()(const f32x4 (&acc)[2][2][4][2], const Unit& u, int wr, int wc, int fr, int fq) const {
        const int row0 = u.pm * BM + wr * 64 + fr, col0 = u.pn * BM + wc * 32 + 8 * fq;
        float rs[8]; row_rs8(rs, ssq, row0, fq);
#pragma unroll
        for (int ai = 0; ai < 2; ++ai)
#pragma unroll
            for (int m = 0; m < 4; ++m) { const int row = row0 + ai * HALF + m * 16; const float r = rs[ai * 4 + m];
                bf16_t* rowp = O + (size_t)row * ldc + col0;
#pragma unroll
                for (int bj = 0; bj < 2; ++bj) { f32x4 v0 = acc[ai][bj][m][0] * r, v1 = acc[ai][bj][m][1] * r;
#pragma unroll
                    for (int e = 0; e < 4; ++e) { const float a = fmaxf(v0[e], 0.f), b = fmaxf(v1[e], 0.f); v0[e] = a * a; v1[e] = b * b; }
                    *(u32x4*)(rowp + bj * HALF) = pack8(v0, v1); } }
    }
};
struct EpiPle {
    static constexpr bool PERM = true, AFTER_DRAIN = false;
    const bf16_t* Rin; bf16_t* XBo; const float* ssq_in; float* ssq_out; const bf16_t* PP;
    __device__ __forceinline__ void operator()(const f32x4 (&acc)[2][2][4][2], const Unit& u, int wr, int wc, int fr, int fq) const {
        const int row0 = u.pm * BM + wr * 64 + fr, col0 = u.pn * BM + wc * 32 + 8 * fq;
#pragma unroll
        for (int ai = 0; ai < 2; ++ai)
#pragma unroll
          for (int mh = 0; mh < 2; ++mh) {
            u32x4 rv[2][2], pw[2][2]; f32x4 p[2];
#pragma unroll
            for (int mm = 0; mm < 2; ++mm) { const int rowl = row0 + ai * HALF + (2 * mh + mm) * 16; p[mm] = *(const f32x4*)(ssq_in + (size_t)rowl * 16 + 4 * fq);
#pragma unroll
                for (int bj = 0; bj < 2; ++bj) { const size_t off = (size_t)rowl * DMODEL + col0 + bj * HALF; rv[mm][bj] = *(const u32x4*)(Rin + off); pw[mm][bj] = *(const u32x4*)(PP + off); } }
#pragma unroll
            for (int mm = 0; mm < 2; ++mm) { const int m = 2 * mh + mm; const int row = row0 + ai * HALF + m * 16; float part = 0.f;
                float sr = (p[mm][0] + p[mm][1]) + (p[mm][2] + p[mm][3]); sr += __shfl_xor(sr, 16); sr += __shfl_xor(sr, 32); const float r = __builtin_amdgcn_rsqf(sr * (1.0f / DMODEL) + RMS_EPS);
#pragma unroll
                for (int bj = 0; bj < 2; ++bj) { f32x4 r0, r1, p0, p1; unpack8(rv[mm][bj], r0, r1); unpack8(pw[mm][bj], p0, p1);
                    f32x4 g0 = acc[ai][bj][m][0] * r, g1 = acc[ai][bj][m][1] * r;
#pragma unroll
                    for (int e = 0; e < 4; ++e) { g0[e] = __builtin_amdgcn_rcpf(1.f + __builtin_amdgcn_exp2f(-1.4426950408889634f * g0[e])); g1[e] = __builtin_amdgcn_rcpf(1.f + __builtin_amdgcn_exp2f(-1.4426950408889634f * g1[e])); }
                    const f32x4 h0 = r0 + g0 * p0, h1 = r1 + g1 * p1; part += sumsq8(h0, h1);
                    *(u32x4*)(XBo + (size_t)row * DMODEL + col0 + bj * HALF) = pack8(h0, h1); }
                part += __shfl_xor(part, 16); part += __shfl_xor(part, 32);
                if (fq == 0) ssq_out[(size_t)row * 16 + u.pn * 4 + wc] = part; }
            asm volatile("" ::: "memory"); }
    }
};

template <class Epi, class Sched, bool ALIGN_EPI = false, bool SP2 = false>
__device__ __forceinline__ void gemm_phase(PG8_LAS unsigned char* lds, const Gemm g, const Sched& S, const Epi& E) {
    const int tid = tid_opaque(), wid = __builtin_amdgcn_readfirstlane(tid >> 6), lane = tid & 63, wr = wid >> 2, wc = wid & 3, fr = lane & 15, fq = lane >> 4;
    const int K = g.K, nt = K / BK;
    unsigned voffA[2], voffB[2];
#pragma unroll
    for (int i = 0; i < 2; ++i) { int R, C; stage_rc(tid * 16 + i * 8192, R, C); const int Rb = Epi::PERM ? ((R & ~31) + perm32(R & 31)) : R;
        voffA[i] = (unsigned)(R * K + C) * 2u; voffB[i] = (unsigned)(Rb * K + C) * 2u; }
    const size_t kstep = (size_t)(BK * 2);
    const size_t hstep = (size_t)HALF * K * 2;
    const size_t tstep = 2 * hstep;
    const unsigned ldsw = (unsigned)wid * 1024u;
    const int aoff = lds_byte(wr * 64 + fr, fq * 8), boff = lds_byte(wc * 32 + fr, fq * 8);
#define PG8_SA(b, h) (((b) * 2 + (h)) * HTB)
#define PG8_SB(b, h) ((4 + (b) * 2 + (h)) * HTB)
#define PG8_STAGE(bufoff, gbase, voff) do { _Pragma("unroll") for (int _i = 0; _i < 2; ++_i) \
        __builtin_amdgcn_global_load_lds((const unsigned*)((const char*)(gbase) + (voff)[_i]), (PG8_LAS unsigned*)(lds + (bufoff) + ldsw + _i * 8192), 16, 0, 0); } while (0)
#define PG8_LDA(dst, b, h) do { _Pragma("unroll") for (int m = 0; m < 4; ++m) _Pragma("unroll") for (int k = 0; k < 2; ++k) dst[m][k] = *(const PG8_LAS bf16x8*)(lds + PG8_SA(b, h) + aoff + m * 2048 + k * 1024); } while (0)
#define PG8_LDB(dst, b, h) do { _Pragma("unroll") for (int n = 0; n < 2; ++n) _Pragma("unroll") for (int k = 0; k < 2; ++k) dst[n][k] = *(const PG8_LAS bf16x8*)(lds + PG8_SB(b, h) + boff + n * 2048 + k * 1024); } while (0)
#define PG8_MMA(ai, bj, At, Bt) do { __builtin_amdgcn_s_setprio(1); _Pragma("unroll") for (int m = 0; m < 4; ++m) _Pragma("unroll") for (int n = 0; n < 2; ++n) _Pragma("unroll") for (int k = 0; k < 2; ++k) \
        acc[ai][bj][m][n] = __builtin_amdgcn_mfma_f32_16x16x32_bf16(Bt[n][k], At[m][k], acc[ai][bj][m][n], 0, 0, 0); __builtin_amdgcn_s_setprio(0); } while (0)
#define PG8_WAIT_V(n) asm volatile("s_waitcnt vmcnt(" #n ")" ::: "memory")
#define PG8_WAIT_L(n) asm volatile("s_waitcnt lgkmcnt(" #n ")" ::: "memory")
#define PG8_BAR __builtin_amdgcn_s_barrier()
#define PG8_SCHED __builtin_amdgcn_sched_barrier(0)
    Unit cur, nxt; int ui = 0;
    if (!S.next(0, cur)) return;
    f32x4 acc[2][2][4][2];
#pragma unroll
    for (int a = 0; a < 2; ++a)
#pragma unroll
        for (int b = 0; b < 2; ++b)
#pragma unroll
            for (int m = 0; m < 4; ++m)
#pragma unroll
                for (int n = 0; n < 2; ++n) acc[a][b][m][n] = (f32x4){0.f, 0.f, 0.f, 0.f};
    bf16x8 At[4][2], B0[2][2], B1[2][2];
    const char* cA = (const char*)g.A + (size_t)cur.pm * tstep; const char* cB = (const char*)g.Bt + (size_t)cur.pn * tstep;
    S.a_ready(cur);
    if constexpr (SP2) {
        PG8_STAGE(PG8_SB(0, 0), cB, voffB); PG8_STAGE(PG8_SB(0, 1), cB + hstep, voffB); PG8_STAGE(PG8_SA(0, 0), cA, voffA); PG8_STAGE(PG8_SA(0, 1), cA + hstep, voffA);
        if (wr == 1) PG8_BAR;
        PG8_WAIT_V(2); PG8_BAR;
        PG8_STAGE(PG8_SB(1, 0), cB + kstep, voffB); PG8_STAGE(PG8_SA(1, 0), cA + kstep, voffA); PG8_STAGE(PG8_SB(1, 1), cB + hstep + kstep, voffB);
        PG8_WAIT_V(6); PG8_BAR;
    } else {
        PG8_STAGE(PG8_SB(0, 0), cB, voffB); PG8_STAGE(PG8_SA(0, 0), cA, voffA); PG8_STAGE(PG8_SB(0, 1), cB + hstep, voffB); PG8_STAGE(PG8_SA(0, 1), cA + hstep, voffA);
        if (wr == 1) PG8_BAR;
        PG8_WAIT_V(4); PG8_BAR;
        PG8_STAGE(PG8_SB(1, 0), cB + kstep, voffB); PG8_STAGE(PG8_SA(1, 0), cA + kstep, voffA); PG8_STAGE(PG8_SB(1, 1), cB + hstep + kstep, voffB);
        PG8_WAIT_V(6); PG8_BAR;
    }
    for (;;) {
        const bool has_next = S.next(ui + 1, nxt);
        const char* nA = has_next ? (const char*)g.A + (size_t)nxt.pm * tstep : cA; const char* nB = has_next ? (const char*)g.Bt + (size_t)nxt.pn * tstep : cB;
        for (int t = 0; t < nt; t += 2) {
            const bool last = (t == nt - 2);
            const char* a1 = cA + (size_t)(t + 1) * kstep;
            const char* a2 = last ? nA : cA + (size_t)(t + 2) * kstep; const char* b2 = last ? nB : cB + (size_t)(t + 2) * kstep;
            const char* a3 = a2 + kstep; const char* b3 = b2 + kstep;
            if (last && has_next) S.a_ready(nxt);
            if constexpr (SP2) {
            PG8_LDB(B0, 0, 0); PG8_LDB(B1, 0, 1); PG8_SCHED; PG8_LDA(At, 0, 0); PG8_STAGE(PG8_SA(1, 1), a1 + hstep, voffA);
            PG8_WAIT_V(8); PG8_WAIT_L(0); PG8_BAR; PG8_MMA(0, 0, At, B0); PG8_MMA(0, 1, At, B1); PG8_BAR; PG8_SCHED;
            PG8_LDA(At, 0, 1); PG8_STAGE(PG8_SB(0, 0), b2, voffB); PG8_STAGE(PG8_SB(0, 1), b2 + hstep, voffB); PG8_STAGE(PG8_SA(0, 0), a2, voffA);
            PG8_WAIT_V(8); PG8_WAIT_L(0); PG8_BAR; PG8_MMA(1, 0, At, B0); PG8_MMA(1, 1, At, B1); PG8_BAR; PG8_SCHED;
            PG8_LDB(B0, 1, 0); PG8_LDB(B1, 1, 1); PG8_SCHED; PG8_LDA(At, 1, 0); PG8_STAGE(PG8_SA(0, 1), a2 + hstep, voffA);
            PG8_WAIT_V(8); PG8_WAIT_L(0); PG8_BAR; PG8_MMA(0, 0, At, B0); PG8_MMA(0, 1, At, B1); PG8_BAR; PG8_SCHED;
            PG8_LDA(At, 1, 1); PG8_STAGE(PG8_SB(1, 0), b3, voffB); PG8_STAGE(PG8_SB(1, 1), b3 + hstep, voffB); PG8_STAGE(PG8_SA(1, 0), a3, voffA);
            PG8_WAIT_V(8); PG8_WAIT_L(0); PG8_BAR; PG8_MMA(1, 0, At, B0); PG8_MMA(1, 1, At, B1); PG8_BAR; PG8_SCHED;
            } else {
            PG8_LDB(B0, 0, 0); PG8_SCHED; PG8_LDA(At, 0, 0); PG8_STAGE(PG8_SA(1, 1), a1 + hstep, voffA);
            PG8_WAIT_L(8); PG8_BAR; PG8_WAIT_L(0); PG8_MMA(0, 0, At, B0); PG8_BAR; PG8_SCHED;
            PG8_LDB(B1, 0, 1); PG8_STAGE(PG8_SB(0, 0), b2, voffB);
            PG8_BAR; PG8_WAIT_L(0); PG8_MMA(0, 1, At, B1); PG8_BAR;
            PG8_LDA(At, 0, 1); PG8_STAGE(PG8_SA(0, 0), a2, voffA);
            PG8_BAR; PG8_WAIT_L(0); PG8_MMA(1, 0, At, B0); PG8_BAR; PG8_SCHED;
            PG8_STAGE(PG8_SB(0, 1), b2 + hstep, voffB);
            PG8_WAIT_V(6); PG8_BAR; PG8_MMA(1, 1, At, B1); PG8_BAR;
            PG8_LDB(B0, 1, 0); PG8_SCHED; PG8_LDA(At, 1, 0); PG8_STAGE(PG8_SA(0, 1), a2 + hstep, voffA);
            PG8_WAIT_L(8); PG8_BAR; PG8_WAIT_L(0); PG8_MMA(0, 0, At, B0); PG8_BAR; PG8_SCHED;
            PG8_LDB(B1, 1, 1); PG8_STAGE(PG8_SB(1, 0), b3, voffB);
            PG8_BAR; PG8_WAIT_L(0); PG8_MMA(0, 1, At, B1); PG8_BAR;
            PG8_LDA(At, 1, 1); PG8_STAGE(PG8_SA(1, 0), a3, voffA);
            PG8_BAR; PG8_WAIT_L(0); PG8_MMA(1, 0, At, B0); PG8_BAR; PG8_SCHED;
            PG8_STAGE(PG8_SB(1, 1), b3 + hstep, voffB);
            PG8_WAIT_V(6); PG8_BAR; PG8_MMA(1, 1, At, B1); PG8_BAR;
            }
        }
        if constexpr (ALIGN_EPI) { if (wr == 0) PG8_BAR; }
        if constexpr (!Epi::AFTER_DRAIN) { const int t2 = tid_opaque(), w2 = __builtin_amdgcn_readfirstlane(t2 >> 6), l2 = t2 & 63;
            E(acc, cur, w2 >> 2, w2 & 3, l2 & 15, l2 >> 4); S.done(cur); }
        if (!has_next) break;
#pragma unroll
        for (int a = 0; a < 2; ++a)
#pragma unroll
            for (int b = 0; b < 2; ++b)
#pragma unroll
                for (int m = 0; m < 4; ++m)
#pragma unroll
                    for (int n = 0; n < 2; ++n) acc[a][b][m][n] = (f32x4){0.f, 0.f, 0.f, 0.f};
        cur = nxt; cA = nA; cB = nB; ++ui;
        if constexpr (ALIGN_EPI) { if (wr == 1) PG8_BAR; }
    }
    PG8_WAIT_V(0);
    if constexpr (!ALIGN_EPI) { if (wr == 0) PG8_BAR; }
    PG8_BAR;
    if constexpr (Epi::AFTER_DRAIN) { E.fused(acc, cur, wr, wc, fr, fq, lds, wid, lane); S.done(cur); }
#undef PG8_SA
#undef PG8_SB
#undef PG8_STAGE
#undef PG8_LDA
#undef PG8_LDB
#undef PG8_MMA
#undef PG8_WAIT_V
#undef PG8_WAIT_L
#undef PG8_BAR
#undef PG8_SCHED
}
}
#ifndef PG8_SP2
#define PG8_SP2 true
#endif
#include <hip/hip_bf16.h>
#include <cmath>
namespace attn_body {
using bf16=__hip_bfloat16;
using bf16x8=__attribute__((ext_vector_type(8)))short;
using s16x4=__attribute__((ext_vector_type(4)))short;
using f32x16=__attribute__((ext_vector_type(16)))float;
using u32x4=__attribute__((ext_vector_type(4)))unsigned;
constexpr int D=64,PQ=2560,PO=1024;
constexpr int NW=8,QBLK=32,QB=QBLK*NW,KVBLK=64;
constexpr int ATTN_UNIT_ROWS=QB;
__device__ __forceinline__ int crow(int r,int hi){return (r&3)+8*(r>>2)+4*hi;}
#define SBAR() __builtin_amdgcn_sched_barrier(0)
__device__ __forceinline__ void cmask(f32x16&p0,f32x16&p1,int jb,int qrel,int hi){
  const float NEG=-INFINITY; int kb=64*jb+4*hi;
  #pragma unroll
  for(int r=0;r<16;++r){int kv=kb+(r&3)+8*(r>>2); if(kv>qrel)p0[r]=NEG; if(kv+32>qrel)p1[r]=NEG;}
}

constexpr int NSLOT=3, SLOTB=8192;
constexpr int LDS_K=0, LDS_V=NSLOT*SLOTB, LDS_WS=2*NSLOT*SLOTB, LDS_OST=LDS_WS+NW*64*4, LDS_BYTES=LDS_OST+NW*4096;
constexpr float C2=0.125f*1.4426950408889634f;
__device__ __forceinline__ void glds16(const void*gsrc,unsigned lds_dst){unsigned keep;
  asm volatile("s_mov_b32 %0, m0\n\ts_mov_b32 m0, %2\n\ts_nop 0\n\tglobal_load_lds_dwordx4 %1, off\n\ts_mov_b32 m0, %0":"=&s"(keep):"v"(gsrc),"s"(lds_dst):"memory");}
__device__ __forceinline__ float max3f(float a,float b,float c){float r;asm("v_max3_f32 %0, %1, %2, %3":"=v"(r):"v"(a),"v"(b),"v"(c));return r;}
__device__ __forceinline__ float max2f(float a,float b){float r;asm("v_max_f32_e32 %0, %1, %2":"=v"(r):"v"(a),"v"(b));return r;}
__device__ __forceinline__ float fadd_s(float a,float b){float r;asm("v_add_f32_e32 %0, %1, %2":"=v"(r):"v"(a),"v"(b));return r;}
__device__ __forceinline__ float fsub_s(float a,float b){float r;asm("v_sub_f32_e32 %0, %1, %2":"=v"(r):"v"(a),"v"(b));return r;}
typedef float f32x2_t __attribute__((ext_vector_type(2))); typedef __bf16 bf16x2_t __attribute__((ext_vector_type(2)));
__device__ __forceinline__ unsigned cvtpk_s(float lo,float hi){f32x2_t v={lo,hi};bf16x2_t b=__builtin_convertvector(v,bf16x2_t);return __builtin_bit_cast(unsigned,b);}
#define WAIT_BAR(N) asm volatile("s_waitcnt vmcnt(" #N ") lgkmcnt(0)\n\ts_barrier":::"memory")

__device__ __forceinline__ void qkt(f32x16&p0,f32x16&p1,const char*Kslot,const bf16x8*qr,const f32x16&negm,int r32,int hi){
  const char*kb=Kslot+hi*1024+r32*16;
  #pragma unroll
  for(int d0=0;d0<4;++d0){
    const bf16x8 b0=*reinterpret_cast<const bf16x8*>(kb+d0*2048);
    const bf16x8 b1=*reinterpret_cast<const bf16x8*>(kb+d0*2048+512);
    if(d0==0){p0=__builtin_amdgcn_mfma_f32_32x32x16_bf16(b0,qr[0],negm,0,0,0);p1=__builtin_amdgcn_mfma_f32_32x32x16_bf16(b1,qr[0],negm,0,0,0);}
    else{p0=__builtin_amdgcn_mfma_f32_32x32x16_bf16(b0,qr[d0],p0,0,0,0);p1=__builtin_amdgcn_mfma_f32_32x32x16_bf16(b1,qr[d0],p1,0,0,0);}}
}
typedef __attribute__((address_space(3))) const char* lds_cptr;
typedef short v4i16_t __attribute__((ext_vector_type(4)));
__device__ __forceinline__ void kload8(bf16x8*kf,lds_cptr kp){
  kf[0]=*(const __attribute__((address_space(3))) bf16x8*)(kp);      kf[1]=*(const __attribute__((address_space(3))) bf16x8*)(kp+512);
  kf[2]=*(const __attribute__((address_space(3))) bf16x8*)(kp+2048); kf[3]=*(const __attribute__((address_space(3))) bf16x8*)(kp+2560);
  kf[4]=*(const __attribute__((address_space(3))) bf16x8*)(kp+4096); kf[5]=*(const __attribute__((address_space(3))) bf16x8*)(kp+4608);
  kf[6]=*(const __attribute__((address_space(3))) bf16x8*)(kp+6144); kf[7]=*(const __attribute__((address_space(3))) bf16x8*)(kp+6656);
}
__device__ __forceinline__ void kload2(bf16x8*kf,lds_cptr kp,int j){ kf[2*j]=*(const __attribute__((address_space(3))) bf16x8*)(kp+j*2048); kf[2*j+1]=*(const __attribute__((address_space(3))) bf16x8*)(kp+j*2048+512); }
__device__ __forceinline__ s16x4 vtr(lds_cptr p){ return __builtin_bit_cast(s16x4,__builtin_amdgcn_ds_read_tr16_b64_v4i16((__attribute__((address_space(3))) v4i16_t*)p)); }
__device__ __forceinline__ float rowmax(const f32x16&p0,const f32x16&p1){
  float a=max3f(p0[0],p0[1],p1[0]),b=max3f(p0[2],p0[3],p1[1]);a=max3f(a,p1[2],p1[3]);
  #pragma unroll
  for(int r=4;r<16;r+=4){a=max3f(a,p0[r],p0[r+1]);b=max3f(b,p0[r+2],p0[r+3]);a=max3f(a,p1[r],p1[r+1]);b=max3f(b,p1[r+2],p1[r+3]);}
  const float m=max2f(a,b);
  auto rr=__builtin_amdgcn_permlane32_swap(__float_as_uint(m),__float_as_uint(m),false,false);
  return max2f(__uint_as_float(rr[0]),__uint_as_float(rr[1]));
}
__device__ __forceinline__ void pv(f32x16*o,int vb,bf16x8 pa0,bf16x8 pa1,bf16x8 pa2,bf16x8 pa3){
  #pragma unroll
  for(int d0=0;d0<2;++d0){s16x4 lo[4],hi[4];
    #pragma unroll
    for(int ks=0;ks<4;++ks){
      asm volatile("ds_read_b64_tr_b16 %0,%1 offset:%c2":"=&v"(lo[ks]):"v"(vb),"i"(d0*4096+ks*1024):"memory");
      asm volatile("ds_read_b64_tr_b16 %0,%1 offset:%c2":"=&v"(hi[ks]):"v"(vb),"i"(d0*4096+ks*1024+512):"memory");}
    asm volatile("s_waitcnt lgkmcnt(0)":::"memory");SBAR();
    #define PK(k) (bf16x8){lo[k][0],lo[k][1],lo[k][2],lo[k][3],hi[k][0],hi[k][1],hi[k][2],hi[k][3]}
    o[d0]=__builtin_amdgcn_mfma_f32_32x32x16_bf16(pa0,PK(0),o[d0],0,0,0);
    o[d0]=__builtin_amdgcn_mfma_f32_32x32x16_bf16(pa1,PK(1),o[d0],0,0,0);
    o[d0]=__builtin_amdgcn_mfma_f32_32x32x16_bf16(pa2,PK(2),o[d0],0,0,0);
    o[d0]=__builtin_amdgcn_mfma_f32_32x32x16_bf16(pa3,PK(3),o[d0],0,0,0);
    #undef PK
  }
}

#ifndef ATTN_STORE16
#define ATTN_STORE16(p,v) (*(u32x4*)(p)=(v))
#endif
template<int THRL> __device__ __forceinline__ void attn_unit(int qb,const bf16*Qh,const bf16*__restrict__ Kh,const bf16*__restrict__ Vh,bf16*Oh,char*shm){
  const int tid=tid_opaque(),lane=tid&63,r32=lane&31,hi=lane>>5; const int wid=__builtin_amdgcn_readfirstlane(tid>>6);
  const int q0=qb*QB;
  const bf16*Qw=Qh+(long)(q0+wid*QBLK)*PQ;
  const unsigned lds0=(unsigned)(uintptr_t)shm;
  float*wsf=(float*)(shm+LDS_WS)+wid*64;
  const bf16*ksrc=Kh+(long)lane*PQ+wid*8;
  const bf16*vsrc=Vh+(long)(16*(wid&3)+(lane>>2))*PQ+(wid>>2)*32+(lane&3)*8;
  const unsigned kdst=lds0+LDS_K+wid*1024, vdst=lds0+LDS_V+wid*1024;
  #define DMA_K(t,slot) glds16(ksrc+(long)(t)*KVBLK*PQ,(unsigned)__builtin_amdgcn_readfirstlane(kdst+(slot)))
  #define DMA_V(t,slot) glds16(vsrc+(long)(t)*KVBLK*PQ,(unsigned)__builtin_amdgcn_readfirstlane(vdst+(slot)))
  const int vb0=(int)(lds0+LDS_V)+((lane>>4)&1)*32+(lane&3)*8+(4*hi+((lane&15)>>2))*64;
  const char*Kbase=shm+LDS_K; bf16x8 kf[8];
  const lds_cptr shm3=(lds_cptr)shm; const lds_cptr kp0=shm3+LDS_K+hi*1024+r32*16; const lds_cptr vp0=shm3+LDS_V+((lane>>4)&1)*32+(lane&3)*8+(4*hi+((lane&15)>>2))*64;
  const int NT=(q0+QB)/KVBLK;
  DMA_K(0,0);DMA_V(0,0);DMA_K(1,SLOTB);
  bf16x8 qr[4];
  #pragma unroll
  for(int d0=0;d0<4;++d0)qr[d0]=*reinterpret_cast<const bf16x8*>(&Qw[(long)r32*PQ+d0*16+hi*8]);
  float mhat=0.f,l_reg=0.f;f32x16 o[2];o[0]=f32x16{};o[1]=f32x16{};f32x16 negm=f32x16{};asm volatile("":"+v"(negm));
  const int qrel=wid*QBLK+r32;
  #define CMASK(P0,P1,t) do{int jb_=(t)-(NT-4); if(jb_>=0)cmask(P0,P1,jb_,qrel,hi);}while(0)
  bool resc=false;
  #define START(P0,P1) do{ const float rm=rowmax(P0,P1); resc=false; \
    { const float dl=rm; mhat=fadd_s(mhat,dl); \
      _Pragma("unroll") for(int r=0;r<16;++r){P0[r]=fsub_s(P0[r],dl);P1[r]=fsub_s(P1[r],dl);} \
      _Pragma("unroll") for(int r=0;r<16;++r)negm[r]=-mhat; asm volatile("":"+v"(negm)); } \
    _Pragma("unroll") for(int r=0;r<16;++r)P0[r]=__builtin_amdgcn_exp2f(P0[r]); }while(0)
  #define RESC() do{ if(resc){ asm volatile("s_waitcnt lgkmcnt(0)":::"memory"); \
      _Pragma("unroll") for(int d_=0;d_<2;++d_) _Pragma("unroll") for(int r=0;r<16;++r)o[d_][r]*=wsf[crow(r,hi)]; } }while(0)
  f32x16 pA0,pA1,pB0,pB1;
  int sl_prev=0,sl_cur=0,sl_next=SLOTB;
  #define ROT() do{sl_prev=sl_cur;sl_cur=sl_next;sl_next=(sl_next==(NSLOT-1)*SLOTB)?0:sl_next+SLOTB;}while(0)
  DMA_K(2,2*SLOTB);
  WAIT_BAR(3);
  qkt(pA0,pA1,Kbase,qr,negm,r32,hi);asm volatile("s_nop 15\n\ts_nop 7":"+v"(pA0),"+v"(pA1));CMASK(pA0,pA1,0);
  START(pA0,pA1);
  _Pragma("unroll") for(int r=0;r<16;++r)pA1[r]=__builtin_amdgcn_exp2f(pA1[r]);
  WAIT_BAR(0);
  DMA_K(3,0);DMA_V(1,SLOTB);
  ROT();
  kload8(kf,kp0+sl_cur);
  WAIT_BAR(2);
  s16x4 vlo[8],vhi[8]; u32x4 pw0,pw1,pw2,pw3;
  #define PKW(P,B) cvtpk_s(P[B],P[B+1])
  #define PAF(k) __builtin_bit_cast(bf16x8,pw##k)
  #define VFR(i) (bf16x8){vlo[i][0],vlo[i][1],vlo[i][2],vlo[i][3],vhi[i][0],vhi[i][1],vhi[i][2],vhi[i][3]}
  #define PIN(x) asm volatile("":"+v"(x))
  #define MX3(a,b,c) __builtin_fmaxf(__builtin_fmaxf((a),(b)),(c))
  #define GAPA(MF,A0,A1,A2,A3,W0,W1,PW) do{ MF; sacc+=A0; sacc+=A1; sacc+=A2; sacc+=A3; PIN(sacc); W0; W1; PIN(PW); SBAR(); }while(0)
  #define EX(v) __builtin_amdgcn_exp2f(v)
  #define GAPB(MF,X,B) do{ MF; X[B]=EX(X[B]); X[B+1]=EX(X[B+1]); X[B+2]=EX(X[B+2]); X[B+3]=EX(X[B+3]); PIN(X); SBAR(); }while(0)
  #define VRD(i) do{ vlo[i]=vtr(vp_+(((i)>>2)*4096+((i)&3)*1024)); vhi[i]=vtr(vp_+(((i)>>2)*4096+((i)&3)*1024+512)); }while(0)
  #define KRD(G,j) do{ if(G){ kload2(kf,kp0+sl_next,j); SBAR(); } }while(0)
  #define STEP(C0,C1,P0,P1,t,GK,GV,GL) do{ SBAR(); \
    const lds_cptr vp_=vp0+sl_prev; \
    VRD(0); SBAR(); float sacc=(P0[0]+P0[1]); \
    GAPA(C0=__builtin_amdgcn_mfma_f32_32x32x16_bf16(kf[0],qr[0],negm,0,0,0), P0[2],P0[3],P0[4],P0[5],     pw0[0]=PKW(P0,0), pw0[1]=PKW(P0,2), pw0); \
    VRD(4); SBAR(); GAPA(C1=__builtin_amdgcn_mfma_f32_32x32x16_bf16(kf[1],qr[0],negm,0,0,0), P0[6],P0[7],P0[8],P0[9],     pw0[2]=PKW(P0,4), pw0[3]=PKW(P0,6), pw0); \
    VRD(1); SBAR(); GAPA(C0=__builtin_amdgcn_mfma_f32_32x32x16_bf16(kf[2],qr[1],C0,0,0,0),   P0[10],P0[11],P0[12],P0[13], pw1[0]=PKW(P0,8), pw1[1]=PKW(P0,10), pw1); \
    VRD(5); SBAR(); GAPA(C1=__builtin_amdgcn_mfma_f32_32x32x16_bf16(kf[3],qr[1],C1,0,0,0),   P0[14],P0[15],P1[0],P1[1],   pw1[2]=PKW(P0,12),pw1[3]=PKW(P0,14), pw1); \
    VRD(2); SBAR(); GAPA(C0=__builtin_amdgcn_mfma_f32_32x32x16_bf16(kf[4],qr[2],C0,0,0,0),   P1[2],P1[3],P1[4],P1[5],     pw2[0]=PKW(P1,0), pw2[1]=PKW(P1,2), pw2); \
    VRD(6); SBAR(); GAPA(C1=__builtin_amdgcn_mfma_f32_32x32x16_bf16(kf[5],qr[2],C1,0,0,0),   P1[6],P1[7],P1[8],P1[9],     pw2[2]=PKW(P1,4), pw2[3]=PKW(P1,6), pw2); \
    VRD(3); SBAR(); GAPA(C0=__builtin_amdgcn_mfma_f32_32x32x16_bf16(kf[6],qr[3],C0,0,0,0),   P1[10],P1[11],P1[12],P1[13], pw3[0]=PKW(P1,8), pw3[1]=PKW(P1,10), pw3); \
    VRD(7); SBAR(); GAPA(C1=__builtin_amdgcn_mfma_f32_32x32x16_bf16(kf[7],qr[3],C1,0,0,0),   P1[14],P1[15],0.f,0.f,       pw3[2]=PKW(P1,12),pw3[3]=PKW(P1,14), pw3); \
    l_reg+=sacc; \
    if(GK){DMA_K((t)+3,sl_cur);} if(GV){DMA_V((t)+1,sl_next);} \
    CMASK(C0,C1,t); \
    { float a=MX3(C0[0],C0[1],C1[0]),b=MX3(C0[2],C0[3],C1[1]); a=MX3(a,C1[2],C1[3]); \
      _Pragma("unroll") for(int r=4;r<16;r+=4){a=MX3(a,C0[r],C0[r+1]);b=MX3(b,C0[r+2],C0[r+3]);a=MX3(a,C1[r],C1[r+1]);b=MX3(b,C1[r+2],C1[r+3]);} \
      float rm=__builtin_fmaxf(a,b); { auto rr=__builtin_amdgcn_permlane32_swap(__float_as_uint(rm),__float_as_uint(rm),false,false); rm=__builtin_fmaxf(__uint_as_float(rr[0]),__uint_as_float(rr[1])); } \
      resc=false; \
      if(__builtin_expect(__any(rm>(float)THRL),0)){ const float dl=__builtin_fmaxf(rm,0.f); mhat+=dl; \
        _Pragma("unroll") for(int r=0;r<16;++r){C0[r]-=dl;C1[r]-=dl;} \
        _Pragma("unroll") for(int r=0;r<16;++r)negm[r]=-mhat; asm volatile("":"+v"(negm)); \
        const float f=__builtin_amdgcn_exp2f(-dl); l_reg*=f; if(hi==0)wsf[r32]=f; resc=true; } } \
    SBAR(); \
    GAPB(o[0]=__builtin_amdgcn_mfma_f32_32x32x16_bf16(PAF(0),VFR(0),o[0],0,0,0), C0,0); \
    GAPB(o[1]=__builtin_amdgcn_mfma_f32_32x32x16_bf16(PAF(0),VFR(4),o[1],0,0,0), C0,4); \
    KRD(GL,0); GAPB(o[0]=__builtin_amdgcn_mfma_f32_32x32x16_bf16(PAF(1),VFR(1),o[0],0,0,0), C0,8); \
    KRD(GL,1); GAPB(o[1]=__builtin_amdgcn_mfma_f32_32x32x16_bf16(PAF(1),VFR(5),o[1],0,0,0), C0,12); \
    KRD(GL,2); GAPB(o[0]=__builtin_amdgcn_mfma_f32_32x32x16_bf16(PAF(2),VFR(2),o[0],0,0,0), C1,0); \
    KRD(GL,3); GAPB(o[1]=__builtin_amdgcn_mfma_f32_32x32x16_bf16(PAF(2),VFR(6),o[1],0,0,0), C1,4); \
    GAPB(o[0]=__builtin_amdgcn_mfma_f32_32x32x16_bf16(PAF(3),VFR(3),o[0],0,0,0), C1,8); \
    GAPB(o[1]=__builtin_amdgcn_mfma_f32_32x32x16_bf16(PAF(3),VFR(7),o[1],0,0,0), C1,12); \
    }while(0)
  int t=1;
  #undef CMASK
  #define CMASK(P0,P1,t) do{}while(0)
  for(;t+5<NT;t+=2){
    STEP(pB0,pB1,pA0,pA1,t,true,true,true);     WAIT_BAR(2); RESC(); ROT();
    STEP(pA0,pA1,pB0,pB1,t+1,true,true,true);   WAIT_BAR(2); RESC(); ROT();
  }
  #undef CMASK
  #define CMASK(P0,P1,t) do{int jb_=(t)-(NT-4); if(jb_>=0)cmask(P0,P1,jb_,qrel,hi);}while(0)
  #define ENDW(tt) do{ if((tt)+3<NT){WAIT_BAR(2);} else if((tt)+2<NT){WAIT_BAR(1);} else {WAIT_BAR(0);} }while(0)
  for(;t+1<NT;t+=2){
    STEP(pB0,pB1,pA0,pA1,t,(t+3<NT),(t+1<NT),(t+1<NT));       ENDW(t);   RESC(); ROT();
    STEP(pA0,pA1,pB0,pB1,t+1,(t+4<NT),(t+2<NT),(t+2<NT));     ENDW(t+1); RESC(); ROT();
  }
  STEP(pB0,pB1,pA0,pA1,NT-1,false,false,false); RESC();
  { float sacc=pB0[0]+pB0[1]; _Pragma("unroll") for(int r=2;r<16;++r)sacc+=pB0[r]; _Pragma("unroll") for(int r=0;r<16;++r)sacc+=pB1[r]; l_reg+=sacc;
    pw0=(u32x4){PKW(pB0,0),PKW(pB0,2),PKW(pB0,4),PKW(pB0,6)};pw1=(u32x4){PKW(pB0,8),PKW(pB0,10),PKW(pB0,12),PKW(pB0,14)};pw2=(u32x4){PKW(pB1,0),PKW(pB1,2),PKW(pB1,4),PKW(pB1,6)};pw3=(u32x4){PKW(pB1,8),PKW(pB1,10),PKW(pB1,12),PKW(pB1,14)};
    SBAR(); pv(o,vb0+sl_cur,PAF(0),PAF(1),PAF(2),PAF(3)); }
  #undef PKW
  #undef PAF
  #undef VFR
  #undef PIN
  #undef MX3
  #undef GAPA
  #undef GAPB
  #undef EX
  #undef VRD
  #undef KRD
  #undef STEP
  #undef ENDW
  {auto rr=__builtin_amdgcn_permlane32_swap(__float_as_uint(l_reg),__float_as_uint(l_reg),false,false);l_reg=__uint_as_float(rr[0])+__uint_as_float(rr[1]);}
  if(hi==0)wsf[32+r32]=l_reg;asm volatile("s_waitcnt lgkmcnt(0)":::"memory");
  float rli[16];
  #pragma unroll
  for(int r=0;r<16;++r)rli[r]=__builtin_amdgcn_rcpf(wsf[32+crow(r,hi)]);
  bf16*Ow=Oh+(long)(q0+wid*QBLK)*PO;
  { bf16*stg=(bf16*)(shm+LDS_OST)+wid*2048;
    #pragma unroll
    for(int r=0;r<16;++r){const int orow=crow(r,hi);
      #pragma unroll
      for(int d0=0;d0<2;++d0)stg[orow*64+d0*32+r32]=__float2bfloat16(o[d0][r]*rli[r]);}
    asm volatile("s_waitcnt lgkmcnt(0)":::"memory");
    #pragma unroll
    for(int i=0;i<4;++i){const int row=i*8+(lane>>3),ch=lane&7; const u32x4 v=*(const u32x4*)(stg+row*64+ch*8); ATTN_STORE16(Ow+(long)row*PO+ch*8,v);} }
  asm volatile("s_waitcnt lgkmcnt(0)\n\ts_barrier":::"memory");
  #undef DMA_K
  #undef DMA_V
  #undef CMASK
  #undef START
  #undef RESC
  #undef ROT
}
constexpr int ATTN_LDS_BYTES=LDS_BYTES;
#undef SBAR
#undef WAIT_BAR
}
namespace attn2 {
using namespace attn_body;
constexpr int KSLOT=8192, VSLOT=16384;
constexpr int L_K=0, L_V=3*KSLOT, L_WS=L_V+3*VSLOT, L_Q=L_WS+NW*64*4, L_END=L_Q+NW*4096;
#define SBAR() __builtin_amdgcn_sched_barrier(0)
#define WAIT_BAR(N) asm volatile("s_waitcnt vmcnt(" #N ") lgkmcnt(0)\n\ts_barrier":::"memory")
__device__ __forceinline__ void pv4(f32x16*o,int vb,bf16x8 pa0,bf16x8 pa1,bf16x8 pa2,bf16x8 pa3){
  #pragma unroll
  for(int d0=0;d0<4;++d0){s16x4 lo[4],hi[4];
    #pragma unroll
    for(int ks=0;ks<4;++ks){
      asm volatile("ds_read_b64_tr_b16 %0,%1 offset:%c2":"=&v"(lo[ks]):"v"(vb),"i"(d0*4096+ks*1024):"memory");
      asm volatile("ds_read_b64_tr_b16 %0,%1 offset:%c2":"=&v"(hi[ks]):"v"(vb),"i"(d0*4096+ks*1024+512):"memory");}
    asm volatile("s_waitcnt lgkmcnt(0)":::"memory");SBAR();
    #define PK(k) (bf16x8){lo[k][0],lo[k][1],lo[k][2],lo[k][3],hi[k][0],hi[k][1],hi[k][2],hi[k][3]}
    o[d0]=__builtin_amdgcn_mfma_f32_32x32x16_bf16(pa0,PK(0),o[d0],0,0,0);
    o[d0]=__builtin_amdgcn_mfma_f32_32x32x16_bf16(pa1,PK(1),o[d0],0,0,0);
    o[d0]=__builtin_amdgcn_mfma_f32_32x32x16_bf16(pa2,PK(2),o[d0],0,0,0);
    o[d0]=__builtin_amdgcn_mfma_f32_32x32x16_bf16(pa3,PK(3),o[d0],0,0,0);
    #undef PK
  }
}
template<int THRL> __device__ __forceinline__ void attn_unit128(int qb,const bf16*Qh,const bf16*__restrict__ Kh,const bf16*__restrict__ Vh,bf16*Oh,char*shm){
  const int tid=tid_opaque(),lane=tid&63,r32=lane&31,hi=lane>>5; const int wid=__builtin_amdgcn_readfirstlane(tid>>6);
  const int q0=qb*QB;
  const bf16*Qw=Qh+(long)(q0+wid*QBLK)*PQ;
  const unsigned lds0=(unsigned)(uintptr_t)shm;
  float*wsf=(float*)(shm+L_WS)+wid*64;
  const bf16*ksrc=Kh+(long)lane*PQ+wid*8;
  const bf16*vsrc=Vh+(long)(16*(wid&3)+(lane>>2))*PQ+(wid>>2)*32+(lane&3)*8;
  const unsigned kdst=lds0+L_K+wid*1024, vdst=lds0+L_V+wid*1024, qdst=lds0+L_Q+wid*4096;
  #define DMA_K(t,slot) glds16(ksrc+(long)(t)*KVBLK*PQ,(unsigned)__builtin_amdgcn_readfirstlane(kdst+(slot)))
  #define DMA_V(t,slot) do{ glds16(vsrc+(long)(t)*KVBLK*PQ,(unsigned)__builtin_amdgcn_readfirstlane(vdst+2*(slot))); glds16(vsrc+(long)(t)*KVBLK*PQ+64,(unsigned)__builtin_amdgcn_readfirstlane(vdst+2*(slot)+8192)); }while(0)
  const int vb0=(int)(lds0+L_V)+((lane>>4)&1)*32+(lane&3)*8+(4*hi+((lane&15)>>2))*64;
  const char*Kbase=shm+L_K; bf16x8 kf[8];
  const lds_cptr shm3=(lds_cptr)shm; const lds_cptr kp0=shm3+L_K+hi*1024+r32*16; const lds_cptr vp0=shm3+L_V+((lane>>4)&1)*32+(lane&3)*8+(4*hi+((lane&15)>>2))*64;
  const lds_cptr qp=shm3+L_Q+wid*4096+lane*16;
  #define QLD(d) (*(const __attribute__((address_space(3))) bf16x8*)(qp+(d)*1024))
  const int NT=(q0+QB)/KVBLK;
  DMA_K(0,0);DMA_V(0,0);DMA_K(1,KSLOT);
  #pragma unroll
  for(int d0=0;d0<4;++d0)glds16(&Qw[(long)r32*PQ+d0*16+hi*8],(unsigned)__builtin_amdgcn_readfirstlane(qdst+d0*1024));
  float mhat=0.f,l_reg=0.f;f32x16 o[4];o[0]=f32x16{};o[1]=f32x16{};o[2]=f32x16{};o[3]=f32x16{};
  const f32x16 zero16=f32x16{};
  const int qrel=wid*QBLK+r32;
  #define CMASK(P0,P1,t) do{int jb_=(t)-(NT-4); if(jb_>=0)cmask(P0,P1,jb_,qrel,hi);}while(0)
  bool resc=false;
  #define START(P0,P1) do{ const float rm=rowmax(P0,P1); resc=false; \
    { const float dl=rm; mhat=fadd_s(mhat,dl); \
      _Pragma("unroll") for(int r=0;r<16;++r){P0[r]=fsub_s(P0[r],dl);P1[r]=fsub_s(P1[r],dl);} } \
    _Pragma("unroll") for(int r=0;r<16;++r)P0[r]=__builtin_amdgcn_exp2f(P0[r]); }while(0)
  #define RESC() do{ if(resc){ asm volatile("s_waitcnt lgkmcnt(0)":::"memory"); \
      _Pragma("unroll") for(int d_=0;d_<4;++d_) _Pragma("unroll") for(int r=0;r<16;++r)o[d_][r]*=wsf[crow(r,hi)]; } }while(0)
  f32x16 pA0,pA1,pB0,pB1;
  int sl_prev=0,sl_cur=0,sl_next=KSLOT;
  #define ROT() do{sl_prev=sl_cur;sl_cur=sl_next;sl_next=(sl_next==(NSLOT-1)*KSLOT)?0:sl_next+KSLOT;}while(0)
  DMA_K(2,2*KSLOT);
  WAIT_BAR(1);
  { bf16x8 q4[4];
    #pragma unroll
    for(int d0=0;d0<4;++d0)q4[d0]=QLD(d0);
    qkt(pA0,pA1,Kbase,q4,zero16,r32,hi); }
  asm volatile("s_nop 15\n\ts_nop 7":"+v"(pA0),"+v"(pA1));CMASK(pA0,pA1,0);
  START(pA0,pA1);
  _Pragma("unroll") for(int r=0;r<16;++r)pA1[r]=__builtin_amdgcn_exp2f(pA1[r]);
  WAIT_BAR(0);
  DMA_K(3,0);DMA_V(1,KSLOT);
  ROT();
  kload8(kf,kp0+sl_cur);
  WAIT_BAR(3);
  s16x4 vlo[16],vhi[16]; u32x4 pw0,pw1,pw2,pw3;
  #define PKW(P,B) cvtpk_s(P[B],P[B+1])
  #define PAF(k) __builtin_bit_cast(bf16x8,pw##k)
  #define VFR(i) (bf16x8){vlo[i][0],vlo[i][1],vlo[i][2],vlo[i][3],vhi[i][0],vhi[i][1],vhi[i][2],vhi[i][3]}
  #define PIN(x) asm volatile("":"+v"(x))
  #define MX3(a,b,c) __builtin_fmaxf(__builtin_fmaxf((a),(b)),(c))
  #define GAPA(MF,A0,A1,A2,A3,W0,W1,PW) do{ MF; sacc+=A0; sacc+=A1; sacc+=A2; sacc+=A3; PIN(sacc); W0; W1; PIN(PW); SBAR(); }while(0)
  #define EX(v) __builtin_amdgcn_exp2f((v)-mhat)
  #define GAPB(MF,X,B) do{ MF; X[B]=EX(X[B]); X[B+1]=EX(X[B+1]); PIN(X); SBAR(); }while(0)
  #define VRD(i) do{ vlo[i]=vtr(vp_+(((i)>>2)*4096+((i)&3)*1024)); vhi[i]=vtr(vp_+(((i)>>2)*4096+((i)&3)*1024+512)); }while(0)
  #define KRD(G,j) do{ if(G){ kload2(kf,kp0+sl_next,j); SBAR(); } }while(0)
  #define PVM(d,ks) o[d]=__builtin_amdgcn_mfma_f32_32x32x16_bf16(PAF(ks),VFR((d)*4+(ks)),o[d],0,0,0)
  #define STEP(C0,C1,P0,P1,t,GK,GV,GL) do{ SBAR(); \
    const lds_cptr vp_=vp0+2*sl_prev; \
    const bf16x8 q0_=QLD(0),q1_=QLD(1),q2_=QLD(2),q3_=QLD(3); \
    VRD(0); SBAR(); float sacc=(P0[0]+P0[1]); \
    GAPA(C0=__builtin_amdgcn_mfma_f32_32x32x16_bf16(kf[0],q0_,zero16,0,0,0), P0[2],P0[3],P0[4],P0[5],     pw0[0]=PKW(P0,0), pw0[1]=PKW(P0,2), pw0); \
    VRD(4); SBAR(); GAPA(C1=__builtin_amdgcn_mfma_f32_32x32x16_bf16(kf[1],q0_,zero16,0,0,0), P0[6],P0[7],P0[8],P0[9],     pw0[2]=PKW(P0,4), pw0[3]=PKW(P0,6), pw0); \
    VRD(8); SBAR(); GAPA(C0=__builtin_amdgcn_mfma_f32_32x32x16_bf16(kf[2],q1_,C0,0,0,0),   P0[10],P0[11],P0[12],P0[13], pw1[0]=PKW(P0,8), pw1[1]=PKW(P0,10), pw1); \
    VRD(12); SBAR(); GAPA(C1=__builtin_amdgcn_mfma_f32_32x32x16_bf16(kf[3],q1_,C1,0,0,0),   P0[14],P0[15],P1[0],P1[1],   pw1[2]=PKW(P0,12),pw1[3]=PKW(P0,14), pw1); \
    VRD(1); SBAR(); GAPA(C0=__builtin_amdgcn_mfma_f32_32x32x16_bf16(kf[4],q2_,C0,0,0,0),   P1[2],P1[3],P1[4],P1[5],     pw2[0]=PKW(P1,0), pw2[1]=PKW(P1,2), pw2); \
    VRD(5); SBAR(); GAPA(C1=__builtin_amdgcn_mfma_f32_32x32x16_bf16(kf[5],q2_,C1,0,0,0),   P1[6],P1[7],P1[8],P1[9],     pw2[2]=PKW(P1,4), pw2[3]=PKW(P1,6), pw2); \
    VRD(9); SBAR(); GAPA(C0=__builtin_amdgcn_mfma_f32_32x32x16_bf16(kf[6],q3_,C0,0,0,0),   P1[10],P1[11],P1[12],P1[13], pw3[0]=PKW(P1,8), pw3[1]=PKW(P1,10), pw3); \
    VRD(13); SBAR(); GAPA(C1=__builtin_amdgcn_mfma_f32_32x32x16_bf16(kf[7],q3_,C1,0,0,0),   P1[14],P1[15],0.f,0.f,       pw3[2]=PKW(P1,12),pw3[3]=PKW(P1,14), pw3); \
    l_reg+=sacc; \
    if(GK){DMA_K((t)+3,sl_cur);} if(GV){DMA_V((t)+1,sl_next);} \
    CMASK(C0,C1,t); \
    { float a=MX3(C0[0],C0[1],C1[0]),b=MX3(C0[2],C0[3],C1[1]); a=MX3(a,C1[2],C1[3]); \
      _Pragma("unroll") for(int r=4;r<16;r+=4){a=MX3(a,C0[r],C0[r+1]);b=MX3(b,C0[r+2],C0[r+3]);a=MX3(a,C1[r],C1[r+1]);b=MX3(b,C1[r+2],C1[r+3]);} \
      float rm=__builtin_fmaxf(a,b); { auto rr=__builtin_amdgcn_permlane32_swap(__float_as_uint(rm),__float_as_uint(rm),false,false); rm=__builtin_fmaxf(__uint_as_float(rr[0]),__uint_as_float(rr[1])); } \
      rm-=mhat; resc=false; \
      if(__builtin_expect(__any(rm>(float)THRL),0)){ const float dl=__builtin_fmaxf(rm,0.f); mhat+=dl; \
        const float f=__builtin_amdgcn_exp2f(-dl); l_reg*=f; if(hi==0)wsf[r32]=f; resc=true; } } \
    SBAR(); \
    GAPB(PVM(0,0), C0,0);  VRD(2);  SBAR(); \
    GAPB(PVM(1,0), C0,2);  VRD(6);  SBAR(); \
    GAPB(PVM(2,0), C0,4);  VRD(10); SBAR(); \
    GAPB(PVM(3,0), C0,6);  VRD(14); SBAR(); \
    GAPB(PVM(0,1), C0,8);  VRD(3);  SBAR(); \
    GAPB(PVM(1,1), C0,10); VRD(7);  SBAR(); \
    GAPB(PVM(2,1), C0,12); VRD(11); SBAR(); \
    GAPB(PVM(3,1), C0,14); VRD(15); SBAR(); \
    KRD(GL,0); GAPB(PVM(0,2), C1,0); \
    GAPB(PVM(1,2), C1,2); \
    KRD(GL,1); GAPB(PVM(2,2), C1,4); \
    GAPB(PVM(3,2), C1,6); \
    KRD(GL,2); GAPB(PVM(0,3), C1,8); \
    GAPB(PVM(1,3), C1,10); \
    KRD(GL,3); GAPB(PVM(2,3), C1,12); \
    GAPB(PVM(3,3), C1,14); \
    }while(0)
  int t=1;
  #undef CMASK
  #define CMASK(P0,P1,t) do{}while(0)
  for(;t+5<NT;t+=2){
    STEP(pB0,pB1,pA0,pA1,t,true,true,true);     WAIT_BAR(3); RESC(); ROT();
    STEP(pA0,pA1,pB0,pB1,t+1,true,true,true);   WAIT_BAR(3); RESC(); ROT();
  }
  #undef CMASK
  #define CMASK(P0,P1,t) do{int jb_=(t)-(NT-4); if(jb_>=0)cmask(P0,P1,jb_,qrel,hi);}while(0)
  #define ENDW(tt) do{ if((tt)+3<NT){WAIT_BAR(3);} else if((tt)+2<NT){WAIT_BAR(2);} else {WAIT_BAR(0);} }while(0)
  for(;t+1<NT;t+=2){
    STEP(pB0,pB1,pA0,pA1,t,(t+3<NT),(t+1<NT),(t+1<NT));       ENDW(t);   RESC(); ROT();
    STEP(pA0,pA1,pB0,pB1,t+1,(t+4<NT),(t+2<NT),(t+2<NT));     ENDW(t+1); RESC(); ROT();
  }
  STEP(pB0,pB1,pA0,pA1,NT-1,false,false,false); RESC();
  { float sacc=pB0[0]+pB0[1]; _Pragma("unroll") for(int r=2;r<16;++r)sacc+=pB0[r]; _Pragma("unroll") for(int r=0;r<16;++r)sacc+=pB1[r]; l_reg+=sacc;
    pw0=(u32x4){PKW(pB0,0),PKW(pB0,2),PKW(pB0,4),PKW(pB0,6)};pw1=(u32x4){PKW(pB0,8),PKW(pB0,10),PKW(pB0,12),PKW(pB0,14)};pw2=(u32x4){PKW(pB1,0),PKW(pB1,2),PKW(pB1,4),PKW(pB1,6)};pw3=(u32x4){PKW(pB1,8),PKW(pB1,10),PKW(pB1,12),PKW(pB1,14)};
    SBAR(); pv4(o,vb0+2*sl_cur,PAF(0),PAF(1),PAF(2),PAF(3)); }
  #undef PKW
  #undef PAF
  #undef VFR
  #undef PIN
  #undef MX3
  #undef GAPA
  #undef GAPB
  #undef EX
  #undef VRD
  #undef KRD
  #undef PVM
  #undef STEP
  #undef ENDW
  {auto rr=__builtin_amdgcn_permlane32_swap(__float_as_uint(l_reg),__float_as_uint(l_reg),false,false);l_reg=__uint_as_float(rr[0])+__uint_as_float(rr[1]);}
  if(hi==0)wsf[32+r32]=l_reg;asm volatile("s_waitcnt lgkmcnt(0)":::"memory");
  float rli[16];
  #pragma unroll
  for(int r=0;r<16;++r)rli[r]=__builtin_amdgcn_rcpf(wsf[32+crow(r,hi)]);
  bf16*Ow=Oh+(long)(q0+wid*QBLK)*PO;
  { bf16*stg=(bf16*)(shm+L_Q)+wid*2048;
    #pragma unroll
    for(int hf=0;hf<2;++hf){
      #pragma unroll
      for(int r=0;r<16;++r){const int orow=crow(r,hi);
        #pragma unroll
        for(int d0=0;d0<2;++d0)stg[orow*64+d0*32+r32]=__float2bfloat16(o[2*hf+d0][r]*rli[r]);}
      asm volatile("s_waitcnt lgkmcnt(0)":::"memory");
      #pragma unroll
      for(int i=0;i<4;++i){const int row=i*8+(lane>>3),ch=lane&7; const u32x4 v=*(const u32x4*)(stg+row*64+ch*8); ATTN_STORE16(Ow+(long)row*PO+hf*64+ch*8,v);}
      asm volatile("s_waitcnt lgkmcnt(0)":::"memory"); } }
  asm volatile("s_waitcnt lgkmcnt(0)\n\ts_barrier":::"memory");
  #undef DMA_K
  #undef DMA_V
  #undef QLD
  #undef CMASK
  #undef START
  #undef RESC
  #undef ROT
}
#undef SBAR
#undef WAIT_BAR
}
#include <hip/hip_cooperative_groups.h>
namespace cg = cooperative_groups;
constexpr int NWAVES = 8;
constexpr int BATCH = 16, SEQ = 2048, D = 1024, DEPTH = 4, FF = 4096, PLE = 256, INW = 2560, AW = 512, RW = 512;
constexpr int M = BATCH * SEQ;
constexpr size_t MiB = 1u << 20;
constexpr size_t WS_CS = 1 * MiB;
constexpr size_t WS_SSQ0 = 3 * MiB, WS_SSQ1 = 5 * MiB;
constexpr size_t WS_W = 8 * MiB, W_LAYER = 25 * MiB + 512 * 1024;
constexpr size_t WO_IN = 0, WO_OUT = 5 * MiB, WO_W1 = 7 * MiB, WO_W2 = 15 * MiB, WO_PG = 23 * MiB, WO_PP = 25 * MiB;
constexpr size_t WS_P16 = 110 * MiB;
constexpr size_t WS_XB0 = 126 * MiB;
constexpr size_t WS_R = 190 * MiB;
constexpr size_t WS_PROJ = WS_R;
constexpr size_t WS_OV = WS_R + 160 * MiB;
constexpr size_t WS_AO = WS_R + 224 * MiB;
constexpr size_t WS_HB = WS_R;
constexpr size_t WS_XBF = WS_R + 64 * MiB;
constexpr size_t WS_PP = WS_R;
constexpr size_t WS_END = WS_R + 288 * MiB;
static_assert(WS_W + DEPTH * W_LAYER <= WS_P16 && WS_P16 + (size_t)M * PLE * 2 <= WS_XB0 && WS_XB0 + (size_t)M * D * 2 <= WS_R && WS_HB + (size_t)M * FF * 2 <= WS_END, "d_ws map");
constexpr int RING_BYTES = 131072;
constexpr int LDS_BYTES = 147456;

#define GAS __attribute__((address_space(1)))
#define LAS __attribute__((address_space(3)))
typedef unsigned short bf16;
typedef unsigned v4u __attribute__((ext_vector_type(4)));
typedef float f32x4 __attribute__((ext_vector_type(4)));
typedef short bf16x8 __attribute__((ext_vector_type(8)));
#define LDS_WAIT() asm volatile("s_waitcnt lgkmcnt(0)" ::: "memory")
#define VM_WAIT() asm volatile("s_waitcnt vmcnt(0)" ::: "memory")
__device__ __forceinline__ unsigned f2bf(float f) { unsigned u = __builtin_bit_cast(unsigned, f); return (u + 0x7fffu + ((u >> 16) & 1u)) >> 16; }
__device__ __forceinline__ unsigned pk2(float lo, float hi) { unsigned r; asm("v_cvt_pk_bf16_f32 %0, %1, %2" : "=v"(r) : "v"(lo), "v"(hi)); return r; }
__device__ __forceinline__ float bf2f(unsigned short v) { return __uint_as_float((unsigned)v << 16); }
__device__ __forceinline__ float sigmoid_f(float x) { return __builtin_amdgcn_rcpf(1.f + __builtin_amdgcn_exp2f(-1.4426950408889634f * x)); }

typedef GAS unsigned gu32;
#define RLX_AGENT __ATOMIC_RELAXED, __HIP_MEMORY_SCOPE_AGENT
#define XB_TMO      128
#define XB_XCNT(j)  (256  + 64 * (j))
#define XB_XSUB(j)  (1280 + 64 * (j))
#define XB_XGEN(j)  (2304 + 64 * (j))
#define XB_TOP      3328
#define XB_TOPGEN   3392
#define XCD_BAR_WORDS 3456
#define XB_SPIN_CAP (1u << 18)

__device__ __forceinline__ unsigned xb_ld(unsigned* p)              { return __hip_atomic_load(p, __ATOMIC_RELAXED, __HIP_MEMORY_SCOPE_AGENT); }
__device__ __forceinline__ unsigned xb_add(unsigned* p, unsigned v) { return __hip_atomic_fetch_add(p, v, __ATOMIC_RELAXED, __HIP_MEMORY_SCOPE_AGENT); }
__device__ __forceinline__ unsigned xb_xcc_id() { return (unsigned)__builtin_amdgcn_s_getreg((3 << 11) | 20) & 0xFu; }
#define XB_SPIN(cond, bar) do { unsigned _sp = 0; while (cond) { __builtin_amdgcn_s_sleep(1); \
    if ((++_sp & 255u) == 0u) { if (xb_ld(&(bar)[XB_TMO])) break; if (_sp > XB_SPIN_CAP) { atomicAdd(&(bar)[XB_TMO], 1u); break; } } } } while (0)

struct XcdBarrier {
    unsigned* bar; unsigned x;
    volatile LAS unsigned* st;
};

__device__ __forceinline__ XcdBarrier xcd_barrier_post(unsigned* bar, volatile LAS unsigned* st) {
    XcdBarrier b; b.bar = bar; b.x = xb_xcc_id(); b.st = st;
    if (threadIdx.x == 0) st[4] = xb_add(&bar[XB_XCNT(b.x)], 1u);
    return b;
}
__device__ __forceinline__ void xcd_barrier_complete(unsigned* bar, unsigned x, unsigned& nloc, unsigned& nx) {
    const unsigned G = gridDim.x * gridDim.y * gridDim.z;
    unsigned sum, cnt, mine, sp = 0u;
    for (;;) {
        sum = 0u; cnt = 0u; mine = 0u;
#pragma unroll
        for (unsigned j = 0; j < 16; ++j) { const unsigned c = xb_ld(&bar[XB_XCNT(j)]); sum += c; cnt += (c > 0u) ? 1u : 0u; mine = (j == x) ? c : mine; }
        if (sum == G) break;
        __builtin_amdgcn_s_sleep(1);
        if ((++sp & 255u) == 0u) { if (xb_ld(&bar[XB_TMO])) break; if (sp > XB_SPIN_CAP) { atomicAdd(&bar[XB_TMO], 1u); break; } }
    }
    nloc = mine > 0u ? mine : 1u; nx = cnt > 0u ? cnt : 1u;
}

__device__ __forceinline__ void xcd_barrier(const XcdBarrier& b) {
    asm volatile("s_waitcnt vmcnt(0)" ::: "memory");
    __syncthreads();
    if (threadIdx.x == 0) {
        unsigned* bar = b.bar;
        __builtin_amdgcn_s_waitcnt(0);
        unsigned nloc = b.st[0], nx = b.st[1];
        if (nloc == 0u) { xcd_barrier_complete(bar, b.x, nloc, nx); b.st[0] = nloc; b.st[1] = nx; }
        const unsigned old = xb_add(&bar[XB_XSUB(b.x)], 1u);
        const unsigned gen = old / nloc;
        if (old + 1u == (gen + 1u) * nloc) {
            __builtin_amdgcn_fence(__ATOMIC_RELEASE, "agent");
            asm volatile("s_waitcnt vmcnt(0)" ::: "memory");
            const unsigned og = xb_add(&bar[XB_TOP], 1u);
            const unsigned tg = og / nx;
            if (og + 1u == (tg + 1u) * nx) xb_add(&bar[XB_TOPGEN], 1u);
            else XB_SPIN(xb_ld(&bar[XB_TOPGEN]) == tg, bar);
            __builtin_amdgcn_fence(__ATOMIC_ACQUIRE, "agent");
            xb_add(&bar[XB_XGEN(b.x)], 1u);
            asm volatile("s_waitcnt vmcnt(0)" ::: "memory");
        } else {
            XB_SPIN(xb_ld(&bar[XB_XGEN(b.x)]) == gen, bar);
            __builtin_amdgcn_fence(__ATOMIC_ACQUIRE, "agent");
            asm volatile("s_waitcnt vmcnt(0)" ::: "memory");
        }
    }
    __syncthreads();
}
template <class BG> __device__ __forceinline__ void xcd_barrier_bg(const XcdBarrier& b, const BG& bgwork) {
    asm volatile("s_waitcnt vmcnt(0)" ::: "memory");
    __syncthreads();
    if (threadIdx.x == 0) {
        unsigned* bar = b.bar;
        __builtin_amdgcn_s_waitcnt(0);
        unsigned nloc = b.st[0], nx = b.st[1];
        if (nloc == 0u) { xcd_barrier_complete(bar, b.x, nloc, nx); b.st[0] = nloc; b.st[1] = nx; }
        const unsigned old = xb_add(&bar[XB_XSUB(b.x)], 1u);
        const unsigned gen = old / nloc;
        if (old + 1u == (gen + 1u) * nloc) {
            __builtin_amdgcn_fence(__ATOMIC_RELEASE, "agent");
            asm volatile("s_waitcnt vmcnt(0)" ::: "memory");
            const unsigned og = xb_add(&bar[XB_TOP], 1u);
            const unsigned tg = og / nx;
            if (og + 1u == (tg + 1u) * nx) xb_add(&bar[XB_TOPGEN], 1u);
            else XB_SPIN(xb_ld(&bar[XB_TOPGEN]) == tg, bar);
            __builtin_amdgcn_fence(__ATOMIC_ACQUIRE, "agent");
            xb_add(&bar[XB_XGEN(b.x)], 1u);
            asm volatile("s_waitcnt vmcnt(0)" ::: "memory");
        } else {
            XB_SPIN(xb_ld(&bar[XB_XGEN(b.x)]) == gen, bar);
            __builtin_amdgcn_fence(__ATOMIC_ACQUIRE, "agent");
            asm volatile("s_waitcnt vmcnt(0)" ::: "memory");
        }
    }
    if (threadIdx.x >= 64) bgwork();
    __syncthreads();
}
template <class BG> __device__ __forceinline__ void xcd_barrier_local_bg(const XcdBarrier& b, const BG& bgwork, bool with_bg) {
    asm volatile("s_waitcnt vmcnt(0)" ::: "memory");
    __syncthreads();
    if (threadIdx.x == 0) {
        unsigned* bar = b.bar;
        __builtin_amdgcn_s_waitcnt(0);
        const unsigned nloc = b.st[0];
        const unsigned old = xb_add(&bar[XB_XSUB(b.x)], 1u);
        const unsigned gen = old / nloc;
        if (old + 1u == (gen + 1u) * nloc) xb_add(&bar[XB_XGEN(b.x)], 1u);
        else XB_SPIN(xb_ld(&bar[XB_XGEN(b.x)]) == gen, bar);
        __builtin_amdgcn_fence(__ATOMIC_ACQUIRE, "agent");
        asm volatile("s_waitcnt vmcnt(0)" ::: "memory");
    }
    if (with_bg && threadIdx.x >= 64) bgwork();
    __syncthreads();
}

struct Frame {
    LAS unsigned char* lds;
    LAS const unsigned long long* tab;
};
struct Who { int tid, lane, wave, vcu, G, bx, local; };
constexpr int LDSW_OFF = 131072 + 2048;
__device__ __forceinline__ Who who() { Who w; w.tid = tid_opaque(); w.lane = w.tid & 63; w.wave = __builtin_amdgcn_readfirstlane(w.tid >> 6);
    extern __shared__ __attribute__((aligned(16))) unsigned char lds_who_[];
    volatile LAS unsigned* cw = (volatile LAS unsigned*)((LAS unsigned char*)lds_who_ + LDSW_OFF);
    int bx = __builtin_amdgcn_readfirstlane((int)cw[2]), lc = __builtin_amdgcn_readfirstlane((int)cw[3]), G = gridDim.x; asm volatile("" : "+s"(bx), "+s"(G), "+s"(lc));
    w.G = G; w.bx = bx; w.local = lc; w.vcu = (G % 8 == 0) ? (bx % 8) * (G / 8) + bx / 8 : bx; return w; }
__device__ __forceinline__ int opaque_s(int v) { asm volatile("" : "+s"(v)); return v; }
__device__ __forceinline__ const void* ptab(LAS const unsigned long long* tab, int k) {
    const unsigned long long v = tab[k]; const unsigned lo = __builtin_amdgcn_readfirstlane((unsigned)v), hi = __builtin_amdgcn_readfirstlane((unsigned)(v >> 32));
    GAS const char* g = (GAS const char*)(((unsigned long long)hi << 32) | lo);
    return (const void*)g;
}
#define FIN(k) ((const float*)ptab(F.tab, (k)))
#define FOUT() ((float*)ptab(F.tab, 23))
#define FWS(off) ((unsigned char*)ptab(F.tab, 24) + (off))
enum { I_X = 0, I_P, I_POS, I_WIN, I_WOUT, I_GMIX, I_GSUBLN, I_LAMQ, I_LAMK, I_CONVW, I_CONVB, I_WGA, I_BGA, I_WGX, I_BGX, I_LRULAM, I_GMLP, I_WMLPIN, I_WMLPOUT, I_GPLE, I_WPLEGATE, I_WPLEPROJ, I_GFINAL };
enum { RB_PROJ, RB_OV, RB_AO, RB_HB, RB_PP, RB_XBF };
#define RBUF(which) ((bf16*)rbuf_(FWS(0), W.local, W.bx, (which)))
__device__ __forceinline__ unsigned char* rbuf_(unsigned char* ws, int local, int bx, int which) {
    const size_t pitchB = (which == RB_PROJ) ? (size_t)INW * 2 : (which == RB_HB) ? (size_t)FF * 2 : (size_t)D * 2;
    if (!local) return ws + (which == RB_PROJ ? WS_PROJ : which == RB_OV ? WS_OV : which == RB_AO ? WS_AO : which == RB_HB ? WS_HB : which == RB_PP ? WS_PP : WS_XBF);
    const size_t x = (size_t)(bx % 8), off = (which == RB_OV) ? 20 * MiB : (which == RB_AO) ? 28 * MiB : (which == RB_XBF) ? 8 * MiB : 0;
    return ws + WS_R + x * (36 * MiB) + off - x * (size_t)(M / 8) * pitchB;
}

__device__ __forceinline__ float wave_sum(float v) {
#pragma unroll
    for (int o = 1; o < 64; o <<= 1) v += __shfl_xor(v, o);
    return v;
}
__device__ __forceinline__ void p0_transpose_item(const float* W, const float* gain, int K, int N, bf16* WT, LAS float* scr, int item, int lane) {
    const int nblk = N / 32, kb = item / nblk, nb = item % nblk, k0 = 64 * kb, n0 = 32 * nb;
    const int c = lane & 7;
    float v[32];
#pragma unroll
    for (int i = 0; i < 32; ++i) v[i] = W[(size_t)(k0 + 2 * i + (lane >> 5)) * N + n0 + (lane & 31)];
    f32x4 ga = {1.f, 1.f, 1.f, 1.f}, gb = ga;
    if (gain) { ga = *(const f32x4*)(gain + k0 + 8 * c); gb = *(const f32x4*)(gain + k0 + 8 * c + 4); }
#pragma unroll
    for (int i = 0; i < 32; ++i) scr[(2 * i + (lane >> 5)) * 33 + (lane & 31)] = v[i];
    LDS_WAIT(); asm volatile("" ::: "memory");
#pragma unroll
    for (int j = 0; j < 4; ++j) { const int n = (lane >> 3) + 8 * j; const LAS float* s = scr + (8 * c) * 33 + n;
        v4u o; o.x = pk2(s[0 * 33] * ga.x, s[1 * 33] * ga.y); o.y = pk2(s[2 * 33] * ga.z, s[3 * 33] * ga.w); o.z = pk2(s[4 * 33] * gb.x, s[5 * 33] * gb.y); o.w = pk2(s[6 * 33] * gb.z, s[7 * 33] * gb.w);
        *(GAS v4u*)(WT + (size_t)(n0 + n) * K + k0 + 8 * c) = o; }
    LDS_WAIT(); asm volatile("" ::: "memory");
}
__device__ __forceinline__ void p0_prologue(Frame& F) {
    const Who W = who();
    LAS float* scr = (LAS float*)(F.lds + W.wave * 16384);
    const int gw = W.vcu * NWAVES + W.wave, NGW = W.G * NWAVES;
    unsigned char* ws = FWS(0);
    const float *w_in = FIN(I_WIN), *w_out = FIN(I_WOUT), *w_mlp_in = FIN(I_WMLPIN), *w_mlp_out = FIN(I_WMLPOUT), *w_ple_gate = FIN(I_WPLEGATE), *w_ple_proj = FIN(I_WPLEPROJ), *g_mix = FIN(I_GMIX), *g_mlp = FIN(I_GMLP), *g_ple = FIN(I_GPLE);
    constexpr int I_IN = (D / 64) * (INW / 32), I_OUT = (D / 64) * (D / 32), I_1 = (D / 64) * (FF / 32), I_2 = (FF / 64) * (D / 32), I_PG = I_OUT, I_PP = (PLE / 64) * (D / 32);
    constexpr int PER_L = I_IN + I_OUT + I_1 + I_2 + I_PG + I_PP;
    for (int it = gw; it < DEPTH * PER_L; it += NGW) {
        const int l = it / PER_L; int r = it % PER_L; bf16* wl = (bf16*)(ws + WS_W + (size_t)l * W_LAYER);
        if (r < I_IN) { p0_transpose_item(w_in + (size_t)l * D * INW, g_mix + l * D, D, INW, (bf16*)((unsigned char*)wl + WO_IN), scr, r, W.lane); continue; } r -= I_IN;
        if (r < I_OUT) { p0_transpose_item(w_out + (size_t)l * D * D, nullptr, D, D, (bf16*)((unsigned char*)wl + WO_OUT), scr, r, W.lane); continue; } r -= I_OUT;
        if (r < I_1) { p0_transpose_item(w_mlp_in + (size_t)l * D * FF, g_mlp + l * D, D, FF, (bf16*)((unsigned char*)wl + WO_W1), scr, r, W.lane); continue; } r -= I_1;
        if (r < I_2) { p0_transpose_item(w_mlp_out + (size_t)l * FF * D, nullptr, FF, D, (bf16*)((unsigned char*)wl + WO_W2), scr, r, W.lane); continue; } r -= I_2;
        if (r < I_PG) { p0_transpose_item(w_ple_gate + (size_t)l * D * D, g_ple + l * D, D, D, (bf16*)((unsigned char*)wl + WO_PG), scr, r, W.lane); continue; } r -= I_PG;
        p0_transpose_item(w_ple_proj + (size_t)l * PLE * D, nullptr, PLE, D, (bf16*)((unsigned char*)wl + WO_PP), scr, r, W.lane);
    }
    const float* x_ = FIN(I_X); bf16* XB1_ = (bf16*)FOUT(); float* SSQ1_ = (float*)(ws + WS_SSQ1); float* CS_ = (float*)(ws + WS_CS); const int* pos_ = (const int*)FIN(I_POS);
#pragma unroll 4
    for (int m = gw; m < M; m += NGW) {
        const GAS f32x4* xr = (const GAS f32x4*)(x_ + (size_t)m * D) + W.lane;
        GAS unsigned long long* o8 = (GAS unsigned long long*)(XB1_ + (size_t)m * D) + W.lane; float s = 0.f;
#pragma unroll
        for (int j = 0; j < 4; ++j) { const f32x4 v = xr[64 * j]; s += (v.x * v.x + v.y * v.y) + (v.z * v.z + v.w * v.w);
            o8[64 * j] = (unsigned long long)pk2(v.x, v.y) | ((unsigned long long)pk2(v.z, v.w) << 32); }
        s = wave_sum(s);
        if (W.lane < 16) SSQ1_[(size_t)m * 16 + W.lane] = (W.lane == 0) ? s : 0.f;
    }
}
__device__ __forceinline__ void convert_p_slice(Frame& F, int l, int slice) {
    const Who W = who();
    const float* src = FIN(I_P) + (size_t)l * M * PLE; bf16* P16_ = (bf16*)FWS(WS_P16);
    const size_t NV = W.local ? (size_t)(M / 8) * PLE / 8 : (size_t)M * PLE / 8, base = W.local ? (size_t)(W.bx % 8) * NV : 0;
    const size_t PER = (NV + 2) / 3, lo = (size_t)slice * PER, hi = (lo + PER < NV) ? lo + PER : NV;
    const size_t nthr = (W.local ? (size_t)(W.G / 8) : (size_t)W.G) * (NWAVES - 1) * 64, me = (W.local ? (size_t)(W.bx / 8) : (size_t)W.bx) * (NWAVES - 1) * 64 + (W.tid - 64);
#pragma unroll 4
    for (size_t e = lo + me; e < hi; e += nthr) {
        const f32x4 a = *(const GAS f32x4*)(src + (base + e) * 8), b = *(const GAS f32x4*)(src + (base + e) * 8 + 4);
        v4u o; o.x = pk2(a.x, a.y); o.y = pk2(a.z, a.w); o.z = pk2(b.x, b.y); o.w = pk2(b.z, b.w);
        *(GAS v4u*)(P16_ + (base + e) * 8) = o; }
}
struct BgConvert { Frame F; int l, slice; __device__ __forceinline__ void operator()() const { Frame f = F; convert_p_slice(f, l, slice); } };
__device__ __forceinline__ void final_norm(Frame& F) {
    const Who W = who();
    const int NGW = (W.local ? W.G / 8 : W.G) * NWAVES, gw = (W.local ? W.bx / 8 : W.bx) * NWAVES + W.wave, m0 = W.local ? (W.bx % 8) * (M / 8) : 0, m1 = W.local ? m0 + M / 8 : M;
    const float* SSQ1_ = (const float*)FWS(WS_SSQ1); float* O_ = FOUT(); const float* gf_ = FIN(I_GFINAL); const bf16* XBF_ = RBUF(RB_XBF);
#pragma unroll 4
    for (int m = m0 + gw; m < m1; m += NGW) {
        const float rs = pg8::row_rs(SSQ1_, m);
        const GAS unsigned long long* hr = (const GAS unsigned long long*)(XBF_ + (size_t)m * D) + W.lane; GAS f32x4* orow = (GAS f32x4*)(O_ + (size_t)m * D) + W.lane; const GAS f32x4* gr = (const GAS f32x4*)gf_ + W.lane;
#pragma unroll
        for (int j = 0; j < 4; ++j) { const unsigned long long w8 = hr[64 * j]; const unsigned lo = (unsigned)w8, hi = (unsigned)(w8 >> 32); const f32x4 g = gr[64 * j];
            const f32x4 v = {pg8::bf_lo(lo), pg8::bf_hi(lo), pg8::bf_lo(hi), pg8::bf_hi(hi)}; orow[64 * j] = v * rs * g; }
    }
}

__device__ __forceinline__ void lru_item(Frame& F, int l, int item) {
    const int b = item >> 4, g = (item >> 1) & 7, hf = item & 1;
    const int tid_ = tid_opaque(), lane = tid_ & 63, w = __builtin_amdgcn_readfirstlane(tid_ >> 6), r = lane & 15, q = lane >> 4;
    LAS float* xcs = (LAS float*)(F.lds + w * 4352);
    LAS float* car = (LAS float*)(F.lds + 36864);
    const Who W = who();
    const bf16* pj = RBUF(RB_PROJ) + (size_t)b * SEQ * INW;
    bf16* ao = RBUF(RB_AO) + (size_t)b * SEQ * D;
    v4u* lb = (v4u*)FWS(WS_XB0) + ((size_t)item * NWAVES + w) * (16 * 2 * 64) + lane;
    const int t0 = w * 256;
    const bf16* gcol = pj + 3 * AW + RW + g * 64 + hf * 32 + r;
    bf16* ycol = ao + AW + g * 64 + hf * 32 + r;
    float hin[2] = {0.f, 0.f};
    {
        const int cch = g * 64 + lane;
        const float* conv_w = FIN(I_CONVW);
        const float cw0 = conv_w[(l * 4 + 0) * RW + cch], cw1 = conv_w[(l * 4 + 1) * RW + cch], cw2 = conv_w[(l * 4 + 2) * RW + cch], cw3 = conv_w[(l * 4 + 3) * RW + cch], cb = FIN(I_CONVB)[l * RW + cch];
        bf16x8 Bf[2][2][2];
#pragma unroll
        for (int gate = 0; gate < 2; ++gate) { const float* W = (gate ? FIN(I_WGX) : FIN(I_WGA)) + (size_t)(l * 8 + g) * 64 * 64;
#pragma unroll
            for (int n = 0; n < 2; ++n)
#pragma unroll
                for (int kk = 0; kk < 2; ++kk) { const float* wp = W + (size_t)(32 * kk + 8 * q) * 64 + hf * 32 + 16 * n + r; v4u pw;
                    pw.x = pk2(wp[0 * 64], wp[1 * 64]); pw.y = pk2(wp[2 * 64], wp[3 * 64]); pw.z = pk2(wp[4 * 64], wp[5 * 64]); pw.w = pk2(wp[6 * 64], wp[7 * 64]);
                    Bf[gate][n][kk] = __builtin_bit_cast(bf16x8, pw); } }
        float ba[2], bx[2], sp8[2];
#pragma unroll
        for (int n = 0; n < 2; ++n) { const int ch = l * RW + g * 64 + hf * 32 + 16 * n + r; ba[n] = FIN(I_BGA)[ch]; bx[n] = FIN(I_BGX)[ch];
            const float z = -FIN(I_LRULAM)[ch]; sp8[n] = 8.f * (fmaxf(z, 0.f) + log1pf(__expf(-fabsf(z)))); }
        const bf16* xcol = pj + 3 * AW + cch;
        float h3 = 0.f, h2 = 0.f, h1 = 0.f;
        if (t0 != 0) { h3 = bf2f(xcol[(size_t)(t0 - 3) * INW]); h2 = bf2f(xcol[(size_t)(t0 - 2) * INW]); h1 = bf2f(xcol[(size_t)(t0 - 1) * INW]); }
        float hrun[2] = {0.f, 0.f}, Arun[2] = {1.f, 1.f};
        unsigned short xq[16];
#pragma unroll
        for (int tt = 0; tt < 16; ++tt) xq[tt] = xcol[(size_t)(t0 + tt) * INW];
#pragma unroll 1
        for (int sc = 0; sc < 16; ++sc) {
            const int ts = t0 + sc * 16, tn = (sc < 15) ? ts + 16 : ts;
            unsigned short xn[16];
#pragma unroll
            for (int tt = 0; tt < 16; ++tt) xn[tt] = xcol[(size_t)(tn + tt) * INW];
#pragma unroll
            for (int tt = 0; tt < 16; ++tt) { const float xv = bf2f(xq[tt]); const float xc = cb + cw0 * h3 + cw1 * h2 + cw2 * h1 + cw3 * xv; h3 = h2; h2 = h1; h1 = xv; xcs[tt * 68 + lane] = xc; }
            asm volatile("s_waitcnt lgkmcnt(0)" ::: "memory");
            bf16x8 Af[2];
#pragma unroll
            for (int kk = 0; kk < 2; ++kk) { const LAS f32x4* ap = (const LAS f32x4*)(xcs + r * 68 + 32 * kk + 8 * q); const f32x4 a0 = ap[0], a1 = ap[1];
                v4u pw; pw.x = pk2(a0.x, a0.y); pw.y = pk2(a0.z, a0.w); pw.z = pk2(a1.x, a1.y); pw.w = pk2(a1.z, a1.w); Af[kk] = __builtin_bit_cast(bf16x8, pw); }
            f32x4 Da[2], Dx[2];
#pragma unroll
            for (int n = 0; n < 2; ++n) { Da[n] = (f32x4){0.f, 0.f, 0.f, 0.f}; Dx[n] = Da[n];
#pragma unroll
                for (int kk = 0; kk < 2; ++kk) { Da[n] = __builtin_amdgcn_mfma_f32_16x16x32_bf16(Af[kk], Bf[0][n][kk], Da[n], 0, 0, 0); Dx[n] = __builtin_amdgcn_mfma_f32_16x16x32_bf16(Af[kk], Bf[1][n][kk], Dx[n], 0, 0, 0); } }
#pragma unroll
            for (int n = 0; n < 2; ++n) {
                float a[4], bb[4]; v4u st;
#pragma unroll
                for (int i = 0; i < 4; ++i) { const float xcv = xcs[(4 * q + i) * 68 + hf * 32 + 16 * n + r];
                    const float ra = sigmoid_f(Da[n][i] + ba[n]), ix = sigmoid_f(Dx[n][i] + bx[n]);
                    const float la = -ra * sp8[n];
                    const float y2 = 2.f * la;
                    const float ser = -y2 * (1.f + y2 * (0.5f + y2 * (0.16666667f + y2 * (0.041666668f + y2 * 0.008333334f))));
                    const float av = __builtin_amdgcn_exp2f(1.4426950408889634f * la);
                    const float em = (y2 > -0.25f) ? ser : (1.f - av * av);
                    const float bv = __builtin_amdgcn_sqrtf(fmaxf(em, 0.f)) * (ix * xcv);
                    const unsigned pr = pk2(la * 1.4426950408889634f, bv); st[i] = pr;
                    a[i] = __builtin_amdgcn_exp2f(bf2f((unsigned short)(pr & 0xffffu))); bb[i] = __uint_as_float(pr & 0xffff0000u); }
                lb[(sc * 2 + n) * 64] = st;
                const float Al = (a[0] * a[1]) * (a[2] * a[3]);
                const float Hl = ((bb[0] * a[1] + bb[1]) * a[2] + bb[2]) * a[3] + bb[3];
                const float A0 = __shfl(Al, r), A1 = __shfl(Al, r + 16), A2 = __shfl(Al, r + 32), A3 = __shfl(Al, r + 48);
                const float H0 = __shfl(Hl, r), H1 = __shfl(Hl, r + 16), H2 = __shfl(Hl, r + 32), H3 = __shfl(Hl, r + 48);
                const float c0 = hrun[n], c1 = A0 * c0 + H0, c2 = A1 * c1 + H1, c3 = A2 * c2 + H2, c4 = A3 * c3 + H3;
                hrun[n] = c4; Arun[n] *= (A0 * A1) * (A2 * A3);
            }
#pragma unroll
            for (int tt = 0; tt < 16; ++tt) xq[tt] = xn[tt];
        }
        if (q == 0) {
#pragma unroll
            for (int n = 0; n < 2; ++n) { car[w * 64 + n * 16 + r] = Arun[n]; car[w * 64 + 32 + n * 16 + r] = hrun[n]; } }
        __syncthreads();
#pragma unroll
        for (int n = 0; n < 2; ++n) { float h = 0.f; for (int w2 = 0; w2 < w; ++w2) h = car[w2 * 64 + n * 16 + r] * h + car[w2 * 64 + 32 + n * 16 + r]; hin[n] = h; }
    }
    {
        VM_WAIT();
        float hrun[2] = {hin[0], hin[1]};
        v4u cur[2]; cur[0] = lb[0]; cur[1] = lb[64];
#pragma unroll 1
        for (int sc = 0; sc < 16; ++sc) {
            const int ts = t0 + sc * 16, scn = (sc < 15) ? sc + 1 : sc;
            v4u nxt[2]; nxt[0] = lb[(scn * 2 + 0) * 64]; nxt[1] = lb[(scn * 2 + 1) * 64];
            unsigned short gq[2][4];
#pragma unroll
            for (int n = 0; n < 2; ++n)
#pragma unroll
                for (int i = 0; i < 4; ++i) gq[n][i] = gcol[(size_t)(ts + 4 * q + i) * INW + 16 * n];
#pragma unroll
            for (int n = 0; n < 2; ++n) {
                float a[4], bb[4];
#pragma unroll
                for (int i = 0; i < 4; ++i) { const unsigned pr = cur[n][i]; a[i] = __builtin_amdgcn_exp2f(__uint_as_float(pr << 16)); bb[i] = __uint_as_float(pr & 0xffff0000u); }
                const float Al = (a[0] * a[1]) * (a[2] * a[3]);
                const float Hl = ((bb[0] * a[1] + bb[1]) * a[2] + bb[2]) * a[3] + bb[3];
                const float A0 = __shfl(Al, r), A1 = __shfl(Al, r + 16), A2 = __shfl(Al, r + 32);
                const float H0 = __shfl(Hl, r), H1 = __shfl(Hl, r + 16), H2 = __shfl(Hl, r + 32), H3 = __shfl(Hl, r + 48), A3 = __shfl(Al, r + 48);
                const float c0 = hrun[n], c1 = A0 * c0 + H0, c2 = A1 * c1 + H1, c3 = A2 * c2 + H2, c4 = A3 * c3 + H3;
                hrun[n] = c4;
                float h = (q == 0) ? c0 : (q == 1) ? c1 : (q == 2) ? c2 : c3;
#pragma unroll
                for (int i = 0; i < 4; ++i) { h = a[i] * h + bb[i]; const float gv = bf2f(gq[n][i]);
                    const float ge = gv * sigmoid_f(1.5957691216057308f * (gv + 0.044715f * gv * gv * gv));
                    ycol[(size_t)(ts + 4 * q + i) * D + 16 * n] = (bf16)(pk2(h * ge, 0.f) & 0xffffu); }
            }
            cur[0] = nxt[0]; cur[1] = nxt[1];
        }
    }
    __syncthreads();
}

__device__ __forceinline__ void attn_post(Frame& F, int l, int b, int h, int qb, float lam, float oscale) {
    const int tid_ = tid_opaque(), lane = tid_ & 63, wave_ = __builtin_amdgcn_readfirstlane(tid_ >> 6), rsub = lane >> 4, e8 = (lane & 15) * 8;
    const float* gs = FIN(I_GSUBLN) + l * 128 + e8; const Who W = who(); const bf16* OV_ = RBUF(RB_OV); bf16* AO_ = RBUF(RB_AO); const f32x4 g0 = *(const f32x4*)gs, g1 = *(const f32x4*)(gs + 4);
    const size_t rowbase = (size_t)b * SEQ + qb * 256 + wave_ * 32;
#pragma unroll
    for (int it = 0; it < 8; ++it) { const size_t row = rowbase + it * 4 + rsub;
        const v4u a = *(const GAS v4u*)(OV_ + row * D + h * 256 + e8), c = *(const GAS v4u*)(OV_ + row * D + h * 256 + 128 + e8);
        f32x4 d0 = {pg8::bf_lo(a.x) - lam * pg8::bf_lo(c.x), pg8::bf_hi(a.x) - lam * pg8::bf_hi(c.x), pg8::bf_lo(a.y) - lam * pg8::bf_lo(c.y), pg8::bf_hi(a.y) - lam * pg8::bf_hi(c.y)};
        f32x4 d1 = {pg8::bf_lo(a.z) - lam * pg8::bf_lo(c.z), pg8::bf_hi(a.z) - lam * pg8::bf_hi(c.z), pg8::bf_lo(a.w) - lam * pg8::bf_lo(c.w), pg8::bf_hi(a.w) - lam * pg8::bf_hi(c.w)};
        float ss = pg8::sumsq8(d0, d1);
        ss += __shfl_xor(ss, 1); ss += __shfl_xor(ss, 2); ss += __shfl_xor(ss, 4); ss += __shfl_xor(ss, 8);
        const float rs = __builtin_amdgcn_rsqf(ss * (1.f / 128.f) + 1e-6f) * oscale;
        d0 = d0 * rs * g0; d1 = d1 * rs * g1;
        v4u o; o.x = pk2(d0.x, d0.y); o.y = pk2(d0.z, d0.w); o.z = pk2(d1.x, d1.y); o.w = pk2(d1.z, d1.w);
        *(GAS v4u*)(AO_ + row * D + h * 128 + e8) = o; }
}

struct Args { const void* in[23]; float* out; unsigned char* ws; int ph_lo, ph_hi; };
constexpr int N_PHASES = 2 + 6 * DEPTH;
__global__ void __launch_bounds__(NWAVES * 64, 2) hymba_fwd(Args args) {
    extern __shared__ __attribute__((aligned(16))) unsigned char lds[];
    cg::grid_group grid = cg::this_grid();
    Frame F;
    F.lds = (LAS unsigned char*)lds;
    { LAS unsigned long long* tabw = (LAS unsigned long long*)(F.lds + RING_BYTES + 1024);
      if (threadIdx.x == 0) {
#pragma unroll
          for (int k = 0; k < 23; ++k) tabw[k] = (unsigned long long)args.in[k];
          tabw[23] = (unsigned long long)args.out; tabw[24] = (unsigned long long)args.ws; }
      F.tab = tabw; }
    __syncthreads();
    const int lo = args.ph_lo, hi = args.ph_hi;
#define IN(k) (lo <= (k) && (k) < hi)
#define SEAM(k) do { if (IN(k) && IN((k) + 1)) { if (local_mode && (k) != N_PHASES - 2) {     const BgConvert bg{F, 0, 0}; xcd_barrier_local_bg(bar, bg, false); } else xcd_barrier(bar); } } while (0)
#define SEAM_BG(k, sl) do { const BgConvert bg{F, opaque_s(l_), (sl)}; if (IN(k) && IN((k) + 1)) { if (local_mode) xcd_barrier_local_bg(bar, bg, true); else xcd_barrier_bg(bar, bg); } else if (IN((k) + 1)) { if (threadIdx.x >= 64) bg(); __syncthreads(); } } while (0)

    if (blockIdx.x == 0) { unsigned* bw = (unsigned*)args.ws; for (int u = threadIdx.x; u < XCD_BAR_WORDS; u += NWAVES * 64) bw[u] = 0u; }
    if (threadIdx.x < 8) ((volatile LAS unsigned*)(F.lds + LDSW_OFF))[threadIdx.x] = (threadIdx.x == 2) ? blockIdx.x : 0u;
    __syncthreads();
    if (IN(0)) { p0_prologue(F); }
    grid.sync();
    XcdBarrier bar = xcd_barrier_post((unsigned*)args.ws, (volatile LAS unsigned*)(F.lds + LDSW_OFF));
    xcd_barrier(bar);
    if (threadIdx.x == 0) {
        volatile LAS unsigned* cw = (volatile LAS unsigned*)(F.lds + LDSW_OFF); const unsigned G = gridDim.x, nloc = cw[0], nx = cw[1], rank = cw[4];
        unsigned slot = 0u; bool uniform = true;
#pragma unroll
        for (unsigned j = 0; j < 16; ++j) { const unsigned c = xb_ld(&bar.bar[XB_XCNT(j)]); if (c > 0u) { if (j < bar.x) ++slot; if (c != nloc) uniform = false; } }
        const bool local = uniform && nx == 8u && nloc * 8u == G && slot < 8u && rank < nloc && xb_ld(&bar.bar[XB_TMO]) == 0u;
        cw[2] = local ? rank * 8u + slot : blockIdx.x; cw[3] = local ? 1u : 0u; }
    __syncthreads();
    const bool local_mode = __builtin_amdgcn_readfirstlane((int)((volatile LAS unsigned*)(F.lds + LDSW_OFF))[3]) != 0;

#pragma unroll 1
    for (int l_ = 0; l_ < DEPTH; ++l_) {
        const int pb = 1 + 6 * l_;
        if (IN(pb + 0)) {
            const Who W = who(); const int l = opaque_s(l_);
            unsigned char* ws = FWS(0); const unsigned char* wl = ws + WS_W + (size_t)l * W_LAYER;
            pg8::Gemm g{(const bf16*)FOUT(), (const bf16*)(wl + WO_IN), M, INW, D}; pg8::StaticOrder S; S.init(M, INW, W.G, W.bx);
            pg8::EpiIn E{RBUF(RB_PROJ), INW, (const float*)(ws + WS_SSQ1), (const int*)FIN(I_POS), attn_body::C2};
            pg8::gemm_phase<pg8::EpiIn, pg8::StaticOrder, true, true>(F.lds, g, S, E);
        }
        SEAM_BG(pb + 0, 0);
        if (IN(pb + 1)) {
            const Who W = who(); const int l = opaque_s(l_);
            float lam, oscale;
            { const float* lq = FIN(I_LAMQ) + l * 128; const float* lk = FIN(I_LAMK) + l * 128;
              const float d0 = wave_sum(lq[W.lane] * lk[W.lane]), d1 = wave_sum(lq[64 + W.lane] * lk[64 + W.lane]);
              const float li = 0.8f - 0.6f * __expf(-0.3f * (float)l); lam = __expf(d0) - __expf(d1) + li; oscale = 1.f - li; }
#if defined(PROBE_ATTN2)
            for (int rep_ = 0; rep_ < 2; ++rep_)
#endif
            for (int item = W.vcu; item < 256; item += W.G) {
                const int bh = item >> 2, s = item & 3, b = bh >> 2, h = bh & 3;
                const attn_body::bf16* pj = (const attn_body::bf16*)(RBUF(RB_PROJ) + (size_t)b * SEQ * INW); attn_body::bf16* ov = (attn_body::bf16*)(RBUF(RB_OV) + (size_t)b * SEQ * D);
#pragma unroll 1
                for (int k = 0; k < 2; ++k) { const int qb = k ? 7 - s : s;
#pragma unroll 1
                    for (int c = 0; c < 2; ++c)
                        attn2::attn_unit128<8>(qb, pj + (h * 2 + c) * 64, pj + AW + (h * 2 + c) * 64, pj + 2 * AW + h * 128, ov + h * 256 + c * 128, (char*)lds);
                    VM_WAIT(); __syncthreads(); __builtin_amdgcn_fence(__ATOMIC_ACQUIRE, "agent"); VM_WAIT();
                    attn_post(F, l, b, h, qb, lam, oscale);
                }
            }
            __syncthreads();
#if defined(PROBE_LRU2)
            for (int rep_ = 0; rep_ < 2; ++rep_)
#endif
            for (int item = W.vcu; item < 256; item += W.G) lru_item(F, l, item);
        }
        SEAM_BG(pb + 1, 1);
        if (IN(pb + 2)) {
            const Who W = who(); const int l = opaque_s(l_);
            unsigned char* ws = FWS(0); const unsigned char* wl = ws + WS_W + (size_t)l * W_LAYER;
            pg8::Gemm g{RBUF(RB_AO), (const bf16*)(wl + WO_OUT), M, D, D}; pg8::StaticOrder S; S.init(M, D, W.G, W.bx);
            pg8::EpiRes E{(const bf16*)FOUT(), (bf16*)(ws + WS_XB0), (float*)(ws + WS_SSQ0)};
            pg8::gemm_phase<pg8::EpiRes, pg8::StaticOrder, true, true>(F.lds, g, S, E);
        }
        SEAM_BG(pb + 2, 2);
        if (IN(pb + 3)) {
            const Who W = who(); const int l = opaque_s(l_);
            unsigned char* ws = FWS(0); const unsigned char* wl = ws + WS_W + (size_t)l * W_LAYER;
            pg8::Gemm g{(const bf16*)(ws + WS_XB0), (const bf16*)(wl + WO_W1), M, FF, D}; pg8::StaticOrder S; S.init(M, FF, W.G, W.bx);
            pg8::EpiMlpIn E{RBUF(RB_HB), FF, (const float*)(ws + WS_SSQ0)};
            pg8::gemm_phase<pg8::EpiMlpIn, pg8::StaticOrder, true, true>(F.lds, g, S, E);
        }
        SEAM(pb + 3);
        if (IN(pb + 4)) {
            const Who W = who(); const int l = opaque_s(l_);
            unsigned char* ws = FWS(0); const unsigned char* wl = ws + WS_W + (size_t)l * W_LAYER;
            pg8::Gemm g{RBUF(RB_HB), (const bf16*)(wl + WO_W2), M, D, FF}; pg8::StaticOrder S; S.init(M, D, W.G, W.bx);
            pg8::EpiRes E{(const bf16*)(ws + WS_XB0), (bf16*)(ws + WS_XB0), (float*)(ws + WS_SSQ0)};
            pg8::gemm_phase<pg8::EpiRes, pg8::StaticOrder, true, true>(F.lds, g, S, E);
        }
        SEAM(pb + 4);
        if (IN(pb + 5)) {
            const Who W = who(); const int l = opaque_s(l_);
            { unsigned char* ws = FWS(0); const unsigned char* wl = ws + WS_W + (size_t)l * W_LAYER;
              pg8::Gemm g{(const bf16*)(ws + WS_P16), (const bf16*)(wl + WO_PP), M, D, opaque_s(PLE)}; pg8::StaticOrder S; S.init(M, D, W.G, W.bx);
              pg8::EpiPlain E{RBUF(RB_PP), D};
              pg8::gemm_phase<pg8::EpiPlain, pg8::StaticOrder, true, true>(F.lds, g, S, E); }
            VM_WAIT(); __syncthreads();
            { unsigned char* ws = FWS(0); const unsigned char* wl = ws + WS_W + (size_t)l * W_LAYER;
              pg8::Gemm g{(const bf16*)(ws + WS_XB0), (const bf16*)(wl + WO_PG), M, D, D}; pg8::StaticOrder S; S.init(M, D, W.G, W.bx);
              pg8::EpiPle E{(const bf16*)(ws + WS_XB0), (l == DEPTH - 1) ? RBUF(RB_XBF) : (bf16*)FOUT(), (const float*)(ws + WS_SSQ0), (float*)(ws + WS_SSQ1), (const bf16*)RBUF(RB_PP)};
              pg8::gemm_phase<pg8::EpiPle, pg8::StaticOrder, true, true>(F.lds, g, S, E); }
        }
        SEAM(pb + 5);
    }
    if (IN(N_PHASES - 1)) final_norm(F);
#undef IN
#undef SEAM
#undef SEAM_BG
}

extern "C" void kernel_launch(void* const* d_in, const int* in_sizes, int n_in, void* d_out, int out_size, void* d_ws, size_t ws_size, hipStream_t stream) {
    static int grid = 0;
    if (grid == 0) {
        if (n_in != 23 || in_sizes[0] != M * D || out_size != M * D || ws_size < WS_END) { fprintf(stderr, "kernel_launch: unexpected shapes: n_in %d in0 %d out %d ws %zu (need %zu); nothing launched\n", n_in, n_in > 0 ? in_sizes[0] : -1, out_size, ws_size, (size_t)WS_END); grid = -1; return; }
        int dev = 0, cus = 0, per_cu = 0;
        if (hipGetDevice(&dev) != hipSuccess || hipDeviceGetAttribute(&cus, hipDeviceAttributeMultiprocessorCount, dev) != hipSuccess) { grid = -1; return; }
        if (hipFuncSetAttribute((const void*)hymba_fwd, hipFuncAttributeMaxDynamicSharedMemorySize, LDS_BYTES) != hipSuccess) { fprintf(stderr, "kernel_launch: hipFuncSetAttribute failed\n"); grid = -1; return; }
        if (hipOccupancyMaxActiveBlocksPerMultiprocessor(&per_cu, (const void*)hymba_fwd, NWAVES * 64, LDS_BYTES) != hipSuccess || per_cu < 1) { fprintf(stderr, "kernel_launch: occupancy query reports %d\n", per_cu); per_cu = 1; }
        (void)hipGetLastError();
        grid = cus * per_cu;
    }
    if (grid < 0) return;
    Args a{};
    for (int i = 0; i < 23; ++i) a.in[i] = d_in[i];
    a.out = (float*)d_out; a.ws = (unsigned char*)d_ws;
#ifndef MK_CUTS
    a.ph_lo = 0; a.ph_hi = N_PHASES;
    void* kargs[] = {&a};
    hipError_t e = hipLaunchCooperativeKernel((const void*)hymba_fwd, dim3(grid), dim3(NWAVES * 64), kargs, LDS_BYTES, stream);
    if (e != hipSuccess) fprintf(stderr, "kernel_launch: cooperative launch failed: %s (grid %d)\n", hipGetErrorString(e), grid);
#else
    for (int ph = 0; ph < N_PHASES; ++ph) { a.ph_lo = ph; a.ph_hi = ph + 1; void* kargs[] = {&a};
        hipError_t e = hipLaunchCooperativeKernel((const void*)hymba_fwd, dim3(grid), dim3(NWAVES * 64), kargs, LDS_BYTES, stream);
        if (e != hipSuccess) { fprintf(stderr, "kernel_launch: launch %d failed: %s\n", ph, hipGetErrorString(e)); break; } }
#endif
}
```

```cpp
#include <hip/hip_runtime.h>
#include <cstdio>
#include <cstdint>
__device__ __forceinline__ int tid_opaque() { int t = threadIdx.x; asm volatile("" : "+v"(t)); return t; }
namespace pg8 {
#define PG8_LAS __attribute__((address_space(3)))
typedef unsigned short bf16_t;
typedef short bf16x8 __attribute__((ext_vector_type(8)));
typedef float f32x4 __attribute__((ext_vector_type(4)));
typedef unsigned u32x4 __attribute__((ext_vector_type(4)));
constexpr int BM = 256, BK = 64, HALF = 128, HTB = HALF * BK * 2  , STAGE_BYTES = 8 * HTB, NXCD = 8, WGM = 8;

__host__ __device__ __forceinline__ int lds_byte(int r, int c) { const int st = (r >> 4) * 2 + (c >> 5), rr = r & 15, cc = c & 31, ob = rr * 64 + cc * 2; return st * 1024 + (ob ^ (((ob >> 9) & 1) << 5)); }
__host__ __device__ __forceinline__ void stage_rc(int b, int& R, int& C) { const int st = b / 1024, sb = b % 1024, swz = sb ^ (((sb >> 9) & 1) << 5); R = (st >> 1) * 16 + swz / 64; C = (st & 1) * 32 + (swz % 64) / 2; }
__host__ __device__ __forceinline__ int perm32(int rho) { const int n = rho >> 4, i = rho & 15; return 8 * (i >> 2) + 4 * n + (i & 3); }

struct Unit { int pm, pn; };
struct Gemm { const bf16_t* A; const bf16_t* Bt; int M, N, K; };

struct StaticOrder {
    int nM, nN, nwg, G, c;
    __host__ __device__ void init(int M, int N, int G_, int c_) { nM = M / BM; nN = N / BM; nwg = nM * nN; G = G_; c = c_; }
    __host__ __device__ bool next(int i, Unit& u) const {
        const long L = (long)i * G + c; if (L >= nwg) return false;
        int wgid = (int)L; { const int q = nwg / NXCD, r = nwg % NXCD, xcd = wgid % NXCD, off = wgid / NXCD; wgid = (xcd < r ? xcd * (q + 1) : r * (q + 1) + (xcd - r) * q) + off; }
        const int nig = WGM * nN, gid = wgid / nig, fm = gid * WGM, gsz = (nM - fm) < WGM ? (nM - fm) : WGM;
        u.pm = fm + ((wgid % nig) % gsz); u.pn = (wgid % nig) / gsz; return true;
    }
    __device__ __forceinline__ void a_ready(const Unit&) const {}
    __device__ __forceinline__ void done(const Unit&) const {}
};

__device__ __forceinline__ unsigned cvt_pk_bf16(float lo, float hi) { unsigned r; asm volatile("v_cvt_pk_bf16_f32 %0, %1, %2" : "=v"(r) : "v"(lo), "v"(hi)); return r; }
__device__ __forceinline__ u32x4 pack8(const f32x4 v0, const f32x4 v1) { u32x4 w; w.x = cvt_pk_bf16(v0[0], v0[1]); w.y = cvt_pk_bf16(v0[2], v0[3]); w.z = cvt_pk_bf16(v1[0], v1[1]); w.w = cvt_pk_bf16(v1[2], v1[3]); return w; }
__device__ __forceinline__ float bf_lo(unsigned w) { return __uint_as_float(w << 16); }
__device__ __forceinline__ float bf_hi(unsigned w) { return __uint_as_float(w & 0xffff0000u); }
constexpr int DMODEL = 1024;
constexpr float RMS_EPS = 1e-6f;
__device__ __forceinline__ float row_rs(const float* ssq, int row) {
    const f32x4* p = (const f32x4*)(ssq + (size_t)row * 16);
    const f32x4 a = p[0], b = p[1], c = p[2], d = p[3];
    const float s = (((a[0] + a[1]) + (a[2] + a[3])) + ((b[0] + b[1]) + (b[2] + b[3]))) + (((c[0] + c[1]) + (c[2] + c[3])) + ((d[0] + d[1]) + (d[2] + d[3])));
    return __builtin_amdgcn_rsqf(s * (1.0f / DMODEL) + RMS_EPS);
}
__device__ __forceinline__ float sumsq8(const f32x4 a, const f32x4 b) { return ((a[0] * a[0] + a[1] * a[1]) + (a[2] * a[2] + a[3] * a[3])) + ((b[0] * b[0] + b[1] * b[1]) + (b[2] * b[2] + b[3] * b[3])); }

struct EpiPlain {
    static constexpr bool PERM = true, AFTER_DRAIN = false;
    bf16_t* O; int ldc;
    __device__ __forceinline__ void operator()(const f32x4 (&acc)[2][2][4][2], const Unit& u, int wr, int wc, int fr, int fq) const {
        const int row0 = u.pm * BM + wr * 64 + fr, col0 = u.pn * BM + wc * 32 + 8 * fq;
#pragma unroll
        for (int ai = 0; ai < 2; ++ai)
#pragma unroll
            for (int m = 0; m < 4; ++m) { bf16_t* rowp = O + (size_t)(row0 + ai * HALF + m * 16) * ldc + col0;
#pragma unroll
                for (int bj = 0; bj < 2; ++bj) *(u32x4*)(rowp + bj * HALF) = pack8(acc[ai][bj][m][0], acc[ai][bj][m][1]); }
    }
};
__device__ __forceinline__ void row_rs8(float (&rs)[8], const float* ssq, int row0, int fq) {
    f32x4 p[8];
#pragma unroll
    for (int i = 0; i < 8; ++i) p[i] = *(const f32x4*)(ssq + (size_t)(row0 + (i >> 2) * HALF + (i & 3) * 16) * 16 + 4 * fq);
#pragma unroll
    for (int i = 0; i < 8; ++i) { float s = (p[i][0] + p[i][1]) + (p[i][2] + p[i][3]); s += __shfl_xor(s, 16); s += __shfl_xor(s, 32); rs[i] = __builtin_amdgcn_rsqf(s * (1.0f / DMODEL) + RMS_EPS); }
}
struct EpiIn {
    static constexpr bool PERM = true, AFTER_DRAIN = false;
    bf16_t* O; int ldc; const float* ssq; const int* pos; float qscale;
    __device__ __forceinline__ void operator()(const f32x4 (&acc)[2][2][4][2], const Unit& u, int wr, int wc, int fr, int fq) const {
        const int row0 = u.pm * BM + wr * 64 + fr, col0 = u.pn * BM + wc * 32 + 8 * fq;
        const bool rope = (u.pn < 4) && !(wc & 1);
        const float sc = (u.pn < 2) ? qscale : 1.f;
        float rs[8]; row_rs8(rs, ssq, row0, fq);
        if (rope) {
            int ps[8];
#pragma unroll
            for (int i = 0; i < 8; ++i) ps[i] = pos[row0 + (i >> 2) * HALF + (i & 3) * 16];
            const bool mine = fq < 2; const float sgn = (fq == 0) ? -1.f : 1.f;
            const float invf[8] = {1.0f, 0.1939227432012558f, 0.03760603070259094f, 0.007292664609849453f, 0.0014142135623842478f, 0.00027424818836152554f, 5.3182957344688475e-05f, 1.0313385246263351e-05f};
#pragma unroll
            for (int ai = 0; ai < 2; ++ai)
#pragma unroll
                for (int m = 0; m < 4; ++m) { const int row = row0 + ai * HALF + m * 16; const float r = rs[ai * 4 + m] * sc; const float pf = (float)ps[ai * 4 + m];
                    bf16_t* rowp = O + (size_t)row * ldc + col0;
                    float c[8], sn[8];
#pragma unroll
                    for (int e = 0; e < 8; ++e) { const float rev = __builtin_amdgcn_fractf((pf * invf[e]) * 0.15915494309189535f); c[e] = mine ? __builtin_amdgcn_cosf(rev) : 1.f; sn[e] = mine ? __builtin_amdgcn_sinf(rev) * sgn : 0.f; }
#pragma unroll
                    for (int bj = 0; bj < 2; ++bj) { f32x4 v0 = acc[ai][bj][m][0] * r, v1 = acc[ai][bj][m][1] * r; f32x4 p0, p1;
#pragma unroll
                        for (int e = 0; e < 4; ++e) { p0[e] = __shfl_xor(v0[e], 16); p1[e] = __shfl_xor(v1[e], 16); }
#pragma unroll
                        for (int e = 0; e < 4; ++e) { v0[e] = v0[e] * c[e] + p0[e] * sn[e]; v1[e] = v1[e] * c[4 + e] + p1[e] * sn[4 + e]; }
                        *(u32x4*)(rowp + bj * HALF) = pack8(v0, v1); } }
        } else {
#pragma unroll
            for (int ai = 0; ai < 2; ++ai)
#pragma unroll
                for (int m = 0; m < 4; ++m) { const int row = row0 + ai * HALF + m * 16; const float r = rs[ai * 4 + m] * sc;
                    bf16_t* rowp = O + (size_t)row * ldc + col0;
#pragma unroll
                    for (int bj = 0; bj < 2; ++bj) *(u32x4*)(rowp + bj * HALF) = pack8(acc[ai][bj][m][0] * r, acc[ai][bj][m][1] * r); }
        }
    }
};
__device__ __forceinline__ void unpack8(const u32x4 w, f32x4& a, f32x4& b) { a = (f32x4){bf_lo(w.x), bf_hi(w.x), bf_lo(w.y), bf_hi(w.y)}; b = (f32x4){bf_lo(w.z), bf_hi(w.z), bf_lo(w.w), bf_hi(w.w)}; }
struct EpiRes {
    static constexpr bool PERM = true, AFTER_DRAIN = false;
    const bf16_t* Rin; bf16_t* XBo; float* ssq;
    __device__ __forceinline__ void operator()(const f32x4 (&acc)[2][2][4][2], const Unit& u, int wr, int wc, int fr, int fq) const {
        const int row0 = u.pm * BM + wr * 64 + fr, col0 = u.pn * BM + wc * 32 + 8 * fq;
        u32x4 rv[8][2];
#pragma unroll
        for (int i = 0; i < 8; ++i)
#pragma unroll
            for (int bj = 0; bj < 2; ++bj) rv[i][bj] = *(const u32x4*)(Rin + (size_t)(row0 + (i >> 2) * HALF + (i & 3) * 16) * DMODEL + col0 + bj * HALF);
#pragma unroll
        for (int ai = 0; ai < 2; ++ai)
#pragma unroll
            for (int m = 0; m < 4; ++m) { const int row = row0 + ai * HALF + m * 16; float part = 0.f;
#pragma unroll
                for (int bj = 0; bj < 2; ++bj) { f32x4 r0, r1; unpack8(rv[ai * 4 + m][bj], r0, r1);
                    const f32x4 h0 = r0 + acc[ai][bj][m][0], h1 = r1 + acc[ai][bj][m][1]; part += sumsq8(h0, h1);
                    *(u32x4*)(XBo + (size_t)row * DMODEL + col0 + bj * HALF) = pack8(h0, h1); }
                part += __shfl_xor(part, 16); part += __shfl_xor(part, 32);
                if (fq == 0) ssq[(size_t)row * 16 + u.pn * 4 + wc] = part; }
    }
};
struct EpiMlpIn {
    static constexpr bool PERM = true, AFTER_DRAIN = false;
    bf16_t* O; int ldc; const float* ssq;
    __device__ __forceinline__ void operator()(const f32x4 (&acc)[2][2][4][2], const Unit& u, int wr, int wc, int fr, int fq) const {
        const int row0 = u.pm * BM + wr * 64 + fr, col0 = u.pn * BM + wc * 32 + 8 * fq;
        float rs[8]; row_rs8(rs, ssq, row0, fq);
#pragma unroll
        for (int ai = 0; ai < 2; ++ai)
#pragma unroll
            for (int m = 0; m < 4; ++m) { const int row = row0 + ai * HALF + m * 16; const float r = rs[ai * 4 + m];
                bf16_t* rowp = O + (size_t)row * ldc + col0;
#pragma unroll
                for (int bj = 0; bj < 2; ++bj) { f32x4 v0 = acc[ai][bj][m][0] * r, v1 = acc[ai][bj][m][1] * r;
#pragma unroll
                    for (int e = 0; e < 4; ++e) { const float a = fmaxf(v0[e], 0.f), b = fmaxf(v1[e], 0.f); v0[e] = a * a; v1[e] = b * b; }
                    *(u32x4*)(rowp + bj * HALF) = pack8(v0, v1); } }
    }
};
struct EpiPle {
    static constexpr bool PERM = true, AFTER_DRAIN = false;
    const bf16_t* Rin; bf16_t* XBo; const float* ssq_in; float* ssq_out; const bf16_t* PP;
    __device__ __forceinline__ void operator()(const f32x4 (&acc)[2][2][4][2], const Unit& u, int wr, int wc, int fr, int fq) const {
        const int row0 = u.pm * BM + wr * 64 + fr, col0 = u.pn * BM + wc * 32 + 8 * fq;
#pragma unroll
        for (int ai = 0; ai < 2; ++ai)
#pragma unroll
          for (int mh = 0; mh < 2; ++mh) {
            u32x4 rv[2][2], pw[2][2]; f32x4 p[2];
#pragma unroll
            for (int mm = 0; mm < 2; ++mm) { const int rowl = row0 + ai * HALF + (2 * mh + mm) * 16; p[mm] = *(const f32x4*)(ssq_in + (size_t)rowl * 16 + 4 * fq);
#pragma unroll
                for (int bj = 0; bj < 2; ++bj) { const size_t off = (size_t)rowl * DMODEL + col0 + bj * HALF; rv[mm][bj] = *(const u32x4*)(Rin + off); pw[mm][bj] = *(const u32x4*)(PP + off); } }
#pragma unroll
            for (int mm = 0; mm < 2; ++mm) { const int m = 2 * mh + mm; const int row = row0 + ai * HALF + m * 16; float part = 0.f;
                float sr = (p[mm][0] + p[mm][1]) + (p[mm][2] + p[mm][3]); sr += __shfl_xor(sr, 16); sr += __shfl_xor(sr, 32); const float r = __builtin_amdgcn_rsqf(sr * (1.0f / DMODEL) + RMS_EPS);
#pragma unroll
                for (int bj = 0; bj < 2; ++bj) { f32x4 r0, r1, p0, p1; unpack8(rv[mm][bj], r0, r1); unpack8(pw[mm][bj], p0, p1);
                    f32x4 g0 = acc[ai][bj][m][0] * r, g1 = acc[ai][bj][m][1] * r;
#pragma unroll
                    for (int e = 0; e < 4; ++e) { g0[e] = __builtin_amdgcn_rcpf(1.f + __builtin_amdgcn_exp2f(-1.4426950408889634f * g0[e])); g1[e] = __builtin_amdgcn_rcpf(1.f + __builtin_amdgcn_exp2f(-1.4426950408889634f * g1[e])); }
                    const f32x4 h0 = r0 + g0 * p0, h1 = r1 + g1 * p1; part += sumsq8(h0, h1);
                    *(u32x4*)(XBo + (size_t)row * DMODEL + col0 + bj * HALF) = pack8(h0, h1); }
                part += __shfl_xor(part, 16); part += __shfl_xor(part, 32);
                if (fq == 0) ssq_out[(size_t)row * 16 + u.pn * 4 + wc] = part; }
            asm volatile("" ::: "memory"); }
    }
};

template <class Epi, class Sched, bool ALIGN_EPI = false, bool SP2 = false>
__device__ __forceinline__ void gemm_phase(PG8_LAS unsigned char* lds, const Gemm g, const Sched& S, const Epi& E) {
    const int tid = tid_opaque(), wid = __builtin_amdgcn_readfirstlane(tid >> 6), lane = tid & 63, wr = wid >> 2, wc = wid & 3, fr = lane & 15, fq = lane >> 4;
    const int K = g.K, nt = K / BK;
    unsigned voffA[2], voffB[2];
#pragma unroll
    for (int i = 0; i < 2; ++i) { int R, C; stage_rc(tid * 16 + i * 8192, R, C); const int Rb = Epi::PERM ? ((R & ~31) + perm32(R & 31)) : R;
        voffA[i] = (unsigned)(R * K + C) * 2u; voffB[i] = (unsigned)(Rb * K + C) * 2u; }
    const size_t kstep = (size_t)(BK * 2);
    const size_t hstep = (size_t)HALF * K * 2;
    const size_t tstep = 2 * hstep;
    const unsigned ldsw = (unsigned)wid * 1024u;
    const int aoff = lds_byte(wr * 64 + fr, fq * 8), boff = lds_byte(wc * 32 + fr, fq * 8);
#define PG8_SA(b, h) (((b) * 2 + (h)) * HTB)
#define PG8_SB(b, h) ((4 + (b) * 2 + (h)) * HTB)
#define PG8_STAGE(bufoff, gbase, voff) do { _Pragma("unroll") for (int _i = 0; _i < 2; ++_i) \
        __builtin_amdgcn_global_load_lds((const unsigned*)((const char*)(gbase) + (voff)[_i]), (PG8_LAS unsigned*)(lds + (bufoff) + ldsw + _i * 8192), 16, 0, 0); } while (0)
#define PG8_LDA(dst, b, h) do { _Pragma("unroll") for (int m = 0; m < 4; ++m) _Pragma("unroll") for (int k = 0; k < 2; ++k) dst[m][k] = *(const PG8_LAS bf16x8*)(lds + PG8_SA(b, h) + aoff + m * 2048 + k * 1024); } while (0)
#define PG8_LDB(dst, b, h) do { _Pragma("unroll") for (int n = 0; n < 2; ++n) _Pragma("unroll") for (int k = 0; k < 2; ++k) dst[n][k] = *(const PG8_LAS bf16x8*)(lds + PG8_SB(b, h) + boff + n * 2048 + k * 1024); } while (0)
#define PG8_MMA(ai, bj, At, Bt) do { __builtin_amdgcn_s_setprio(1); _Pragma("unroll") for (int m = 0; m < 4; ++m) _Pragma("unroll") for (int n = 0; n < 2; ++n) _Pragma("unroll") for (int k = 0; k < 2; ++k) \
        acc[ai][bj][m][n] = __builtin_amdgcn_mfma_f32_16x16x32_bf16(Bt[n][k], At[m][k], acc[ai][bj][m][n], 0, 0, 0); __builtin_amdgcn_s_setprio(0); } while (0)
#define PG8_WAIT_V(n) asm volatile("s_waitcnt vmcnt(" #n ")" ::: "memory")
#define PG8_WAIT_L(n) asm volatile("s_waitcnt lgkmcnt(" #n ")" ::: "memory")
#define PG8_BAR __builtin_amdgcn_s_barrier()
#define PG8_SCHED __builtin_amdgcn_sched_barrier(0)
    Unit cur, nxt; int ui = 0;
    if (!S.next(0, cur)) return;
    f32x4 acc[2][2][4][2];
#pragma unroll
    for (int a = 0; a < 2; ++a)
#pragma unroll
        for (int b = 0; b < 2; ++b)
#pragma unroll
            for (int m = 0; m < 4; ++m)
#pragma unroll
                for (int n = 0; n < 2; ++n) acc[a][b][m][n] = (f32x4){0.f, 0.f, 0.f, 0.f};
    bf16x8 At[4][2], B0[2][2], B1[2][2];
    const char* cA = (const char*)g.A + (size_t)cur.pm * tstep; const char* cB = (const char*)g.Bt + (size_t)cur.pn * tstep;
    S.a_ready(cur);
    if constexpr (SP2) {
        PG8_STAGE(PG8_SB(0, 0), cB, voffB); PG8_STAGE(PG8_SB(0, 1), cB + hstep, voffB); PG8_STAGE(PG8_SA(0, 0), cA, voffA); PG8_STAGE(PG8_SA(0, 1), cA + hstep, voffA);
        if (wr == 1) PG8_BAR;
        PG8_WAIT_V(2); PG8_BAR;
        PG8_STAGE(PG8_SB(1, 0), cB + kstep, voffB); PG8_STAGE(PG8_SA(1, 0), cA + kstep, voffA); PG8_STAGE(PG8_SB(1, 1), cB + hstep + kstep, voffB);
        PG8_WAIT_V(6); PG8_BAR;
    } else {
        PG8_STAGE(PG8_SB(0, 0), cB, voffB); PG8_STAGE(PG8_SA(0, 0), cA, voffA); PG8_STAGE(PG8_SB(0, 1), cB + hstep, voffB); PG8_STAGE(PG8_SA(0, 1), cA + hstep, voffA);
        if (wr == 1) PG8_BAR;
        PG8_WAIT_V(4); PG8_BAR;
        PG8_STAGE(PG8_SB(1, 0), cB + kstep, voffB); PG8_STAGE(PG8_SA(1, 0), cA + kstep, voffA); PG8_STAGE(PG8_SB(1, 1), cB + hstep + kstep, voffB);
        PG8_WAIT_V(6); PG8_BAR;
    }
    for (;;) {
        const bool has_next = S.next(ui + 1, nxt);
        const char* nA = has_next ? (const char*)g.A + (size_t)nxt.pm * tstep : cA; const char* nB = has_next ? (const char*)g.Bt + (size_t)nxt.pn * tstep : cB;
        for (int t = 0; t < nt; t += 2) {
            const bool last = (t == nt - 2);
            const char* a1 = cA + (size_t)(t + 1) * kstep;
            const char* a2 = last ? nA : cA + (size_t)(t + 2) * kstep; const char* b2 = last ? nB : cB + (size_t)(t + 2) * kstep;
            const char* a3 = a2 + kstep; const char* b3 = b2 + kstep;
            if (last && has_next) S.a_ready(nxt);
            if constexpr (SP2) {
            PG8_LDB(B0, 0, 0); PG8_LDB(B1, 0, 1); PG8_SCHED; PG8_LDA(At, 0, 0); PG8_STAGE(PG8_SA(1, 1), a1 + hstep, voffA);
            PG8_WAIT_V(8); PG8_WAIT_L(0); PG8_BAR; PG8_MMA(0, 0, At, B0); PG8_MMA(0, 1, At, B1); PG8_BAR; PG8_SCHED;
            PG8_LDA(At, 0, 1); PG8_STAGE(PG8_SB(0, 0), b2, voffB); PG8_STAGE(PG8_SB(0, 1), b2 + hstep, voffB); PG8_STAGE(PG8_SA(0, 0), a2, voffA);
            PG8_WAIT_V(8); PG8_WAIT_L(0); PG8_BAR; PG8_MMA(1, 0, At, B0); PG8_MMA(1, 1, At, B1); PG8_BAR; PG8_SCHED;
            PG8_LDB(B0, 1, 0); PG8_LDB(B1, 1, 1); PG8_SCHED; PG8_LDA(At, 1, 0); PG8_STAGE(PG8_SA(0, 1), a2 + hstep, voffA);
            PG8_WAIT_V(8); PG8_WAIT_L(0); PG8_BAR; PG8_MMA(0, 0, At, B0); PG8_MMA(0, 1, At, B1); PG8_BAR; PG8_SCHED;
            PG8_LDA(At, 1, 1); PG8_STAGE(PG8_SB(1, 0), b3, voffB); PG8_STAGE(PG8_SB(1, 1), b3 + hstep, voffB); PG8_STAGE(PG8_SA(1, 0), a3, voffA);
            PG8_WAIT_V(8); PG8_WAIT_L(0); PG8_BAR; PG8_MMA(1, 0, At, B0); PG8_MMA(1, 1, At, B1); PG8_BAR; PG8_SCHED;
            } else {
            PG8_LDB(B0, 0, 0); PG8_SCHED; PG8_LDA(At, 0, 0); PG8_STAGE(PG8_SA(1, 1), a1 + hstep, voffA);
            PG8_WAIT_L(8); PG8_BAR; PG8_WAIT_L(0); PG8_MMA(0, 0, At, B0); PG8_BAR; PG8_SCHED;
            PG8_LDB(B1, 0, 1); PG8_STAGE(PG8_SB(0, 0), b2, voffB);
            PG8_BAR; PG8_WAIT_L(0); PG8_MMA(0, 1, At, B1); PG8_BAR;
            PG8_LDA(At, 0, 1); PG8_STAGE(PG8_SA(0, 0), a2, voffA);
            PG8_BAR; PG8_WAIT_L(0); PG8_MMA(1, 0, At, B0); PG8_BAR; PG8_SCHED;
            PG8_STAGE(PG8_SB(0, 1), b2 + hstep, voffB);
            PG8_WAIT_V(6); PG8_BAR; PG8_MMA(1, 1, At, B1); PG8_BAR;
            PG8_LDB(B0, 1, 0); PG8_SCHED; PG8_LDA(At, 1, 0); PG8_STAGE(PG8_SA(0, 1), a2 + hstep, voffA);
            PG8_WAIT_L(8); PG8_BAR; PG8_WAIT_L(0); PG8_MMA(0, 0, At, B0); PG8_BAR; PG8_SCHED;
            PG8_LDB(B1, 1, 1); PG8_STAGE(PG8_SB(1, 0), b3, voffB);
            PG8_BAR; PG8_WAIT_L(0); PG8_MMA(0, 1, At, B1); PG8_BAR;
            PG8_LDA(At, 1, 1); PG8_STAGE(PG8_SA(1, 0), a3, voffA);
            PG8_BAR; PG8_WAIT_L(0); PG8_MMA(1, 0, At, B0); PG8_BAR; PG8_SCHED;
            PG8_STAGE(PG8_SB(1, 1), b3 + hstep, voffB);
            PG8_WAIT_V(6); PG8_BAR; PG8_MMA(1, 1, At, B1); PG8_BAR;
            }
        }
        if constexpr (ALIGN_EPI) { if (wr == 0) PG8_BAR; }
        if constexpr (!Epi::AFTER_DRAIN) { const int t2 = tid_opaque(), w2 = __builtin_amdgcn_readfirstlane(t2 >> 6), l2 = t2 & 63;
            E(acc, cur, w2 >> 2, w2 & 3, l2 & 15, l2 >> 4); S.done(cur); }
        if (!has_next) break;
#pragma unroll
        for (int a = 0; a < 2; ++a)
#pragma unroll
            for (int b = 0; b < 2; ++b)
#pragma unroll
                for (int m = 0; m < 4; ++m)
#pragma unroll
                    for (int n = 0; n < 2; ++n) acc[a][b][m][n] = (f32x4){0.f, 0.f, 0.f, 0.f};
        cur = nxt; cA = nA; cB = nB; ++ui;
        if constexpr (ALIGN_EPI) { if (wr == 1) PG8_BAR; }
    }
    PG8_WAIT_V(0);
    if constexpr (!ALIGN_EPI) { if (wr == 0) PG8_BAR; }
    PG8_BAR;
    if constexpr (Epi::AFTER_DRAIN) { E.fused(acc, cur, wr, wc, fr, fq, lds, wid, lane); S.done(cur); }
#undef PG8_SA
#undef PG8_SB
#undef PG8_STAGE
#undef PG8_LDA
#undef PG8_LDB
#undef PG8_MMA
#undef PG8_WAIT_V
#undef PG8_WAIT_L
#undef PG8_BAR
#undef PG8_SCHED
}
}
#ifndef PG8_SP2
#define PG8_SP2 true
#endif
#include <hip/hip_bf16.h>
#include <cmath>
namespace attn_body {
using bf16=__hip_bfloat16;
using bf16x8=__attribute__((ext_vector_type(8)))short;
using s16x4=__attribute__((ext_vector_type(4)))short;
using f32x16=__attribute__((ext_vector_type(16)))float;
using u32x4=__attribute__((ext_vector_type(4)))unsigned;
constexpr int D=64,PQ=2560,PO=1024;
constexpr int NW=8,QBLK=32,QB=QBLK*NW,KVBLK=64;
constexpr int ATTN_UNIT_ROWS=QB;
__device__ __forceinline__ int crow(int r,int hi){return (r&3)+8*(r>>2)+4*hi;}
#define SBAR() __builtin_amdgcn_sched_barrier(0)
__device__ __forceinline__ void cmask(f32x16&p0,f32x16&p1,int jb,int qrel,int hi){
  const float NEG=-INFINITY; int kb=64*jb+4*hi;
  #pragma unroll
  for(int r=0;r<16;++r){int kv=kb+(r&3)+8*(r>>2); if(kv>qrel)p0[r]=NEG; if(kv+32>qrel)p1[r]=NEG;}
}

constexpr int NSLOT=3, SLOTB=8192;
constexpr int LDS_K=0, LDS_V=NSLOT*SLOTB, LDS_WS=2*NSLOT*SLOTB, LDS_OST=LDS_WS+NW*64*4, LDS_BYTES=LDS_OST+NW*4096;
constexpr float C2=0.125f*1.4426950408889634f;
__device__ __forceinline__ void glds16(const void*gsrc,unsigned lds_dst){unsigned keep;
  asm volatile("s_mov_b32 %0, m0\n\ts_mov_b32 m0, %2\n\ts_nop 0\n\tglobal_load_lds_dwordx4 %1, off\n\ts_mov_b32 m0, %0":"=&s"(keep):"v"(gsrc),"s"(lds_dst):"memory");}
__device__ __forceinline__ float max3f(float a,float b,float c){float r;asm("v_max3_f32 %0, %1, %2, %3":"=v"(r):"v"(a),"v"(b),"v"(c));return r;}
__device__ __forceinline__ float max2f(float a,float b){float r;asm("v_max_f32_e32 %0, %1, %2":"=v"(r):"v"(a),"v"(b));return r;}
__device__ __forceinline__ float fadd_s(float a,float b){float r;asm("v_add_f32_e32 %0, %1, %2":"=v"(r):"v"(a),"v"(b));return r;}
__device__ __forceinline__ float fsub_s(float a,float b){float r;asm("v_sub_f32_e32 %0, %1, %2":"=v"(r):"v"(a),"v"(b));return r;}
typedef float f32x2_t __attribute__((ext_vector_type(2))); typedef __bf16 bf16x2_t __attribute__((ext_vector_type(2)));
__device__ __forceinline__ unsigned cvtpk_s(float lo,float hi){f32x2_t v={lo,hi};bf16x2_t b=__builtin_convertvector(v,bf16x2_t);return __builtin_bit_cast(unsigned,b);}
#define WAIT_BAR(N) asm volatile("s_waitcnt vmcnt(" #N ") lgkmcnt(0)\n\ts_barrier":::"memory")

__device__ __forceinline__ void qkt(f32x16&p0,f32x16&p1,const char*Kslot,const bf16x8*qr,const f32x16&negm,int r32,int hi){
  const char*kb=Kslot+hi*1024+r32*16;
  #pragma unroll
  for(int d0=0;d0<4;++d0){
    const bf16x8 b0=*reinterpret_cast<const bf16x8*>(kb+d0*2048);
    const bf16x8 b1=*reinterpret_cast<const bf16x8*>(kb+d0*2048+512);
    if(d0==0){p0=__builtin_amdgcn_mfma_f32_32x32x16_bf16(b0,qr[0],negm,0,0,0);p1=__builtin_amdgcn_mfma_f32_32x32x16_bf16(b1,qr[0],negm,0,0,0);}
    else{p0=__builtin_amdgcn_mfma_f32_32x32x16_bf16(b0,qr[d0],p0,0,0,0);p1=__builtin_amdgcn_mfma_f32_32x32x16_bf16(b1,qr[d0],p1,0,0,0);}}
}
typedef __attribute__((address_space(3))) const char* lds_cptr;
typedef short v4i16_t __attribute__((ext_vector_type(4)));
__device__ __forceinline__ void kload8(bf16x8*kf,lds_cptr kp){
  kf[0]=*(const __attribute__((address_space(3))) bf16x8*)(kp);      kf[1]=*(const __attribute__((address_space(3))) bf16x8*)(kp+512);
  kf[2]=*(const __attribute__((address_space(3))) bf16x8*)(kp+2048); kf[3]=*(const __attribute__((address_space(3))) bf16x8*)(kp+2560);
  kf[4]=*(const __attribute__((address_space(3))) bf16x8*)(kp+4096); kf[5]=*(const __attribute__((address_space(3))) bf16x8*)(kp+4608);
  kf[6]=*(const __attribute__((address_space(3))) bf16x8*)(kp+6144); kf[7]=*(const __attribute__((address_space(3))) bf16x8*)(kp+6656);
}
__device__ __forceinline__ void kload2(bf16x8*kf,lds_cptr kp,int j){ kf[2*j]=*(const __attribute__((address_space(3))) bf16x8*)(kp+j*2048); kf[2*j+1]=*(const __attribute__((address_space(3))) bf16x8*)(kp+j*2048+512); }
__device__ __forceinline__ s16x4 vtr(lds_cptr p){ return __builtin_bit_cast(s16x4,__builtin_amdgcn_ds_read_tr16_b64_v4i16((__attribute__((address_space(3))) v4i16_t*)p)); }
__device__ __forceinline__ float rowmax(const f32x16&p0,const f32x16&p1){
  float a=max3f(p0[0],p0[1],p1[0]),b=max3f(p0[2],p0[3],p1[1]);a=max3f(a,p1[2],p1[3]);
  #pragma unroll
  for(int r=4;r<16;r+=4){a=max3f(a,p0[r],p0[r+1]);b=max3f(b,p0[r+2],p0[r+3]);a=max3f(a,p1[r],p1[r+1]);b=max3f(b,p1[r+2],p1[r+3]);}
  const float m=max2f(a,b);
  auto rr=__builtin_amdgcn_permlane32_swap(__float_as_uint(m),__float_as_uint(m),false,false);
  return max2f(__uint_as_float(rr[0]),__uint_as_float(rr[1]));
}
__device__ __forceinline__ void pv(f32x16*o,int vb,bf16x8 pa0,bf16x8 pa1,bf16x8 pa2,bf16x8 pa3){
  #pragma unroll
  for(int d0=0;d0<2;++d0){s16x4 lo[4],hi[4];
    #pragma unroll
    for(int ks=0;ks<4;++ks){
      asm volatile("ds_read_b64_tr_b16 %0,%1 offset:%c2":"=&v"(lo[ks]):"v"(vb),"i"(d0*4096+ks*1024):"memory");
      asm volatile("ds_read_b64_tr_b16 %0,%1 offset:%c2":"=&v"(hi[ks]):"v"(vb),"i"(d0*4096+ks*1024+512):"memory");}
    asm volatile("s_waitcnt lgkmcnt(0)":::"memory");SBAR();
    #define PK(k) (bf16x8){lo[k][0],lo[k][1],lo[k][2],lo[k][3],hi[k][0],hi[k][1],hi[k][2],hi[k][3]}
    o[d0]=__builtin_amdgcn_mfma_f32_32x32x16_bf16(pa0,PK(0),o[d0],0,0,0);
    o[d0]=__builtin_amdgcn_mfma_f32_32x32x16_bf16(pa1,PK(1),o[d0],0,0,0);
    o[d0]=__builtin_amdgcn_mfma_f32_32x32x16_bf16(pa2,PK(2),o[d0],0,0,0);
    o[d0]=__builtin_amdgcn_mfma_f32_32x32x16_bf16(pa3,PK(3),o[d0],0,0,0);
    #undef PK
  }
}

#ifndef ATTN_STORE16
#define ATTN_STORE16(p,v) (*(u32x4*)(p)=(v))
#endif
template<int THRL> __device__ __forceinline__ void attn_unit(int qb,const bf16*Qh,const bf16*__restrict__ Kh,const bf16*__restrict__ Vh,bf16*Oh,char*shm){
  const int tid=tid_opaque(),lane=tid&63,r32=lane&31,hi=lane>>5; const int wid=__builtin_amdgcn_readfirstlane(tid>>6);
  const int q0=qb*QB;
  const bf16*Qw=Qh+(long)(q0+wid*QBLK)*PQ;
  const unsigned lds0=(unsigned)(uintptr_t)shm;
  float*wsf=(float*)(shm+LDS_WS)+wid*64;
  const bf16*ksrc=Kh+(long)lane*PQ+wid*8;
  const bf16*vsrc=Vh+(long)(16*(wid&3)+(lane>>2))*PQ+(wid>>2)*32+(lane&3)*8;
  const unsigned kdst=lds0+LDS_K+wid*1024, vdst=lds0+LDS_V+wid*1024;
  #define DMA_K(t,slot) glds16(ksrc+(long)(t)*KVBLK*PQ,(unsigned)__builtin_amdgcn_readfirstlane(kdst+(slot)))
  #define DMA_V(t,slot) glds16(vsrc+(long)(t)*KVBLK*PQ,(unsigned)__builtin_amdgcn_readfirstlane(vdst+(slot)))
  const int vb0=(int)(lds0+LDS_V)+((lane>>4)&1)*32+(lane&3)*8+(4*hi+((lane&15)>>2))*64;
  const char*Kbase=shm+LDS_K; bf16x8 kf[8];
  const lds_cptr shm3=(lds_cptr)shm; const lds_cptr kp0=shm3+LDS_K+hi*1024+r32*16; const lds_cptr vp0=shm3+LDS_V+((lane>>4)&1)*32+(lane&3)*8+(4*hi+((lane&15)>>2))*64;
  const int NT=(q0+QB)/KVBLK;
  DMA_K(0,0);DMA_V(0,0);DMA_K(1,SLOTB);
  bf16x8 qr[4];
  #pragma unroll
  for(int d0=0;d0<4;++d0)qr[d0]=*reinterpret_cast<const bf16x8*>(&Qw[(long)r32*PQ+d0*16+hi*8]);
  float mhat=0.f,l_reg=0.f;f32x16 o[2];o[0]=f32x16{};o[1]=f32x16{};f32x16 negm=f32x16{};asm volatile("":"+v"(negm));
  const int qrel=wid*QBLK+r32;
  #define CMASK(P0,P1,t) do{int jb_=(t)-(NT-4); if(jb_>=0)cmask(P0,P1,jb_,qrel,hi);}while(0)
  bool resc=false;
  #define START(P0,P1) do{ const float rm=rowmax(P0,P1); resc=false; \
    { const float dl=rm; mhat=fadd_s(mhat,dl); \
      _Pragma("unroll") for(int r=0;r<16;++r){P0[r]=fsub_s(P0[r],dl);P1[r]=fsub_s(P1[r],dl);} \
      _Pragma("unroll") for(int r=0;r<16;++r)negm[r]=-mhat; asm volatile("":"+v"(negm)); } \
    _Pragma("unroll") for(int r=0;r<16;++r)P0[r]=__builtin_amdgcn_exp2f(P0[r]); }while(0)
  #define RESC() do{ if(resc){ asm volatile("s_waitcnt lgkmcnt(0)":::"memory"); \
      _Pragma("unroll") for(int d_=0;d_<2;++d_) _Pragma("unroll") for(int r=0;r<16;++r)o[d_][r]*=wsf[crow(r,hi)]; } }while(0)
  f32x16 pA0,pA1,pB0,pB1;
  int sl_prev=0,sl_cur=0,sl_next=SLOTB;
  #define ROT() do{sl_prev=sl_cur;sl_cur=sl_next;sl_next=(sl_next==(NSLOT-1)*SLOTB)?0:sl_next+SLOTB;}while(0)
  DMA_K(2,2*SLOTB);
  WAIT_BAR(3);
  qkt(pA0,pA1,Kbase,qr,negm,r32,hi);asm volatile("s_nop 15\n\ts_nop 7":"+v"(pA0),"+v"(pA1));CMASK(pA0,pA1,0);
  START(pA0,pA1);
  _Pragma("unroll") for(int r=0;r<16;++r)pA1[r]=__builtin_amdgcn_exp2f(pA1[r]);
  WAIT_BAR(0);
  DMA_K(3,0);DMA_V(1,SLOTB);
  ROT();
  kload8(kf,kp0+sl_cur);
  WAIT_BAR(2);
  s16x4 vlo[8],vhi[8]; u32x4 pw0,pw1,pw2,pw3;
  #define PKW(P,B) cvtpk_s(P[B],P[B+1])
  #define PAF(k) __builtin_bit_cast(bf16x8,pw##k)
  #define VFR(i) (bf16x8){vlo[i][0],vlo[i][1],vlo[i][2],vlo[i][3],vhi[i][0],vhi[i][1],vhi[i][2],vhi[i][3]}
  #define PIN(x) asm volatile("":"+v"(x))
  #define MX3(a,b,c) __builtin_fmaxf(__builtin_fmaxf((a),(b)),(c))
  #define GAPA(MF,A0,A1,A2,A3,W0,W1,PW) do{ MF; sacc+=A0; sacc+=A1; sacc+=A2; sacc+=A3; PIN(sacc); W0; W1; PIN(PW); SBAR(); }while(0)
  #define EX(v) __builtin_amdgcn_exp2f(v)
  #define GAPB(MF,X,B) do{ MF; X[B]=EX(X[B]); X[B+1]=EX(X[B+1]); X[B+2]=EX(X[B+2]); X[B+3]=EX(X[B+3]); PIN(X); SBAR(); }while(0)
  #define VRD(i) do{ vlo[i]=vtr(vp_+(((i)>>2)*4096+((i)&3)*1024)); vhi[i]=vtr(vp_+(((i)>>2)*4096+((i)&3)*1024+512)); }while(0)
  #define KRD(G,j) do{ if(G){ kload2(kf,kp0+sl_next,j); SBAR(); } }while(0)
  #define STEP(C0,C1,P0,P1,t,GK,GV,GL) do{ SBAR(); \
    const lds_cptr vp_=vp0+sl_prev; \
    VRD(0); SBAR(); float sacc=(P0[0]+P0[1]); \
    GAPA(C0=__builtin_amdgcn_mfma_f32_32x32x16_bf16(kf[0],qr[0],negm,0,0,0), P0[2],P0[3],P0[4],P0[5],     pw0[0]=PKW(P0,0), pw0[1]=PKW(P0,2), pw0); \
    VRD(4); SBAR(); GAPA(C1=__builtin_amdgcn_mfma_f32_32x32x16_bf16(kf[1],qr[0],negm,0,0,0), P0[6],P0[7],P0[8],P0[9],     pw0[2]=PKW(P0,4), pw0[3]=PKW(P0,6), pw0); \
    VRD(1); SBAR(); GAPA(C0=__builtin_amdgcn_mfma_f32_32x32x16_bf16(kf[2],qr[1],C0,0,0,0),   P0[10],P0[11],P0[12],P0[13], pw1[0]=PKW(P0,8), pw1[1]=PKW(P0,10), pw1); \
    VRD(5); SBAR(); GAPA(C1=__builtin_amdgcn_mfma_f32_32x32x16_bf16(kf[3],qr[1],C1,0,0,0),   P0[14],P0[15],P1[0],P1[1],   pw1[2]=PKW(P0,12),pw1[3]=PKW(P0,14), pw1); \
    VRD(2); SBAR(); GAPA(C0=__builtin_amdgcn_mfma_f32_32x32x16_bf16(kf[4],qr[2],C0,0,0,0),   P1[2],P1[3],P1[4],P1[5],     pw2[0]=PKW(P1,0), pw2[1]=PKW(P1,2), pw2); \
    VRD(6); SBAR(); GAPA(C1=__builtin_amdgcn_mfma_f32_32x32x16_bf16(kf[5],qr[2],C1,0,0,0),   P1[6],P1[7],P1[8],P1[9],     pw2[2]=PKW(P1,4), pw2[3]=PKW(P1,6), pw2); \
    VRD(3); SBAR(); GAPA(C0=__builtin_amdgcn_mfma_f32_32x32x16_bf16(kf[6],qr[3],C0,0,0,0),   P1[10],P1[11],P1[12],P1[13], pw3[0]=PKW(P1,8), pw3[1]=PKW(P1,10), pw3); \
    VRD(7); SBAR(); GAPA(C1=__builtin_amdgcn_mfma_f32_32x32x16_bf16(kf[7],qr[3],C1,0,0,0),   P1[14],P1[15],0.f,0.f,       pw3[2]=PKW(P1,12),pw3[3]=PKW(P1,14), pw3); \
    l_reg+=sacc; \
    if(GK){DMA_K((t)+3,sl_cur);} if(GV){DMA_V((t)+1,sl_next);} \
    CMASK(C0,C1,t); \
    { float a=MX3(C0[0],C0[1],C1[0]),b=MX3(C0[2],C0[3],C1[1]); a=MX3(a,C1[2],C1[3]); \
      _Pragma("unroll") for(int r=4;r<16;r+=4){a=MX3(a,C0[r],C0[r+1]);b=MX3(b,C0[r+2],C0[r+3]);a=MX3(a,C1[r],C1[r+1]);b=MX3(b,C1[r+2],C1[r+3]);} \
      float rm=__builtin_fmaxf(a,b); { auto rr=__builtin_amdgcn_permlane32_swap(__float_as_uint(rm),__float_as_uint(rm),false,false); rm=__builtin_fmaxf(__uint_as_float(rr[0]),__uint_as_float(rr[1])); } \
      resc=false; \
      if(__builtin_expect(__any(rm>(float)THRL),0)){ const float dl=__builtin_fmaxf(rm,0.f); mhat+=dl; \
        _Pragma("unroll") for(int r=0;r<16;++r){C0[r]-=dl;C1[r]-=dl;} \
        _Pragma("unroll") for(int r=0;r<16;++r)negm[r]=-mhat; asm volatile("":"+v"(negm)); \
        const float f=__builtin_amdgcn_exp2f(-dl); l_reg*=f; if(hi==0)wsf[r32]=f; resc=true; } } \
    SBAR(); \
    GAPB(o[0]=__builtin_amdgcn_mfma_f32_32x32x16_bf16(PAF(0),VFR(0),o[0],0,0,0), C0,0); \
    GAPB(o[1]=__builtin_amdgcn_mfma_f32_32x32x16_bf16(PAF(0),VFR(4),o[1],0,0,0), C0,4); \
    KRD(GL,0); GAPB(o[0]=__builtin_amdgcn_mfma_f32_32x32x16_bf16(PAF(1),VFR(1),o[0],0,0,0), C0,8); \
    KRD(GL,1); GAPB(o[1]=__builtin_amdgcn_mfma_f32_32x32x16_bf16(PAF(1),VFR(5),o[1],0,0,0), C0,12); \
    KRD(GL,2); GAPB(o[0]=__builtin_amdgcn_mfma_f32_32x32x16_bf16(PAF(2),VFR(2),o[0],0,0,0), C1,0); \
    KRD(GL,3); GAPB(o[1]=__builtin_amdgcn_mfma_f32_32x32x16_bf16(PAF(2),VFR(6),o[1],0,0,0), C1,4); \
    GAPB(o[0]=__builtin_amdgcn_mfma_f32_32x32x16_bf16(PAF(3),VFR(3),o[0],0,0,0), C1,8); \
    GAPB(o[1]=__builtin_amdgcn_mfma_f32_32x32x16_bf16(PAF(3),VFR(7),o[1],0,0,0), C1,12); \
    }while(0)
  int t=1;
  #undef CMASK
  #define CMASK(P0,P1,t) do{}while(0)
  for(;t+5<NT;t+=2){
    STEP(pB0,pB1,pA0,pA1,t,true,true,true);     WAIT_BAR(2); RESC(); ROT();
    STEP(pA0,pA1,pB0,pB1,t+1,true,true,true);   WAIT_BAR(2); RESC(); ROT();
  }
  #undef CMASK
  #define CMASK(P0,P1,t) do{int jb_=(t)-(NT-4); if(jb_>=0)cmask(P0,P1,jb_,qrel,hi);}while(0)
  #define ENDW(tt) do{ if((tt)+3<NT){WAIT_BAR(2);} else if((tt)+2<NT){WAIT_BAR(1);} else {WAIT_BAR(0);} }while(0)
  for(;t+1<NT;t+=2){
    STEP(pB0,pB1,pA0,pA1,t,(t+3<NT),(t+1<NT),(t+1<NT));       ENDW(t);   RESC(); ROT();
    STEP(pA0,pA1,pB0,pB1,t+1,(t+4<NT),(t+2<NT),(t+2<NT));     ENDW(t+1); RESC(); ROT();
  }
  STEP(pB0,pB1,pA0,pA1,NT-1,false,false,false); RESC();
  { float sacc=pB0[0]+pB0[1]; _Pragma("unroll") for(int r=2;r<16;++r)sacc+=pB0[r]; _Pragma("unroll") for(int r=0;r<16;++r)sacc+=pB1[r]; l_reg+=sacc;
    pw0=(u32x4){PKW(pB0,0),PKW(pB0,2),PKW(pB0,4),PKW(pB0,6)};pw1=(u32x4){PKW(pB0,8),PKW(pB0,10),PKW(pB0,12),PKW(pB0,14)};pw2=(u32x4){PKW(pB1,0),PKW(pB1,2),PKW(pB1,4),PKW(pB1,6)};pw3=(u32x4){PKW(pB1,8),PKW(pB1,10),PKW(pB1,12),PKW(pB1,14)};
    SBAR(); pv(o,vb0+sl_cur,PAF(0),PAF(1),PAF(2),PAF(3)); }
  #undef PKW
  #undef PAF
  #undef VFR
  #undef PIN
  #undef MX3
  #undef GAPA
  #undef GAPB
  #undef EX
  #undef VRD
  #undef KRD
  #undef STEP
  #undef ENDW
  {auto rr=__builtin_amdgcn_permlane32_swap(__float_as_uint(l_reg),__float_as_uint(l_reg),false,false);l_reg=__uint_as_float(rr[0])+__uint_as_float(rr[1]);}
  if(hi==0)wsf[32+r32]=l_reg;asm volatile("s_waitcnt lgkmcnt(0)":::"memory");
  float rli[16];
  #pragma unroll
  for(int r=0;r<16;++r)rli[r]=__builtin_amdgcn_rcpf(wsf[32+crow(r,hi)]);
  bf16*Ow=Oh+(long)(q0+wid*QBLK)*PO;
  { bf16*stg=(bf16*)(shm+LDS_OST)+wid*2048;
    #pragma unroll
    for(int r=0;r<16;++r){const int orow=crow(r,hi);
      #pragma unroll
      for(int d0=0;d0<2;++d0)stg[orow*64+d0*32+r32]=__float2bfloat16(o[d0][r]*rli[r]);}
    asm volatile("s_waitcnt lgkmcnt(0)":::"memory");
    #pragma unroll
    for(int i=0;i<4;++i){const int row=i*8+(lane>>3),ch=lane&7; const u32x4 v=*(const u32x4*)(stg+row*64+ch*8); ATTN_STORE16(Ow+(long)row*PO+ch*8,v);} }
  asm volatile("s_waitcnt lgkmcnt(0)\n\ts_barrier":::"memory");
  #undef DMA_K
  #undef DMA_V
  #undef CMASK
  #undef START
  #undef RESC
  #undef ROT
}
constexpr int ATTN_LDS_BYTES=LDS_BYTES;
#undef SBAR
#undef WAIT_BAR
}
namespace attn2 {
using namespace attn_body;
constexpr int KSLOT=8192, VSLOT=16384;
constexpr int L_K=0, L_V=3*KSLOT, L_WS=L_V+3*VSLOT, L_Q=L_WS+NW*64*4, L_END=L_Q+NW*4096;
#define SBAR() __builtin_amdgcn_sched_barrier(0)
#define WAIT_BAR(N) asm volatile("s_waitcnt vmcnt(" #N ") lgkmcnt(0)\n\ts_barrier":::"memory")
__device__ __forceinline__ void pv4(f32x16*o,int vb,bf16x8 pa0,bf16x8 pa1,bf16x8 pa2,bf16x8 pa3){
  #pragma unroll
  for(int d0=0;d0<4;++d0){s16x4 lo[4],hi[4];
    #pragma unroll
    for(int ks=0;ks<4;++ks){
      asm volatile("ds_read_b64_tr_b16 %0,%1 offset:%c2":"=&v"(lo[ks]):"v"(vb),"i"(d0*4096+ks*1024):"memory");
      asm volatile("ds_read_b64_tr_b16 %0,%1 offset:%c2":"=&v"(hi[ks]):"v"(vb),"i"(d0*4096+ks*1024+512):"memory");}
    asm volatile("s_waitcnt lgkmcnt(0)":::"memory");SBAR();
    #define PK(k) (bf16x8){lo[k][0],lo[k][1],lo[k][2],lo[k][3],hi[k][0],hi[k][1],hi[k][2],hi[k][3]}
    o[d0]=__builtin_amdgcn_mfma_f32_32x32x16_bf16(pa0,PK(0),o[d0],0,0,0);
    o[d0]=__builtin_amdgcn_mfma_f32_32x32x16_bf16(pa1,PK(1),o[d0],0,0,0);
    o[d0]=__builtin_amdgcn_mfma_f32_32x32x16_bf16(pa2,PK(2),o[d0],0,0,0);
    o[d0]=__builtin_amdgcn_mfma_f32_32x32x16_bf16(pa3,PK(3),o[d0],0,0,0);
    #undef PK
  }
}
template<int THRL> __device__ __forceinline__ void attn_unit128(int qb,const bf16*Qh,const bf16*__restrict__ Kh,const bf16*__restrict__ Vh,bf16*Oh,char*shm){
  const int tid=tid_opaque(),lane=tid&63,r32=lane&31,hi=lane>>5; const int wid=__builtin_amdgcn_readfirstlane(tid>>6);
  const int q0=qb*QB;
  const bf16*Qw=Qh+(long)(q0+wid*QBLK)*PQ;
  const unsigned lds0=(unsigned)(uintptr_t)shm;
  float*wsf=(float*)(shm+L_WS)+wid*64;
  const bf16*ksrc=Kh+(long)lane*PQ+wid*8;
  const bf16*vsrc=Vh+(long)(16*(wid&3)+(lane>>2))*PQ+(wid>>2)*32+(lane&3)*8;
  const unsigned kdst=lds0+L_K+wid*1024, vdst=lds0+L_V+wid*1024, qdst=lds0+L_Q+wid*4096;
  #define DMA_K(t,slot) glds16(ksrc+(long)(t)*KVBLK*PQ,(unsigned)__builtin_amdgcn_readfirstlane(kdst+(slot)))
  #define DMA_V(t,slot) do{ glds16(vsrc+(long)(t)*KVBLK*PQ,(unsigned)__builtin_amdgcn_readfirstlane(vdst+2*(slot))); glds16(vsrc+(long)(t)*KVBLK*PQ+64,(unsigned)__builtin_amdgcn_readfirstlane(vdst+2*(slot)+8192)); }while(0)
  const int vb0=(int)(lds0+L_V)+((lane>>4)&1)*32+(lane&3)*8+(4*hi+((lane&15)>>2))*64;
  const char*Kbase=shm+L_K; bf16x8 kf[8];
  const lds_cptr shm3=(lds_cptr)shm; const lds_cptr kp0=shm3+L_K+hi*1024+r32*16; const lds_cptr vp0=shm3+L_V+((lane>>4)&1)*32+(lane&3)*8+(4*hi+((lane&15)>>2))*64;
  const lds_cptr qp=shm3+L_Q+wid*4096+lane*16;
  #define QLD(d) (*(const __attribute__((address_space(3))) bf16x8*)(qp+(d)*1024))
  const int NT=(q0+QB)/KVBLK;
  DMA_K(0,0);DMA_V(0,0);DMA_K(1,KSLOT);
  #pragma unroll
  for(int d0=0;d0<4;++d0)glds16(&Qw[(long)r32*PQ+d0*16+hi*8],(unsigned)__builtin_amdgcn_readfirstlane(qdst+d0*1024));
  float mhat=0.f,l_reg=0.f;f32x16 o[4];o[0]=f32x16{};o[1]=f32x16{};o[2]=f32x16{};o[3]=f32x16{};
  const f32x16 zero16=f32x16{};
  const int qrel=wid*QBLK+r32;
  #define CMASK(P0,P1,t) do{int jb_=(t)-(NT-4); if(jb_>=0)cmask(P0,P1,jb_,qrel,hi);}while(0)
  bool resc=false;
  #define START(P0,P1) do{ const float rm=rowmax(P0,P1); resc=false; \
    { const float dl=rm; mhat=fadd_s(mhat,dl); \
      _Pragma("unroll") for(int r=0;r<16;++r){P0[r]=fsub_s(P0[r],dl);P1[r]=fsub_s(P1[r],dl);} } \
    _Pragma("unroll") for(int r=0;r<16;++r)P0[r]=__builtin_amdgcn_exp2f(P0[r]); }while(0)
  #define RESC() do{ if(resc){ asm volatile("s_waitcnt lgkmcnt(0)":::"memory"); \
      _Pragma("unroll") for(int d_=0;d_<4;++d_) _Pragma("unroll") for(int r=0;r<16;++r)o[d_][r]*=wsf[crow(r,hi)]; } }while(0)
  f32x16 pA0,pA1,pB0,pB1;
  int sl_prev=0,sl_cur=0,sl_next=KSLOT;
  #define ROT() do{sl_prev=sl_cur;sl_cur=sl_next;sl_next=(sl_next==(NSLOT-1)*KSLOT)?0:sl_next+KSLOT;}while(0)
  DMA_K(2,2*KSLOT);
  WAIT_BAR(1);
  { bf16x8 q4[4];
    #pragma unroll
    for(int d0=0;d0<4;++d0)q4[d0]=QLD(d0);
    qkt(pA0,pA1,Kbase,q4,zero16,r32,hi); }
  asm volatile("s_nop 15\n\ts_nop 7":"+v"(pA0),"+v"(pA1));CMASK(pA0,pA1,0);
  START(pA0,pA1);
  _Pragma("unroll") for(int r=0;r<16;++r)pA1[r]=__builtin_amdgcn_exp2f(pA1[r]);
  WAIT_BAR(0);
  DMA_K(3,0);DMA_V(1,KSLOT);
  ROT();
  kload8(kf,kp0+sl_cur);
  WAIT_BAR(3);
  s16x4 vlo[16],vhi[16]; u32x4 pw0,pw1,pw2,pw3;
  #define PKW(P,B) cvtpk_s(P[B],P[B+1])
  #define PAF(k) __builtin_bit_cast(bf16x8,pw##k)
  #define VFR(i) (bf16x8){vlo[i][0],vlo[i][1],vlo[i][2],vlo[i][3],vhi[i][0],vhi[i][1],vhi[i][2],vhi[i][3]}
  #define PIN(x) asm volatile("":"+v"(x))
  #define MX3(a,b,c) __builtin_fmaxf(__builtin_fmaxf((a),(b)),(c))
  #define GAPA(MF,A0,A1,A2,A3,W0,W1,PW) do{ MF; sacc+=A0; sacc+=A1; sacc+=A2; sacc+=A3; PIN(sacc); W0; W1; PIN(PW); SBAR(); }while(0)
  #define EX(v) __builtin_amdgcn_exp2f((v)-mhat)
  #define GAPB(MF,X,B) do{ MF; X[B]=EX(X[B]); X[B+1]=EX(X[B+1]); PIN(X); SBAR(); }while(0)
  #define VRD(i) do{ vlo[i]=vtr(vp_+(((i)>>2)*4096+((i)&3)*1024)); vhi[i]=vtr(vp_+(((i)>>2)*4096+((i)&3)*1024+512)); }while(0)
  #define KRD(G,j) do{ if(G){ kload2(kf,kp0+sl_next,j); SBAR(); } }while(0)
  #define PVM(d,ks) o[d]=__builtin_amdgcn_mfma_f32_32x32x16_bf16(PAF(ks),VFR((d)*4+(ks)),o[d],0,0,0)
  #define STEP(C0,C1,P0,P1,t,GK,GV,GL) do{ SBAR(); \
    const lds_cptr vp_=vp0+2*sl_prev; \
    const bf16x8 q0_=QLD(0),q1_=QLD(1),q2_=QLD(2),q3_=QLD(3); \
    VRD(0); SBAR(); float sacc=(P0[0]+P0[1]); \
    GAPA(C0=__builtin_amdgcn_mfma_f32_32x32x16_bf16(kf[0],q0_,zero16,0,0,0), P0[2],P0[3],P0[4],P0[5],     pw0[0]=PKW(P0,0), pw0[1]=PKW(P0,2), pw0); \
    VRD(4); SBAR(); GAPA(C1=__builtin_amdgcn_mfma_f32_32x32x16_bf16(kf[1],q0_,zero16,0,0,0), P0[6],P0[7],P0[8],P0[9],     pw0[2]=PKW(P0,4), pw0[3]=PKW(P0,6), pw0); \
    VRD(8); SBAR(); GAPA(C0=__builtin_amdgcn_mfma_f32_32x32x16_bf16(kf[2],q1_,C0,0,0,0),   P0[10],P0[11],P0[12],P0[13], pw1[0]=PKW(P0,8), pw1[1]=PKW(P0,10), pw1); \
    VRD(12); SBAR(); GAPA(C1=__builtin_amdgcn_mfma_f32_32x32x16_bf16(kf[3],q1_,C1,0,0,0),   P0[14],P0[15],P1[0],P1[1],   pw1[2]=PKW(P0,12),pw1[3]=PKW(P0,14), pw1); \
    VRD(1); SBAR(); GAPA(C0=__builtin_amdgcn_mfma_f32_32x32x16_bf16(kf[4],q2_,C0,0,0,0),   P1[2],P1[3],P1[4],P1[5],     pw2[0]=PKW(P1,0), pw2[1]=PKW(P1,2), pw2); \
    VRD(5); SBAR(); GAPA(C1=__builtin_amdgcn_mfma_f32_32x32x16_bf16(kf[5],q2_,C1,0,0,0),   P1[6],P1[7],P1[8],P1[9],     pw2[2]=PKW(P1,4), pw2[3]=PKW(P1,6), pw2); \
    VRD(9); SBAR(); GAPA(C0=__builtin_amdgcn_mfma_f32_32x32x16_bf16(kf[6],q3_,C0,0,0,0),   P1[10],P1[11],P1[12],P1[13], pw3[0]=PKW(P1,8), pw3[1]=PKW(P1,10), pw3); \
    VRD(13); SBAR(); GAPA(C1=__builtin_amdgcn_mfma_f32_32x32x16_bf16(kf[7],q3_,C1,0,0,0),   P1[14],P1[15],0.f,0.f,       pw3[2]=PKW(P1,12),pw3[3]=PKW(P1,14), pw3); \
    l_reg+=sacc; \
    if(GK){DMA_K((t)+3,sl_cur);} if(GV){DMA_V((t)+1,sl_next);} \
    CMASK(C0,C1,t); \
    { float a=MX3(C0[0],C0[1],C1[0]),b=MX3(C0[2],C0[3],C1[1]); a=MX3(a,C1[2],C1[3]); \
      _Pragma("unroll") for(int r=4;r<16;r+=4){a=MX3(a,C0[r],C0[r+1]);b=MX3(b,C0[r+2],C0[r+3]);a=MX3(a,C1[r],C1[r+1]);b=MX3(b,C1[r+2],C1[r+3]);} \
      float rm=__builtin_fmaxf(a,b); { auto rr=__builtin_amdgcn_permlane32_swap(__float_as_uint(rm),__float_as_uint(rm),false,false); rm=__builtin_fmaxf(__uint_as_float(rr[0]),__uint_as_float(rr[1])); } \
      rm-=mhat; resc=false; \
      if(__builtin_expect(__any(rm>(float)THRL),0)){ const float dl=__builtin_fmaxf(rm,0.f); mhat+=dl; \
        const float f=__builtin_amdgcn_exp2f(-dl); l_reg*=f; if(hi==0)wsf[r32]=f; resc=true; } } \
    SBAR(); \
    GAPB(PVM(0,0), C0,0);  VRD(2);  SBAR(); \
    GAPB(PVM(1,0), C0,2);  VRD(6);  SBAR(); \
    GAPB(PVM(2,0), C0,4);  VRD(10); SBAR(); \
    GAPB(PVM(3,0), C0,6);  VRD(14); SBAR(); \
    GAPB(PVM(0,1), C0,8);  VRD(3);  SBAR(); \
    GAPB(PVM(1,1), C0,10); VRD(7);  SBAR(); \
    GAPB(PVM(2,1), C0,12); VRD(11); SBAR(); \
    GAPB(PVM(3,1), C0,14); VRD(15); SBAR(); \
    KRD(GL,0); GAPB(PVM(0,2), C1,0); \
    GAPB(PVM(1,2), C1,2); \
    KRD(GL,1); GAPB(PVM(2,2), C1,4); \
    GAPB(PVM(3,2), C1,6); \
    KRD(GL,2); GAPB(PVM(0,3), C1,8); \
    GAPB(PVM(1,3), C1,10); \
    KRD(GL,3); GAPB(PVM(2,3), C1,12); \
    GAPB(PVM(3,3), C1,14); \
    }while(0)
  int t=1;
  #undef CMASK
  #define CMASK(P0,P1,t) do{}while(0)
  for(;t+5<NT;t+=2){
    STEP(pB0,pB1,pA0,pA1,t,true,true,true);     WAIT_BAR(3); RESC(); ROT();
    STEP(pA0,pA1,pB0,pB1,t+1,true,true,true);   WAIT_BAR(3); RESC(); ROT();
  }
  #undef CMASK
  #define CMASK(P0,P1,t) do{int jb_=(t)-(NT-4); if(jb_>=0)cmask(P0,P1,jb_,qrel,hi);}while(0)
  #define ENDW(tt) do{ if((tt)+3<NT){WAIT_BAR(3);} else if((tt)+2<NT){WAIT_BAR(2);} else {WAIT_BAR(0);} }while(0)
  for(;t+1<NT;t+=2){
    STEP(pB0,pB1,pA0,pA1,t,(t+3<NT),(t+1<NT),(t+1<NT));       ENDW(t);   RESC(); ROT();
    STEP(pA0,pA1,pB0,pB1,t+1,(t+4<NT),(t+2<NT),(t+2<NT));     ENDW(t+1); RESC(); ROT();
  }
  STEP(pB0,pB1,pA0,pA1,NT-1,false,false,false); RESC();
  { float sacc=pB0[0]+pB0[1]; _Pragma("unroll") for(int r=2;r<16;++r)sacc+=pB0[r]; _Pragma("unroll") for(int r=0;r<16;++r)sacc+=pB1[r]; l_reg+=sacc;
    pw0=(u32x4){PKW(pB0,0),PKW(pB0,2),PKW(pB0,4),PKW(pB0,6)};pw1=(u32x4){PKW(pB0,8),PKW(pB0,10),PKW(pB0,12),PKW(pB0,14)};pw2=(u32x4){PKW(pB1,0),PKW(pB1,2),PKW(pB1,4),PKW(pB1,6)};pw3=(u32x4){PKW(pB1,8),PKW(pB1,10),PKW(pB1,12),PKW(pB1,14)};
    SBAR(); pv4(o,vb0+2*sl_cur,PAF(0),PAF(1),PAF(2),PAF(3)); }
  #undef PKW
  #undef PAF
  #undef VFR
  #undef PIN
  #undef MX3
  #undef GAPA
  #undef GAPB
  #undef EX
  #undef VRD
  #undef KRD
  #undef PVM
  #undef STEP
  #undef ENDW
  {auto rr=__builtin_amdgcn_permlane32_swap(__float_as_uint(l_reg),__float_as_uint(l_reg),false,false);l_reg=__uint_as_float(rr[0])+__uint_as_float(rr[1]);}
  if(hi==0)wsf[32+r32]=l_reg;asm volatile("s_waitcnt lgkmcnt(0)":::"memory");
  float rli[16];
  #pragma unroll
  for(int r=0;r<16;++r)rli[r]=__builtin_amdgcn_rcpf(wsf[32+crow(r,hi)]);
  bf16*Ow=Oh+(long)(q0+wid*QBLK)*PO;
  { bf16*stg=(bf16*)(shm+L_Q)+wid*2048;
    #pragma unroll
    for(int hf=0;hf<2;++hf){
      #pragma unroll
      for(int r=0;r<16;++r){const int orow=crow(r,hi);
        #pragma unroll
        for(int d0=0;d0<2;++d0)stg[orow*64+d0*32+r32]=__float2bfloat16(o[2*hf+d0][r]*rli[r]);}
      asm volatile("s_waitcnt lgkmcnt(0)":::"memory");
      #pragma unroll
      for(int i=0;i<4;++i){const int row=i*8+(lane>>3),ch=lane&7; const u32x4 v=*(const u32x4*)(stg+row*64+ch*8); ATTN_STORE16(Ow+(long)row*PO+hf*64+ch*8,v);}
      asm volatile("s_waitcnt lgkmcnt(0)":::"memory"); } }
  asm volatile("s_waitcnt lgkmcnt(0)\n\ts_barrier":::"memory");
  #undef DMA_K
  #undef DMA_V
  #undef QLD
  #undef CMASK
  #undef START
  #undef RESC
  #undef ROT
}
#undef SBAR
#undef WAIT_BAR
}
#include <hip/hip_cooperative_groups.h>
namespace cg = cooperative_groups;
constexpr int NWAVES = 8;
constexpr int BATCH = 16, SEQ = 2048, D = 1024, DEPTH = 4, FF = 4096, PLE = 256, INW = 2560, AW = 512, RW = 512;
constexpr int M = BATCH * SEQ;
constexpr size_t MiB = 1u << 20;
constexpr size_t WS_CS = 1 * MiB;
constexpr size_t WS_SSQ0 = 3 * MiB, WS_SSQ1 = 5 * MiB;
constexpr size_t WS_W = 8 * MiB, W_LAYER = 25 * MiB + 512 * 1024;
constexpr size_t WO_IN = 0, WO_OUT = 5 * MiB, WO_W1 = 7 * MiB, WO_W2 = 15 * MiB, WO_PG = 23 * MiB, WO_PP = 25 * MiB;
constexpr size_t WS_P16 = 110 * MiB;
constexpr size_t WS_XB0 = 126 * MiB;
constexpr size_t WS_R = 190 * MiB;
constexpr size_t WS_PROJ = WS_R;
constexpr size_t WS_OV = WS_R + 160 * MiB;
constexpr size_t WS_AO = WS_R + 224 * MiB;
constexpr size_t WS_HB = WS_R;
constexpr size_t WS_XBF = WS_R + 64 * MiB;
constexpr size_t WS_PP = WS_R;
constexpr size_t WS_END = WS_R + 288 * MiB;
static_assert(WS_W + DEPTH * W_LAYER <= WS_P16 && WS_P16 + (size_t)M * PLE * 2 <= WS_XB0 && WS_XB0 + (size_t)M * D * 2 <= WS_R && WS_HB + (size_t)M * FF * 2 <= WS_END, "d_ws map");
constexpr int RING_BYTES = 131072;
constexpr int LDS_BYTES = 147456;

#define GAS __attribute__((address_space(1)))
#define LAS __attribute__((address_space(3)))
typedef unsigned short bf16;
typedef unsigned v4u __attribute__((ext_vector_type(4)));
typedef float f32x4 __attribute__((ext_vector_type(4)));
typedef short bf16x8 __attribute__((ext_vector_type(8)));
#define LDS_WAIT() asm volatile("s_waitcnt lgkmcnt(0)" ::: "memory")
#define VM_WAIT() asm volatile("s_waitcnt vmcnt(0)" ::: "memory")
__device__ __forceinline__ unsigned f2bf(float f) { unsigned u = __builtin_bit_cast(unsigned, f); return (u + 0x7fffu + ((u >> 16) & 1u)) >> 16; }
__device__ __forceinline__ unsigned pk2(float lo, float hi) { unsigned r; asm("v_cvt_pk_bf16_f32 %0, %1, %2" : "=v"(r) : "v"(lo), "v"(hi)); return r; }
__device__ __forceinline__ float bf2f(unsigned short v) { return __uint_as_float((unsigned)v << 16); }
__device__ __forceinline__ float sigmoid_f(float x) { return __builtin_amdgcn_rcpf(1.f + __builtin_amdgcn_exp2f(-1.4426950408889634f * x)); }

typedef GAS unsigned gu32;
#define RLX_AGENT __ATOMIC_RELAXED, __HIP_MEMORY_SCOPE_AGENT
#define XB_TMO      128
#define XB_XCNT(j)  (256  + 64 * (j))
#define XB_XSUB(j)  (1280 + 64 * (j))
#define XB_XGEN(j)  (2304 + 64 * (j))
#define XB_TOP      3328
#define XB_TOPGEN   3392
#define XCD_BAR_WORDS 3456
#define XB_SPIN_CAP (1u << 18)

__device__ __forceinline__ unsigned xb_ld(unsigned* p)              { return __hip_atomic_load(p, __ATOMIC_RELAXED, __HIP_MEMORY_SCOPE_AGENT); }
__device__ __forceinline__ unsigned xb_add(unsigned* p, unsigned v) { return __hip_atomic_fetch_add(p, v, __ATOMIC_RELAXED, __HIP_MEMORY_SCOPE_AGENT); }
__device__ __forceinline__ unsigned xb_xcc_id() { return (unsigned)__builtin_amdgcn_s_getreg((3 << 11) | 20) & 0xFu; }
#define XB_SPIN(cond, bar) do { unsigned _sp = 0; while (cond) { __builtin_amdgcn_s_sleep(1); \
    if ((++_sp & 255u) == 0u) { if (xb_ld(&(bar)[XB_TMO])) break; if (_sp > XB_SPIN_CAP) { atomicAdd(&(bar)[XB_TMO], 1u); break; } } } } while (0)

struct XcdBarrier {
    unsigned* bar; unsigned x;
    volatile LAS unsigned* st;
};

__device__ __forceinline__ XcdBarrier xcd_barrier_post(unsigned* bar, volatile LAS unsigned* st) {
    XcdBarrier b; b.bar = bar; b.x = xb_xcc_id(); b.st = st;
    if (threadIdx.x == 0) st[4] = xb_add(&bar[XB_XCNT(b.x)], 1u);
    return b;
}
__device__ __forceinline__ void xcd_barrier_complete(unsigned* bar, unsigned x, unsigned& nloc, unsigned& nx) {
    const unsigned G = gridDim.x * gridDim.y * gridDim.z;
    unsigned sum, cnt, mine, sp = 0u;
    for (;;) {
        sum = 0u; cnt = 0u; mine = 0u;
#pragma unroll
        for (unsigned j = 0; j < 16; ++j) { const unsigned c = xb_ld(&bar[XB_XCNT(j)]); sum += c; cnt += (c > 0u) ? 1u : 0u; mine = (j == x) ? c : mine; }
        if (sum == G) break;
        __builtin_amdgcn_s_sleep(1);
        if ((++sp & 255u) == 0u) { if (xb_ld(&bar[XB_TMO])) break; if (sp > XB_SPIN_CAP) { atomicAdd(&bar[XB_TMO], 1u); break; } }
    }
    nloc = mine > 0u ? mine : 1u; nx = cnt > 0u ? cnt : 1u;
}

__device__ __forceinline__ void xcd_barrier(const XcdBarrier& b) {
    asm volatile("s_waitcnt vmcnt(0)" ::: "memory");
    __syncthreads();
    if (threadIdx.x == 0) {
        unsigned* bar = b.bar;
        __builtin_amdgcn_s_waitcnt(0);
        unsigned nloc = b.st[0], nx = b.st[1];
        if (nloc == 0u) { xcd_barrier_complete(bar, b.x, nloc, nx); b.st[0] = nloc; b.st[1] = nx; }
        const unsigned old = xb_add(&bar[XB_XSUB(b.x)], 1u);
        const unsigned gen = old / nloc;
        if (old + 1u == (gen + 1u) * nloc) {
            __builtin_amdgcn_fence(__ATOMIC_RELEASE, "agent");
            asm volatile("s_waitcnt vmcnt(0)" ::: "memory");
            const unsigned og = xb_add(&bar[XB_TOP], 1u);
            const unsigned tg = og / nx;
            if (og + 1u == (tg + 1u) * nx) xb_add(&bar[XB_TOPGEN], 1u);
            else XB_SPIN(xb_ld(&bar[XB_TOPGEN]) == tg, bar);
            __builtin_amdgcn_fence(__ATOMIC_ACQUIRE, "agent");
            xb_add(&bar[XB_XGEN(b.x)], 1u);
            asm volatile("s_waitcnt vmcnt(0)" ::: "memory");
        } else {
            XB_SPIN(xb_ld(&bar[XB_XGEN(b.x)]) == gen, bar);
            __builtin_amdgcn_fence(__ATOMIC_ACQUIRE, "agent");
            asm volatile("s_waitcnt vmcnt(0)" ::: "memory");
        }
    }
    __syncthreads();
}
template <class BG> __device__ __forceinline__ void xcd_barrier_bg(const XcdBarrier& b, const BG& bgwork) {
    asm volatile("s_waitcnt vmcnt(0)" ::: "memory");
    __syncthreads();
    if (threadIdx.x == 0) {
        unsigned* bar = b.bar;
        __builtin_amdgcn_s_waitcnt(0);
        unsigned nloc = b.st[0], nx = b.st[1];
        if (nloc == 0u) { xcd_barrier_complete(bar, b.x, nloc, nx); b.st[0] = nloc; b.st[1] = nx; }
        const unsigned old = xb_add(&bar[XB_XSUB(b.x)], 1u);
        const unsigned gen = old / nloc;
        if (old + 1u == (gen + 1u) * nloc) {
            __builtin_amdgcn_fence(__ATOMIC_RELEASE, "agent");
            asm volatile("s_waitcnt vmcnt(0)" ::: "memory");
            const unsigned og = xb_add(&bar[XB_TOP], 1u);
            const unsigned tg = og / nx;
            if (og + 1u == (tg + 1u) * nx) xb_add(&bar[XB_TOPGEN], 1u);
            else XB_SPIN(xb_ld(&bar[XB_TOPGEN]) == tg, bar);
            __builtin_amdgcn_fence(__ATOMIC_ACQUIRE, "agent");
            xb_add(&bar[XB_XGEN(b.x)], 1u);
            asm volatile("s_waitcnt vmcnt(0)" ::: "memory");
        } else {
            XB_SPIN(xb_ld(&bar[XB_XGEN(b.x)]) == gen, bar);
            __builtin_amdgcn_fence(__ATOMIC_ACQUIRE, "agent");
            asm volatile("s_waitcnt vmcnt(0)" ::: "memory");
        }
    }
    if (threadIdx.x >= 64) bgwork();
    __syncthreads();
}
template <class BG> __device__ __forceinline__ void xcd_barrier_local_bg(const XcdBarrier& b, const BG& bgwork, bool with_bg) {
    asm volatile("s_waitcnt vmcnt(0)" ::: "memory");
    __syncthreads();
    if (threadIdx.x == 0) {
        unsigned* bar = b.bar;
        __builtin_amdgcn_s_waitcnt(0);
        const unsigned nloc = b.st[0];
        const unsigned old = xb_add(&bar[XB_XSUB(b.x)], 1u);
        const unsigned gen = old / nloc;
        if (old + 1u == (gen + 1u) * nloc) xb_add(&bar[XB_XGEN(b.x)], 1u);
        else XB_SPIN(xb_ld(&bar[XB_XGEN(b.x)]) == gen, bar);
        __builtin_amdgcn_fence(__ATOMIC_ACQUIRE, "agent");
        asm volatile("s_waitcnt vmcnt(0)" ::: "memory");
    }
    if (with_bg && threadIdx.x >= 64) bgwork();
    __syncthreads();
}

struct Frame {
    LAS unsigned char* lds;
    LAS const unsigned long long* tab;
};
struct Who { int tid, lane, wave, vcu, G, bx, local; };
constexpr int LDSW_OFF = 131072 + 2048;
__device__ __forceinline__ Who who() { Who w; w.tid = tid_opaque(); w.lane = w.tid & 63; w.wave = __builtin_amdgcn_readfirstlane(w.tid >> 6);
    extern __shared__ __attribute__((aligned(16))) unsigned char lds_who_[];
    volatile LAS unsigned* cw = (volatile LAS unsigned*)((LAS unsigned char*)lds_who_ + LDSW_OFF);
    int bx = __builtin_amdgcn_readfirstlane((int)cw[2]), lc = __builtin_amdgcn_readfirstlane((int)cw[3]), G = gridDim.x; asm volatile("" : "+s"(bx), "+s"(G), "+s"(lc));
    w.G = G; w.bx = bx; w.local = lc; w.vcu = (G % 8 == 0) ? (bx % 8) * (G / 8) + bx / 8 : bx; return w; }
__device__ __forceinline__ int opaque_s(int v) { asm volatile("" : "+s"(v)); return v; }
__device__ __forceinline__ const void* ptab(LAS const unsigned long long* tab, int k) {
    const unsigned long long v = tab[k]; const unsigned lo = __builtin_amdgcn_readfirstlane((unsigned)v), hi = __builtin_amdgcn_readfirstlane((unsigned)(v >> 32));
    GAS const char* g = (GAS const char*)(((unsigned long long)hi << 32) | lo);
    return (const void*)g;
}
#define FIN(k) ((const float*)ptab(F.tab, (k)))
#define FOUT() ((float*)ptab(F.tab, 23))
#define FWS(off) ((unsigned char*)ptab(F.tab, 24) + (off))
enum { I_X = 0, I_P, I_POS, I_WIN, I_WOUT, I_GMIX, I_GSUBLN, I_LAMQ, I_LAMK, I_CONVW, I_CONVB, I_WGA, I_BGA, I_WGX, I_BGX, I_LRULAM, I_GMLP, I_WMLPIN, I_WMLPOUT, I_GPLE, I_WPLEGATE, I_WPLEPROJ, I_GFINAL };
enum { RB_PROJ, RB_OV, RB_AO, RB_HB, RB_PP, RB_XBF };
#define RBUF(which) ((bf16*)rbuf_(FWS(0), W.local, W.bx, (which)))
__device__ __forceinline__ unsigned char* rbuf_(unsigned char* ws, int local, int bx, int which) {
    const size_t pitchB = (which == RB_PROJ) ? (size_t)INW * 2 : (which == RB_HB) ? (size_t)FF * 2 : (size_t)D * 2;
    if (!local) return ws + (which == RB_PROJ ? WS_PROJ : which == RB_OV ? WS_OV : which == RB_AO ? WS_AO : which == RB_HB ? WS_HB : which == RB_PP ? WS_PP : WS_XBF);
    const size_t x = (size_t)(bx % 8), off = (which == RB_OV) ? 20 * MiB : (which == RB_AO) ? 28 * MiB : (which == RB_XBF) ? 8 * MiB : 0;
    return ws + WS_R + x * (36 * MiB) + off - x * (size_t)(M / 8) * pitchB;
}

__device__ __forceinline__ float wave_sum(float v) {
#pragma unroll
    for (int o = 1; o < 64; o <<= 1) v += __shfl_xor(v, o);
    return v;
}
__device__ __forceinline__ void p0_transpose_item(const float* W, const float* gain, int K, int N, bf16* WT, LAS float* scr, int item, int lane) {
    const int nblk = N / 32, kb = item / nblk, nb = item % nblk, k0 = 64 * kb, n0 = 32 * nb;
    const int c = lane & 7;
    float v[32];
#pragma unroll
    for (int i = 0; i < 32; ++i) v[i] = W[(size_t)(k0 + 2 * i + (lane >> 5)) * N + n0 + (lane & 31)];
    f32x4 ga = {1.f, 1.f, 1.f, 1.f}, gb = ga;
    if (gain) { ga = *(const f32x4*)(gain + k0 + 8 * c); gb = *(const f32x4*)(gain + k0 + 8 * c + 4); }
#pragma unroll
    for (int i = 0; i < 32; ++i) scr[(2 * i + (lane >> 5)) * 33 + (lane & 31)] = v[i];
    LDS_WAIT(); asm volatile("" ::: "memory");
#pragma unroll
    for (int j = 0; j < 4; ++j) { const int n = (lane >> 3) + 8 * j; const LAS float* s = scr + (8 * c) * 33 + n;
        v4u o; o.x = pk2(s[0 * 33] * ga.x, s[1 * 33] * ga.y); o.y = pk2(s[2 * 33] * ga.z, s[3 * 33] * ga.w); o.z = pk2(s[4 * 33] * gb.x, s[5 * 33] * gb.y); o.w = pk2(s[6 * 33] * gb.z, s[7 * 33] * gb.w);
        *(GAS v4u*)(WT + (size_t)(n0 + n) * K + k0 + 8 * c) = o; }
    LDS_WAIT(); asm volatile("" ::: "memory");
}
__device__ __forceinline__ void p0_prologue(Frame& F) {
    const Who W = who();
    LAS float* scr = (LAS float*)(F.lds + W.wave * 16384);
    const int gw = W.vcu * NWAVES + W.wave, NGW = W.G * NWAVES;
    unsigned char* ws = FWS(0);
    const float *w_in = FIN(I_WIN), *w_out = FIN(I_WOUT), *w_mlp_in = FIN(I_WMLPIN), *w_mlp_out = FIN(I_WMLPOUT), *w_ple_gate = FIN(I_WPLEGATE), *w_ple_proj = FIN(I_WPLEPROJ), *g_mix = FIN(I_GMIX), *g_mlp = FIN(I_GMLP), *g_ple = FIN(I_GPLE);
    constexpr int I_IN = (D / 64) * (INW / 32), I_OUT = (D / 64) * (D / 32), I_1 = (D / 64) * (FF / 32), I_2 = (FF / 64) * (D / 32), I_PG = I_OUT, I_PP = (PLE / 64) * (D / 32);
    constexpr int PER_L = I_IN + I_OUT + I_1 + I_2 + I_PG + I_PP;
    for (int it = gw; it < DEPTH * PER_L; it += NGW) {
        const int l = it / PER_L; int r = it % PER_L; bf16* wl = (bf16*)(ws + WS_W + (size_t)l * W_LAYER);
        if (r < I_IN) { p0_transpose_item(w_in + (size_t)l * D * INW, g_mix + l * D, D, INW, (bf16*)((unsigned char*)wl + WO_IN), scr, r, W.lane); continue; } r -= I_IN;
        if (r < I_OUT) { p0_transpose_item(w_out + (size_t)l * D * D, nullptr, D, D, (bf16*)((unsigned char*)wl + WO_OUT), scr, r, W.lane); continue; } r -= I_OUT;
        if (r < I_1) { p0_transpose_item(w_mlp_in + (size_t)l * D * FF, g_mlp + l * D, D, FF, (bf16*)((unsigned char*)wl + WO_W1), scr, r, W.lane); continue; } r -= I_1;
        if (r < I_2) { p0_transpose_item(w_mlp_out + (size_t)l * FF * D, nullptr, FF, D, (bf16*)((unsigned char*)wl + WO_W2), scr, r, W.lane); continue; } r -= I_2;
        if (r < I_PG) { p0_transpose_item(w_ple_gate + (size_t)l * D * D, g_ple + l * D, D, D, (bf16*)((unsigned char*)wl + WO_PG), scr, r, W.lane); continue; } r -= I_PG;
        p0_transpose_item(w_ple_proj + (size_t)l * PLE * D, nullptr, PLE, D, (bf16*)((unsigned char*)wl + WO_PP), scr, r, W.lane);
    }
    const float* x_ = FIN(I_X); bf16* XB1_ = (bf16*)FOUT(); float* SSQ1_ = (float*)(ws + WS_SSQ1); float* CS_ = (float*)(ws + WS_CS); const int* pos_ = (const int*)FIN(I_POS);
#pragma unroll 4
    for (int m = gw; m < M; m += NGW) {
        const GAS f32x4* xr = (const GAS f32x4*)(x_ + (size_t)m * D) + W.lane;
        GAS unsigned long long* o8 = (GAS unsigned long long*)(XB1_ + (size_t)m * D) + W.lane; float s = 0.f;
#pragma unroll
        for (int j = 0; j < 4; ++j) { const f32x4 v = xr[64 * j]; s += (v.x * v.x + v.y * v.y) + (v.z * v.z + v.w * v.w);
            o8[64 * j] = (unsigned long long)pk2(v.x, v.y) | ((unsigned long long)pk2(v.z, v.w) << 32); }
        s = wave_sum(s);
        if (W.lane < 16) SSQ1_[(size_t)m * 16 + W.lane] = (W.lane == 0) ? s : 0.f;
    }
}
__device__ __forceinline__ void convert_p_slice(Frame& F, int l, int slice) {
    const Who W = who();
    const float* src = FIN(I_P) + (size_t)l * M * PLE; bf16* P16_ = (bf16*)FWS(WS_P16);
    const size_t NV = W.local ? (size_t)(M / 8) * PLE / 8 : (size_t)M * PLE / 8, base = W.local ? (size_t)(W.bx % 8) * NV : 0;
    const size_t PER = (NV + 2) / 3, lo = (size_t)slice * PER, hi = (lo + PER < NV) ? lo + PER : NV;
    const size_t nthr = (W.local ? (size_t)(W.G / 8) : (size_t)W.G) * (NWAVES - 1) * 64, me = (W.local ? (size_t)(W.bx / 8) : (size_t)W.bx) * (NWAVES - 1) * 64 + (W.tid - 64);
#pragma unroll 4
    for (size_t e = lo + me; e < hi; e += nthr) {
        const f32x4 a = *(const GAS f32x4*)(src + (base + e) * 8), b = *(const GAS f32x4*)(src + (base + e) * 8 + 4);
        v4u o; o.x = pk2(a.x, a.y); o.y = pk2(a.z, a.w); o.z = pk2(b.x, b.y); o.w = pk2(b.z, b.w);
        *(GAS v4u*)(P16_ + (base + e) * 8) = o; }
}
struct BgConvert { Frame F; int l, slice; __device__ __forceinline__ void operator()() const { Frame f = F; convert_p_slice(f, l, slice); } };
__device__ __forceinline__ void final_norm(Frame& F) {
    const Who W = who();
    const int NGW = (W.local ? W.G / 8 : W.G) * NWAVES, gw = (W.local ? W.bx / 8 : W.bx) * NWAVES + W.wave, m0 = W.local ? (W.bx % 8) * (M / 8) : 0, m1 = W.local ? m0 + M / 8 : M;
    const float* SSQ1_ = (const float*)FWS(WS_SSQ1); float* O_ = FOUT(); const float* gf_ = FIN(I_GFINAL); const bf16* XBF_ = RBUF(RB_XBF);
#pragma unroll 4
    for (int m = m0 + gw; m < m1; m += NGW) {
        const float rs = pg8::row_rs(SSQ1_, m);
        const GAS unsigned long long* hr = (const GAS unsigned long long*)(XBF_ + (size_t)m * D) + W.lane; GAS f32x4* orow = (GAS f32x4*)(O_ + (size_t)m * D) + W.lane; const GAS f32x4* gr = (const GAS f32x4*)gf_ + W.lane;
#pragma unroll
        for (int j = 0; j < 4; ++j) { const unsigned long long w8 = hr[64 * j]; const unsigned lo = (unsigned)w8, hi = (unsigned)(w8 >> 32); const f32x4 g = gr[64 * j];
            const f32x4 v = {pg8::bf_lo(lo), pg8::bf_hi(lo), pg8::bf_lo(hi), pg8::bf_hi(hi)}; orow[64 * j] = v * rs * g; }
    }
}

__device__ __forceinline__ void lru_item(Frame& F, int l, int item) {
    const int b = item >> 4, g = (item >> 1) & 7, hf = item & 1;
    const int tid_ = tid_opaque(), lane = tid_ & 63, w = __builtin_amdgcn_readfirstlane(tid_ >> 6), r = lane & 15, q = lane >> 4;
    LAS float* xcs = (LAS float*)(F.lds + w * 4352);
    LAS float* car = (LAS float*)(F.lds + 36864);
    const Who W = who();
    const bf16* pj = RBUF(RB_PROJ) + (size_t)b * SEQ * INW;
    bf16* ao = RBUF(RB_AO) + (size_t)b * SEQ * D;
    v4u* lb = (v4u*)FWS(WS_XB0) + ((size_t)item * NWAVES + w) * (16 * 2 * 64) + lane;
    const int t0 = w * 256;
    const bf16* gcol = pj + 3 * AW + RW + g * 64 + hf * 32 + r;
    bf16* ycol = ao + AW + g * 64 + hf * 32 + r;
    float hin[2] = {0.f, 0.f};
    {
        const int cch = g * 64 + lane;
        const float* conv_w = FIN(I_CONVW);
        const float cw0 = conv_w[(l * 4 + 0) * RW + cch], cw1 = conv_w[(l * 4 + 1) * RW + cch], cw2 = conv_w[(l * 4 + 2) * RW + cch], cw3 = conv_w[(l * 4 + 3) * RW + cch], cb = FIN(I_CONVB)[l * RW + cch];
        bf16x8 Bf[2][2][2];
#pragma unroll
        for (int gate = 0; gate < 2; ++gate) { const float* W = (gate ? FIN(I_WGX) : FIN(I_WGA)) + (size_t)(l * 8 + g) * 64 * 64;
#pragma unroll
            for (int n = 0; n < 2; ++n)
#pragma unroll
                for (int kk = 0; kk < 2; ++kk) { const float* wp = W + (size_t)(32 * kk + 8 * q) * 64 + hf * 32 + 16 * n + r; v4u pw;
                    pw.x = pk2(wp[0 * 64], wp[1 * 64]); pw.y = pk2(wp[2 * 64], wp[3 * 64]); pw.z = pk2(wp[4 * 64], wp[5 * 64]); pw.w = pk2(wp[6 * 64], wp[7 * 64]);
                    Bf[gate][n][kk] = __builtin_bit_cast(bf16x8, pw); } }
        float ba[2], bx[2], sp8[2];
#pragma unroll
        for (int n = 0; n < 2; ++n) { const int ch = l * RW + g * 64 + hf * 32 + 16 * n + r; ba[n] = FIN(I_BGA)[ch]; bx[n] = FIN(I_BGX)[ch];
            const float z = -FIN(I_LRULAM)[ch]; sp8[n] = 8.f * (fmaxf(z, 0.f) + log1pf(__expf(-fabsf(z)))); }
        const bf16* xcol = pj + 3 * AW + cch;
        float h3 = 0.f, h2 = 0.f, h1 = 0.f;
        if (t0 != 0) { h3 = bf2f(xcol[(size_t)(t0 - 3) * INW]); h2 = bf2f(xcol[(size_t)(t0 - 2) * INW]); h1 = bf2f(xcol[(size_t)(t0 - 1) * INW]); }
        float hrun[2] = {0.f, 0.f}, Arun[2] = {1.f, 1.f};
        unsigned short xq[16], xn[16];
#pragma unroll
        for (int tt = 0; tt < 16; ++tt) { xq[tt] = xcol[(size_t)(t0 + tt) * INW]; xn[tt] = xcol[(size_t)(t0 + 16 + tt) * INW]; }
#pragma unroll 1
        for (int sc = 0; sc < 16; ++sc) {
            const int ts = t0 + sc * 16, tn = (sc < 14) ? ts + 32 : ts;
            unsigned short xnn[16];
#pragma unroll
            for (int tt = 0; tt < 16; ++tt) xnn[tt] = xcol[(size_t)(tn + tt) * INW];
#pragma unroll
            for (int tt = 0; tt < 16; ++tt) { const float xv = bf2f(xq[tt]); const float xc = cb + cw0 * h3 + cw1 * h2 + cw2 * h1 + cw3 * xv; h3 = h2; h2 = h1; h1 = xv; xcs[tt * 68 + lane] = xc; }
            asm volatile("s_waitcnt lgkmcnt(0)" ::: "memory");
            bf16x8 Af[2];
#pragma unroll
            for (int kk = 0; kk < 2; ++kk) { const LAS f32x4* ap = (const LAS f32x4*)(xcs + r * 68 + 32 * kk + 8 * q); const f32x4 a0 = ap[0], a1 = ap[1];
                v4u pw; pw.x = pk2(a0.x, a0.y); pw.y = pk2(a0.z, a0.w); pw.z = pk2(a1.x, a1.y); pw.w = pk2(a1.z, a1.w); Af[kk] = __builtin_bit_cast(bf16x8, pw); }
            f32x4 Da[2], Dx[2];
#pragma unroll
            for (int n = 0; n < 2; ++n) { Da[n] = (f32x4){0.f, 0.f, 0.f, 0.f}; Dx[n] = Da[n];
#pragma unroll
                for (int kk = 0; kk < 2; ++kk) { Da[n] = __builtin_amdgcn_mfma_f32_16x16x32_bf16(Af[kk], Bf[0][n][kk], Da[n], 0, 0, 0); Dx[n] = __builtin_amdgcn_mfma_f32_16x16x32_bf16(Af[kk], Bf[1][n][kk], Dx[n], 0, 0, 0); } }
#pragma unroll
            for (int n = 0; n < 2; ++n) {
                float a[4], bb[4]; v4u st;
#pragma unroll
                for (int i = 0; i < 4; ++i) { const float xcv = xcs[(4 * q + i) * 68 + hf * 32 + 16 * n + r];
                    const float ra = sigmoid_f(Da[n][i] + ba[n]), ix = sigmoid_f(Dx[n][i] + bx[n]);
                    const float la = -ra * sp8[n];
                    const float y2 = 2.f * la;
                    const float ser = -y2 * (1.f + y2 * (0.5f + y2 * (0.16666667f + y2 * (0.041666668f + y2 * 0.008333334f))));
                    const float av = __builtin_amdgcn_exp2f(1.4426950408889634f * la);
                    const float em = (y2 > -0.25f) ? ser : (1.f - av * av);
                    const float bv = __builtin_amdgcn_sqrtf(fmaxf(em, 0.f)) * (ix * xcv);
                    const unsigned pr = pk2(la * 1.4426950408889634f, bv); st[i] = pr;
                    a[i] = __builtin_amdgcn_exp2f(bf2f((unsigned short)(pr & 0xffffu))); bb[i] = __uint_as_float(pr & 0xffff0000u); }
                lb[(sc * 2 + n) * 64] = st;
                const float Al = (a[0] * a[1]) * (a[2] * a[3]);
                const float Hl = ((bb[0] * a[1] + bb[1]) * a[2] + bb[2]) * a[3] + bb[3];
                const float A0 = __shfl(Al, r), A1 = __shfl(Al, r + 16), A2 = __shfl(Al, r + 32), A3 = __shfl(Al, r + 48);
                const float H0 = __shfl(Hl, r), H1 = __shfl(Hl, r + 16), H2 = __shfl(Hl, r + 32), H3 = __shfl(Hl, r + 48);
                const float c0 = hrun[n], c1 = A0 * c0 + H0, c2 = A1 * c1 + H1, c3 = A2 * c2 + H2, c4 = A3 * c3 + H3;
                hrun[n] = c4; Arun[n] *= (A0 * A1) * (A2 * A3);
            }
#pragma unroll
            for (int tt = 0; tt < 16; ++tt) { xq[tt] = xn[tt]; xn[tt] = xnn[tt]; }
        }
        if (q == 0) {
#pragma unroll
            for (int n = 0; n < 2; ++n) { car[w * 64 + n * 16 + r] = Arun[n]; car[w * 64 + 32 + n * 16 + r] = hrun[n]; } }
        __syncthreads();
#pragma unroll
        for (int n = 0; n < 2; ++n) { float h = 0.f; for (int w2 = 0; w2 < w; ++w2) h = car[w2 * 64 + n * 16 + r] * h + car[w2 * 64 + 32 + n * 16 + r]; hin[n] = h; }
    }
    {
        VM_WAIT();
        float hrun[2] = {hin[0], hin[1]};
        v4u cur[2], nxt[2]; cur[0] = lb[0]; cur[1] = lb[64]; nxt[0] = lb[128]; nxt[1] = lb[192];
        unsigned short gq[2][4];
#pragma unroll
        for (int n = 0; n < 2; ++n)
#pragma unroll
            for (int i = 0; i < 4; ++i) gq[n][i] = gcol[(size_t)(t0 + 4 * q + i) * INW + 16 * n];
#pragma unroll 1
        for (int sc = 0; sc < 16; ++sc) {
            const int ts = t0 + sc * 16, scn = (sc < 14) ? sc + 2 : sc, tg = (sc < 15) ? ts + 16 : ts;
            v4u nn[2]; nn[0] = lb[(scn * 2 + 0) * 64]; nn[1] = lb[(scn * 2 + 1) * 64];
            unsigned short gn[2][4];
#pragma unroll
            for (int n = 0; n < 2; ++n)
#pragma unroll
                for (int i = 0; i < 4; ++i) gn[n][i] = gcol[(size_t)(tg + 4 * q + i) * INW + 16 * n];
#pragma unroll
            for (int n = 0; n < 2; ++n) {
                float a[4], bb[4];
#pragma unroll
                for (int i = 0; i < 4; ++i) { const unsigned pr = cur[n][i]; a[i] = __builtin_amdgcn_exp2f(__uint_as_float(pr << 16)); bb[i] = __uint_as_float(pr & 0xffff0000u); }
                const float Al = (a[0] * a[1]) * (a[2] * a[3]);
                const float Hl = ((bb[0] * a[1] + bb[1]) * a[2] + bb[2]) * a[3] + bb[3];
                const float A0 = __shfl(Al, r), A1 = __shfl(Al, r + 16), A2 = __shfl(Al, r + 32);
                const float H0 = __shfl(Hl, r), H1 = __shfl(Hl, r + 16), H2 = __shfl(Hl, r + 32), H3 = __shfl(Hl, r + 48), A3 = __shfl(Al, r + 48);
                const float c0 = hrun[n], c1 = A0 * c0 + H0, c2 = A1 * c1 + H1, c3 = A2 * c2 + H2, c4 = A3 * c3 + H3;
                hrun[n] = c4;
                float h = (q == 0) ? c0 : (q == 1) ? c1 : (q == 2) ? c2 : c3;
#pragma unroll
                for (int i = 0; i < 4; ++i) { h = a[i] * h + bb[i]; const float gv = bf2f(gq[n][i]);
                    const float ge = gv * sigmoid_f(1.5957691216057308f * (gv + 0.044715f * gv * gv * gv));
                    ycol[(size_t)(ts + 4 * q + i) * D + 16 * n] = (bf16)(pk2(h * ge, 0.f) & 0xffffu); }
            }
            cur[0] = nxt[0]; cur[1] = nxt[1]; nxt[0] = nn[0]; nxt[1] = nn[1];
#pragma unroll
            for (int n = 0; n < 2; ++n)
#pragma unroll
                for (int i = 0; i < 4; ++i) gq[n][i] = gn[n][i];
        }
    }
    __syncthreads();
}

__device__ __forceinline__ void attn_post(Frame& F, int l, int b, int h, int qb, float lam, float oscale) {
    const int tid_ = tid_opaque(), lane = tid_ & 63, wave_ = __builtin_amdgcn_readfirstlane(tid_ >> 6), rsub = lane >> 4, e8 = (lane & 15) * 8;
    const float* gs = FIN(I_GSUBLN) + l * 128 + e8; const Who W = who(); const bf16* OV_ = RBUF(RB_OV); bf16* AO_ = RBUF(RB_AO); const f32x4 g0 = *(const f32x4*)gs, g1 = *(const f32x4*)(gs + 4);
    const size_t rowbase = (size_t)b * SEQ + qb * 256 + wave_ * 32;
#pragma unroll
    for (int it = 0; it < 8; ++it) { const size_t row = rowbase + it * 4 + rsub;
        const v4u a = *(const GAS v4u*)(OV_ + row * D + h * 256 + e8), c = *(const GAS v4u*)(OV_ + row * D + h * 256 + 128 + e8);
        f32x4 d0 = {pg8::bf_lo(a.x) - lam * pg8::bf_lo(c.x), pg8::bf_hi(a.x) - lam * pg8::bf_hi(c.x), pg8::bf_lo(a.y) - lam * pg8::bf_lo(c.y), pg8::bf_hi(a.y) - lam * pg8::bf_hi(c.y)};
        f32x4 d1 = {pg8::bf_lo(a.z) - lam * pg8::bf_lo(c.z), pg8::bf_hi(a.z) - lam * pg8::bf_hi(c.z), pg8::bf_lo(a.w) - lam * pg8::bf_lo(c.w), pg8::bf_hi(a.w) - lam * pg8::bf_hi(c.w)};
        float ss = pg8::sumsq8(d0, d1);
        ss += __shfl_xor(ss, 1); ss += __shfl_xor(ss, 2); ss += __shfl_xor(ss, 4); ss += __shfl_xor(ss, 8);
        const float rs = __builtin_amdgcn_rsqf(ss * (1.f / 128.f) + 1e-6f) * oscale;
        d0 = d0 * rs * g0; d1 = d1 * rs * g1;
        v4u o; o.x = pk2(d0.x, d0.y); o.y = pk2(d0.z, d0.w); o.z = pk2(d1.x, d1.y); o.w = pk2(d1.z, d1.w);
        *(GAS v4u*)(AO_ + row * D + h * 128 + e8) = o; }
}

struct Args { const void* in[23]; float* out; unsigned char* ws; int ph_lo, ph_hi; };
constexpr int N_PHASES = 2 + 6 * DEPTH;
__global__ void __launch_bounds__(NWAVES * 64, 2) hymba_fwd(Args args) {
    extern __shared__ __attribute__((aligned(16))) unsigned char lds[];
    cg::grid_group grid = cg::this_grid();
    Frame F;
    F.lds = (LAS unsigned char*)lds;
    { LAS unsigned long long* tabw = (LAS unsigned long long*)(F.lds + RING_BYTES + 1024);
      if (threadIdx.x == 0) {
#pragma unroll
          for (int k = 0; k < 23; ++k) tabw[k] = (unsigned long long)args.in[k];
          tabw[23] = (unsigned long long)args.out; tabw[24] = (unsigned long long)args.ws; }
      F.tab = tabw; }
    __syncthreads();
    const int lo = args.ph_lo, hi = args.ph_hi;
#define IN(k) (lo <= (k) && (k) < hi)
#define SEAM(k) do { if (IN(k) && IN((k) + 1)) { if (local_mode && (k) != N_PHASES - 2) {     const BgConvert bg{F, 0, 0}; xcd_barrier_local_bg(bar, bg, false); } else xcd_barrier(bar); } } while (0)
#define SEAM_BG(k, sl) do { const BgConvert bg{F, opaque_s(l_), (sl)}; if (IN(k) && IN((k) + 1)) { if (local_mode) xcd_barrier_local_bg(bar, bg, true); else xcd_barrier_bg(bar, bg); } else if (IN((k) + 1)) { if (threadIdx.x >= 64) bg(); __syncthreads(); } } while (0)

    if (blockIdx.x == 0) { unsigned* bw = (unsigned*)args.ws; for (int u = threadIdx.x; u < XCD_BAR_WORDS; u += NWAVES * 64) bw[u] = 0u; }
    if (threadIdx.x < 8) ((volatile LAS unsigned*)(F.lds + LDSW_OFF))[threadIdx.x] = (threadIdx.x == 2) ? blockIdx.x : 0u;
    __syncthreads();
    if (IN(0)) { p0_prologue(F); }
    grid.sync();
    XcdBarrier bar = xcd_barrier_post((unsigned*)args.ws, (volatile LAS unsigned*)(F.lds + LDSW_OFF));
    xcd_barrier(bar);
    if (threadIdx.x == 0) {
        volatile LAS unsigned* cw = (volatile LAS unsigned*)(F.lds + LDSW_OFF); const unsigned G = gridDim.x, nloc = cw[0], nx = cw[1], rank = cw[4];
        unsigned slot = 0u; bool uniform = true;
#pragma unroll
        for (unsigned j = 0; j < 16; ++j) { const unsigned c = xb_ld(&bar.bar[XB_XCNT(j)]); if (c > 0u) { if (j < bar.x) ++slot; if (c != nloc) uniform = false; } }
        const bool local = uniform && nx == 8u && nloc * 8u == G && slot < 8u && rank < nloc && xb_ld(&bar.bar[XB_TMO]) == 0u;
        cw[2] = local ? rank * 8u + slot : blockIdx.x; cw[3] = local ? 1u : 0u; }
    __syncthreads();
    const bool local_mode = __builtin_amdgcn_readfirstlane((int)((volatile LAS unsigned*)(F.lds + LDSW_OFF))[3]) != 0;

#pragma unroll 1
    for (int l_ = 0; l_ < DEPTH; ++l_) {
        const int pb = 1 + 6 * l_;
        if (IN(pb + 0)) {
            const Who W = who(); const int l = opaque_s(l_);
            unsigned char* ws = FWS(0); const unsigned char* wl = ws + WS_W + (size_t)l * W_LAYER;
            pg8::Gemm g{(const bf16*)FOUT(), (const bf16*)(wl + WO_IN), M, INW, D}; pg8::StaticOrder S; S.init(M, INW, W.G, W.bx);
            pg8::EpiIn E{RBUF(RB_PROJ), INW, (const float*)(ws + WS_SSQ1), (const int*)FIN(I_POS), attn_body::C2};
            pg8::gemm_phase<pg8::EpiIn, pg8::StaticOrder, true, true>(F.lds, g, S, E);
        }
        SEAM_BG(pb + 0, 0);
        if (IN(pb + 1)) {
            const Who W = who(); const int l = opaque_s(l_);
            float lam, oscale;
            { const float* lq = FIN(I_LAMQ) + l * 128; const float* lk = FIN(I_LAMK) + l * 128;
              const float d0 = wave_sum(lq[W.lane] * lk[W.lane]), d1 = wave_sum(lq[64 + W.lane] * lk[64 + W.lane]);
              const float li = 0.8f - 0.6f * __expf(-0.3f * (float)l); lam = __expf(d0) - __expf(d1) + li; oscale = 1.f - li; }
#if defined(PROBE_ATTN2)
            for (int rep_ = 0; rep_ < 2; ++rep_)
#endif
            for (int item = W.vcu; item < 256; item += W.G) {
                const int bh = item >> 2, s = item & 3, b = bh >> 2, h = bh & 3;
                const attn_body::bf16* pj = (const attn_body::bf16*)(RBUF(RB_PROJ) + (size_t)b * SEQ * INW); attn_body::bf16* ov = (attn_body::bf16*)(RBUF(RB_OV) + (size_t)b * SEQ * D);
#pragma unroll 1
                for (int k = 0; k < 2; ++k) { const int qb = k ? 7 - s : s;
#pragma unroll 1
                    for (int c = 0; c < 2; ++c)
                        attn2::attn_unit128<8>(qb, pj + (h * 2 + c) * 64, pj + AW + (h * 2 + c) * 64, pj + 2 * AW + h * 128, ov + h * 256 + c * 128, (char*)lds);
                    VM_WAIT(); __syncthreads(); __builtin_amdgcn_fence(__ATOMIC_ACQUIRE, "agent"); VM_WAIT();
                    attn_post(F, l, b, h, qb, lam, oscale);
                }
            }
            __syncthreads();
#if defined(PROBE_LRU2)
            for (int rep_ = 0; rep_ < 2; ++rep_)
#endif
            for (int item = W.vcu; item < 256; item += W.G) lru_item(F, l, item);
        }
        SEAM_BG(pb + 1, 1);
        if (IN(pb + 2)) {
            const Who W = who(); const int l = opaque_s(l_);
            unsigned char* ws = FWS(0); const unsigned char* wl = ws + WS_W + (size_t)l * W_LAYER;
            pg8::Gemm g{RBUF(RB_AO), (const bf16*)(wl + WO_OUT), M, D, D}; pg8::StaticOrder S; S.init(M, D, W.G, W.bx);
            pg8::EpiRes E{(const bf16*)FOUT(), (bf16*)(ws + WS_XB0), (float*)(ws + WS_SSQ0)};
            pg8::gemm_phase<pg8::EpiRes, pg8::StaticOrder, true, true>(F.lds, g, S, E);
        }
        SEAM_BG(pb + 2, 2);
        if (IN(pb + 3)) {
            const Who W = who(); const int l = opaque_s(l_);
            unsigned char* ws = FWS(0); const unsigned char* wl = ws + WS_W + (size_t)l * W_LAYER;
            pg8::Gemm g{(const bf16*)(ws + WS_XB0), (const bf16*)(wl + WO_W1), M, FF, D}; pg8::StaticOrder S; S.init(M, FF, W.G, W.bx);
            pg8::EpiMlpIn E{RBUF(RB_HB), FF, (const float*)(ws + WS_SSQ0)};
            pg8::gemm_phase<pg8::EpiMlpIn, pg8::StaticOrder, true, true>(F.lds, g, S, E);
        }
        SEAM(pb + 3);
        if (IN(pb + 4)) {
            const Who W = who(); const int l = opaque_s(l_);
            unsigned char* ws = FWS(0); const unsigned char* wl = ws + WS_W + (size_t)l * W_LAYER;
            pg8::Gemm g{RBUF(RB_HB), (const bf16*)(wl + WO_W2), M, D, FF}; pg8::StaticOrder S; S.init(M, D, W.G, W.bx);
            pg8::EpiRes E{(const bf16*)(ws + WS_XB0), (bf16*)(ws + WS_XB0), (float*)(ws + WS_SSQ0)};
            pg8::gemm_phase<pg8::EpiRes, pg8::StaticOrder, true, true>(F.lds, g, S, E);
        }
        SEAM(pb + 4);
        if (IN(pb + 5)) {
            const Who W = who(); const int l = opaque_s(l_);
            { unsigned char* ws = FWS(0); const unsigned char* wl = ws + WS_W + (size_t)l * W_LAYER;
              pg8::Gemm g{(const bf16*)(ws + WS_P16), (const bf16*)(wl + WO_PP), M, D, opaque_s(PLE)}; pg8::StaticOrder S; S.init(M, D, W.G, W.bx);
              pg8::EpiPlain E{RBUF(RB_PP), D};
              pg8::gemm_phase<pg8::EpiPlain, pg8::StaticOrder, true, true>(F.lds, g, S, E); }
            VM_WAIT(); __syncthreads();
            { unsigned char* ws = FWS(0); const unsigned char* wl = ws + WS_W + (size_t)l * W_LAYER;
              pg8::Gemm g{(const bf16*)(ws + WS_XB0), (const bf16*)(wl + WO_PG), M, D, D}; pg8::StaticOrder S; S.init(M, D, W.G, W.bx);
              pg8::EpiPle E{(const bf16*)(ws + WS_XB0), (l == DEPTH - 1) ? RBUF(RB_XBF) : (bf16*)FOUT(), (const float*)(ws + WS_SSQ0), (float*)(ws + WS_SSQ1), (const bf16*)RBUF(RB_PP)};
              pg8::gemm_phase<pg8::EpiPle, pg8::StaticOrder, true, true>(F.lds, g, S, E); }
        }
        SEAM(pb + 5);
    }
    if (IN(N_PHASES - 1)) final_norm(F);
#undef IN
#undef SEAM
#undef SEAM_BG
}

extern "C" void kernel_launch(void* const* d_in, const int* in_sizes, int n_in, void* d_out, int out_size, void* d_ws, size_t ws_size, hipStream_t stream) {
    static int grid = 0;
    if (grid == 0) {
        if (n_in != 23 || in_sizes[0] != M * D || out_size != M * D || ws_size < WS_END) { fprintf(stderr, "kernel_launch: unexpected shapes: n_in %d in0 %d out %d ws %zu (need %zu); nothing launched\n", n_in, n_in > 0 ? in_sizes[0] : -1, out_size, ws_size, (size_t)WS_END); grid = -1; return; }
        int dev = 0, cus = 0, per_cu = 0;
        if (hipGetDevice(&dev) != hipSuccess || hipDeviceGetAttribute(&cus, hipDeviceAttributeMultiprocessorCount, dev) != hipSuccess) { grid = -1; return; }
        if (hipFuncSetAttribute((const void*)hymba_fwd, hipFuncAttributeMaxDynamicSharedMemorySize, LDS_BYTES) != hipSuccess) { fprintf(stderr, "kernel_launch: hipFuncSetAttribute failed\n"); grid = -1; return; }
        if (hipOccupancyMaxActiveBlocksPerMultiprocessor(&per_cu, (const void*)hymba_fwd, NWAVES * 64, LDS_BYTES) != hipSuccess || per_cu < 1) { fprintf(stderr, "kernel_launch: occupancy query reports %d\n", per_cu); per_cu = 1; }
        (void)hipGetLastError();
        grid = cus * per_cu;
    }
    if (grid < 0) return;
    Args a{};
    for (int i = 0; i < 23; ++i) a.in[i] = d_in[i];
    a.out = (float*)d_out; a.ws = (unsigned char*)d_ws;
#ifndef MK_CUTS
    a.ph_lo = 0; a.ph_hi = N_PHASES;
    void* kargs[] = {&a};
    hipError_t e = hipLaunchCooperativeKernel((const void*)hymba_fwd, dim3(grid), dim3(NWAVES * 64), kargs, LDS_BYTES, stream);
    if (e != hipSuccess) fprintf(stderr, "kernel_launch: cooperative launch failed: %s (grid %d)\n", hipGetErrorString(e), grid);
#else
    for (int ph = 0; ph < N_PHASES; ++ph) { a.ph_lo = ph; a.ph_hi = ph + 1; void* kargs[] = {&a};
        hipError_t e = hipLaunchCooperativeKernel((const void*)hymba_fwd, dim3(grid), dim3(NWAVES * 64), kargs, LDS_BYTES, stream);
        if (e != hipSuccess) { fprintf(stderr, "kernel_launch: launch %d failed: %s\n", ph, hipGetErrorString(e)); break; } }
#endif
}
```

```cpp
#include <hip/hip_runtime.h>
#include <cstdio>
#include <cstdint>
__device__ __forceinline__ int tid_opaque() { int t = threadIdx.x; asm volatile("" : "+v"(t)); return t; }
namespace pg8 {
#define PG8_LAS __attribute__((address_space(3)))
typedef unsigned short bf16_t;
typedef short bf16x8 __attribute__((ext_vector_type(8)));
typedef float f32x4 __attribute__((ext_vector_type(4)));
typedef unsigned u32x4 __attribute__((ext_vector_type(4)));
constexpr int BM = 256, BK = 64, HALF = 128, HTB = HALF * BK * 2  , STAGE_BYTES = 8 * HTB, NXCD = 8, WGM = 8;

__host__ __device__ __forceinline__ int lds_byte(int r, int c) { const int st = (r >> 4) * 2 + (c >> 5), rr = r & 15, cc = c & 31, ob = rr * 64 + cc * 2; return st * 1024 + (ob ^ (((ob >> 9) & 1) << 5)); }
__host__ __device__ __forceinline__ void stage_rc(int b, int& R, int& C) { const int st = b / 1024, sb = b % 1024, swz = sb ^ (((sb >> 9) & 1) << 5); R = (st >> 1) * 16 + swz / 64; C = (st & 1) * 32 + (swz % 64) / 2; }
__host__ __device__ __forceinline__ int perm32(int rho) { const int n = rho >> 4, i = rho & 15; return 8 * (i >> 2) + 4 * n + (i & 3); }

struct Unit { int pm, pn; };
struct Gemm { const bf16_t* A; const bf16_t* Bt; int M, N, K; };

struct StaticOrder {
    int nM, nN, nwg, G, c, rev;
    __host__ __device__ void init(int M, int N, int G_, int c_, int rev_ = 0) { nM = M / BM; nN = N / BM; nwg = nM * nN; G = G_; c = c_; rev = (rev_ && nwg % G_ == 0) ? 1 : 0; }
    __host__ __device__ bool next(int i, Unit& u) const {
        const int nr = (nwg + G - 1) / G; if (i >= nr) return false;
        const long L = (long)(rev ? nr - 1 - i : i) * G + c; if (L >= nwg) return false;
        int wgid = (int)L; { const int q = nwg / NXCD, r = nwg % NXCD, xcd = wgid % NXCD, off = wgid / NXCD; wgid = (xcd < r ? xcd * (q + 1) : r * (q + 1) + (xcd - r) * q) + off; }
        const int nig = WGM * nN, gid = wgid / nig, fm = gid * WGM, gsz = (nM - fm) < WGM ? (nM - fm) : WGM;
        u.pm = fm + ((wgid % nig) % gsz); u.pn = (wgid % nig) / gsz; return true;
    }
    __device__ __forceinline__ void a_ready(const Unit&) const {}
    __device__ __forceinline__ void done(const Unit&) const {}
};

__device__ __forceinline__ unsigned cvt_pk_bf16(float lo, float hi) { unsigned r; asm volatile("v_cvt_pk_bf16_f32 %0, %1, %2" : "=v"(r) : "v"(lo), "v"(hi)); return r; }
__device__ __forceinline__ u32x4 pack8(const f32x4 v0, const f32x4 v1) { u32x4 w; w.x = cvt_pk_bf16(v0[0], v0[1]); w.y = cvt_pk_bf16(v0[2], v0[3]); w.z = cvt_pk_bf16(v1[0], v1[1]); w.w = cvt_pk_bf16(v1[2], v1[3]); return w; }
__device__ __forceinline__ float bf_lo(unsigned w) { return __uint_as_float(w << 16); }
__device__ __forceinline__ float bf_hi(unsigned w) { return __uint_as_float(w & 0xffff0000u); }
constexpr int DMODEL = 1024;
constexpr float RMS_EPS = 1e-6f;
__device__ __forceinline__ float row_rs(const float* ssq, int row) {
    const f32x4* p = (const f32x4*)(ssq + (size_t)row * 16);
    const f32x4 a = p[0], b = p[1], c = p[2], d = p[3];
    const float s = (((a[0] + a[1]) + (a[2] + a[3])) + ((b[0] + b[1]) + (b[2] + b[3]))) + (((c[0] + c[1]) + (c[2] + c[3])) + ((d[0] + d[1]) + (d[2] + d[3])));
    return __builtin_amdgcn_rsqf(s * (1.0f / DMODEL) + RMS_EPS);
}
__device__ __forceinline__ float sumsq8(const f32x4 a, const f32x4 b) { return ((a[0] * a[0] + a[1] * a[1]) + (a[2] * a[2] + a[3] * a[3])) + ((b[0] * b[0] + b[1] * b[1]) + (b[2] * b[2] + b[3] * b[3])); }

struct EpiPlain {
    static constexpr bool PERM = true, AFTER_DRAIN = false, LOADS_BEFORE_STORES = false;
    bf16_t* O; int ldc;
    __device__ __forceinline__ void operator()(const f32x4 (&acc)[2][2][4][2], const Unit& u, int wr, int wc, int fr, int fq) const {
        const int row0 = u.pm * BM + wr * 64 + fr, col0 = u.pn * BM + wc * 32 + 8 * fq;
#pragma unroll
        for (int ai = 0; ai < 2; ++ai)
#pragma unroll
            for (int m = 0; m < 4; ++m) { bf16_t* rowp = O + (size_t)(row0 + ai * HALF + m * 16) * ldc + col0;
#pragma unroll
                for (int bj = 0; bj < 2; ++bj) *(u32x4*)(rowp + bj * HALF) = pack8(acc[ai][bj][m][0], acc[ai][bj][m][1]); }
    }
};
__device__ __forceinline__ void row_rs8(float (&rs)[8], const float* ssq, int row0, int fq) {
    f32x4 p[8];
#pragma unroll
    for (int i = 0; i < 8; ++i) p[i] = *(const f32x4*)(ssq + (size_t)(row0 + (i >> 2) * HALF + (i & 3) * 16) * 16 + 4 * fq);
#pragma unroll
    for (int i = 0; i < 8; ++i) { float s = (p[i][0] + p[i][1]) + (p[i][2] + p[i][3]); s += __shfl_xor(s, 16); s += __shfl_xor(s, 32); rs[i] = __builtin_amdgcn_rsqf(s * (1.0f / DMODEL) + RMS_EPS); }
}
struct EpiIn {
    static constexpr bool PERM = true, AFTER_DRAIN = false, LOADS_BEFORE_STORES = true;
    bf16_t* O; int ldc; const float* ssq; const int* pos; float qscale; bf16_t* KC; bf16_t* VC;
    __device__ __forceinline__ bf16_t* dst(const Unit& u, int row, int bj, int wc, int fq, int col0) const {
        if (u.pn < 2 || u.pn >= 6) return O + (size_t)row * ldc + col0 + bj * HALF;
        const int b = row >> 11, t = row & 2047;
        if (u.pn < 4) { const int hc = (u.pn - 2) * 4 + bj * 2 + (wc >> 1), chunk = (wc & 1) * 4 + fq;
            return KC + (size_t)((b * 8 + hc) * 32 + (t >> 6)) * 4096 + chunk * 512 + (t & 63) * 8; }
        const int h = (u.pn - 4) * 2 + bj, piece = wc * 4 + ((t & 63) >> 4);
        return VC + (size_t)((b * 4 + h) * 32 + (t >> 6)) * 8192 + piece * 512 + (t & 15) * 32 + fq * 8;
    }
    __device__ __forceinline__ void operator()(const f32x4 (&acc)[2][2][4][2], const Unit& u, int wr, int wc, int fr, int fq) const {
        const int row0 = u.pm * BM + wr * 64 + fr, col0 = u.pn * BM + wc * 32 + 8 * fq;
        const bool rope = (u.pn < 4) && !(wc & 1);
        const float sc = (u.pn < 2) ? qscale : 1.f;
        float rs[8]; row_rs8(rs, ssq, row0, fq);
        if (rope) {
            int ps[8];
#pragma unroll
            for (int i = 0; i < 8; ++i) ps[i] = pos[row0 + (i >> 2) * HALF + (i & 3) * 16];
            const bool mine = fq < 2; const float sgn = (fq == 0) ? -1.f : 1.f;
            const float invf[8] = {1.0f, 0.1939227432012558f, 0.03760603070259094f, 0.007292664609849453f, 0.0014142135623842478f, 0.00027424818836152554f, 5.3182957344688475e-05f, 1.0313385246263351e-05f};
#pragma unroll
            for (int ai = 0; ai < 2; ++ai)
#pragma unroll
                for (int m = 0; m < 4; ++m) { const int row = row0 + ai * HALF + m * 16; const float r = rs[ai * 4 + m] * sc; const float pf = (float)ps[ai * 4 + m];
                    float c[8], sn[8];
#pragma unroll
                    for (int e = 0; e < 8; ++e) { const float rev = __builtin_amdgcn_fractf((pf * invf[e]) * 0.15915494309189535f); c[e] = mine ? __builtin_amdgcn_cosf(rev) : 1.f; sn[e] = mine ? __builtin_amdgcn_sinf(rev) * sgn : 0.f; }
#pragma unroll
                    for (int bj = 0; bj < 2; ++bj) { f32x4 v0 = acc[ai][bj][m][0] * r, v1 = acc[ai][bj][m][1] * r; f32x4 p0, p1;
#pragma unroll
                        for (int e = 0; e < 4; ++e) { p0[e] = __shfl_xor(v0[e], 16); p1[e] = __shfl_xor(v1[e], 16); }
#pragma unroll
                        for (int e = 0; e < 4; ++e) { v0[e] = v0[e] * c[e] + p0[e] * sn[e]; v1[e] = v1[e] * c[4 + e] + p1[e] * sn[4 + e]; }
                        *(u32x4*)dst(u, row, bj, wc, fq, col0) = pack8(v0, v1); } }
        } else {
#pragma unroll
            for (int ai = 0; ai < 2; ++ai)
#pragma unroll
                for (int m = 0; m < 4; ++m) { const int row = row0 + ai * HALF + m * 16; const float r = rs[ai * 4 + m] * sc;
#pragma unroll
                    for (int bj = 0; bj < 2; ++bj) *(u32x4*)dst(u, row, bj, wc, fq, col0) = pack8(acc[ai][bj][m][0] * r, acc[ai][bj][m][1] * r); }
        }
    }
};
__device__ __forceinline__ void unpack8(const u32x4 w, f32x4& a, f32x4& b) { a = (f32x4){bf_lo(w.x), bf_hi(w.x), bf_lo(w.y), bf_hi(w.y)}; b = (f32x4){bf_lo(w.z), bf_hi(w.z), bf_lo(w.w), bf_hi(w.w)}; }
struct EpiRes {
    static constexpr bool PERM = true, AFTER_DRAIN = false, LOADS_BEFORE_STORES = true;
    const bf16_t* Rin; bf16_t* XBo; float* ssq;
    __device__ __forceinline__ void operator()(const f32x4 (&acc)[2][2][4][2], const Unit& u, int wr, int wc, int fr, int fq) const {
        const int row0 = u.pm * BM + wr * 64 + fr, col0 = u.pn * BM + wc * 32 + 8 * fq;
        u32x4 rv[8][2];
#pragma unroll
        for (int i = 0; i < 8; ++i)
#pragma unroll
            for (int bj = 0; bj < 2; ++bj) rv[i][bj] = *(const u32x4*)(Rin + (size_t)(row0 + (i >> 2) * HALF + (i & 3) * 16) * DMODEL + col0 + bj * HALF);
#pragma unroll
        for (int ai = 0; ai < 2; ++ai)
#pragma unroll
            for (int m = 0; m < 4; ++m) { const int row = row0 + ai * HALF + m * 16; float part = 0.f;
#pragma unroll
                for (int bj = 0; bj < 2; ++bj) { f32x4 r0, r1; unpack8(rv[ai * 4 + m][bj], r0, r1);
                    const f32x4 h0 = r0 + acc[ai][bj][m][0], h1 = r1 + acc[ai][bj][m][1]; part += sumsq8(h0, h1);
                    *(u32x4*)(XBo + (size_t)row * DMODEL + col0 + bj * HALF) = pack8(h0, h1); }
                part += __shfl_xor(part, 16); part += __shfl_xor(part, 32);
                if (fq == 0) ssq[(size_t)row * 16 + u.pn * 4 + wc] = part; }
    }
};
struct EpiMlpIn {
    static constexpr bool PERM = true, AFTER_DRAIN = false, LOADS_BEFORE_STORES = true;
    bf16_t* O; int ldc; const float* ssq;
    __device__ __forceinline__ void operator()(const f32x4 (&acc)[2][2][4][2], const Unit& u, int wr, int wc, int fr, int fq) const {
        const int row0 = u.pm * BM + wr * 64 + fr, col0 = u.pn * BM + wc * 32 + 8 * fq;
        float rs[8]; row_rs8(rs, ssq, row0, fq);
#pragma unroll
        for (int ai = 0; ai < 2; ++ai)
#pragma unroll
            for (int m = 0; m < 4; ++m) { const int row = row0 + ai * HALF + m * 16; const float r = rs[ai * 4 + m];
                bf16_t* rowp = O + (size_t)row * ldc + col0;
#pragma unroll
                for (int bj = 0; bj < 2; ++bj) { f32x4 v0 = acc[ai][bj][m][0] * r, v1 = acc[ai][bj][m][1] * r;
#pragma unroll
                    for (int e = 0; e < 4; ++e) { const float a = fmaxf(v0[e], 0.f), b = fmaxf(v1[e], 0.f); v0[e] = a * a; v1[e] = b * b; }
                    *(u32x4*)(rowp + bj * HALF) = pack8(v0, v1); } }
    }
};
struct EpiPle {
    static constexpr bool PERM = true, AFTER_DRAIN = false, LOADS_BEFORE_STORES = true;
    const bf16_t* Rin; bf16_t* XBo; const float* ssq_in; float* ssq_out; const bf16_t* PP;
    __device__ __forceinline__ void operator()(const f32x4 (&acc)[2][2][4][2], const Unit& u, int wr, int wc, int fr, int fq) const {
        const int row0 = u.pm * BM + wr * 64 + fr, col0 = u.pn * BM + wc * 32 + 8 * fq;
#pragma unroll
        for (int ai = 0; ai < 2; ++ai)
#pragma unroll
          for (int mh = 0; mh < 2; ++mh) {
            u32x4 rv[2][2], pw[2][2]; f32x4 p[2];
#pragma unroll
            for (int mm = 0; mm < 2; ++mm) { const int rowl = row0 + ai * HALF + (2 * mh + mm) * 16; p[mm] = *(const f32x4*)(ssq_in + (size_t)rowl * 16 + 4 * fq);
#pragma unroll
                for (int bj = 0; bj < 2; ++bj) { const size_t off = (size_t)rowl * DMODEL + col0 + bj * HALF; rv[mm][bj] = *(const u32x4*)(Rin + off); pw[mm][bj] = *(const u32x4*)(PP + off); } }
#pragma unroll
            for (int mm = 0; mm < 2; ++mm) { const int m = 2 * mh + mm; const int row = row0 + ai * HALF + m * 16; float part = 0.f;
                float sr = (p[mm][0] + p[mm][1]) + (p[mm][2] + p[mm][3]); sr += __shfl_xor(sr, 16); sr += __shfl_xor(sr, 32); const float r = __builtin_amdgcn_rsqf(sr * (1.0f / DMODEL) + RMS_EPS);
#pragma unroll
                for (int bj = 0; bj < 2; ++bj) { f32x4 r0, r1, p0, p1; unpack8(rv[mm][bj], r0, r1); unpack8(pw[mm][bj], p0, p1);
                    f32x4 g0 = acc[ai][bj][m][0] * r, g1 = acc[ai][bj][m][1] * r;
#pragma unroll
                    for (int e = 0; e < 4; ++e) { g0[e] = __builtin_amdgcn_rcpf(1.f + __builtin_amdgcn_exp2f(-1.4426950408889634f * g0[e])); g1[e] = __builtin_amdgcn_rcpf(1.f + __builtin_amdgcn_exp2f(-1.4426950408889634f * g1[e])); }
                    const f32x4 h0 = r0 + g0 * p0, h1 = r1 + g1 * p1; part += sumsq8(h0, h1);
                    *(u32x4*)(XBo + (size_t)row * DMODEL + col0 + bj * HALF) = pack8(h0, h1); }
                part += __shfl_xor(part, 16); part += __shfl_xor(part, 32);
                if (fq == 0) ssq_out[(size_t)row * 16 + u.pn * 4 + wc] = part; }
            asm volatile("" ::: "memory"); }
    }
};

template <class Epi, class Sched, bool ALIGN_EPI = false, bool SP2 = false>
__device__ __forceinline__ void gemm_phase(PG8_LAS unsigned char* lds, const Gemm g, const Sched& S, const Epi& E) {
    const int tid = tid_opaque(), wid = __builtin_amdgcn_readfirstlane(tid >> 6), lane = tid & 63, wr = wid >> 2, wc = wid & 3, fr = lane & 15, fq = lane >> 4;
    const int K = g.K, nt = K / BK;
    unsigned voffA[2], voffB[2];
#pragma unroll
    for (int i = 0; i < 2; ++i) { int R, C; stage_rc(tid * 16 + i * 8192, R, C); const int Rb = Epi::PERM ? ((R & ~31) + perm32(R & 31)) : R;
        voffA[i] = (unsigned)(R * K + C) * 2u; voffB[i] = (unsigned)(Rb * K + C) * 2u; }
    const size_t kstep = (size_t)(BK * 2);
    const size_t hstep = (size_t)HALF * K * 2;
    const size_t tstep = 2 * hstep;
    const unsigned ldsw = (unsigned)wid * 1024u;
    const int aoff = lds_byte(wr * 64 + fr, fq * 8), boff = lds_byte(wc * 32 + fr, fq * 8);
#define PG8_SA(b, h) (((b) * 2 + (h)) * HTB)
#define PG8_SB(b, h) ((4 + (b) * 2 + (h)) * HTB)
#define PG8_STAGE(bufoff, gbase, voff) do { _Pragma("unroll") for (int _i = 0; _i < 2; ++_i) \
        __builtin_amdgcn_global_load_lds((const unsigned*)((const char*)(gbase) + (voff)[_i]), (PG8_LAS unsigned*)(lds + (bufoff) + ldsw + _i * 8192), 16, 0, 0); } while (0)
#define PG8_LDA(dst, b, h) do { _Pragma("unroll") for (int m = 0; m < 4; ++m) _Pragma("unroll") for (int k = 0; k < 2; ++k) dst[m][k] = *(const PG8_LAS bf16x8*)(lds + PG8_SA(b, h) + aoff + m * 2048 + k * 1024); } while (0)
#define PG8_LDB(dst, b, h) do { _Pragma("unroll") for (int n = 0; n < 2; ++n) _Pragma("unroll") for (int k = 0; k < 2; ++k) dst[n][k] = *(const PG8_LAS bf16x8*)(lds + PG8_SB(b, h) + boff + n * 2048 + k * 1024); } while (0)
#define PG8_MMA(ai, bj, At, Bt) do { __builtin_amdgcn_s_setprio(1); _Pragma("unroll") for (int m = 0; m < 4; ++m) _Pragma("unroll") for (int n = 0; n < 2; ++n) _Pragma("unroll") for (int k = 0; k < 2; ++k) \
        acc[ai][bj][m][n] = __builtin_amdgcn_mfma_f32_16x16x32_bf16(Bt[n][k], At[m][k], acc[ai][bj][m][n], 0, 0, 0); __builtin_amdgcn_s_setprio(0); } while (0)
#define PG8_WAIT_V(n) asm volatile("s_waitcnt vmcnt(" #n ")" ::: "memory")
#define PG8_WAIT_L(n) asm volatile("s_waitcnt lgkmcnt(" #n ")" ::: "memory")
#define PG8_WAIT_V8_UNLESS(flag) asm volatile("s_cmp_lg_i32 %0, 0\n\ts_cbranch_scc1 .Lpg8rx%=\n\ts_waitcnt vmcnt(8)\n.Lpg8rx%=:" :: "s"(__builtin_amdgcn_readfirstlane(flag)) : "scc", "memory")
#define PG8_BAR __builtin_amdgcn_s_barrier()
#define PG8_SCHED __builtin_amdgcn_sched_barrier(0)
    Unit cur, nxt; int ui = 0; bool relax = false;
    if (!S.next(0, cur)) return;
    f32x4 acc[2][2][4][2];
#pragma unroll
    for (int a = 0; a < 2; ++a)
#pragma unroll
        for (int b = 0; b < 2; ++b)
#pragma unroll
            for (int m = 0; m < 4; ++m)
#pragma unroll
                for (int n = 0; n < 2; ++n) acc[a][b][m][n] = (f32x4){0.f, 0.f, 0.f, 0.f};
    bf16x8 At[4][2], B0[2][2], B1[2][2];
    const char* cA = (const char*)g.A + (size_t)cur.pm * tstep; const char* cB = (const char*)g.Bt + (size_t)cur.pn * tstep;
    S.a_ready(cur);
    if constexpr (SP2) {
        PG8_STAGE(PG8_SB(0, 0), cB, voffB); PG8_STAGE(PG8_SB(0, 1), cB + hstep, voffB); PG8_STAGE(PG8_SA(0, 0), cA, voffA); PG8_STAGE(PG8_SA(0, 1), cA + hstep, voffA);
        if (wr == 1) PG8_BAR;
        PG8_WAIT_V(2); PG8_BAR;
        PG8_STAGE(PG8_SB(1, 0), cB + kstep, voffB); PG8_STAGE(PG8_SA(1, 0), cA + kstep, voffA); PG8_STAGE(PG8_SB(1, 1), cB + hstep + kstep, voffB);
        PG8_WAIT_V(6); PG8_BAR;
    } else {
        PG8_STAGE(PG8_SB(0, 0), cB, voffB); PG8_STAGE(PG8_SA(0, 0), cA, voffA); PG8_STAGE(PG8_SB(0, 1), cB + hstep, voffB); PG8_STAGE(PG8_SA(0, 1), cA + hstep, voffA);
        if (wr == 1) PG8_BAR;
        PG8_WAIT_V(4); PG8_BAR;
        PG8_STAGE(PG8_SB(1, 0), cB + kstep, voffB); PG8_STAGE(PG8_SA(1, 0), cA + kstep, voffA); PG8_STAGE(PG8_SB(1, 1), cB + hstep + kstep, voffB);
        PG8_WAIT_V(6); PG8_BAR;
    }
    for (;;) {
        const bool has_next = S.next(ui + 1, nxt);
        const char* nA = has_next ? (const char*)g.A + (size_t)nxt.pm * tstep : cA; const char* nB = has_next ? (const char*)g.Bt + (size_t)nxt.pn * tstep : cB;
        for (int t = 0; t < nt; t += 2) {
            const bool last = (t == nt - 2);
            const char* a1 = cA + (size_t)(t + 1) * kstep;
            const char* a2 = last ? nA : cA + (size_t)(t + 2) * kstep; const char* b2 = last ? nB : cB + (size_t)(t + 2) * kstep;
            const char* a3 = a2 + kstep; const char* b3 = b2 + kstep;
            if (last && has_next) S.a_ready(nxt);
            if constexpr (SP2) {
            const int rx = (relax && t == 0) ? 1 : 0;
            PG8_STAGE(PG8_SA(1, 1), a1 + hstep, voffA); PG8_SCHED; PG8_LDB(B0, 0, 0); PG8_LDB(B1, 0, 1); PG8_SCHED; PG8_LDA(At, 0, 0);
            PG8_WAIT_V8_UNLESS(rx); PG8_WAIT_L(0); PG8_BAR; PG8_MMA(0, 0, At, B0); PG8_MMA(0, 1, At, B1); PG8_BAR; PG8_SCHED;
            PG8_STAGE(PG8_SB(0, 0), b2, voffB); PG8_STAGE(PG8_SB(0, 1), b2 + hstep, voffB); PG8_STAGE(PG8_SA(0, 0), a2, voffA); PG8_SCHED; PG8_LDA(At, 0, 1);
            PG8_WAIT_V8_UNLESS(rx); PG8_WAIT_L(0); PG8_BAR; PG8_MMA(1, 0, At, B0); PG8_MMA(1, 1, At, B1); PG8_BAR; PG8_SCHED;
            PG8_STAGE(PG8_SA(0, 1), a2 + hstep, voffA); PG8_SCHED; PG8_LDB(B0, 1, 0); PG8_LDB(B1, 1, 1); PG8_SCHED; PG8_LDA(At, 1, 0);
            PG8_WAIT_V(8); PG8_WAIT_L(0); PG8_BAR; PG8_MMA(0, 0, At, B0); PG8_MMA(0, 1, At, B1); PG8_BAR; PG8_SCHED;
            PG8_STAGE(PG8_SB(1, 0), b3, voffB); PG8_STAGE(PG8_SB(1, 1), b3 + hstep, voffB); PG8_STAGE(PG8_SA(1, 0), a3, voffA); PG8_SCHED; PG8_LDA(At, 1, 1);
            PG8_WAIT_V(8); PG8_WAIT_L(0); PG8_BAR; PG8_MMA(1, 0, At, B0); PG8_MMA(1, 1, At, B1); PG8_BAR; PG8_SCHED;
            } else {
            PG8_LDB(B0, 0, 0); PG8_SCHED; PG8_LDA(At, 0, 0); PG8_STAGE(PG8_SA(1, 1), a1 + hstep, voffA);
            PG8_WAIT_L(8); PG8_BAR; PG8_WAIT_L(0); PG8_MMA(0, 0, At, B0); PG8_BAR; PG8_SCHED;
            PG8_LDB(B1, 0, 1); PG8_STAGE(PG8_SB(0, 0), b2, voffB);
            PG8_BAR; PG8_WAIT_L(0); PG8_MMA(0, 1, At, B1); PG8_BAR;
            PG8_LDA(At, 0, 1); PG8_STAGE(PG8_SA(0, 0), a2, voffA);
            PG8_BAR; PG8_WAIT_L(0); PG8_MMA(1, 0, At, B0); PG8_BAR; PG8_SCHED;
            PG8_STAGE(PG8_SB(0, 1), b2 + hstep, voffB);
            PG8_WAIT_V(6); PG8_BAR; PG8_MMA(1, 1, At, B1); PG8_BAR;
            PG8_LDB(B0, 1, 0); PG8_SCHED; PG8_LDA(At, 1, 0); PG8_STAGE(PG8_SA(0, 1), a2 + hstep, voffA);
            PG8_WAIT_L(8); PG8_BAR; PG8_WAIT_L(0); PG8_MMA(0, 0, At, B0); PG8_BAR; PG8_SCHED;
            PG8_LDB(B1, 1, 1); PG8_STAGE(PG8_SB(1, 0), b3, voffB);
            PG8_BAR; PG8_WAIT_L(0); PG8_MMA(0, 1, At, B1); PG8_BAR;
            PG8_LDA(At, 1, 1); PG8_STAGE(PG8_SA(1, 0), a3, voffA);
            PG8_BAR; PG8_WAIT_L(0); PG8_MMA(1, 0, At, B0); PG8_BAR; PG8_SCHED;
            PG8_STAGE(PG8_SB(1, 1), b3 + hstep, voffB);
            PG8_WAIT_V(6); PG8_BAR; PG8_MMA(1, 1, At, B1); PG8_BAR;
            }
        }
        if constexpr (ALIGN_EPI) { if (wr == 0) PG8_BAR; }
        if constexpr (!Epi::AFTER_DRAIN) { const int t2 = tid_opaque(), w2 = __builtin_amdgcn_readfirstlane(t2 >> 6), l2 = t2 & 63;
            E(acc, cur, w2 >> 2, w2 & 3, l2 & 15, l2 >> 4); S.done(cur); }
        if (!has_next) break;
#pragma unroll
        for (int a = 0; a < 2; ++a)
#pragma unroll
            for (int b = 0; b < 2; ++b)
#pragma unroll
                for (int m = 0; m < 4; ++m)
#pragma unroll
                    for (int n = 0; n < 2; ++n) acc[a][b][m][n] = (f32x4){0.f, 0.f, 0.f, 0.f};
        cur = nxt; cA = nA; cB = nB; ++ui; relax = Epi::LOADS_BEFORE_STORES && !Epi::AFTER_DRAIN && SP2;
        if constexpr (ALIGN_EPI) { if (wr == 1) PG8_BAR; }
    }
    PG8_WAIT_V(0);
    if constexpr (!ALIGN_EPI) { if (wr == 0) PG8_BAR; }
    PG8_BAR;
    if constexpr (Epi::AFTER_DRAIN) { E.fused(acc, cur, wr, wc, fr, fq, lds, wid, lane); S.done(cur); }
#undef PG8_SA
#undef PG8_SB
#undef PG8_STAGE
#undef PG8_LDA
#undef PG8_LDB
#undef PG8_MMA
#undef PG8_WAIT_V
#undef PG8_WAIT_L
#undef PG8_WAIT_V8_UNLESS
#undef PG8_BAR
#undef PG8_SCHED
}
}
#ifndef PG8_SP2
#define PG8_SP2 true
#endif
#include <hip/hip_bf16.h>
#include <cmath>
namespace attn_body {
using bf16=__hip_bfloat16;
using bf16x8=__attribute__((ext_vector_type(8)))short;
using s16x4=__attribute__((ext_vector_type(4)))short;
using f32x16=__attribute__((ext_vector_type(16)))float;
using u32x4=__attribute__((ext_vector_type(4)))unsigned;
constexpr int D=64,PQ=2560,PO=1024;
constexpr int NW=8,QBLK=32,QB=QBLK*NW,KVBLK=64;
constexpr int ATTN_UNIT_ROWS=QB;
__device__ __forceinline__ int crow(int r,int hi){return (r&3)+8*(r>>2)+4*hi;}
#define SBAR() __builtin_amdgcn_sched_barrier(0)
__device__ __forceinline__ void cmask(f32x16&p0,f32x16&p1,int jb,int qrel,int hi){
  const float NEG=-INFINITY; int kb=64*jb+4*hi;
  #pragma unroll
  for(int r=0;r<16;++r){int kv=kb+(r&3)+8*(r>>2); if(kv>qrel)p0[r]=NEG; if(kv+32>qrel)p1[r]=NEG;}
}

constexpr int NSLOT=3, SLOTB=8192;
constexpr int LDS_K=0, LDS_V=NSLOT*SLOTB, LDS_WS=2*NSLOT*SLOTB, LDS_OST=LDS_WS+NW*64*4, LDS_BYTES=LDS_OST+NW*4096;
constexpr float C2=0.125f*1.4426950408889634f;
__device__ __forceinline__ void glds16(const void*gsrc,unsigned lds_dst){unsigned keep;
  asm volatile("s_mov_b32 %0, m0\n\ts_mov_b32 m0, %2\n\ts_nop 0\n\tglobal_load_lds_dwordx4 %1, off\n\ts_mov_b32 m0, %0":"=&s"(keep):"v"(gsrc),"s"(lds_dst):"memory");}
__device__ __forceinline__ float max3f(float a,float b,float c){float r;asm("v_max3_f32 %0, %1, %2, %3":"=v"(r):"v"(a),"v"(b),"v"(c));return r;}
__device__ __forceinline__ float max2f(float a,float b){float r;asm("v_max_f32_e32 %0, %1, %2":"=v"(r):"v"(a),"v"(b));return r;}
__device__ __forceinline__ float fadd_s(float a,float b){float r;asm("v_add_f32_e32 %0, %1, %2":"=v"(r):"v"(a),"v"(b));return r;}
__device__ __forceinline__ float fsub_s(float a,float b){float r;asm("v_sub_f32_e32 %0, %1, %2":"=v"(r):"v"(a),"v"(b));return r;}
typedef float f32x2_t __attribute__((ext_vector_type(2))); typedef __bf16 bf16x2_t __attribute__((ext_vector_type(2)));
__device__ __forceinline__ unsigned cvtpk_s(float lo,float hi){f32x2_t v={lo,hi};bf16x2_t b=__builtin_convertvector(v,bf16x2_t);return __builtin_bit_cast(unsigned,b);}
#define WAIT_BAR(N) asm volatile("s_waitcnt vmcnt(" #N ") lgkmcnt(0)\n\ts_barrier":::"memory")

__device__ __forceinline__ void qkt(f32x16&p0,f32x16&p1,const char*Kslot,const bf16x8*qr,const f32x16&negm,int r32,int hi){
  const char*kb=Kslot+hi*1024+r32*16;
  #pragma unroll
  for(int d0=0;d0<4;++d0){
    const bf16x8 b0=*reinterpret_cast<const bf16x8*>(kb+d0*2048);
    const bf16x8 b1=*reinterpret_cast<const bf16x8*>(kb+d0*2048+512);
    if(d0==0){p0=__builtin_amdgcn_mfma_f32_32x32x16_bf16(b0,qr[0],negm,0,0,0);p1=__builtin_amdgcn_mfma_f32_32x32x16_bf16(b1,qr[0],negm,0,0,0);}
    else{p0=__builtin_amdgcn_mfma_f32_32x32x16_bf16(b0,qr[d0],p0,0,0,0);p1=__builtin_amdgcn_mfma_f32_32x32x16_bf16(b1,qr[d0],p1,0,0,0);}}
}
typedef __attribute__((address_space(3))) const char* lds_cptr;
typedef short v4i16_t __attribute__((ext_vector_type(4)));
__device__ __forceinline__ void kload8(bf16x8*kf,lds_cptr kp){
  kf[0]=*(const __attribute__((address_space(3))) bf16x8*)(kp);      kf[1]=*(const __attribute__((address_space(3))) bf16x8*)(kp+512);
  kf[2]=*(const __attribute__((address_space(3))) bf16x8*)(kp+2048); kf[3]=*(const __attribute__((address_space(3))) bf16x8*)(kp+2560);
  kf[4]=*(const __attribute__((address_space(3))) bf16x8*)(kp+4096); kf[5]=*(const __attribute__((address_space(3))) bf16x8*)(kp+4608);
  kf[6]=*(const __attribute__((address_space(3))) bf16x8*)(kp+6144); kf[7]=*(const __attribute__((address_space(3))) bf16x8*)(kp+6656);
}
__device__ __forceinline__ void kload2(bf16x8*kf,lds_cptr kp,int j){ kf[2*j]=*(const __attribute__((address_space(3))) bf16x8*)(kp+j*2048); kf[2*j+1]=*(const __attribute__((address_space(3))) bf16x8*)(kp+j*2048+512); }
__device__ __forceinline__ s16x4 vtr(lds_cptr p){ return __builtin_bit_cast(s16x4,__builtin_amdgcn_ds_read_tr16_b64_v4i16((__attribute__((address_space(3))) v4i16_t*)p)); }
__device__ __forceinline__ float rowmax(const f32x16&p0,const f32x16&p1){
  float a=max3f(p0[0],p0[1],p1[0]),b=max3f(p0[2],p0[3],p1[1]);a=max3f(a,p1[2],p1[3]);
  #pragma unroll
  for(int r=4;r<16;r+=4){a=max3f(a,p0[r],p0[r+1]);b=max3f(b,p0[r+2],p0[r+3]);a=max3f(a,p1[r],p1[r+1]);b=max3f(b,p1[r+2],p1[r+3]);}
  const float m=max2f(a,b);
  auto rr=__builtin_amdgcn_permlane32_swap(__float_as_uint(m),__float_as_uint(m),false,false);
  return max2f(__uint_as_float(rr[0]),__uint_as_float(rr[1]));
}
__device__ __forceinline__ void pv(f32x16*o,int vb,bf16x8 pa0,bf16x8 pa1,bf16x8 pa2,bf16x8 pa3){
  #pragma unroll
  for(int d0=0;d0<2;++d0){s16x4 lo[4],hi[4];
    #pragma unroll
    for(int ks=0;ks<4;++ks){
      asm volatile("ds_read_b64_tr_b16 %0,%1 offset:%c2":"=&v"(lo[ks]):"v"(vb),"i"(d0*4096+ks*1024):"memory");
      asm volatile("ds_read_b64_tr_b16 %0,%1 offset:%c2":"=&v"(hi[ks]):"v"(vb),"i"(d0*4096+ks*1024+512):"memory");}
    asm volatile("s_waitcnt lgkmcnt(0)":::"memory");SBAR();
    #define PK(k) (bf16x8){lo[k][0],lo[k][1],lo[k][2],lo[k][3],hi[k][0],hi[k][1],hi[k][2],hi[k][3]}
    o[d0]=__builtin_amdgcn_mfma_f32_32x32x16_bf16(pa0,PK(0),o[d0],0,0,0);
    o[d0]=__builtin_amdgcn_mfma_f32_32x32x16_bf16(pa1,PK(1),o[d0],0,0,0);
    o[d0]=__builtin_amdgcn_mfma_f32_32x32x16_bf16(pa2,PK(2),o[d0],0,0,0);
    o[d0]=__builtin_amdgcn_mfma_f32_32x32x16_bf16(pa3,PK(3),o[d0],0,0,0);
    #undef PK
  }
}

#ifndef ATTN_STORE16
#define ATTN_STORE16(p,v) (*(u32x4*)(p)=(v))
#endif
template<int THRL> __device__ __forceinline__ void attn_unit(int qb,const bf16*Qh,const bf16*__restrict__ Kh,const bf16*__restrict__ Vh,bf16*Oh,char*shm){
  const int tid=tid_opaque(),lane=tid&63,r32=lane&31,hi=lane>>5; const int wid=__builtin_amdgcn_readfirstlane(tid>>6);
  const int q0=qb*QB;
  const bf16*Qw=Qh+(long)(q0+wid*QBLK)*PQ;
  const unsigned lds0=(unsigned)(uintptr_t)shm;
  float*wsf=(float*)(shm+LDS_WS)+wid*64;
  const bf16*ksrc=Kh+(long)lane*PQ+wid*8;
  const bf16*vsrc=Vh+(long)(16*(wid&3)+(lane>>2))*PQ+(wid>>2)*32+(lane&3)*8;
  const unsigned kdst=lds0+LDS_K+wid*1024, vdst=lds0+LDS_V+wid*1024;
  #define DMA_K(t,slot) glds16(ksrc+(long)(t)*KVBLK*PQ,(unsigned)__builtin_amdgcn_readfirstlane(kdst+(slot)))
  #define DMA_V(t,slot) glds16(vsrc+(long)(t)*KVBLK*PQ,(unsigned)__builtin_amdgcn_readfirstlane(vdst+(slot)))
  const int vb0=(int)(lds0+LDS_V)+((lane>>4)&1)*32+(lane&3)*8+(4*hi+((lane&15)>>2))*64;
  const char*Kbase=shm+LDS_K; bf16x8 kf[8];
  const lds_cptr shm3=(lds_cptr)shm; const lds_cptr kp0=shm3+LDS_K+hi*1024+r32*16; const lds_cptr vp0=shm3+LDS_V+((lane>>4)&1)*32+(lane&3)*8+(4*hi+((lane&15)>>2))*64;
  const int NT=(q0+QB)/KVBLK;
  DMA_K(0,0);DMA_V(0,0);DMA_K(1,SLOTB);
  bf16x8 qr[4];
  #pragma unroll
  for(int d0=0;d0<4;++d0)qr[d0]=*reinterpret_cast<const bf16x8*>(&Qw[(long)r32*PQ+d0*16+hi*8]);
  float mhat=0.f,l_reg=0.f;f32x16 o[2];o[0]=f32x16{};o[1]=f32x16{};f32x16 negm=f32x16{};asm volatile("":"+v"(negm));
  const int qrel=wid*QBLK+r32;
  #define CMASK(P0,P1,t) do{int jb_=(t)-(NT-4); if(jb_>=0)cmask(P0,P1,jb_,qrel,hi);}while(0)
  bool resc=false;
  #define START(P0,P1) do{ const float rm=rowmax(P0,P1); resc=false; \
    { const float dl=rm; mhat=fadd_s(mhat,dl); \
      _Pragma("unroll") for(int r=0;r<16;++r){P0[r]=fsub_s(P0[r],dl);P1[r]=fsub_s(P1[r],dl);} \
      _Pragma("unroll") for(int r=0;r<16;++r)negm[r]=-mhat; asm volatile("":"+v"(negm)); } \
    _Pragma("unroll") for(int r=0;r<16;++r)P0[r]=__builtin_amdgcn_exp2f(P0[r]); }while(0)
  #define RESC() do{ if(resc){ asm volatile("s_waitcnt lgkmcnt(0)":::"memory"); \
      _Pragma("unroll") for(int d_=0;d_<2;++d_) _Pragma("unroll") for(int r=0;r<16;++r)o[d_][r]*=wsf[crow(r,hi)]; } }while(0)
  f32x16 pA0,pA1,pB0,pB1;
  int sl_prev=0,sl_cur=0,sl_next=SLOTB;
  #define ROT() do{sl_prev=sl_cur;sl_cur=sl_next;sl_next=(sl_next==(NSLOT-1)*SLOTB)?0:sl_next+SLOTB;}while(0)
  DMA_K(2,2*SLOTB);
  WAIT_BAR(3);
  qkt(pA0,pA1,Kbase,qr,negm,r32,hi);asm volatile("s_nop 15\n\ts_nop 7":"+v"(pA0),"+v"(pA1));CMASK(pA0,pA1,0);
  START(pA0,pA1);
  _Pragma("unroll") for(int r=0;r<16;++r)pA1[r]=__builtin_amdgcn_exp2f(pA1[r]);
  WAIT_BAR(0);
  DMA_K(3,0);DMA_V(1,SLOTB);
  ROT();
  kload8(kf,kp0+sl_cur);
  WAIT_BAR(2);
  s16x4 vlo[8],vhi[8]; u32x4 pw0,pw1,pw2,pw3;
  #define PKW(P,B) cvtpk_s(P[B],P[B+1])
  #define PAF(k) __builtin_bit_cast(bf16x8,pw##k)
  #define VFR(i) (bf16x8){vlo[i][0],vlo[i][1],vlo[i][2],vlo[i][3],vhi[i][0],vhi[i][1],vhi[i][2],vhi[i][3]}
  #define PIN(x) asm volatile("":"+v"(x))
  #define MX3(a,b,c) __builtin_fmaxf(__builtin_fmaxf((a),(b)),(c))
  #define GAPA(MF,A0,A1,A2,A3,W0,W1,PW) do{ MF; sacc+=A0; sacc+=A1; sacc+=A2; sacc+=A3; PIN(sacc); W0; W1; PIN(PW); SBAR(); }while(0)
  #define EX(v) __builtin_amdgcn_exp2f(v)
  #define GAPB(MF,X,B) do{ MF; X[B]=EX(X[B]); X[B+1]=EX(X[B+1]); X[B+2]=EX(X[B+2]); X[B+3]=EX(X[B+3]); PIN(X); SBAR(); }while(0)
  #define VRD(i) do{ vlo[i]=vtr(vp_+(((i)>>2)*4096+((i)&3)*1024)); vhi[i]=vtr(vp_+(((i)>>2)*4096+((i)&3)*1024+512)); }while(0)
  #define KRD(G,j) do{ if(G){ kload2(kf,kp0+sl_next,j); SBAR(); } }while(0)
  #define STEP(C0,C1,P0,P1,t,GK,GV,GL) do{ SBAR(); \
    const lds_cptr vp_=vp0+sl_prev; \
    VRD(0); SBAR(); float sacc=(P0[0]+P0[1]); \
    GAPA(C0=__builtin_amdgcn_mfma_f32_32x32x16_bf16(kf[0],qr[0],negm,0,0,0), P0[2],P0[3],P0[4],P0[5],     pw0[0]=PKW(P0,0), pw0[1]=PKW(P0,2), pw0); \
    VRD(4); SBAR(); GAPA(C1=__builtin_amdgcn_mfma_f32_32x32x16_bf16(kf[1],qr[0],negm,0,0,0), P0[6],P0[7],P0[8],P0[9],     pw0[2]=PKW(P0,4), pw0[3]=PKW(P0,6), pw0); \
    VRD(1); SBAR(); GAPA(C0=__builtin_amdgcn_mfma_f32_32x32x16_bf16(kf[2],qr[1],C0,0,0,0),   P0[10],P0[11],P0[12],P0[13], pw1[0]=PKW(P0,8), pw1[1]=PKW(P0,10), pw1); \
    VRD(5); SBAR(); GAPA(C1=__builtin_amdgcn_mfma_f32_32x32x16_bf16(kf[3],qr[1],C1,0,0,0),   P0[14],P0[15],P1[0],P1[1],   pw1[2]=PKW(P0,12),pw1[3]=PKW(P0,14), pw1); \
    VRD(2); SBAR(); GAPA(C0=__builtin_amdgcn_mfma_f32_32x32x16_bf16(kf[4],qr[2],C0,0,0,0),   P1[2],P1[3],P1[4],P1[5],     pw2[0]=PKW(P1,0), pw2[1]=PKW(P1,2), pw2); \
    VRD(6); SBAR(); GAPA(C1=__builtin_amdgcn_mfma_f32_32x32x16_bf16(kf[5],qr[2],C1,0,0,0),   P1[6],P1[7],P1[8],P1[9],     pw2[2]=PKW(P1,4), pw2[3]=PKW(P1,6), pw2); \
    VRD(3); SBAR(); GAPA(C0=__builtin_amdgcn_mfma_f32_32x32x16_bf16(kf[6],qr[3],C0,0,0,0),   P1[10],P1[11],P1[12],P1[13], pw3[0]=PKW(P1,8), pw3[1]=PKW(P1,10), pw3); \
    VRD(7); SBAR(); GAPA(C1=__builtin_amdgcn_mfma_f32_32x32x16_bf16(kf[7],qr[3],C1,0,0,0),   P1[14],P1[15],0.f,0.f,       pw3[2]=PKW(P1,12),pw3[3]=PKW(P1,14), pw3); \
    l_reg+=sacc; \
    if(GK){DMA_K((t)+3,sl_cur);} if(GV){DMA_V((t)+1,sl_next);} \
    CMASK(C0,C1,t); \
    { float a=MX3(C0[0],C0[1],C1[0]),b=MX3(C0[2],C0[3],C1[1]); a=MX3(a,C1[2],C1[3]); \
      _Pragma("unroll") for(int r=4;r<16;r+=4){a=MX3(a,C0[r],C0[r+1]);b=MX3(b,C0[r+2],C0[r+3]);a=MX3(a,C1[r],C1[r+1]);b=MX3(b,C1[r+2],C1[r+3]);} \
      float rm=__builtin_fmaxf(a,b); { auto rr=__builtin_amdgcn_permlane32_swap(__float_as_uint(rm),__float_as_uint(rm),false,false); rm=__builtin_fmaxf(__uint_as_float(rr[0]),__uint_as_float(rr[1])); } \
      resc=false; \
      if(__builtin_expect(__any(rm>(float)THRL),0)){ const float dl=__builtin_fmaxf(rm,0.f); mhat+=dl; \
        _Pragma("unroll") for(int r=0;r<16;++r){C0[r]-=dl;C1[r]-=dl;} \
        _Pragma("unroll") for(int r=0;r<16;++r)negm[r]=-mhat; asm volatile("":"+v"(negm)); \
        const float f=__builtin_amdgcn_exp2f(-dl); l_reg*=f; if(hi==0)wsf[r32]=f; resc=true; } } \
    SBAR(); \
    GAPB(o[0]=__builtin_amdgcn_mfma_f32_32x32x16_bf16(PAF(0),VFR(0),o[0],0,0,0), C0,0); \
    GAPB(o[1]=__builtin_amdgcn_mfma_f32_32x32x16_bf16(PAF(0),VFR(4),o[1],0,0,0), C0,4); \
    KRD(GL,0); GAPB(o[0]=__builtin_amdgcn_mfma_f32_32x32x16_bf16(PAF(1),VFR(1),o[0],0,0,0), C0,8); \
    KRD(GL,1); GAPB(o[1]=__builtin_amdgcn_mfma_f32_32x32x16_bf16(PAF(1),VFR(5),o[1],0,0,0), C0,12); \
    KRD(GL,2); GAPB(o[0]=__builtin_amdgcn_mfma_f32_32x32x16_bf16(PAF(2),VFR(2),o[0],0,0,0), C1,0); \
    KRD(GL,3); GAPB(o[1]=__builtin_amdgcn_mfma_f32_32x32x16_bf16(PAF(2),VFR(6),o[1],0,0,0), C1,4); \
    GAPB(o[0]=__builtin_amdgcn_mfma_f32_32x32x16_bf16(PAF(3),VFR(3),o[0],0,0,0), C1,8); \
    GAPB(o[1]=__builtin_amdgcn_mfma_f32_32x32x16_bf16(PAF(3),VFR(7),o[1],0,0,0), C1,12); \
    }while(0)
  int t=1;
  #undef CMASK
  #define CMASK(P0,P1,t) do{}while(0)
  for(;t+5<NT;t+=2){
    STEP(pB0,pB1,pA0,pA1,t,true,true,true);     WAIT_BAR(2); RESC(); ROT();
    STEP(pA0,pA1,pB0,pB1,t+1,true,true,true);   WAIT_BAR(2); RESC(); ROT();
  }
  #undef CMASK
  #define CMASK(P0,P1,t) do{int jb_=(t)-(NT-4); if(jb_>=0)cmask(P0,P1,jb_,qrel,hi);}while(0)
  #define ENDW(tt) do{ if((tt)+3<NT){WAIT_BAR(2);} else if((tt)+2<NT){WAIT_BAR(1);} else {WAIT_BAR(0);} }while(0)
  for(;t+1<NT;t+=2){
    STEP(pB0,pB1,pA0,pA1,t,(t+3<NT),(t+1<NT),(t+1<NT));       ENDW(t);   RESC(); ROT();
    STEP(pA0,pA1,pB0,pB1,t+1,(t+4<NT),(t+2<NT),(t+2<NT));     ENDW(t+1); RESC(); ROT();
  }
  STEP(pB0,pB1,pA0,pA1,NT-1,false,false,false); RESC();
  { float sacc=pB0[0]+pB0[1]; _Pragma("unroll") for(int r=2;r<16;++r)sacc+=pB0[r]; _Pragma("unroll") for(int r=0;r<16;++r)sacc+=pB1[r]; l_reg+=sacc;
    pw0=(u32x4){PKW(pB0,0),PKW(pB0,2),PKW(pB0,4),PKW(pB0,6)};pw1=(u32x4){PKW(pB0,8),PKW(pB0,10),PKW(pB0,12),PKW(pB0,14)};pw2=(u32x4){PKW(pB1,0),PKW(pB1,2),PKW(pB1,4),PKW(pB1,6)};pw3=(u32x4){PKW(pB1,8),PKW(pB1,10),PKW(pB1,12),PKW(pB1,14)};
    SBAR(); pv(o,vb0+sl_cur,PAF(0),PAF(1),PAF(2),PAF(3)); }
  #undef PKW
  #undef PAF
  #undef VFR
  #undef PIN
  #undef MX3
  #undef GAPA
  #undef GAPB
  #undef EX
  #undef VRD
  #undef KRD
  #undef STEP
  #undef ENDW
  {auto rr=__builtin_amdgcn_permlane32_swap(__float_as_uint(l_reg),__float_as_uint(l_reg),false,false);l_reg=__uint_as_float(rr[0])+__uint_as_float(rr[1]);}
  if(hi==0)wsf[32+r32]=l_reg;asm volatile("s_waitcnt lgkmcnt(0)":::"memory");
  float rli[16];
  #pragma unroll
  for(int r=0;r<16;++r)rli[r]=__builtin_amdgcn_rcpf(wsf[32+crow(r,hi)]);
  bf16*Ow=Oh+(long)(q0+wid*QBLK)*PO;
  { bf16*stg=(bf16*)(shm+LDS_OST)+wid*2048;
    #pragma unroll
    for(int r=0;r<16;++r){const int orow=crow(r,hi);
      #pragma unroll
      for(int d0=0;d0<2;++d0)stg[orow*64+d0*32+r32]=__float2bfloat16(o[d0][r]*rli[r]);}
    asm volatile("s_waitcnt lgkmcnt(0)":::"memory");
    #pragma unroll
    for(int i=0;i<4;++i){const int row=i*8+(lane>>3),ch=lane&7; const u32x4 v=*(const u32x4*)(stg+row*64+ch*8); ATTN_STORE16(Ow+(long)row*PO+ch*8,v);} }
  asm volatile("s_waitcnt lgkmcnt(0)\n\ts_barrier":::"memory");
  #undef DMA_K
  #undef DMA_V
  #undef CMASK
  #undef START
  #undef RESC
  #undef ROT
}
constexpr int ATTN_LDS_BYTES=LDS_BYTES;
#undef SBAR
#undef WAIT_BAR
}
namespace attn2 {
using namespace attn_body;
constexpr int KSLOT=8192, VSLOT=16384;
constexpr int L_K=0, L_V=3*KSLOT, L_WS=L_V+3*VSLOT, L_Q=L_WS+NW*64*4, L_END=L_Q+NW*4096;
#define SBAR() __builtin_amdgcn_sched_barrier(0)
#define WAIT_BAR(N) asm volatile("s_waitcnt vmcnt(" #N ") lgkmcnt(0)\n\ts_barrier":::"memory")
__device__ __forceinline__ void pv4(f32x16*o,int vb,bf16x8 pa0,bf16x8 pa1,bf16x8 pa2,bf16x8 pa3){
  #pragma unroll
  for(int d0=0;d0<4;++d0){s16x4 lo[4],hi[4];
    #pragma unroll
    for(int ks=0;ks<4;++ks){
      asm volatile("ds_read_b64_tr_b16 %0,%1 offset:%c2":"=&v"(lo[ks]):"v"(vb),"i"(d0*4096+ks*1024):"memory");
      asm volatile("ds_read_b64_tr_b16 %0,%1 offset:%c2":"=&v"(hi[ks]):"v"(vb),"i"(d0*4096+ks*1024+512):"memory");}
    asm volatile("s_waitcnt lgkmcnt(0)":::"memory");SBAR();
    #define PK(k) (bf16x8){lo[k][0],lo[k][1],lo[k][2],lo[k][3],hi[k][0],hi[k][1],hi[k][2],hi[k][3]}
    o[d0]=__builtin_amdgcn_mfma_f32_32x32x16_bf16(pa0,PK(0),o[d0],0,0,0);
    o[d0]=__builtin_amdgcn_mfma_f32_32x32x16_bf16(pa1,PK(1),o[d0],0,0,0);
    o[d0]=__builtin_amdgcn_mfma_f32_32x32x16_bf16(pa2,PK(2),o[d0],0,0,0);
    o[d0]=__builtin_amdgcn_mfma_f32_32x32x16_bf16(pa3,PK(3),o[d0],0,0,0);
    #undef PK
  }
}
template<int THRL> __device__ __forceinline__ void attn_unit128(int qb,const bf16*Qh,const bf16*__restrict__ Kh,const bf16*__restrict__ Vh,bf16*Oh,char*shm){
  const int tid=tid_opaque(),lane=tid&63,r32=lane&31,hi=lane>>5; const int wid=__builtin_amdgcn_readfirstlane(tid>>6);
  const int q0=qb*QB;
  const bf16*Qw=Qh+(long)(q0+wid*QBLK)*PQ;
  const unsigned lds0=(unsigned)(uintptr_t)shm;
  float*wsf=(float*)(shm+L_WS)+wid*64;
  const bf16*ksrc=Kh+wid*512+lane*8;
  const bf16*vsrc=Vh+wid*512+lane*8;
  const unsigned kdst=lds0+L_K+wid*1024, vdst=lds0+L_V+wid*1024, qdst=lds0+L_Q+wid*4096;
  #define DMA_K(t,slot) glds16(ksrc+(long)(t)*4096,(unsigned)__builtin_amdgcn_readfirstlane(kdst+(slot)))
  #define DMA_V(t,slot) do{ glds16(vsrc+(long)(t)*8192,(unsigned)__builtin_amdgcn_readfirstlane(vdst+2*(slot))); glds16(vsrc+(long)(t)*8192+4096,(unsigned)__builtin_amdgcn_readfirstlane(vdst+2*(slot)+8192)); }while(0)
  const int vb0=(int)(lds0+L_V)+((lane>>4)&1)*32+(lane&3)*8+(4*hi+((lane&15)>>2))*64;
  const char*Kbase=shm+L_K; bf16x8 kf[8];
  const lds_cptr shm3=(lds_cptr)shm; const lds_cptr kp0=shm3+L_K+hi*1024+r32*16; const lds_cptr vp0=shm3+L_V+((lane>>4)&1)*32+(lane&3)*8+(4*hi+((lane&15)>>2))*64;
  const lds_cptr qp=shm3+L_Q+wid*4096+lane*16;
  #define QLD(d) (*(const __attribute__((address_space(3))) bf16x8*)(qp+(d)*1024))
  const int NT=(q0+QB)/KVBLK;
  DMA_K(0,0);DMA_V(0,0);DMA_K(1,KSLOT);
  #pragma unroll
  for(int d0=0;d0<4;++d0)glds16(&Qw[(long)r32*PQ+d0*16+hi*8],(unsigned)__builtin_amdgcn_readfirstlane(qdst+d0*1024));
  float mhat=0.f,l_reg=0.f;f32x16 o[4];o[0]=f32x16{};o[1]=f32x16{};o[2]=f32x16{};o[3]=f32x16{};
  const f32x16 zero16=f32x16{};
  const int qrel=wid*QBLK+r32;
  #define CMASK(P0,P1,t) do{int jb_=(t)-(NT-4); if(jb_>=0)cmask(P0,P1,jb_,qrel,hi);}while(0)
  bool resc=false;
  #define START(P0,P1) do{ const float rm=rowmax(P0,P1); resc=false; \
    { const float dl=rm; mhat=fadd_s(mhat,dl); \
      _Pragma("unroll") for(int r=0;r<16;++r){P0[r]=fsub_s(P0[r],dl);P1[r]=fsub_s(P1[r],dl);} } \
    _Pragma("unroll") for(int r=0;r<16;++r)P0[r]=__builtin_amdgcn_exp2f(P0[r]); }while(0)
  #define RESC() do{ if(resc){ asm volatile("s_waitcnt lgkmcnt(0)":::"memory"); \
      _Pragma("unroll") for(int d_=0;d_<4;++d_) _Pragma("unroll") for(int r=0;r<16;++r)o[d_][r]*=wsf[crow(r,hi)]; } }while(0)
  f32x16 pA0,pA1,pB0,pB1;
  int sl_prev=0,sl_cur=0,sl_next=KSLOT;
  #define ROT() do{sl_prev=sl_cur;sl_cur=sl_next;sl_next=(sl_next==(NSLOT-1)*KSLOT)?0:sl_next+KSLOT;}while(0)
  DMA_K(2,2*KSLOT);
  WAIT_BAR(1);
  { bf16x8 q4[4];
    #pragma unroll
    for(int d0=0;d0<4;++d0)q4[d0]=QLD(d0);
    qkt(pA0,pA1,Kbase,q4,zero16,r32,hi); }
  asm volatile("s_nop 15\n\ts_nop 7":"+v"(pA0),"+v"(pA1));CMASK(pA0,pA1,0);
  START(pA0,pA1);
  _Pragma("unroll") for(int r=0;r<16;++r)pA1[r]=__builtin_amdgcn_exp2f(pA1[r]);
  WAIT_BAR(0);
  DMA_K(3,0);DMA_V(1,KSLOT);
  ROT();
  kload8(kf,kp0+sl_cur);
  WAIT_BAR(3);
  s16x4 vlo[16],vhi[16]; u32x4 pw0,pw1,pw2,pw3;
  #define PKW(P,B) cvtpk_s(P[B],P[B+1])
  #define PAF(k) __builtin_bit_cast(bf16x8,pw##k)
  #define VFR(i) (bf16x8){vlo[i][0],vlo[i][1],vlo[i][2],vlo[i][3],vhi[i][0],vhi[i][1],vhi[i][2],vhi[i][3]}
  #define PIN(x) asm volatile("":"+v"(x))
  #define MX3(a,b,c) __builtin_fmaxf(__builtin_fmaxf((a),(b)),(c))
  #define GAPA(MF,A0,A1,A2,A3,W0,W1,PW) do{ MF; sacc+=A0; sacc+=A1; sacc+=A2; sacc+=A3; PIN(sacc); W0; W1; PIN(PW); SBAR(); }while(0)
  #define EX(v) __builtin_amdgcn_exp2f((v)-mhat)
  #define GAPB(MF,X,B) do{ MF; X[B]=EX(X[B]); X[B+1]=EX(X[B+1]); PIN(X); SBAR(); }while(0)
  #define VRD(i) do{ vlo[i]=vtr(vp_+(((i)>>2)*4096+((i)&3)*1024)); vhi[i]=vtr(vp_+(((i)>>2)*4096+((i)&3)*1024+512)); }while(0)
  #define KRD(G,j) do{ if(G){ kload2(kf,kp0+sl_next,j); SBAR(); } }while(0)
  #define PVM(d,ks) o[d]=__builtin_amdgcn_mfma_f32_32x32x16_bf16(PAF(ks),VFR((d)*4+(ks)),o[d],0,0,0)
  #define STEP(C0,C1,P0,P1,t,GK,GV,GL) do{ SBAR(); \
    const lds_cptr vp_=vp0+2*sl_prev; \
    const bf16x8 q0_=QLD(0),q1_=QLD(1),q2_=QLD(2),q3_=QLD(3); \
    VRD(0); SBAR(); float sacc=(P0[0]+P0[1]); \
    GAPA(C0=__builtin_amdgcn_mfma_f32_32x32x16_bf16(kf[0],q0_,zero16,0,0,0), P0[2],P0[3],P0[4],P0[5],     pw0[0]=PKW(P0,0), pw0[1]=PKW(P0,2), pw0); \
    VRD(4); SBAR(); GAPA(C1=__builtin_amdgcn_mfma_f32_32x32x16_bf16(kf[1],q0_,zero16,0,0,0), P0[6],P0[7],P0[8],P0[9],     pw0[2]=PKW(P0,4), pw0[3]=PKW(P0,6), pw0); \
    VRD(8); SBAR(); GAPA(C0=__builtin_amdgcn_mfma_f32_32x32x16_bf16(kf[2],q1_,C0,0,0,0),   P0[10],P0[11],P0[12],P0[13], pw1[0]=PKW(P0,8), pw1[1]=PKW(P0,10), pw1); \
    VRD(12); SBAR(); GAPA(C1=__builtin_amdgcn_mfma_f32_32x32x16_bf16(kf[3],q1_,C1,0,0,0),   P0[14],P0[15],P1[0],P1[1],   pw1[2]=PKW(P0,12),pw1[3]=PKW(P0,14), pw1); \
    VRD(1); SBAR(); GAPA(C0=__builtin_amdgcn_mfma_f32_32x32x16_bf16(kf[4],q2_,C0,0,0,0),   P1[2],P1[3],P1[4],P1[5],     pw2[0]=PKW(P1,0), pw2[1]=PKW(P1,2), pw2); \
    VRD(5); SBAR(); GAPA(C1=__builtin_amdgcn_mfma_f32_32x32x16_bf16(kf[5],q2_,C1,0,0,0),   P1[6],P1[7],P1[8],P1[9],     pw2[2]=PKW(P1,4), pw2[3]=PKW(P1,6), pw2); \
    VRD(9); SBAR(); GAPA(C0=__builtin_amdgcn_mfma_f32_32x32x16_bf16(kf[6],q3_,C0,0,0,0),   P1[10],P1[11],P1[12],P1[13], pw3[0]=PKW(P1,8), pw3[1]=PKW(P1,10), pw3); \
    VRD(13); SBAR(); GAPA(C1=__builtin_amdgcn_mfma_f32_32x32x16_bf16(kf[7],q3_,C1,0,0,0),   P1[14],P1[15],0.f,0.f,       pw3[2]=PKW(P1,12),pw3[3]=PKW(P1,14), pw3); \
    l_reg+=sacc; \
    if(GK){DMA_K((t)+3,sl_cur);} if(GV){DMA_V((t)+1,sl_next);} \
    CMASK(C0,C1,t); \
    { float a=MX3(C0[0],C0[1],C1[0]),b=MX3(C0[2],C0[3],C1[1]); a=MX3(a,C1[2],C1[3]); \
      _Pragma("unroll") for(int r=4;r<16;r+=4){a=MX3(a,C0[r],C0[r+1]);b=MX3(b,C0[r+2],C0[r+3]);a=MX3(a,C1[r],C1[r+1]);b=MX3(b,C1[r+2],C1[r+3]);} \
      float rm=__builtin_fmaxf(a,b); { auto rr=__builtin_amdgcn_permlane32_swap(__float_as_uint(rm),__float_as_uint(rm),false,false); rm=__builtin_fmaxf(__uint_as_float(rr[0]),__uint_as_float(rr[1])); } \
      rm-=mhat; resc=false; \
      if(__builtin_expect(__any(rm>(float)THRL),0)){ const float dl=__builtin_fmaxf(rm,0.f); mhat+=dl; \
        const float f=__builtin_amdgcn_exp2f(-dl); l_reg*=f; if(hi==0)wsf[r32]=f; resc=true; } } \
    SBAR(); \
    GAPB(PVM(0,0), C0,0);  VRD(2);  SBAR(); \
    GAPB(PVM(1,0), C0,2);  VRD(6);  SBAR(); \
    GAPB(PVM(2,0), C0,4);  VRD(10); SBAR(); \
    GAPB(PVM(3,0), C0,6);  VRD(14); SBAR(); \
    GAPB(PVM(0,1), C0,8);  VRD(3);  SBAR(); \
    GAPB(PVM(1,1), C0,10); VRD(7);  SBAR(); \
    GAPB(PVM(2,1), C0,12); VRD(11); SBAR(); \
    GAPB(PVM(3,1), C0,14); VRD(15); SBAR(); \
    KRD(GL,0); GAPB(PVM(0,2), C1,0); \
    GAPB(PVM(1,2), C1,2); \
    KRD(GL,1); GAPB(PVM(2,2), C1,4); \
    GAPB(PVM(3,2), C1,6); \
    KRD(GL,2); GAPB(PVM(0,3), C1,8); \
    GAPB(PVM(1,3), C1,10); \
    KRD(GL,3); GAPB(PVM(2,3), C1,12); \
    GAPB(PVM(3,3), C1,14); \
    }while(0)
  int t=1;
  #undef CMASK
  #define CMASK(P0,P1,t) do{}while(0)
  for(;t+5<NT;t+=2){
    STEP(pB0,pB1,pA0,pA1,t,true,true,true);     WAIT_BAR(3); RESC(); ROT();
    STEP(pA0,pA1,pB0,pB1,t+1,true,true,true);   WAIT_BAR(3); RESC(); ROT();
  }
  #undef CMASK
  #define CMASK(P0,P1,t) do{int jb_=(t)-(NT-4); if(jb_>=0)cmask(P0,P1,jb_,qrel,hi);}while(0)
  #define ENDW(tt) do{ if((tt)+3<NT){WAIT_BAR(3);} else if((tt)+2<NT){WAIT_BAR(2);} else {WAIT_BAR(0);} }while(0)
  for(;t+1<NT;t+=2){
    STEP(pB0,pB1,pA0,pA1,t,(t+3<NT),(t+1<NT),(t+1<NT));       ENDW(t);   RESC(); ROT();
    STEP(pA0,pA1,pB0,pB1,t+1,(t+4<NT),(t+2<NT),(t+2<NT));     ENDW(t+1); RESC(); ROT();
  }
  STEP(pB0,pB1,pA0,pA1,NT-1,false,false,false); RESC();
  { float sacc=pB0[0]+pB0[1]; _Pragma("unroll") for(int r=2;r<16;++r)sacc+=pB0[r]; _Pragma("unroll") for(int r=0;r<16;++r)sacc+=pB1[r]; l_reg+=sacc;
    pw0=(u32x4){PKW(pB0,0),PKW(pB0,2),PKW(pB0,4),PKW(pB0,6)};pw1=(u32x4){PKW(pB0,8),PKW(pB0,10),PKW(pB0,12),PKW(pB0,14)};pw2=(u32x4){PKW(pB1,0),PKW(pB1,2),PKW(pB1,4),PKW(pB1,6)};pw3=(u32x4){PKW(pB1,8),PKW(pB1,10),PKW(pB1,12),PKW(pB1,14)};
    SBAR(); pv4(o,vb0+2*sl_cur,PAF(0),PAF(1),PAF(2),PAF(3)); }
  #undef PKW
  #undef PAF
  #undef VFR
  #undef PIN
  #undef MX3
  #undef GAPA
  #undef GAPB
  #undef EX
  #undef VRD
  #undef KRD
  #undef PVM
  #undef STEP
  #undef ENDW
  {auto rr=__builtin_amdgcn_permlane32_swap(__float_as_uint(l_reg),__float_as_uint(l_reg),false,false);l_reg=__uint_as_float(rr[0])+__uint_as_float(rr[1]);}
  if(hi==0)wsf[32+r32]=l_reg;asm volatile("s_waitcnt lgkmcnt(0)":::"memory");
  float rli[16];
  #pragma unroll
  for(int r=0;r<16;++r)rli[r]=__builtin_amdgcn_rcpf(wsf[32+crow(r,hi)]);
  bf16*Ow=Oh+(long)(q0+wid*QBLK)*PO;
  { bf16*stg=(bf16*)(shm+L_Q)+wid*2048;
    #pragma unroll
    for(int hf=0;hf<2;++hf){
      #pragma unroll
      for(int r=0;r<16;++r){const int orow=crow(r,hi);
        #pragma unroll
        for(int d0=0;d0<2;++d0)stg[orow*64+d0*32+r32]=__float2bfloat16(o[2*hf+d0][r]*rli[r]);}
      asm volatile("s_waitcnt lgkmcnt(0)":::"memory");
      #pragma unroll
      for(int i=0;i<4;++i){const int row=i*8+(lane>>3),ch=lane&7; const u32x4 v=*(const u32x4*)(stg+row*64+ch*8); ATTN_STORE16(Ow+(long)row*PO+hf*64+ch*8,v);}
      asm volatile("s_waitcnt lgkmcnt(0)":::"memory"); } }
  asm volatile("s_waitcnt lgkmcnt(0)\n\ts_barrier":::"memory");
  #undef DMA_K
  #undef DMA_V
  #undef QLD
  #undef CMASK
  #undef START
  #undef RESC
  #undef ROT
}
#undef SBAR
#undef WAIT_BAR
}
#include <hip/hip_cooperative_groups.h>
namespace cg = cooperative_groups;
constexpr int NWAVES = 8;
constexpr int BATCH = 16, SEQ = 2048, D = 1024, DEPTH = 4, FF = 4096, PLE = 256, INW = 2560, AW = 512, RW = 512;
constexpr int M = BATCH * SEQ;
constexpr size_t MiB = 1u << 20;
constexpr size_t WS_CS = 1 * MiB;
constexpr size_t WS_SSQ0 = 3 * MiB, WS_SSQ1 = 5 * MiB;
constexpr size_t WS_W = 8 * MiB, W_LAYER = 25 * MiB + 512 * 1024;
constexpr size_t WO_IN = 0, WO_OUT = 5 * MiB, WO_W1 = 7 * MiB, WO_W2 = 15 * MiB, WO_PG = 23 * MiB, WO_PP = 25 * MiB;
constexpr size_t WS_P16 = 110 * MiB;
constexpr size_t WS_XB0 = 126 * MiB;
constexpr size_t WS_R = 190 * MiB;
constexpr size_t WS_PROJ = WS_R;
constexpr size_t WS_OV = WS_R + 160 * MiB;
constexpr size_t WS_AO = WS_R + 224 * MiB;
constexpr size_t WS_HB = WS_R;
constexpr size_t WS_XBF = WS_R + 64 * MiB;
constexpr size_t WS_PP = WS_R;
constexpr size_t WS_END = WS_R + 288 * MiB;
static_assert(WS_W + DEPTH * W_LAYER <= WS_P16 && WS_P16 + (size_t)M * PLE * 2 <= WS_XB0 && WS_XB0 + (size_t)M * D * 2 <= WS_R && WS_HB + (size_t)M * FF * 2 <= WS_END, "d_ws map");
constexpr int RING_BYTES = 131072;
constexpr int LDS_BYTES = 147456;

#define GAS __attribute__((address_space(1)))
#define LAS __attribute__((address_space(3)))
typedef unsigned short bf16;
typedef unsigned v4u __attribute__((ext_vector_type(4)));
typedef float f32x4 __attribute__((ext_vector_type(4)));
typedef short bf16x8 __attribute__((ext_vector_type(8)));
#define LDS_WAIT() asm volatile("s_waitcnt lgkmcnt(0)" ::: "memory")
#define VM_WAIT() asm volatile("s_waitcnt vmcnt(0)" ::: "memory")
__device__ __forceinline__ unsigned f2bf(float f) { unsigned u = __builtin_bit_cast(unsigned, f); return (u + 0x7fffu + ((u >> 16) & 1u)) >> 16; }
__device__ __forceinline__ unsigned pk2(float lo, float hi) { unsigned r; asm("v_cvt_pk_bf16_f32 %0, %1, %2" : "=v"(r) : "v"(lo), "v"(hi)); return r; }
__device__ __forceinline__ float bf2f(unsigned short v) { return __uint_as_float((unsigned)v << 16); }
__device__ __forceinline__ float sigmoid_f(float x) { return __builtin_amdgcn_rcpf(1.f + __builtin_amdgcn_exp2f(-1.4426950408889634f * x)); }

typedef GAS unsigned gu32;
#define RLX_AGENT __ATOMIC_RELAXED, __HIP_MEMORY_SCOPE_AGENT
#define XB_TMO      128
#define XB_XCNT(j)  (256  + 64 * (j))
#define XB_XSUB(j)  (1280 + 64 * (j))
#define XB_XGEN(j)  (2304 + 64 * (j))
#define XB_TOP      3328
#define XB_TOPGEN   3392
#define XCD_BAR_WORDS 3456
#define XB_SPIN_CAP (1u << 18)

__device__ __forceinline__ unsigned xb_ld(unsigned* p)              { return __hip_atomic_load(p, __ATOMIC_RELAXED, __HIP_MEMORY_SCOPE_AGENT); }
__device__ __forceinline__ unsigned xb_add(unsigned* p, unsigned v) { return __hip_atomic_fetch_add(p, v, __ATOMIC_RELAXED, __HIP_MEMORY_SCOPE_AGENT); }
__device__ __forceinline__ unsigned xb_xcc_id() { return (unsigned)__builtin_amdgcn_s_getreg((3 << 11) | 20) & 0xFu; }
#define XB_SPIN(cond, bar) do { unsigned _sp = 0; while (cond) { __builtin_amdgcn_s_sleep(1); \
    if ((++_sp & 255u) == 0u) { if (xb_ld(&(bar)[XB_TMO])) break; if (_sp > XB_SPIN_CAP) { atomicAdd(&(bar)[XB_TMO], 1u); break; } } } } while (0)

struct XcdBarrier {
    unsigned* bar; unsigned x;
    volatile LAS unsigned* st;
};

__device__ __forceinline__ XcdBarrier xcd_barrier_post(unsigned* bar, volatile LAS unsigned* st) {
    XcdBarrier b; b.bar = bar; b.x = xb_xcc_id(); b.st = st;
    if (threadIdx.x == 0) st[4] = xb_add(&bar[XB_XCNT(b.x)], 1u);
    return b;
}
__device__ __forceinline__ void xcd_barrier_complete(unsigned* bar, unsigned x, unsigned& nloc, unsigned& nx) {
    const unsigned G = gridDim.x * gridDim.y * gridDim.z;
    unsigned sum, cnt, mine, sp = 0u;
    for (;;) {
        sum = 0u; cnt = 0u; mine = 0u;
#pragma unroll
        for (unsigned j = 0; j < 16; ++j) { const unsigned c = xb_ld(&bar[XB_XCNT(j)]); sum += c; cnt += (c > 0u) ? 1u : 0u; mine = (j == x) ? c : mine; }
        if (sum == G) break;
        __builtin_amdgcn_s_sleep(1);
        if ((++sp & 255u) == 0u) { if (xb_ld(&bar[XB_TMO])) break; if (sp > XB_SPIN_CAP) { atomicAdd(&bar[XB_TMO], 1u); break; } }
    }
    nloc = mine > 0u ? mine : 1u; nx = cnt > 0u ? cnt : 1u;
}

__device__ __forceinline__ void xcd_barrier(const XcdBarrier& b) {
    asm volatile("s_waitcnt vmcnt(0)" ::: "memory");
    __syncthreads();
    if (threadIdx.x == 0) {
        unsigned* bar = b.bar;
        __builtin_amdgcn_s_waitcnt(0);
        unsigned nloc = b.st[0], nx = b.st[1];
        if (nloc == 0u) { xcd_barrier_complete(bar, b.x, nloc, nx); b.st[0] = nloc; b.st[1] = nx; }
        const unsigned old = xb_add(&bar[XB_XSUB(b.x)], 1u);
        const unsigned gen = old / nloc;
        if (old + 1u == (gen + 1u) * nloc) {
            __builtin_amdgcn_fence(__ATOMIC_RELEASE, "agent");
            asm volatile("s_waitcnt vmcnt(0)" ::: "memory");
            const unsigned og = xb_add(&bar[XB_TOP], 1u);
            const unsigned tg = og / nx;
            if (og + 1u == (tg + 1u) * nx) xb_add(&bar[XB_TOPGEN], 1u);
            else XB_SPIN(xb_ld(&bar[XB_TOPGEN]) == tg, bar);
            __builtin_amdgcn_fence(__ATOMIC_ACQUIRE, "agent");
            xb_add(&bar[XB_XGEN(b.x)], 1u);
            asm volatile("s_waitcnt vmcnt(0)" ::: "memory");
        } else {
            XB_SPIN(xb_ld(&bar[XB_XGEN(b.x)]) == gen, bar);
            __builtin_amdgcn_fence(__ATOMIC_ACQUIRE, "agent");
            asm volatile("s_waitcnt vmcnt(0)" ::: "memory");
        }
    }
    __syncthreads();
}
template <class BG> __device__ __forceinline__ void xcd_barrier_bg(const XcdBarrier& b, const BG& bgwork) {
    asm volatile("s_waitcnt vmcnt(0)" ::: "memory");
    __syncthreads();
    if (threadIdx.x == 0) {
        unsigned* bar = b.bar;
        __builtin_amdgcn_s_waitcnt(0);
        unsigned nloc = b.st[0], nx = b.st[1];
        if (nloc == 0u) { xcd_barrier_complete(bar, b.x, nloc, nx); b.st[0] = nloc; b.st[1] = nx; }
        const unsigned old = xb_add(&bar[XB_XSUB(b.x)], 1u);
        const unsigned gen = old / nloc;
        if (old + 1u == (gen + 1u) * nloc) {
            __builtin_amdgcn_fence(__ATOMIC_RELEASE, "agent");
            asm volatile("s_waitcnt vmcnt(0)" ::: "memory");
            const unsigned og = xb_add(&bar[XB_TOP], 1u);
            const unsigned tg = og / nx;
            if (og + 1u == (tg + 1u) * nx) xb_add(&bar[XB_TOPGEN], 1u);
            else XB_SPIN(xb_ld(&bar[XB_TOPGEN]) == tg, bar);
            __builtin_amdgcn_fence(__ATOMIC_ACQUIRE, "agent");
            xb_add(&bar[XB_XGEN(b.x)], 1u);
            asm volatile("s_waitcnt vmcnt(0)" ::: "memory");
        } else {
            XB_SPIN(xb_ld(&bar[XB_XGEN(b.x)]) == gen, bar);
            __builtin_amdgcn_fence(__ATOMIC_ACQUIRE, "agent");
            asm volatile("s_waitcnt vmcnt(0)" ::: "memory");
        }
    }
    if (threadIdx.x >= 64) bgwork();
    __syncthreads();
}
template <class BG> __device__ __forceinline__ void xcd_barrier_local_bg(const XcdBarrier& b, const BG& bgwork, bool with_bg) {
    asm volatile("s_waitcnt vmcnt(0)" ::: "memory");
    __syncthreads();
    if (threadIdx.x == 0) {
        unsigned* bar = b.bar;
        __builtin_amdgcn_s_waitcnt(0);
        const unsigned nloc = b.st[0];
        const unsigned old = xb_add(&bar[XB_XSUB(b.x)], 1u);
        const unsigned gen = old / nloc;
        if (old + 1u == (gen + 1u) * nloc) xb_add(&bar[XB_XGEN(b.x)], 1u);
        else XB_SPIN(xb_ld(&bar[XB_XGEN(b.x)]) == gen, bar);
        __builtin_amdgcn_fence(__ATOMIC_ACQUIRE, "agent");
        asm volatile("s_waitcnt vmcnt(0)" ::: "memory");
    }
    if (with_bg && threadIdx.x >= 64) bgwork();
    __syncthreads();
}

struct Frame {
    LAS unsigned char* lds;
    LAS const unsigned long long* tab;
};
struct Who { int tid, lane, wave, vcu, G, bx, local; };
constexpr int LDSW_OFF = 131072 + 2048;
__device__ __forceinline__ Who who() { Who w; w.tid = tid_opaque(); w.lane = w.tid & 63; w.wave = __builtin_amdgcn_readfirstlane(w.tid >> 6);
    extern __shared__ __attribute__((aligned(16))) unsigned char lds_who_[];
    volatile LAS unsigned* cw = (volatile LAS unsigned*)((LAS unsigned char*)lds_who_ + LDSW_OFF);
    int bx = __builtin_amdgcn_readfirstlane((int)cw[2]), lc = __builtin_amdgcn_readfirstlane((int)cw[3]), G = gridDim.x; asm volatile("" : "+s"(bx), "+s"(G), "+s"(lc));
    w.G = G; w.bx = bx; w.local = lc; w.vcu = (G % 8 == 0) ? (bx % 8) * (G / 8) + bx / 8 : bx; return w; }
__device__ __forceinline__ int opaque_s(int v) { asm volatile("" : "+s"(v)); return v; }
__device__ __forceinline__ const void* ptab(LAS const unsigned long long* tab, int k) {
    const unsigned long long v = tab[k]; const unsigned lo = __builtin_amdgcn_readfirstlane((unsigned)v), hi = __builtin_amdgcn_readfirstlane((unsigned)(v >> 32));
    GAS const char* g = (GAS const char*)(((unsigned long long)hi << 32) | lo);
    return (const void*)g;
}
#define FIN(k) ((const float*)ptab(F.tab, (k)))
#define FOUT() ((float*)ptab(F.tab, 23))
#define FWS(off) ((unsigned char*)ptab(F.tab, 24) + (off))
enum { I_X = 0, I_P, I_POS, I_WIN, I_WOUT, I_GMIX, I_GSUBLN, I_LAMQ, I_LAMK, I_CONVW, I_CONVB, I_WGA, I_BGA, I_WGX, I_BGX, I_LRULAM, I_GMLP, I_WMLPIN, I_WMLPOUT, I_GPLE, I_WPLEGATE, I_WPLEPROJ, I_GFINAL };
enum { RB_PROJ, RB_OV, RB_AO, RB_HB, RB_PP, RB_XBF };
#define RBUF(which) ((bf16*)rbuf_(FWS(0), W.local, W.bx, (which)))
__device__ __forceinline__ unsigned char* rbuf_(unsigned char* ws, int local, int bx, int which) {
    const size_t pitchB = (which == RB_PROJ) ? (size_t)INW * 2 : (which == RB_HB) ? (size_t)FF * 2 : (size_t)D * 2;
    if (!local) return ws + (which == RB_PROJ ? WS_PROJ : which == RB_OV ? WS_OV : which == RB_AO ? WS_AO : which == RB_HB ? WS_HB : which == RB_PP ? WS_PP : WS_XBF);
    const size_t x = (size_t)(bx % 8), off = (which == RB_OV) ? 20 * MiB : (which == RB_AO) ? 28 * MiB : (which == RB_XBF) ? 8 * MiB : 0;
    return ws + WS_R + x * (36 * MiB) + off - x * (size_t)(M / 8) * pitchB;
}

__device__ __forceinline__ float wave_sum(float v) {
#pragma unroll
    for (int o = 1; o < 64; o <<= 1) v += __shfl_xor(v, o);
    return v;
}
__device__ __forceinline__ void p0_transpose_item(const float* W, const float* gain, int K, int N, bf16* WT, LAS float* scr, int item, int lane) {
    const int nblk = N / 32, kb = item / nblk, nb = item % nblk, k0 = 64 * kb, n0 = 32 * nb;
    const int c = lane & 7;
    float v[32];
#pragma unroll
    for (int i = 0; i < 32; ++i) v[i] = __builtin_nontemporal_load(&W[(size_t)(k0 + 2 * i + (lane >> 5)) * N + n0 + (lane & 31)]);
    f32x4 ga = {1.f, 1.f, 1.f, 1.f}, gb = ga;
    if (gain) { ga = *(const f32x4*)(gain + k0 + 8 * c); gb = *(const f32x4*)(gain + k0 + 8 * c + 4); }
#pragma unroll
    for (int i = 0; i < 32; ++i) scr[(2 * i + (lane >> 5)) * 33 + (lane & 31)] = v[i];
    LDS_WAIT(); asm volatile("" ::: "memory");
#pragma unroll
    for (int j = 0; j < 4; ++j) { const int n = (lane >> 3) + 8 * j; const LAS float* s = scr + (8 * c) * 33 + n;
        v4u o; o.x = pk2(s[0 * 33] * ga.x, s[1 * 33] * ga.y); o.y = pk2(s[2 * 33] * ga.z, s[3 * 33] * ga.w); o.z = pk2(s[4 * 33] * gb.x, s[5 * 33] * gb.y); o.w = pk2(s[6 * 33] * gb.z, s[7 * 33] * gb.w);
        *(GAS v4u*)(WT + (size_t)(n0 + n) * K + k0 + 8 * c) = o; }
    LDS_WAIT(); asm volatile("" ::: "memory");
}
__device__ __forceinline__ void p0_prologue(Frame& F) {
    const Who W = who();
    LAS float* scr = (LAS float*)(F.lds + W.wave * 16384);
    const int gw = W.vcu * NWAVES + W.wave, NGW = W.G * NWAVES;
    unsigned char* ws = FWS(0);
    const float *w_in = FIN(I_WIN), *w_out = FIN(I_WOUT), *w_mlp_in = FIN(I_WMLPIN), *w_mlp_out = FIN(I_WMLPOUT), *w_ple_gate = FIN(I_WPLEGATE), *w_ple_proj = FIN(I_WPLEPROJ), *g_mix = FIN(I_GMIX), *g_mlp = FIN(I_GMLP), *g_ple = FIN(I_GPLE);
    constexpr int I_IN = (D / 64) * (INW / 32), I_OUT = (D / 64) * (D / 32), I_1 = (D / 64) * (FF / 32), I_2 = (FF / 64) * (D / 32), I_PG = I_OUT, I_PP = (PLE / 64) * (D / 32);
    constexpr int PER_L = I_IN + I_OUT + I_1 + I_2 + I_PG + I_PP;
    for (int it = gw; it < DEPTH * PER_L; it += NGW) {
        const int l = it / PER_L; int r = it % PER_L; bf16* wl = (bf16*)(ws + WS_W + (size_t)l * W_LAYER);
        if (r < I_IN) { p0_transpose_item(w_in + (size_t)l * D * INW, g_mix + l * D, D, INW, (bf16*)((unsigned char*)wl + WO_IN), scr, r, W.lane); continue; } r -= I_IN;
        if (r < I_OUT) { p0_transpose_item(w_out + (size_t)l * D * D, nullptr, D, D, (bf16*)((unsigned char*)wl + WO_OUT), scr, r, W.lane); continue; } r -= I_OUT;
        if (r < I_1) { p0_transpose_item(w_mlp_in + (size_t)l * D * FF, g_mlp + l * D, D, FF, (bf16*)((unsigned char*)wl + WO_W1), scr, r, W.lane); continue; } r -= I_1;
        if (r < I_2) { p0_transpose_item(w_mlp_out + (size_t)l * FF * D, nullptr, FF, D, (bf16*)((unsigned char*)wl + WO_W2), scr, r, W.lane); continue; } r -= I_2;
        if (r < I_PG) { p0_transpose_item(w_ple_gate + (size_t)l * D * D, g_ple + l * D, D, D, (bf16*)((unsigned char*)wl + WO_PG), scr, r, W.lane); continue; } r -= I_PG;
        p0_transpose_item(w_ple_proj + (size_t)l * PLE * D, nullptr, PLE, D, (bf16*)((unsigned char*)wl + WO_PP), scr, r, W.lane);
    }
    const float* x_ = FIN(I_X); bf16* XB1_ = (bf16*)FOUT(); float* SSQ1_ = (float*)(ws + WS_SSQ1); float* CS_ = (float*)(ws + WS_CS); const int* pos_ = (const int*)FIN(I_POS);
#pragma unroll 4
    for (int m = gw; m < M; m += NGW) {
        const GAS f32x4* xr = (const GAS f32x4*)(x_ + (size_t)m * D) + W.lane;
        GAS unsigned long long* o8 = (GAS unsigned long long*)(XB1_ + (size_t)m * D) + W.lane; float s = 0.f;
#pragma unroll
        for (int j = 0; j < 4; ++j) { const f32x4 v = __builtin_nontemporal_load(&xr[64 * j]); s += (v.x * v.x + v.y * v.y) + (v.z * v.z + v.w * v.w);
            o8[64 * j] = (unsigned long long)pk2(v.x, v.y) | ((unsigned long long)pk2(v.z, v.w) << 32); }
        s = wave_sum(s);
        if (W.lane < 16) SSQ1_[(size_t)m * 16 + W.lane] = (W.lane == 0) ? s : 0.f;
    }
}
__device__ __forceinline__ void convert_p_slice(Frame& F, int l, int slice) {
    const Who W = who();
    const float* src = FIN(I_P) + (size_t)l * M * PLE; bf16* P16_ = (bf16*)FWS(WS_P16);
    const size_t NV = W.local ? (size_t)(M / 8) * PLE / 8 : (size_t)M * PLE / 8, base = W.local ? (size_t)(W.bx % 8) * NV : 0;
    const size_t PER = (NV + 2) / 3, lo = (size_t)slice * PER, hi = (lo + PER < NV) ? lo + PER : NV;
    const size_t nthr = (W.local ? (size_t)(W.G / 8) : (size_t)W.G) * (NWAVES - 1) * 64, me = (W.local ? (size_t)(W.bx / 8) : (size_t)W.bx) * (NWAVES - 1) * 64 + (W.tid - 64);
#pragma unroll 4
    for (size_t e = lo + me; e < hi; e += nthr) {
        const f32x4 a = __builtin_nontemporal_load((const GAS f32x4*)(src + (base + e) * 8)), b = __builtin_nontemporal_load((const GAS f32x4*)(src + (base + e) * 8 + 4));
        v4u o; o.x = pk2(a.x, a.y); o.y = pk2(a.z, a.w); o.z = pk2(b.x, b.y); o.w = pk2(b.z, b.w);
        *(GAS v4u*)(P16_ + (base + e) * 8) = o; }
}
struct BgConvert { Frame F; int l, slice; __device__ __forceinline__ void operator()() const { Frame f = F; convert_p_slice(f, l, slice); } };
__device__ __forceinline__ void final_norm(Frame& F) {
    const Who W = who();
    const int NGW = (W.local ? W.G / 8 : W.G) * NWAVES, gw = (W.local ? W.bx / 8 : W.bx) * NWAVES + W.wave, m0 = W.local ? (W.bx % 8) * (M / 8) : 0, m1 = W.local ? m0 + M / 8 : M;
    const float* SSQ1_ = (const float*)FWS(WS_SSQ1); float* O_ = FOUT(); const float* gf_ = FIN(I_GFINAL); const bf16* XBF_ = RBUF(RB_XBF);
#pragma unroll 4
    for (int m = m0 + gw; m < m1; m += NGW) {
        const float rs = pg8::row_rs(SSQ1_, m);
        const GAS unsigned long long* hr = (const GAS unsigned long long*)(XBF_ + (size_t)m * D) + W.lane; GAS f32x4* orow = (GAS f32x4*)(O_ + (size_t)m * D) + W.lane; const GAS f32x4* gr = (const GAS f32x4*)gf_ + W.lane;
#pragma unroll
        for (int j = 0; j < 4; ++j) { const unsigned long long w8 = __builtin_nontemporal_load(&hr[64 * j]); const unsigned lo = (unsigned)w8, hi = (unsigned)(w8 >> 32); const f32x4 g = gr[64 * j];
            const f32x4 v = {pg8::bf_lo(lo), pg8::bf_hi(lo), pg8::bf_lo(hi), pg8::bf_hi(hi)}; __builtin_nontemporal_store(v * rs * g, &orow[64 * j]); }
    }
}

__device__ __forceinline__ void lru_item(Frame& F, int l, int item) {
    const int b = item >> 4, g = (item >> 1) & 7, hf = item & 1;
    const int tid_ = tid_opaque(), lane = tid_ & 63, w = __builtin_amdgcn_readfirstlane(tid_ >> 6), r = lane & 15, q = lane >> 4;
    LAS float* xcs = (LAS float*)(F.lds + w * 4352);
    LAS float* car = (LAS float*)(F.lds + 36864);
    const Who W = who();
    const bf16* pj = RBUF(RB_PROJ) + (size_t)b * SEQ * INW;
    bf16* ao = RBUF(RB_AO) + (size_t)b * SEQ * D;
    v4u* lb = (v4u*)FWS(WS_XB0) + ((size_t)item * NWAVES + w) * (16 * 2 * 64) + lane;
    const int t0 = w * 256;
    const bf16* gcol = pj + 3 * AW + RW + g * 64 + hf * 32 + r;
    bf16* ycol = ao + AW + g * 64 + hf * 32 + r;
    float hin[2] = {0.f, 0.f};
    {
        const int cch = g * 64 + lane;
        const float* conv_w = FIN(I_CONVW);
        const float cw0 = conv_w[(l * 4 + 0) * RW + cch], cw1 = conv_w[(l * 4 + 1) * RW + cch], cw2 = conv_w[(l * 4 + 2) * RW + cch], cw3 = conv_w[(l * 4 + 3) * RW + cch], cb = FIN(I_CONVB)[l * RW + cch];
        bf16x8 Bf[2][2][2];
#pragma unroll
        for (int gate = 0; gate < 2; ++gate) { const float* W = (gate ? FIN(I_WGX) : FIN(I_WGA)) + (size_t)(l * 8 + g) * 64 * 64;
#pragma unroll
            for (int n = 0; n < 2; ++n)
#pragma unroll
                for (int kk = 0; kk < 2; ++kk) { const float* wp = W + (size_t)(32 * kk + 8 * q) * 64 + hf * 32 + 16 * n + r; v4u pw;
                    pw.x = pk2(wp[0 * 64], wp[1 * 64]); pw.y = pk2(wp[2 * 64], wp[3 * 64]); pw.z = pk2(wp[4 * 64], wp[5 * 64]); pw.w = pk2(wp[6 * 64], wp[7 * 64]);
                    Bf[gate][n][kk] = __builtin_bit_cast(bf16x8, pw); } }
        float ba[2], bx[2], sp8[2];
#pragma unroll
        for (int n = 0; n < 2; ++n) { const int ch = l * RW + g * 64 + hf * 32 + 16 * n + r; ba[n] = FIN(I_BGA)[ch]; bx[n] = FIN(I_BGX)[ch];
            const float z = -FIN(I_LRULAM)[ch]; sp8[n] = 8.f * (fmaxf(z, 0.f) + log1pf(__expf(-fabsf(z)))); }
        const bf16* xcol = pj + 3 * AW + cch;
        float h3 = 0.f, h2 = 0.f, h1 = 0.f;
        if (t0 != 0) { h3 = bf2f(xcol[(size_t)(t0 - 3) * INW]); h2 = bf2f(xcol[(size_t)(t0 - 2) * INW]); h1 = bf2f(xcol[(size_t)(t0 - 1) * INW]); }
        float hrun[2] = {0.f, 0.f}, Arun[2] = {1.f, 1.f};
        unsigned short xq[16], xn[16];
#pragma unroll
        for (int tt = 0; tt < 16; ++tt) { xq[tt] = xcol[(size_t)(t0 + tt) * INW]; xn[tt] = xcol[(size_t)(t0 + 16 + tt) * INW]; }
#pragma unroll 1
        for (int sc = 0; sc < 16; ++sc) {
            const int ts = t0 + sc * 16, tn = (sc < 14) ? ts + 32 : ts;
            unsigned short xnn[16];
#pragma unroll
            for (int tt = 0; tt < 16; ++tt) xnn[tt] = xcol[(size_t)(tn + tt) * INW];
#pragma unroll
            for (int tt = 0; tt < 16; ++tt) { const float xv = bf2f(xq[tt]); const float xc = cb + cw0 * h3 + cw1 * h2 + cw2 * h1 + cw3 * xv; h3 = h2; h2 = h1; h1 = xv; xcs[tt * 68 + lane] = xc; }
            asm volatile("s_waitcnt lgkmcnt(0)" ::: "memory");
            bf16x8 Af[2];
#pragma unroll
            for (int kk = 0; kk < 2; ++kk) { const LAS f32x4* ap = (const LAS f32x4*)(xcs + r * 68 + 32 * kk + 8 * q); const f32x4 a0 = ap[0], a1 = ap[1];
                v4u pw; pw.x = pk2(a0.x, a0.y); pw.y = pk2(a0.z, a0.w); pw.z = pk2(a1.x, a1.y); pw.w = pk2(a1.z, a1.w); Af[kk] = __builtin_bit_cast(bf16x8, pw); }
            f32x4 Da[2], Dx[2];
#pragma unroll
            for (int n = 0; n < 2; ++n) { Da[n] = (f32x4){0.f, 0.f, 0.f, 0.f}; Dx[n] = Da[n];
#pragma unroll
                for (int kk = 0; kk < 2; ++kk) { Da[n] = __builtin_amdgcn_mfma_f32_16x16x32_bf16(Af[kk], Bf[0][n][kk], Da[n], 0, 0, 0); Dx[n] = __builtin_amdgcn_mfma_f32_16x16x32_bf16(Af[kk], Bf[1][n][kk], Dx[n], 0, 0, 0); } }
#pragma unroll
            for (int n = 0; n < 2; ++n) {
                float a[4], bb[4]; v4u st;
#pragma unroll
                for (int i = 0; i < 4; ++i) { const float xcv = xcs[(4 * q + i) * 68 + hf * 32 + 16 * n + r];
                    const float ra = sigmoid_f(Da[n][i] + ba[n]), ix = sigmoid_f(Dx[n][i] + bx[n]);
                    const float la = -ra * sp8[n];
                    const float y2 = 2.f * la;
                    const float ser = -y2 * (1.f + y2 * (0.5f + y2 * (0.16666667f + y2 * (0.041666668f + y2 * 0.008333334f))));
                    const float av = __builtin_amdgcn_exp2f(1.4426950408889634f * la);
                    const float em = (y2 > -0.25f) ? ser : (1.f - av * av);
                    const float bv = __builtin_amdgcn_sqrtf(fmaxf(em, 0.f)) * (ix * xcv);
                    const unsigned pr = pk2(la * 1.4426950408889634f, bv); st[i] = pr;
                    a[i] = __builtin_amdgcn_exp2f(bf2f((unsigned short)(pr & 0xffffu))); bb[i] = __uint_as_float(pr & 0xffff0000u); }
                lb[(sc * 2 + n) * 64] = st;
                const float Al = (a[0] * a[1]) * (a[2] * a[3]);
                const float Hl = ((bb[0] * a[1] + bb[1]) * a[2] + bb[2]) * a[3] + bb[3];
                const float A0 = __shfl(Al, r), A1 = __shfl(Al, r + 16), A2 = __shfl(Al, r + 32), A3 = __shfl(Al, r + 48);
                const float H0 = __shfl(Hl, r), H1 = __shfl(Hl, r + 16), H2 = __shfl(Hl, r + 32), H3 = __shfl(Hl, r + 48);
                const float c0 = hrun[n], c1 = A0 * c0 + H0, c2 = A1 * c1 + H1, c3 = A2 * c2 + H2, c4 = A3 * c3 + H3;
                hrun[n] = c4; Arun[n] *= (A0 * A1) * (A2 * A3);
            }
#pragma unroll
            for (int tt = 0; tt < 16; ++tt) { xq[tt] = xn[tt]; xn[tt] = xnn[tt]; }
        }
        if (q == 0) {
#pragma unroll
            for (int n = 0; n < 2; ++n) { car[w * 64 + n * 16 + r] = Arun[n]; car[w * 64 + 32 + n * 16 + r] = hrun[n]; } }
        __syncthreads();
#pragma unroll
        for (int n = 0; n < 2; ++n) { float h = 0.f; for (int w2 = 0; w2 < w; ++w2) h = car[w2 * 64 + n * 16 + r] * h + car[w2 * 64 + 32 + n * 16 + r]; hin[n] = h; }
    }
    {
        VM_WAIT();
        float hrun[2] = {hin[0], hin[1]};
        v4u cur[2], nxt[2]; cur[0] = lb[0]; cur[1] = lb[64]; nxt[0] = lb[128]; nxt[1] = lb[192];
        unsigned short gq[2][4];
#pragma unroll
        for (int n = 0; n < 2; ++n)
#pragma unroll
            for (int i = 0; i < 4; ++i) gq[n][i] = gcol[(size_t)(t0 + 4 * q + i) * INW + 16 * n];
#pragma unroll 1
        for (int sc = 0; sc < 16; ++sc) {
            const int ts = t0 + sc * 16, scn = (sc < 14) ? sc + 2 : sc, tg = (sc < 15) ? ts + 16 : ts;
            v4u nn[2]; nn[0] = lb[(scn * 2 + 0) * 64]; nn[1] = lb[(scn * 2 + 1) * 64];
            unsigned short gn[2][4];
#pragma unroll
            for (int n = 0; n < 2; ++n)
#pragma unroll
                for (int i = 0; i < 4; ++i) gn[n][i] = gcol[(size_t)(tg + 4 * q + i) * INW + 16 * n];
#pragma unroll
            for (int n = 0; n < 2; ++n) {
                float a[4], bb[4];
#pragma unroll
                for (int i = 0; i < 4; ++i) { const unsigned pr = cur[n][i]; a[i] = __builtin_amdgcn_exp2f(__uint_as_float(pr << 16)); bb[i] = __uint_as_float(pr & 0xffff0000u); }
                const float Al = (a[0] * a[1]) * (a[2] * a[3]);
                const float Hl = ((bb[0] * a[1] + bb[1]) * a[2] + bb[2]) * a[3] + bb[3];
                const float A0 = __shfl(Al, r), A1 = __shfl(Al, r + 16), A2 = __shfl(Al, r + 32);
                const float H0 = __shfl(Hl, r), H1 = __shfl(Hl, r + 16), H2 = __shfl(Hl, r + 32), H3 = __shfl(Hl, r + 48), A3 = __shfl(Al, r + 48);
                const float c0 = hrun[n], c1 = A0 * c0 + H0, c2 = A1 * c1 + H1, c3 = A2 * c2 + H2, c4 = A3 * c3 + H3;
                hrun[n] = c4;
                float h = (q == 0) ? c0 : (q == 1) ? c1 : (q == 2) ? c2 : c3;
#pragma unroll
                for (int i = 0; i < 4; ++i) { h = a[i] * h + bb[i]; const float gv = bf2f(gq[n][i]);
                    const float ge = gv * sigmoid_f(1.5957691216057308f * (gv + 0.044715f * gv * gv * gv));
                    ycol[(size_t)(ts + 4 * q + i) * D + 16 * n] = (bf16)(pk2(h * ge, 0.f) & 0xffffu); }
            }
            cur[0] = nxt[0]; cur[1] = nxt[1]; nxt[0] = nn[0]; nxt[1] = nn[1];
#pragma unroll
            for (int n = 0; n < 2; ++n)
#pragma unroll
                for (int i = 0; i < 4; ++i) gq[n][i] = gn[n][i];
        }
    }
    __syncthreads();
}

__device__ __forceinline__ void attn_post(Frame& F, int l, int b, int h, int qb, float lam, float oscale) {
    const int tid_ = tid_opaque(), lane = tid_ & 63, wave_ = __builtin_amdgcn_readfirstlane(tid_ >> 6), rsub = lane >> 4, e8 = (lane & 15) * 8;
    const float* gs = FIN(I_GSUBLN) + l * 128 + e8; const Who W = who(); const bf16* OV_ = RBUF(RB_OV); bf16* AO_ = RBUF(RB_AO); const f32x4 g0 = *(const f32x4*)gs, g1 = *(const f32x4*)(gs + 4);
    const size_t rowbase = (size_t)b * SEQ + qb * 256 + wave_ * 32;
#pragma unroll
    for (int it = 0; it < 8; ++it) { const size_t row = rowbase + it * 4 + rsub;
        const v4u a = __builtin_nontemporal_load((const GAS v4u*)(OV_ + row * D + h * 256 + e8)), c = __builtin_nontemporal_load((const GAS v4u*)(OV_ + row * D + h * 256 + 128 + e8));
        f32x4 d0 = {pg8::bf_lo(a.x) - lam * pg8::bf_lo(c.x), pg8::bf_hi(a.x) - lam * pg8::bf_hi(c.x), pg8::bf_lo(a.y) - lam * pg8::bf_lo(c.y), pg8::bf_hi(a.y) - lam * pg8::bf_hi(c.y)};
        f32x4 d1 = {pg8::bf_lo(a.z) - lam * pg8::bf_lo(c.z), pg8::bf_hi(a.z) - lam * pg8::bf_hi(c.z), pg8::bf_lo(a.w) - lam * pg8::bf_lo(c.w), pg8::bf_hi(a.w) - lam * pg8::bf_hi(c.w)};
        float ss = pg8::sumsq8(d0, d1);
        ss += __shfl_xor(ss, 1); ss += __shfl_xor(ss, 2); ss += __shfl_xor(ss, 4); ss += __shfl_xor(ss, 8);
        const float rs = __builtin_amdgcn_rsqf(ss * (1.f / 128.f) + 1e-6f) * oscale;
        d0 = d0 * rs * g0; d1 = d1 * rs * g1;
        v4u o; o.x = pk2(d0.x, d0.y); o.y = pk2(d0.z, d0.w); o.z = pk2(d1.x, d1.y); o.w = pk2(d1.z, d1.w);
        *(GAS v4u*)(AO_ + row * D + h * 128 + e8) = o; }
}

struct Args { const void* in[23]; float* out; unsigned char* ws; int ph_lo, ph_hi; };
constexpr int N_PHASES = 2 + 6 * DEPTH;
__global__ void __launch_bounds__(NWAVES * 64, 2) hymba_fwd(Args args) {
    extern __shared__ __attribute__((aligned(16))) unsigned char lds[];
    cg::grid_group grid = cg::this_grid();
    Frame F;
    F.lds = (LAS unsigned char*)lds;
    { LAS unsigned long long* tabw = (LAS unsigned long long*)(F.lds + RING_BYTES + 1024);
      if (threadIdx.x == 0) {
#pragma unroll
          for (int k = 0; k < 23; ++k) tabw[k] = (unsigned long long)args.in[k];
          tabw[23] = (unsigned long long)args.out; tabw[24] = (unsigned long long)args.ws; }
      F.tab = tabw; }
    __syncthreads();
    const int lo = args.ph_lo, hi = args.ph_hi;
#define IN(k) (lo <= (k) && (k) < hi)
#define SEAM(k) do { if (IN(k) && IN((k) + 1)) { if (local_mode && (k) != N_PHASES - 2) {     const BgConvert bg{F, 0, 0}; xcd_barrier_local_bg(bar, bg, false); } else xcd_barrier(bar); } } while (0)
#define SEAM_BG(k, sl) do { const BgConvert bg{F, opaque_s(l_), (sl)}; if (IN(k) && IN((k) + 1)) { if (local_mode) xcd_barrier_local_bg(bar, bg, true); else xcd_barrier_bg(bar, bg); } else if (IN((k) + 1)) { if (threadIdx.x >= 64) bg(); __syncthreads(); } } while (0)

    if (blockIdx.x == 0) { unsigned* bw = (unsigned*)args.ws; for (int u = threadIdx.x; u < XCD_BAR_WORDS; u += NWAVES * 64) bw[u] = 0u; }
    if (threadIdx.x < 8) ((volatile LAS unsigned*)(F.lds + LDSW_OFF))[threadIdx.x] = (threadIdx.x == 2) ? blockIdx.x : 0u;
    __syncthreads();
    if (IN(0)) { p0_prologue(F); }
    grid.sync();
    XcdBarrier bar = xcd_barrier_post((unsigned*)args.ws, (volatile LAS unsigned*)(F.lds + LDSW_OFF));
    xcd_barrier(bar);
    if (threadIdx.x == 0) {
        volatile LAS unsigned* cw = (volatile LAS unsigned*)(F.lds + LDSW_OFF); const unsigned G = gridDim.x, nloc = cw[0], nx = cw[1], rank = cw[4];
        unsigned slot = 0u; bool uniform = true;
#pragma unroll
        for (unsigned j = 0; j < 16; ++j) { const unsigned c = xb_ld(&bar.bar[XB_XCNT(j)]); if (c > 0u) { if (j < bar.x) ++slot; if (c != nloc) uniform = false; } }
        const bool local = uniform && nx == 8u && nloc * 8u == G && slot < 8u && rank < nloc && xb_ld(&bar.bar[XB_TMO]) == 0u;
        cw[2] = local ? rank * 8u + slot : blockIdx.x; cw[3] = local ? 1u : 0u; }
    __syncthreads();
    const bool local_mode = __builtin_amdgcn_readfirstlane((int)((volatile LAS unsigned*)(F.lds + LDSW_OFF))[3]) != 0;

#pragma unroll 1
    for (int l_ = 0; l_ < DEPTH; ++l_) {
        const int pb = 1 + 6 * l_;
        if (IN(pb + 0)) {
            const Who W = who(); const int l = opaque_s(l_);
            unsigned char* ws = FWS(0); const unsigned char* wl = ws + WS_W + (size_t)l * W_LAYER;
            pg8::Gemm g{(const bf16*)FOUT(), (const bf16*)(wl + WO_IN), M, INW, D}; pg8::StaticOrder S; S.init(M, INW, W.G, W.bx);
            pg8::EpiIn E{RBUF(RB_PROJ), INW, (const float*)(ws + WS_SSQ1), (const int*)FIN(I_POS), attn_body::C2, (bf16*)FOUT() + (size_t)32 * 1024 * 1024, (bf16*)FOUT() + (size_t)48 * 1024 * 1024};
            pg8::gemm_phase<pg8::EpiIn, pg8::StaticOrder, true, true>(F.lds, g, S, E);
        }
        SEAM_BG(pb + 0, 0);
        if (IN(pb + 1)) {
            const Who W = who(); const int l = opaque_s(l_);
            float lam, oscale;
            { const float* lq = FIN(I_LAMQ) + l * 128; const float* lk = FIN(I_LAMK) + l * 128;
              const float d0 = wave_sum(lq[W.lane] * lk[W.lane]), d1 = wave_sum(lq[64 + W.lane] * lk[64 + W.lane]);
              const float li = 0.8f - 0.6f * __expf(-0.3f * (float)l); lam = __expf(d0) - __expf(d1) + li; oscale = 1.f - li; }
#if defined(PROBE_ATTN2)
            for (int rep_ = 0; rep_ < 2; ++rep_)
#endif
            for (int item = W.vcu; item < 256; item += W.G) {
                const int bh = item >> 2, s = item & 3, b = bh >> 2, h = bh & 3;
                const attn_body::bf16* kimg = (const attn_body::bf16*)((const bf16*)FOUT() + (size_t)32 * 1024 * 1024); const attn_body::bf16* vimg = (const attn_body::bf16*)((const bf16*)FOUT() + (size_t)48 * 1024 * 1024);
                const attn_body::bf16* pj = (const attn_body::bf16*)(RBUF(RB_PROJ) + (size_t)b * SEQ * INW); attn_body::bf16* ov = (attn_body::bf16*)(RBUF(RB_OV) + (size_t)b * SEQ * D);
#pragma unroll 1
                for (int k = 0; k < 2; ++k) { const int qb = k ? 7 - s : s;
#pragma unroll 1
                    for (int c = 0; c < 2; ++c)
                        attn2::attn_unit128<8>(qb, pj + (h * 2 + c) * 64, kimg + (size_t)((b * 8 + h * 2 + c) * 32) * 4096, vimg + (size_t)((b * 4 + h) * 32) * 8192, ov + h * 256 + c * 128, (char*)lds);
                    VM_WAIT(); __syncthreads(); __builtin_amdgcn_fence(__ATOMIC_ACQUIRE, "agent"); VM_WAIT();
                    attn_post(F, l, b, h, qb, lam, oscale);
                }
            }
            __syncthreads();
#if defined(PROBE_LRU2)
            for (int rep_ = 0; rep_ < 2; ++rep_)
#endif
            for (int item = W.vcu; item < 256; item += W.G) lru_item(F, l, item);
        }
        SEAM_BG(pb + 1, 1);
        if (IN(pb + 2)) {
            const Who W = who(); const int l = opaque_s(l_);
            unsigned char* ws = FWS(0); const unsigned char* wl = ws + WS_W + (size_t)l * W_LAYER;
            pg8::Gemm g{RBUF(RB_AO), (const bf16*)(wl + WO_OUT), M, D, D}; pg8::StaticOrder S; S.init(M, D, W.G, W.bx);
            pg8::EpiRes E{(const bf16*)FOUT(), (bf16*)(ws + WS_XB0), (float*)(ws + WS_SSQ0)};
            pg8::gemm_phase<pg8::EpiRes, pg8::StaticOrder, true, true>(F.lds, g, S, E);
        }
        SEAM_BG(pb + 2, 2);
        if (IN(pb + 3)) {
            const Who W = who(); const int l = opaque_s(l_);
            unsigned char* ws = FWS(0); const unsigned char* wl = ws + WS_W + (size_t)l * W_LAYER;
            pg8::Gemm g{(const bf16*)(ws + WS_XB0), (const bf16*)(wl + WO_W1), M, FF, D}; pg8::StaticOrder S; S.init(M, FF, W.G, W.bx, 1);
            pg8::EpiMlpIn E{RBUF(RB_HB), FF, (const float*)(ws + WS_SSQ0)};
            pg8::gemm_phase<pg8::EpiMlpIn, pg8::StaticOrder, true, true>(F.lds, g, S, E);
        }
        SEAM(pb + 3);
        if (IN(pb + 4)) {
            const Who W = who(); const int l = opaque_s(l_);
            unsigned char* ws = FWS(0); const unsigned char* wl = ws + WS_W + (size_t)l * W_LAYER;
            pg8::Gemm g{RBUF(RB_HB), (const bf16*)(wl + WO_W2), M, D, FF}; pg8::StaticOrder S; S.init(M, D, W.G, W.bx);
            pg8::EpiRes E{(const bf16*)(ws + WS_XB0), (bf16*)(ws + WS_XB0), (float*)(ws + WS_SSQ0)};
            pg8::gemm_phase<pg8::EpiRes, pg8::StaticOrder, true, true>(F.lds, g, S, E);
        }
        SEAM(pb + 4);
        if (IN(pb + 5)) {
            const Who W = who(); const int l = opaque_s(l_);
            { unsigned char* ws = FWS(0); const unsigned char* wl = ws + WS_W + (size_t)l * W_LAYER;
              pg8::Gemm g{(const bf16*)(ws + WS_P16), (const bf16*)(wl + WO_PP), M, D, opaque_s(PLE)}; pg8::StaticOrder S; S.init(M, D, W.G, W.bx);
              pg8::EpiPlain E{RBUF(RB_PP), D};
              pg8::gemm_phase<pg8::EpiPlain, pg8::StaticOrder, true, true>(F.lds, g, S, E); }
            VM_WAIT(); __syncthreads();
            { unsigned char* ws = FWS(0); const unsigned char* wl = ws + WS_W + (size_t)l * W_LAYER;
              pg8::Gemm g{(const bf16*)(ws + WS_XB0), (const bf16*)(wl + WO_PG), M, D, D}; pg8::StaticOrder S; S.init(M, D, W.G, W.bx, 1);
              pg8::EpiPle E{(const bf16*)(ws + WS_XB0), (l == DEPTH - 1) ? RBUF(RB_XBF) : (bf16*)FOUT(), (const float*)(ws + WS_SSQ0), (float*)(ws + WS_SSQ1), (const bf16*)RBUF(RB_PP)};
              pg8::gemm_phase<pg8::EpiPle, pg8::StaticOrder, true, true>(F.lds, g, S, E); }
        }
        SEAM(pb + 5);
    }
    if (IN(N_PHASES - 1)) final_norm(F);
#undef IN
#undef SEAM
#undef SEAM_BG
}

extern "C" void kernel_launch(void* const* d_in, const int* in_sizes, int n_in, void* d_out, int out_size, void* d_ws, size_t ws_size, hipStream_t stream) {
    static int grid = 0;
    if (grid == 0) {
        if (n_in != 23 || in_sizes[0] != M * D || out_size != M * D || ws_size < WS_END) { fprintf(stderr, "kernel_launch: unexpected shapes: n_in %d in0 %d out %d ws %zu (need %zu); nothing launched\n", n_in, n_in > 0 ? in_sizes[0] : -1, out_size, ws_size, (size_t)WS_END); grid = -1; return; }
        int dev = 0, cus = 0, per_cu = 0;
        if (hipGetDevice(&dev) != hipSuccess || hipDeviceGetAttribute(&cus, hipDeviceAttributeMultiprocessorCount, dev) != hipSuccess) { grid = -1; return; }
        if (hipFuncSetAttribute((const void*)hymba_fwd, hipFuncAttributeMaxDynamicSharedMemorySize, LDS_BYTES) != hipSuccess) { fprintf(stderr, "kernel_launch: hipFuncSetAttribute failed\n"); grid = -1; return; }
        if (hipOccupancyMaxActiveBlocksPerMultiprocessor(&per_cu, (const void*)hymba_fwd, NWAVES * 64, LDS_BYTES) != hipSuccess || per_cu < 1) { fprintf(stderr, "kernel_launch: occupancy query reports %d\n", per_cu); per_cu = 1; }
        (void)hipGetLastError();
        grid = cus * per_cu;
    }
    if (grid < 0) return;
    Args a{};
    for (int i = 0; i < 23; ++i) a.in[i] = d_in[i];
    a.out = (float*)d_out; a.ws = (unsigned char*)d_ws;
#ifndef MK_CUTS
    a.ph_lo = 0; a.ph_hi = N_PHASES;
    void* kargs[] = {&a};
    hipError_t e = hipLaunchCooperativeKernel((const void*)hymba_fwd, dim3(grid), dim3(NWAVES * 64), kargs, LDS_BYTES, stream);
    if (e != hipSuccess) fprintf(stderr, "kernel_launch: cooperative launch failed: %s (grid %d)\n", hipGetErrorString(e), grid);
#else
    for (int ph = 0; ph < N_PHASES; ++ph) { a.ph_lo = ph; a.ph_hi = ph + 1; void* kargs[] = {&a};
        hipError_t e = hipLaunchCooperativeKernel((const void*)hymba_fwd, dim3(grid), dim3(NWAVES * 64), kargs, LDS_BYTES, stream);
        if (e != hipSuccess) { fprintf(stderr, "kernel_launch: launch %d failed: %s\n", ph, hipGetErrorString(e)); break; } }
#endif
}
```

```cpp
#include <hip/hip_runtime.h>
#include <cstdio>
#include <cstdint>
__device__ __forceinline__ int tid_opaque() { int t = threadIdx.x; asm volatile("" : "+v"(t)); return t; }
namespace pg8 {
#define PG8_LAS __attribute__((address_space(3)))
typedef unsigned short bf16_t;
typedef short bf16x8 __attribute__((ext_vector_type(8)));
typedef float f32x4 __attribute__((ext_vector_type(4)));
typedef unsigned u32x4 __attribute__((ext_vector_type(4)));
constexpr int BM = 256, BK = 64, HALF = 128, HTB = HALF * BK * 2  , STAGE_BYTES = 8 * HTB, NXCD = 8, WGM = 8;

__host__ __device__ __forceinline__ int lds_byte(int r, int c) { const int st = (r >> 4) * 2 + (c >> 5), rr = r & 15, cc = c & 31, ob = rr * 64 + cc * 2; return st * 1024 + (ob ^ (((ob >> 9) & 1) << 5)); }
__host__ __device__ __forceinline__ void stage_rc(int b, int& R, int& C) { const int st = b / 1024, sb = b % 1024, swz = sb ^ (((sb >> 9) & 1) << 5); R = (st >> 1) * 16 + swz / 64; C = (st & 1) * 32 + (swz % 64) / 2; }
__host__ __device__ __forceinline__ int perm32(int rho) { const int n = rho >> 4, i = rho & 15; return 8 * (i >> 2) + 4 * n + (i & 3); }

struct Unit { int pm, pn; };
struct Gemm { const bf16_t* A; const bf16_t* Bt; int M, N, K; };

struct StaticOrder {
    int nM, nN, nwg, G, c, rev;
    __host__ __device__ void init(int M, int N, int G_, int c_, int rev_ = 0) { nM = M / BM; nN = N / BM; nwg = nM * nN; G = G_; c = c_; rev = (rev_ && nwg % G_ == 0) ? 1 : 0; }
    __host__ __device__ bool next(int i, Unit& u) const {
        const int nr = (nwg + G - 1) / G; if (i >= nr) return false;
        const long L = (long)(rev ? nr - 1 - i : i) * G + c; if (L >= nwg) return false;
        int wgid = (int)L; { const int q = nwg / NXCD, r = nwg % NXCD, xcd = wgid % NXCD, off = wgid / NXCD; wgid = (xcd < r ? xcd * (q + 1) : r * (q + 1) + (xcd - r) * q) + off; }
        const int nig = WGM * nN, gid = wgid / nig, fm = gid * WGM, gsz = (nM - fm) < WGM ? (nM - fm) : WGM;
        u.pm = fm + ((wgid % nig) % gsz); u.pn = (wgid % nig) / gsz; return true;
    }
    __device__ __forceinline__ void a_ready(const Unit&) const {}
    __device__ __forceinline__ void done(const Unit&) const {}
};

__device__ __forceinline__ unsigned cvt_pk_bf16(float lo, float hi) { unsigned r; asm volatile("v_cvt_pk_bf16_f32 %0, %1, %2" : "=v"(r) : "v"(lo), "v"(hi)); return r; }
__device__ __forceinline__ u32x4 pack8(const f32x4 v0, const f32x4 v1) { u32x4 w; w.x = cvt_pk_bf16(v0[0], v0[1]); w.y = cvt_pk_bf16(v0[2], v0[3]); w.z = cvt_pk_bf16(v1[0], v1[1]); w.w = cvt_pk_bf16(v1[2], v1[3]); return w; }
__device__ __forceinline__ float bf_lo(unsigned w) { return __uint_as_float(w << 16); }
__device__ __forceinline__ float bf_hi(unsigned w) { return __uint_as_float(w & 0xffff0000u); }
constexpr int DMODEL = 1024;
constexpr float RMS_EPS = 1e-6f;
__device__ __forceinline__ float row_rs(const float* ssq, int row) {
    const f32x4* p = (const f32x4*)(ssq + (size_t)row * 16);
    const f32x4 a = p[0], b = p[1], c = p[2], d = p[3];
    const float s = (((a[0] + a[1]) + (a[2] + a[3])) + ((b[0] + b[1]) + (b[2] + b[3]))) + (((c[0] + c[1]) + (c[2] + c[3])) + ((d[0] + d[1]) + (d[2] + d[3])));
    return __builtin_amdgcn_rsqf(s * (1.0f / DMODEL) + RMS_EPS);
}
__device__ __forceinline__ float sumsq8(const f32x4 a, const f32x4 b) { return ((a[0] * a[0] + a[1] * a[1]) + (a[2] * a[2] + a[3] * a[3])) + ((b[0] * b[0] + b[1] * b[1]) + (b[2] * b[2] + b[3] * b[3])); }

struct EpiPlain {
    static constexpr bool PERM = true, AFTER_DRAIN = false, LOADS_BEFORE_STORES = false;
    bf16_t* O; int ldc;
    __device__ __forceinline__ void operator()(const f32x4 (&acc)[2][2][4][2], const Unit& u, int wr, int wc, int fr, int fq) const {
        const int row0 = u.pm * BM + wr * 64 + fr, col0 = u.pn * BM + wc * 32 + 8 * fq;
#pragma unroll
        for (int ai = 0; ai < 2; ++ai)
#pragma unroll
            for (int m = 0; m < 4; ++m) { bf16_t* rowp = O + (size_t)(row0 + ai * HALF + m * 16) * ldc + col0;
#pragma unroll
                for (int bj = 0; bj < 2; ++bj) *(u32x4*)(rowp + bj * HALF) = pack8(acc[ai][bj][m][0], acc[ai][bj][m][1]); }
    }
};
__device__ __forceinline__ void row_rs8(float (&rs)[8], const float* ssq, int row0, int fq) {
    f32x4 p[8];
#pragma unroll
    for (int i = 0; i < 8; ++i) p[i] = *(const f32x4*)(ssq + (size_t)(row0 + (i >> 2) * HALF + (i & 3) * 16) * 16 + 4 * fq);
#pragma unroll
    for (int i = 0; i < 8; ++i) { float s = (p[i][0] + p[i][1]) + (p[i][2] + p[i][3]); s += __shfl_xor(s, 16); s += __shfl_xor(s, 32); rs[i] = __builtin_amdgcn_rsqf(s * (1.0f / DMODEL) + RMS_EPS); }
}
struct EpiIn {
    static constexpr bool PERM = true, AFTER_DRAIN = false, LOADS_BEFORE_STORES = true;
    bf16_t* O; int ldc; const float* ssq; const int* pos; float qscale; bf16_t* KC; bf16_t* VC;
    __device__ __forceinline__ bf16_t* dst(const Unit& u, int row, int bj, int wc, int fq, int col0) const {
        if (u.pn < 2 || u.pn >= 6) return O + (size_t)row * ldc + col0 + bj * HALF;
        const int b = row >> 11, t = row & 2047;
        if (u.pn < 4) { const int hc = (u.pn - 2) * 4 + bj * 2 + (wc >> 1), chunk = (wc & 1) * 4 + fq;
            return KC + (size_t)((b * 8 + hc) * 32 + (t >> 6)) * 4096 + chunk * 512 + (t & 63) * 8; }
        const int h = (u.pn - 4) * 2 + bj, piece = wc * 4 + ((t & 63) >> 4);
        return VC + (size_t)((b * 4 + h) * 32 + (t >> 6)) * 8192 + piece * 512 + (t & 15) * 32 + fq * 8;
    }
    __device__ __forceinline__ void operator()(const f32x4 (&acc)[2][2][4][2], const Unit& u, int wr, int wc, int fr, int fq) const {
        const int row0 = u.pm * BM + wr * 64 + fr, col0 = u.pn * BM + wc * 32 + 8 * fq;
        const bool rope = (u.pn < 4) && !(wc & 1);
        const float sc = (u.pn < 2) ? qscale : 1.f;
        float rs[8]; row_rs8(rs, ssq, row0, fq);
        if (rope) {
            int ps[8];
#pragma unroll
            for (int i = 0; i < 8; ++i) ps[i] = pos[row0 + (i >> 2) * HALF + (i & 3) * 16];
            const bool mine = fq < 2; const float sgn = (fq == 0) ? -1.f : 1.f;
            const float invf[8] = {1.0f, 0.1939227432012558f, 0.03760603070259094f, 0.007292664609849453f, 0.0014142135623842478f, 0.00027424818836152554f, 5.3182957344688475e-05f, 1.0313385246263351e-05f};
#pragma unroll
            for (int ai = 0; ai < 2; ++ai)
#pragma unroll
                for (int m = 0; m < 4; ++m) { const int row = row0 + ai * HALF + m * 16; const float r = rs[ai * 4 + m] * sc; const float pf = (float)ps[ai * 4 + m];
                    float c[8], sn[8];
#pragma unroll
                    for (int e = 0; e < 8; ++e) { const float rev = __builtin_amdgcn_fractf((pf * invf[e]) * 0.15915494309189535f); c[e] = mine ? __builtin_amdgcn_cosf(rev) : 1.f; sn[e] = mine ? __builtin_amdgcn_sinf(rev) * sgn : 0.f; }
#pragma unroll
                    for (int bj = 0; bj < 2; ++bj) { f32x4 v0 = acc[ai][bj][m][0] * r, v1 = acc[ai][bj][m][1] * r; f32x4 p0, p1;
#pragma unroll
                        for (int e = 0; e < 4; ++e) { p0[e] = __shfl_xor(v0[e], 16); p1[e] = __shfl_xor(v1[e], 16); }
#pragma unroll
                        for (int e = 0; e < 4; ++e) { v0[e] = v0[e] * c[e] + p0[e] * sn[e]; v1[e] = v1[e] * c[4 + e] + p1[e] * sn[4 + e]; }
                        *(u32x4*)dst(u, row, bj, wc, fq, col0) = pack8(v0, v1); } }
        } else {
#pragma unroll
            for (int ai = 0; ai < 2; ++ai)
#pragma unroll
                for (int m = 0; m < 4; ++m) { const int row = row0 + ai * HALF + m * 16; const float r = rs[ai * 4 + m] * sc;
#pragma unroll
                    for (int bj = 0; bj < 2; ++bj) *(u32x4*)dst(u, row, bj, wc, fq, col0) = pack8(acc[ai][bj][m][0] * r, acc[ai][bj][m][1] * r); }
        }
    }
};
__device__ __forceinline__ void unpack8(const u32x4 w, f32x4& a, f32x4& b) { a = (f32x4){bf_lo(w.x), bf_hi(w.x), bf_lo(w.y), bf_hi(w.y)}; b = (f32x4){bf_lo(w.z), bf_hi(w.z), bf_lo(w.w), bf_hi(w.w)}; }
struct EpiRes {
    static constexpr bool PERM = true, AFTER_DRAIN = false, LOADS_BEFORE_STORES = true;
    const bf16_t* Rin; bf16_t* XBo; float* ssq;
    __device__ __forceinline__ void operator()(const f32x4 (&acc)[2][2][4][2], const Unit& u, int wr, int wc, int fr, int fq) const {
        const int row0 = u.pm * BM + wr * 64 + fr, col0 = u.pn * BM + wc * 32 + 8 * fq;
        u32x4 rv[8][2];
#pragma unroll
        for (int i = 0; i < 8; ++i)
#pragma unroll
            for (int bj = 0; bj < 2; ++bj) rv[i][bj] = *(const u32x4*)(Rin + (size_t)(row0 + (i >> 2) * HALF + (i & 3) * 16) * DMODEL + col0 + bj * HALF);
#pragma unroll
        for (int ai = 0; ai < 2; ++ai)
#pragma unroll
            for (int m = 0; m < 4; ++m) { const int row = row0 + ai * HALF + m * 16; float part = 0.f;
#pragma unroll
                for (int bj = 0; bj < 2; ++bj) { f32x4 r0, r1; unpack8(rv[ai * 4 + m][bj], r0, r1);
                    const f32x4 h0 = r0 + acc[ai][bj][m][0], h1 = r1 + acc[ai][bj][m][1]; part += sumsq8(h0, h1);
                    *(u32x4*)(XBo + (size_t)row * DMODEL + col0 + bj * HALF) = pack8(h0, h1); }
                part += __shfl_xor(part, 16); part += __shfl_xor(part, 32);
                if (fq == 0) ssq[(size_t)row * 16 + u.pn * 4 + wc] = part; }
    }
};
struct EpiMlpIn {
    static constexpr bool PERM = true, AFTER_DRAIN = false, LOADS_BEFORE_STORES = true;
    bf16_t* O; int ldc; const float* ssq;
    __device__ __forceinline__ void operator()(const f32x4 (&acc)[2][2][4][2], const Unit& u, int wr, int wc, int fr, int fq) const {
        const int row0 = u.pm * BM + wr * 64 + fr, col0 = u.pn * BM + wc * 32 + 8 * fq;
        float rs[8]; row_rs8(rs, ssq, row0, fq);
#pragma unroll
        for (int ai = 0; ai < 2; ++ai)
#pragma unroll
            for (int m = 0; m < 4; ++m) { const int row = row0 + ai * HALF + m * 16; const float r = rs[ai * 4 + m];
                bf16_t* rowp = O + (size_t)row * ldc + col0;
#pragma unroll
                for (int bj = 0; bj < 2; ++bj) { f32x4 v0 = acc[ai][bj][m][0] * r, v1 = acc[ai][bj][m][1] * r;
#pragma unroll
                    for (int e = 0; e < 4; ++e) { const float a = fmaxf(v0[e], 0.f), b = fmaxf(v1[e], 0.f); v0[e] = a * a; v1[e] = b * b; }
                    *(u32x4*)(rowp + bj * HALF) = pack8(v0, v1); } }
    }
};
struct EpiPle {
    static constexpr bool PERM = true, AFTER_DRAIN = false, LOADS_BEFORE_STORES = true;
    const bf16_t* Rin; bf16_t* XBo; const float* ssq_in; float* ssq_out; const bf16_t* PP;
    __device__ __forceinline__ void operator()(const f32x4 (&acc)[2][2][4][2], const Unit& u, int wr, int wc, int fr, int fq) const {
        const int row0 = u.pm * BM + wr * 64 + fr, col0 = u.pn * BM + wc * 32 + 8 * fq;
#pragma unroll
        for (int ai = 0; ai < 2; ++ai)
#pragma unroll
          for (int mh = 0; mh < 2; ++mh) {
            u32x4 rv[2][2], pw[2][2]; f32x4 p[2];
#pragma unroll
            for (int mm = 0; mm < 2; ++mm) { const int rowl = row0 + ai * HALF + (2 * mh + mm) * 16; p[mm] = *(const f32x4*)(ssq_in + (size_t)rowl * 16 + 4 * fq);
#pragma unroll
                for (int bj = 0; bj < 2; ++bj) { const size_t off = (size_t)rowl * DMODEL + col0 + bj * HALF; rv[mm][bj] = *(const u32x4*)(Rin + off); pw[mm][bj] = *(const u32x4*)(PP + off); } }
#pragma unroll
            for (int mm = 0; mm < 2; ++mm) { const int m = 2 * mh + mm; const int row = row0 + ai * HALF + m * 16; float part = 0.f;
                float sr = (p[mm][0] + p[mm][1]) + (p[mm][2] + p[mm][3]); sr += __shfl_xor(sr, 16); sr += __shfl_xor(sr, 32); const float r = __builtin_amdgcn_rsqf(sr * (1.0f / DMODEL) + RMS_EPS);
#pragma unroll
                for (int bj = 0; bj < 2; ++bj) { f32x4 r0, r1, p0, p1; unpack8(rv[mm][bj], r0, r1); unpack8(pw[mm][bj], p0, p1);
                    f32x4 g0 = acc[ai][bj][m][0] * r, g1 = acc[ai][bj][m][1] * r;
#pragma unroll
                    for (int e = 0; e < 4; ++e) { g0[e] = __builtin_amdgcn_rcpf(1.f + __builtin_amdgcn_exp2f(-1.4426950408889634f * g0[e])); g1[e] = __builtin_amdgcn_rcpf(1.f + __builtin_amdgcn_exp2f(-1.4426950408889634f * g1[e])); }
                    const f32x4 h0 = r0 + g0 * p0, h1 = r1 + g1 * p1; part += sumsq8(h0, h1);
                    *(u32x4*)(XBo + (size_t)row * DMODEL + col0 + bj * HALF) = pack8(h0, h1); }
                part += __shfl_xor(part, 16); part += __shfl_xor(part, 32);
                if (fq == 0) ssq_out[(size_t)row * 16 + u.pn * 4 + wc] = part; }
            asm volatile("" ::: "memory"); }
    }
};

template <class Epi, class Sched, bool ALIGN_EPI = false, bool SP2 = false>
__device__ __forceinline__ void gemm_phase(PG8_LAS unsigned char* lds, const Gemm g, const Sched& S, const Epi& E) {
    const int tid = tid_opaque(), wid = __builtin_amdgcn_readfirstlane(tid >> 6), lane = tid & 63, wr = wid >> 2, wc = wid & 3, fr = lane & 15, fq = lane >> 4;
    const int K = g.K, nt = K / BK;
    unsigned voffA[2], voffB[2];
#pragma unroll
    for (int i = 0; i < 2; ++i) { int R, C; stage_rc(tid * 16 + i * 8192, R, C); const int Rb = Epi::PERM ? ((R & ~31) + perm32(R & 31)) : R;
        voffA[i] = (unsigned)(R * K + C) * 2u; voffB[i] = (unsigned)(Rb * K + C) * 2u; }
    const size_t kstep = (size_t)(BK * 2);
    const size_t hstep = (size_t)HALF * K * 2;
    const size_t tstep = 2 * hstep;
    const unsigned ldsw = (unsigned)wid * 1024u;
    const int aoff = lds_byte(wr * 64 + fr, fq * 8), boff = lds_byte(wc * 32 + fr, fq * 8);
#define PG8_SA(b, h) (((b) * 2 + (h)) * HTB)
#define PG8_SB(b, h) ((4 + (b) * 2 + (h)) * HTB)
#define PG8_STAGE(bufoff, gbase, voff) do { _Pragma("unroll") for (int _i = 0; _i < 2; ++_i) \
        __builtin_amdgcn_global_load_lds((const unsigned*)((const char*)(gbase) + (voff)[_i]), (PG8_LAS unsigned*)(lds + (bufoff) + ldsw + _i * 8192), 16, 0, 0); } while (0)
#define PG8_LDA(dst, b, h) do { _Pragma("unroll") for (int m = 0; m < 4; ++m) _Pragma("unroll") for (int k = 0; k < 2; ++k) dst[m][k] = *(const PG8_LAS bf16x8*)(lds + PG8_SA(b, h) + aoff + m * 2048 + k * 1024); } while (0)
#define PG8_LDB(dst, b, h) do { _Pragma("unroll") for (int n = 0; n < 2; ++n) _Pragma("unroll") for (int k = 0; k < 2; ++k) dst[n][k] = *(const PG8_LAS bf16x8*)(lds + PG8_SB(b, h) + boff + n * 2048 + k * 1024); } while (0)
#define PG8_MMA(ai, bj, At, Bt) do { __builtin_amdgcn_s_setprio(1); _Pragma("unroll") for (int m = 0; m < 4; ++m) _Pragma("unroll") for (int n = 0; n < 2; ++n) _Pragma("unroll") for (int k = 0; k < 2; ++k) \
        acc[ai][bj][m][n] = __builtin_amdgcn_mfma_f32_16x16x32_bf16(Bt[n][k], At[m][k], acc[ai][bj][m][n], 0, 0, 0); __builtin_amdgcn_s_setprio(0); } while (0)
#define PG8_WAIT_V(n) asm volatile("s_waitcnt vmcnt(" #n ")" ::: "memory")
#define PG8_WAIT_L(n) asm volatile("s_waitcnt lgkmcnt(" #n ")" ::: "memory")
#define PG8_WAIT_V8_UNLESS(flag) asm volatile("s_cmp_lg_i32 %0, 0\n\ts_cbranch_scc1 .Lpg8rx%=\n\ts_waitcnt vmcnt(8)\n.Lpg8rx%=:" :: "s"(__builtin_amdgcn_readfirstlane(flag)) : "scc", "memory")
#define PG8_BAR __builtin_amdgcn_s_barrier()
#define PG8_SCHED __builtin_amdgcn_sched_barrier(0)
    Unit cur, nxt; int ui = 0; bool relax = false;
    if (!S.next(0, cur)) return;
    f32x4 acc[2][2][4][2];
#pragma unroll
    for (int a = 0; a < 2; ++a)
#pragma unroll
        for (int b = 0; b < 2; ++b)
#pragma unroll
            for (int m = 0; m < 4; ++m)
#pragma unroll
                for (int n = 0; n < 2; ++n) acc[a][b][m][n] = (f32x4){0.f, 0.f, 0.f, 0.f};
    bf16x8 At[4][2], B0[2][2], B1[2][2];
    const char* cA = (const char*)g.A + (size_t)cur.pm * tstep; const char* cB = (const char*)g.Bt + (size_t)cur.pn * tstep;
    S.a_ready(cur);
    if constexpr (SP2) {
        PG8_STAGE(PG8_SB(0, 0), cB, voffB); PG8_STAGE(PG8_SB(0, 1), cB + hstep, voffB); PG8_STAGE(PG8_SA(0, 0), cA, voffA); PG8_STAGE(PG8_SA(0, 1), cA + hstep, voffA);
        if (wr == 1) PG8_BAR;
        PG8_WAIT_V(2); PG8_BAR;
        PG8_STAGE(PG8_SB(1, 0), cB + kstep, voffB); PG8_STAGE(PG8_SA(1, 0), cA + kstep, voffA); PG8_STAGE(PG8_SB(1, 1), cB + hstep + kstep, voffB);
        PG8_WAIT_V(6); PG8_BAR;
    } else {
        PG8_STAGE(PG8_SB(0, 0), cB, voffB); PG8_STAGE(PG8_SA(0, 0), cA, voffA); PG8_STAGE(PG8_SB(0, 1), cB + hstep, voffB); PG8_STAGE(PG8_SA(0, 1), cA + hstep, voffA);
        if (wr == 1) PG8_BAR;
        PG8_WAIT_V(4); PG8_BAR;
        PG8_STAGE(PG8_SB(1, 0), cB + kstep, voffB); PG8_STAGE(PG8_SA(1, 0), cA + kstep, voffA); PG8_STAGE(PG8_SB(1, 1), cB + hstep + kstep, voffB);
        PG8_WAIT_V(6); PG8_BAR;
    }
    for (;;) {
        const bool has_next = S.next(ui + 1, nxt);
        const char* nA = has_next ? (const char*)g.A + (size_t)nxt.pm * tstep : cA; const char* nB = has_next ? (const char*)g.Bt + (size_t)nxt.pn * tstep : cB;
        for (int t = 0; t < nt; t += 2) {
            const bool last = (t == nt - 2);
            const char* a1 = cA + (size_t)(t + 1) * kstep;
            const char* a2 = last ? nA : cA + (size_t)(t + 2) * kstep; const char* b2 = last ? nB : cB + (size_t)(t + 2) * kstep;
            const char* a3 = a2 + kstep; const char* b3 = b2 + kstep;
            if (last && has_next) S.a_ready(nxt);
            if constexpr (SP2) {
            const int rx = (relax && t == 0) ? 1 : 0;
            PG8_STAGE(PG8_SA(1, 1), a1 + hstep, voffA); PG8_SCHED; PG8_LDB(B0, 0, 0); PG8_LDB(B1, 0, 1); PG8_SCHED; PG8_LDA(At, 0, 0);
            PG8_WAIT_V8_UNLESS(rx); PG8_WAIT_L(0); PG8_BAR; PG8_MMA(0, 0, At, B0); PG8_MMA(0, 1, At, B1); PG8_BAR; PG8_SCHED;
            PG8_STAGE(PG8_SB(0, 0), b2, voffB); PG8_STAGE(PG8_SB(0, 1), b2 + hstep, voffB); PG8_STAGE(PG8_SA(0, 0), a2, voffA); PG8_SCHED; PG8_LDA(At, 0, 1);
            PG8_WAIT_V8_UNLESS(rx); PG8_WAIT_L(0); PG8_BAR; PG8_MMA(1, 0, At, B0); PG8_MMA(1, 1, At, B1); PG8_BAR; PG8_SCHED;
            PG8_STAGE(PG8_SA(0, 1), a2 + hstep, voffA); PG8_SCHED; PG8_LDB(B0, 1, 0); PG8_LDB(B1, 1, 1); PG8_SCHED; PG8_LDA(At, 1, 0);
            PG8_WAIT_V(8); PG8_WAIT_L(0); PG8_BAR; PG8_MMA(0, 0, At, B0); PG8_MMA(0, 1, At, B1); PG8_BAR; PG8_SCHED;
            PG8_STAGE(PG8_SB(1, 0), b3, voffB); PG8_STAGE(PG8_SB(1, 1), b3 + hstep, voffB); PG8_STAGE(PG8_SA(1, 0), a3, voffA); PG8_SCHED; PG8_LDA(At, 1, 1);
            PG8_WAIT_V(8); PG8_WAIT_L(0); PG8_BAR; PG8_MMA(1, 0, At, B0); PG8_MMA(1, 1, At, B1); PG8_BAR; PG8_SCHED;
            } else {
            PG8_LDB(B0, 0, 0); PG8_SCHED; PG8_LDA(At, 0, 0); PG8_STAGE(PG8_SA(1, 1), a1 + hstep, voffA);
            PG8_WAIT_L(8); PG8_BAR; PG8_WAIT_L(0); PG8_MMA(0, 0, At, B0); PG8_BAR; PG8_SCHED;
            PG8_LDB(B1, 0, 1); PG8_STAGE(PG8_SB(0, 0), b2, voffB);
            PG8_BAR; PG8_WAIT_L(0); PG8_MMA(0, 1, At, B1); PG8_BAR;
            PG8_LDA(At, 0, 1); PG8_STAGE(PG8_SA(0, 0), a2, voffA);
            PG8_BAR; PG8_WAIT_L(0); PG8_MMA(1, 0, At, B0); PG8_BAR; PG8_SCHED;
            PG8_STAGE(PG8_SB(0, 1), b2 + hstep, voffB);
            PG8_WAIT_V(6); PG8_BAR; PG8_MMA(1, 1, At, B1); PG8_BAR;
            PG8_LDB(B0, 1, 0); PG8_SCHED; PG8_LDA(At, 1, 0); PG8_STAGE(PG8_SA(0, 1), a2 + hstep, voffA);
            PG8_WAIT_L(8); PG8_BAR; PG8_WAIT_L(0); PG8_MMA(0, 0, At, B0); PG8_BAR; PG8_SCHED;
            PG8_LDB(B1, 1, 1); PG8_STAGE(PG8_SB(1, 0), b3, voffB);
            PG8_BAR; PG8_WAIT_L(0); PG8_MMA(0, 1, At, B1); PG8_BAR;
            PG8_LDA(At, 1, 1); PG8_STAGE(PG8_SA(1, 0), a3, voffA);
            PG8_BAR; PG8_WAIT_L(0); PG8_MMA(1, 0, At, B0); PG8_BAR; PG8_SCHED;
            PG8_STAGE(PG8_SB(1, 1), b3 + hstep, voffB);
            PG8_WAIT_V(6); PG8_BAR; PG8_MMA(1, 1, At, B1); PG8_BAR;
            }
        }
        if constexpr (ALIGN_EPI) { if (wr == 0) PG8_BAR; }
        if constexpr (!Epi::AFTER_DRAIN) { const int t2 = tid_opaque(), w2 = __builtin_amdgcn_readfirstlane(t2 >> 6), l2 = t2 & 63;
            E(acc, cur, w2 >> 2, w2 & 3, l2 & 15, l2 >> 4); S.done(cur); }
        if (!has_next) break;
#pragma unroll
        for (int a = 0; a < 2; ++a)
#pragma unroll
            for (int b = 0; b < 2; ++b)
#pragma unroll
                for (int m = 0; m < 4; ++m)
#pragma unroll
                    for (int n = 0; n < 2; ++n) acc[a][b][m][n] = (f32x4){0.f, 0.f, 0.f, 0.f};
        cur = nxt; cA = nA; cB = nB; ++ui; relax = Epi::LOADS_BEFORE_STORES && !Epi::AFTER_DRAIN && SP2;
        if constexpr (ALIGN_EPI) { if (wr == 1) PG8_BAR; }
    }
    PG8_WAIT_V(0);
    if constexpr (!ALIGN_EPI) { if (wr == 0) PG8_BAR; }
    PG8_BAR;
    if constexpr (Epi::AFTER_DRAIN) { E.fused(acc, cur, wr, wc, fr, fq, lds, wid, lane); S.done(cur); }
#undef PG8_SA
#undef PG8_SB
#undef PG8_STAGE
#undef PG8_LDA
#undef PG8_LDB
#undef PG8_MMA
#undef PG8_WAIT_V
#undef PG8_WAIT_L
#undef PG8_WAIT_V8_UNLESS
#undef PG8_BAR
#undef PG8_SCHED
}
}
#ifndef PG8_SP2
#define PG8_SP2 true
#endif
#include <hip/hip_bf16.h>
#include <cmath>
namespace attn_body {
using bf16=__hip_bfloat16;
using bf16x8=__attribute__((ext_vector_type(8)))short;
using s16x4=__attribute__((ext_vector_type(4)))short;
using f32x16=__attribute__((ext_vector_type(16)))float;
using u32x4=__attribute__((ext_vector_type(4)))unsigned;
constexpr int D=64,PQ=2560,PO=1024;
constexpr int NW=8,QBLK=32,QB=QBLK*NW,KVBLK=64;
constexpr int ATTN_UNIT_ROWS=QB;
__device__ __forceinline__ int crow(int r,int hi){return (r&3)+8*(r>>2)+4*hi;}
#define SBAR() __builtin_amdgcn_sched_barrier(0)
__device__ __forceinline__ void cmask(f32x16&p0,f32x16&p1,int jb,int qrel,int hi){
  const float NEG=-INFINITY; int kb=64*jb+4*hi;
  #pragma unroll
  for(int r=0;r<16;++r){int kv=kb+(r&3)+8*(r>>2); if(kv>qrel)p0[r]=NEG; if(kv+32>qrel)p1[r]=NEG;}
}

constexpr int NSLOT=3, SLOTB=8192;
constexpr int LDS_K=0, LDS_V=NSLOT*SLOTB, LDS_WS=2*NSLOT*SLOTB, LDS_OST=LDS_WS+NW*64*4, LDS_BYTES=LDS_OST+NW*4096;
constexpr float C2=0.125f*1.4426950408889634f;
__device__ __forceinline__ void glds16(const void*gsrc,unsigned lds_dst){unsigned keep;
  asm volatile("s_mov_b32 %0, m0\n\ts_mov_b32 m0, %2\n\ts_nop 0\n\tglobal_load_lds_dwordx4 %1, off\n\ts_mov_b32 m0, %0":"=&s"(keep):"v"(gsrc),"s"(lds_dst):"memory");}
__device__ __forceinline__ float max3f(float a,float b,float c){float r;asm("v_max3_f32 %0, %1, %2, %3":"=v"(r):"v"(a),"v"(b),"v"(c));return r;}
__device__ __forceinline__ float max2f(float a,float b){float r;asm("v_max_f32_e32 %0, %1, %2":"=v"(r):"v"(a),"v"(b));return r;}
__device__ __forceinline__ float fadd_s(float a,float b){float r;asm("v_add_f32_e32 %0, %1, %2":"=v"(r):"v"(a),"v"(b));return r;}
__device__ __forceinline__ float fsub_s(float a,float b){float r;asm("v_sub_f32_e32 %0, %1, %2":"=v"(r):"v"(a),"v"(b));return r;}
typedef float f32x2_t __attribute__((ext_vector_type(2))); typedef __bf16 bf16x2_t __attribute__((ext_vector_type(2)));
__device__ __forceinline__ unsigned cvtpk_s(float lo,float hi){f32x2_t v={lo,hi};bf16x2_t b=__builtin_convertvector(v,bf16x2_t);return __builtin_bit_cast(unsigned,b);}
#define WAIT_BAR(N) asm volatile("s_waitcnt vmcnt(" #N ") lgkmcnt(0)\n\ts_barrier":::"memory")

__device__ __forceinline__ void qkt(f32x16&p0,f32x16&p1,const char*Kslot,const bf16x8*qr,const f32x16&negm,int r32,int hi){
  const char*kb=Kslot+hi*1024+r32*16;
  #pragma unroll
  for(int d0=0;d0<4;++d0){
    const bf16x8 b0=*reinterpret_cast<const bf16x8*>(kb+d0*2048);
    const bf16x8 b1=*reinterpret_cast<const bf16x8*>(kb+d0*2048+512);
    if(d0==0){p0=__builtin_amdgcn_mfma_f32_32x32x16_bf16(b0,qr[0],negm,0,0,0);p1=__builtin_amdgcn_mfma_f32_32x32x16_bf16(b1,qr[0],negm,0,0,0);}
    else{p0=__builtin_amdgcn_mfma_f32_32x32x16_bf16(b0,qr[d0],p0,0,0,0);p1=__builtin_amdgcn_mfma_f32_32x32x16_bf16(b1,qr[d0],p1,0,0,0);}}
}
typedef __attribute__((address_space(3))) const char* lds_cptr;
typedef short v4i16_t __attribute__((ext_vector_type(4)));
__device__ __forceinline__ void kload8(bf16x8*kf,lds_cptr kp){
  kf[0]=*(const __attribute__((address_space(3))) bf16x8*)(kp);      kf[1]=*(const __attribute__((address_space(3))) bf16x8*)(kp+512);
  kf[2]=*(const __attribute__((address_space(3))) bf16x8*)(kp+2048); kf[3]=*(const __attribute__((address_space(3))) bf16x8*)(kp+2560);
  kf[4]=*(const __attribute__((address_space(3))) bf16x8*)(kp+4096); kf[5]=*(const __attribute__((address_space(3))) bf16x8*)(kp+4608);
  kf[6]=*(const __attribute__((address_space(3))) bf16x8*)(kp+6144); kf[7]=*(const __attribute__((address_space(3))) bf16x8*)(kp+6656);
}
__device__ __forceinline__ void kload2(bf16x8*kf,lds_cptr kp,int j){ kf[2*j]=*(const __attribute__((address_space(3))) bf16x8*)(kp+j*2048); kf[2*j+1]=*(const __attribute__((address_space(3))) bf16x8*)(kp+j*2048+512); }
__device__ __forceinline__ s16x4 vtr(lds_cptr p){ return __builtin_bit_cast(s16x4,__builtin_amdgcn_ds_read_tr16_b64_v4i16((__attribute__((address_space(3))) v4i16_t*)p)); }
__device__ __forceinline__ float rowmax(const f32x16&p0,const f32x16&p1){
  float a=max3f(p0[0],p0[1],p1[0]),b=max3f(p0[2],p0[3],p1[1]);a=max3f(a,p1[2],p1[3]);
  #pragma unroll
  for(int r=4;r<16;r+=4){a=max3f(a,p0[r],p0[r+1]);b=max3f(b,p0[r+2],p0[r+3]);a=max3f(a,p1[r],p1[r+1]);b=max3f(b,p1[r+2],p1[r+3]);}
  const float m=max2f(a,b);
  auto rr=__builtin_amdgcn_permlane32_swap(__float_as_uint(m),__float_as_uint(m),false,false);
  return max2f(__uint_as_float(rr[0]),__uint_as_float(rr[1]));
}
__device__ __forceinline__ void pv(f32x16*o,int vb,bf16x8 pa0,bf16x8 pa1,bf16x8 pa2,bf16x8 pa3){
  #pragma unroll
  for(int d0=0;d0<2;++d0){s16x4 lo[4],hi[4];
    #pragma unroll
    for(int ks=0;ks<4;++ks){
      asm volatile("ds_read_b64_tr_b16 %0,%1 offset:%c2":"=&v"(lo[ks]):"v"(vb),"i"(d0*4096+ks*1024):"memory");
      asm volatile("ds_read_b64_tr_b16 %0,%1 offset:%c2":"=&v"(hi[ks]):"v"(vb),"i"(d0*4096+ks*1024+512):"memory");}
    asm volatile("s_waitcnt lgkmcnt(0)":::"memory");SBAR();
    #define PK(k) (bf16x8){lo[k][0],lo[k][1],lo[k][2],lo[k][3],hi[k][0],hi[k][1],hi[k][2],hi[k][3]}
    o[d0]=__builtin_amdgcn_mfma_f32_32x32x16_bf16(pa0,PK(0),o[d0],0,0,0);
    o[d0]=__builtin_amdgcn_mfma_f32_32x32x16_bf16(pa1,PK(1),o[d0],0,0,0);
    o[d0]=__builtin_amdgcn_mfma_f32_32x32x16_bf16(pa2,PK(2),o[d0],0,0,0);
    o[d0]=__builtin_amdgcn_mfma_f32_32x32x16_bf16(pa3,PK(3),o[d0],0,0,0);
    #undef PK
  }
}

#ifndef ATTN_STORE16
#define ATTN_STORE16(p,v) (*(u32x4*)(p)=(v))
#endif
template<int THRL> __device__ __forceinline__ void attn_unit(int qb,const bf16*Qh,const bf16*__restrict__ Kh,const bf16*__restrict__ Vh,bf16*Oh,char*shm){
  const int tid=tid_opaque(),lane=tid&63,r32=lane&31,hi=lane>>5; const int wid=__builtin_amdgcn_readfirstlane(tid>>6);
  const int q0=qb*QB;
  const bf16*Qw=Qh+(long)(q0+wid*QBLK)*PQ;
  const unsigned lds0=(unsigned)(uintptr_t)shm;
  float*wsf=(float*)(shm+LDS_WS)+wid*64;
  const bf16*ksrc=Kh+(long)lane*PQ+wid*8;
  const bf16*vsrc=Vh+(long)(16*(wid&3)+(lane>>2))*PQ+(wid>>2)*32+(lane&3)*8;
  const unsigned kdst=lds0+LDS_K+wid*1024, vdst=lds0+LDS_V+wid*1024;
  #define DMA_K(t,slot) glds16(ksrc+(long)(t)*KVBLK*PQ,(unsigned)__builtin_amdgcn_readfirstlane(kdst+(slot)))
  #define DMA_V(t,slot) glds16(vsrc+(long)(t)*KVBLK*PQ,(unsigned)__builtin_amdgcn_readfirstlane(vdst+(slot)))
  const int vb0=(int)(lds0+LDS_V)+((lane>>4)&1)*32+(lane&3)*8+(4*hi+((lane&15)>>2))*64;
  const char*Kbase=shm+LDS_K; bf16x8 kf[8];
  const lds_cptr shm3=(lds_cptr)shm; const lds_cptr kp0=shm3+LDS_K+hi*1024+r32*16; const lds_cptr vp0=shm3+LDS_V+((lane>>4)&1)*32+(lane&3)*8+(4*hi+((lane&15)>>2))*64;
  const int NT=(q0+QB)/KVBLK;
  DMA_K(0,0);DMA_V(0,0);DMA_K(1,SLOTB);
  bf16x8 qr[4];
  #pragma unroll
  for(int d0=0;d0<4;++d0)qr[d0]=*reinterpret_cast<const bf16x8*>(&Qw[(long)r32*PQ+d0*16+hi*8]);
  float mhat=0.f,l_reg=0.f;f32x16 o[2];o[0]=f32x16{};o[1]=f32x16{};f32x16 negm=f32x16{};asm volatile("":"+v"(negm));
  const int qrel=wid*QBLK+r32;
  #define CMASK(P0,P1,t) do{int jb_=(t)-(NT-4); if(jb_>=0)cmask(P0,P1,jb_,qrel,hi);}while(0)
  bool resc=false;
  #define START(P0,P1) do{ const float rm=rowmax(P0,P1); resc=false; \
    { const float dl=rm; mhat=fadd_s(mhat,dl); \
      _Pragma("unroll") for(int r=0;r<16;++r){P0[r]=fsub_s(P0[r],dl);P1[r]=fsub_s(P1[r],dl);} \
      _Pragma("unroll") for(int r=0;r<16;++r)negm[r]=-mhat; asm volatile("":"+v"(negm)); } \
    _Pragma("unroll") for(int r=0;r<16;++r)P0[r]=__builtin_amdgcn_exp2f(P0[r]); }while(0)
  #define RESC() do{ if(resc){ asm volatile("s_waitcnt lgkmcnt(0)":::"memory"); \
      _Pragma("unroll") for(int d_=0;d_<2;++d_) _Pragma("unroll") for(int r=0;r<16;++r)o[d_][r]*=wsf[crow(r,hi)]; } }while(0)
  f32x16 pA0,pA1,pB0,pB1;
  int sl_prev=0,sl_cur=0,sl_next=SLOTB;
  #define ROT() do{sl_prev=sl_cur;sl_cur=sl_next;sl_next=(sl_next==(NSLOT-1)*SLOTB)?0:sl_next+SLOTB;}while(0)
  DMA_K(2,2*SLOTB);
  WAIT_BAR(3);
  qkt(pA0,pA1,Kbase,qr,negm,r32,hi);asm volatile("s_nop 15\n\ts_nop 7":"+v"(pA0),"+v"(pA1));CMASK(pA0,pA1,0);
  START(pA0,pA1);
  _Pragma("unroll") for(int r=0;r<16;++r)pA1[r]=__builtin_amdgcn_exp2f(pA1[r]);
  WAIT_BAR(0);
  DMA_K(3,0);DMA_V(1,SLOTB);
  ROT();
  kload8(kf,kp0+sl_cur);
  WAIT_BAR(2);
  s16x4 vlo[8],vhi[8]; u32x4 pw0,pw1,pw2,pw3;
  #define PKW(P,B) cvtpk_s(P[B],P[B+1])
  #define PAF(k) __builtin_bit_cast(bf16x8,pw##k)
  #define VFR(i) (bf16x8){vlo[i][0],vlo[i][1],vlo[i][2],vlo[i][3],vhi[i][0],vhi[i][1],vhi[i][2],vhi[i][3]}
  #define PIN(x) asm volatile("":"+v"(x))
  #define MX3(a,b,c) __builtin_fmaxf(__builtin_fmaxf((a),(b)),(c))
  #define GAPA(MF,A0,A1,A2,A3,W0,W1,PW) do{ MF; sacc+=A0; sacc+=A1; sacc+=A2; sacc+=A3; PIN(sacc); W0; W1; PIN(PW); SBAR(); }while(0)
  #define EX(v) __builtin_amdgcn_exp2f(v)
  #define GAPB(MF,X,B) do{ MF; X[B]=EX(X[B]); X[B+1]=EX(X[B+1]); X[B+2]=EX(X[B+2]); X[B+3]=EX(X[B+3]); PIN(X); SBAR(); }while(0)
  #define VRD(i) do{ vlo[i]=vtr(vp_+(((i)>>2)*4096+((i)&3)*1024)); vhi[i]=vtr(vp_+(((i)>>2)*4096+((i)&3)*1024+512)); }while(0)
  #define KRD(G,j) do{ if(G){ kload2(kf,kp0+sl_next,j); SBAR(); } }while(0)
  #define STEP(C0,C1,P0,P1,t,GK,GV,GL) do{ SBAR(); \
    const lds_cptr vp_=vp0+sl_prev; \
    VRD(0); SBAR(); float sacc=(P0[0]+P0[1]); \
    GAPA(C0=__builtin_amdgcn_mfma_f32_32x32x16_bf16(kf[0],qr[0],negm,0,0,0), P0[2],P0[3],P0[4],P0[5],     pw0[0]=PKW(P0,0), pw0[1]=PKW(P0,2), pw0); \
    VRD(4); SBAR(); GAPA(C1=__builtin_amdgcn_mfma_f32_32x32x16_bf16(kf[1],qr[0],negm,0,0,0), P0[6],P0[7],P0[8],P0[9],     pw0[2]=PKW(P0,4), pw0[3]=PKW(P0,6), pw0); \
    VRD(1); SBAR(); GAPA(C0=__builtin_amdgcn_mfma_f32_32x32x16_bf16(kf[2],qr[1],C0,0,0,0),   P0[10],P0[11],P0[12],P0[13], pw1[0]=PKW(P0,8), pw1[1]=PKW(P0,10), pw1); \
    VRD(5); SBAR(); GAPA(C1=__builtin_amdgcn_mfma_f32_32x32x16_bf16(kf[3],qr[1],C1,0,0,0),   P0[14],P0[15],P1[0],P1[1],   pw1[2]=PKW(P0,12),pw1[3]=PKW(P0,14), pw1); \
    VRD(2); SBAR(); GAPA(C0=__builtin_amdgcn_mfma_f32_32x32x16_bf16(kf[4],qr[2],C0,0,0,0),   P1[2],P1[3],P1[4],P1[5],     pw2[0]=PKW(P1,0), pw2[1]=PKW(P1,2), pw2); \
    VRD(6); SBAR(); GAPA(C1=__builtin_amdgcn_mfma_f32_32x32x16_bf16(kf[5],qr[2],C1,0,0,0),   P1[6],P1[7],P1[8],P1[9],     pw2[2]=PKW(P1,4), pw2[3]=PKW(P1,6), pw2); \
    VRD(3); SBAR(); GAPA(C0=__builtin_amdgcn_mfma_f32_32x32x16_bf16(kf[6],qr[3],C0,0,0,0),   P1[10],P1[11],P1[12],P1[13], pw3[0]=PKW(P1,8), pw3[1]=PKW(P1,10), pw3); \
    VRD(7); SBAR(); GAPA(C1=__builtin_amdgcn_mfma_f32_32x32x16_bf16(kf[7],qr[3],C1,0,0,0),   P1[14],P1[15],0.f,0.f,       pw3[2]=PKW(P1,12),pw3[3]=PKW(P1,14), pw3); \
    l_reg+=sacc; \
    if(GK){DMA_K((t)+3,sl_cur);} if(GV){DMA_V((t)+1,sl_next);} \
    CMASK(C0,C1,t); \
    { float a=MX3(C0[0],C0[1],C1[0]),b=MX3(C0[2],C0[3],C1[1]); a=MX3(a,C1[2],C1[3]); \
      _Pragma("unroll") for(int r=4;r<16;r+=4){a=MX3(a,C0[r],C0[r+1]);b=MX3(b,C0[r+2],C0[r+3]);a=MX3(a,C1[r],C1[r+1]);b=MX3(b,C1[r+2],C1[r+3]);} \
      float rm=__builtin_fmaxf(a,b); { auto rr=__builtin_amdgcn_permlane32_swap(__float_as_uint(rm),__float_as_uint(rm),false,false); rm=__builtin_fmaxf(__uint_as_float(rr[0]),__uint_as_float(rr[1])); } \
      resc=false; \
      if(__builtin_expect(__any(rm>(float)THRL),0)){ const float dl=__builtin_fmaxf(rm,0.f); mhat+=dl; \
        _Pragma("unroll") for(int r=0;r<16;++r){C0[r]-=dl;C1[r]-=dl;} \
        _Pragma("unroll") for(int r=0;r<16;++r)negm[r]=-mhat; asm volatile("":"+v"(negm)); \
        const float f=__builtin_amdgcn_exp2f(-dl); l_reg*=f; if(hi==0)wsf[r32]=f; resc=true; } } \
    SBAR(); \
    GAPB(o[0]=__builtin_amdgcn_mfma_f32_32x32x16_bf16(PAF(0),VFR(0),o[0],0,0,0), C0,0); \
    GAPB(o[1]=__builtin_amdgcn_mfma_f32_32x32x16_bf16(PAF(0),VFR(4),o[1],0,0,0), C0,4); \
    KRD(GL,0); GAPB(o[0]=__builtin_amdgcn_mfma_f32_32x32x16_bf16(PAF(1),VFR(1),o[0],0,0,0), C0,8); \
    KRD(GL,1); GAPB(o[1]=__builtin_amdgcn_mfma_f32_32x32x16_bf16(PAF(1),VFR(5),o[1],0,0,0), C0,12); \
    KRD(GL,2); GAPB(o[0]=__builtin_amdgcn_mfma_f32_32x32x16_bf16(PAF(2),VFR(2),o[0],0,0,0), C1,0); \
    KRD(GL,3); GAPB(o[1]=__builtin_amdgcn_mfma_f32_32x32x16_bf16(PAF(2),VFR(6),o[1],0,0,0), C1,4); \
    GAPB(o[0]=__builtin_amdgcn_mfma_f32_32x32x16_bf16(PAF(3),VFR(3),o[0],0,0,0), C1,8); \
    GAPB(o[1]=__builtin_amdgcn_mfma_f32_32x32x16_bf16(PAF(3),VFR(7),o[1],0,0,0), C1,12); \
    }while(0)
  int t=1;
  #undef CMASK
  #define CMASK(P0,P1,t) do{}while(0)
  for(;t+5<NT;t+=2){
    STEP(pB0,pB1,pA0,pA1,t,true,true,true);     WAIT_BAR(2); RESC(); ROT();
    STEP(pA0,pA1,pB0,pB1,t+1,true,true,true);   WAIT_BAR(2); RESC(); ROT();
  }
  #undef CMASK
  #define CMASK(P0,P1,t) do{int jb_=(t)-(NT-4); if(jb_>=0)cmask(P0,P1,jb_,qrel,hi);}while(0)
  #define ENDW(tt) do{ if((tt)+3<NT){WAIT_BAR(2);} else if((tt)+2<NT){WAIT_BAR(1);} else {WAIT_BAR(0);} }while(0)
  for(;t+1<NT;t+=2){
    STEP(pB0,pB1,pA0,pA1,t,(t+3<NT),(t+1<NT),(t+1<NT));       ENDW(t);   RESC(); ROT();
    STEP(pA0,pA1,pB0,pB1,t+1,(t+4<NT),(t+2<NT),(t+2<NT));     ENDW(t+1); RESC(); ROT();
  }
  STEP(pB0,pB1,pA0,pA1,NT-1,false,false,false); RESC();
  { float sacc=pB0[0]+pB0[1]; _Pragma("unroll") for(int r=2;r<16;++r)sacc+=pB0[r]; _Pragma("unroll") for(int r=0;r<16;++r)sacc+=pB1[r]; l_reg+=sacc;
    pw0=(u32x4){PKW(pB0,0),PKW(pB0,2),PKW(pB0,4),PKW(pB0,6)};pw1=(u32x4){PKW(pB0,8),PKW(pB0,10),PKW(pB0,12),PKW(pB0,14)};pw2=(u32x4){PKW(pB1,0),PKW(pB1,2),PKW(pB1,4),PKW(pB1,6)};pw3=(u32x4){PKW(pB1,8),PKW(pB1,10),PKW(pB1,12),PKW(pB1,14)};
    SBAR(); pv(o,vb0+sl_cur,PAF(0),PAF(1),PAF(2),PAF(3)); }
  #undef PKW
  #undef PAF
  #undef VFR
  #undef PIN
  #undef MX3
  #undef GAPA
  #undef GAPB
  #undef EX
  #undef VRD
  #undef KRD
  #undef STEP
  #undef ENDW
  {auto rr=__builtin_amdgcn_permlane32_swap(__float_as_uint(l_reg),__float_as_uint(l_reg),false,false);l_reg=__uint_as_float(rr[0])+__uint_as_float(rr[1]);}
  if(hi==0)wsf[32+r32]=l_reg;asm volatile("s_waitcnt lgkmcnt(0)":::"memory");
  float rli[16];
  #pragma unroll
  for(int r=0;r<16;++r)rli[r]=__builtin_amdgcn_rcpf(wsf[32+crow(r,hi)]);
  bf16*Ow=Oh+(long)(q0+wid*QBLK)*PO;
  { bf16*stg=(bf16*)(shm+LDS_OST)+wid*2048;
    #pragma unroll
    for(int r=0;r<16;++r){const int orow=crow(r,hi);
      #pragma unroll
      for(int d0=0;d0<2;++d0)stg[orow*64+d0*32+r32]=__float2bfloat16(o[d0][r]*rli[r]);}
    asm volatile("s_waitcnt lgkmcnt(0)":::"memory");
    #pragma unroll
    for(int i=0;i<4;++i){const int row=i*8+(lane>>3),ch=lane&7; const u32x4 v=*(const u32x4*)(stg+row*64+ch*8); ATTN_STORE16(Ow+(long)row*PO+ch*8,v);} }
  asm volatile("s_waitcnt lgkmcnt(0)\n\ts_barrier":::"memory");
  #undef DMA_K
  #undef DMA_V
  #undef CMASK
  #undef START
  #undef RESC
  #undef ROT
}
constexpr int ATTN_LDS_BYTES=LDS_BYTES;
#undef SBAR
#undef WAIT_BAR
}
namespace attn2 {
using namespace attn_body;
constexpr int KSLOT=8192, VSLOT=16384;
constexpr int L_K=0, L_V=3*KSLOT, L_WS=L_V+3*VSLOT, L_Q=L_WS+NW*64*4, L_END=L_Q+NW*4096;
#define SBAR() __builtin_amdgcn_sched_barrier(0)
#define WAIT_BAR(N) asm volatile("s_waitcnt vmcnt(" #N ") lgkmcnt(0)\n\ts_barrier":::"memory")
__device__ __forceinline__ void pv4(f32x16*o,int vb,bf16x8 pa0,bf16x8 pa1,bf16x8 pa2,bf16x8 pa3){
  #pragma unroll
  for(int d0=0;d0<4;++d0){s16x4 lo[4],hi[4];
    #pragma unroll
    for(int ks=0;ks<4;++ks){
      asm volatile("ds_read_b64_tr_b16 %0,%1 offset:%c2":"=&v"(lo[ks]):"v"(vb),"i"(d0*4096+ks*1024):"memory");
      asm volatile("ds_read_b64_tr_b16 %0,%1 offset:%c2":"=&v"(hi[ks]):"v"(vb),"i"(d0*4096+ks*1024+512):"memory");}
    asm volatile("s_waitcnt lgkmcnt(0)":::"memory");SBAR();
    #define PK(k) (bf16x8){lo[k][0],lo[k][1],lo[k][2],lo[k][3],hi[k][0],hi[k][1],hi[k][2],hi[k][3]}
    o[d0]=__builtin_amdgcn_mfma_f32_32x32x16_bf16(pa0,PK(0),o[d0],0,0,0);
    o[d0]=__builtin_amdgcn_mfma_f32_32x32x16_bf16(pa1,PK(1),o[d0],0,0,0);
    o[d0]=__builtin_amdgcn_mfma_f32_32x32x16_bf16(pa2,PK(2),o[d0],0,0,0);
    o[d0]=__builtin_amdgcn_mfma_f32_32x32x16_bf16(pa3,PK(3),o[d0],0,0,0);
    #undef PK
  }
}
template<int THRL> __device__ __forceinline__ void attn_unit128(int qb,const bf16*Qh,const bf16*__restrict__ Kh,const bf16*__restrict__ Vh,bf16*Oh,char*shm){
  const int tid=tid_opaque(),lane=tid&63,r32=lane&31,hi=lane>>5; const int wid=__builtin_amdgcn_readfirstlane(tid>>6);
  const int q0=qb*QB;
  const bf16*Qw=Qh+(long)(q0+wid*QBLK)*PQ;
  const unsigned lds0=(unsigned)(uintptr_t)shm;
  float*wsf=(float*)(shm+L_WS)+wid*64;
  const bf16*ksrc=Kh+wid*512+lane*8;
  const bf16*vsrc=Vh+wid*512+lane*8;
  const unsigned kdst=lds0+L_K+wid*1024, vdst=lds0+L_V+wid*1024, qdst=lds0+L_Q+wid*4096;
  #define DMA_K(t,slot) glds16(ksrc+(long)(t)*4096,(unsigned)__builtin_amdgcn_readfirstlane(kdst+(slot)))
  #define DMA_V(t,slot) do{ glds16(vsrc+(long)(t)*8192,(unsigned)__builtin_amdgcn_readfirstlane(vdst+2*(slot))); glds16(vsrc+(long)(t)*8192+4096,(unsigned)__builtin_amdgcn_readfirstlane(vdst+2*(slot)+8192)); }while(0)
  const int vb0=(int)(lds0+L_V)+((lane>>4)&1)*32+(lane&3)*8+(4*hi+((lane&15)>>2))*64;
  const char*Kbase=shm+L_K; bf16x8 kf[8];
  const lds_cptr shm3=(lds_cptr)shm; const lds_cptr kp0=shm3+L_K+hi*1024+r32*16; const lds_cptr vp0=shm3+L_V+((lane>>4)&1)*32+(lane&3)*8+(4*hi+((lane&15)>>2))*64;
  const lds_cptr qp=shm3+L_Q+wid*4096+lane*16;
  #define QLD(d) (*(const __attribute__((address_space(3))) bf16x8*)(qp+(d)*1024))
  const int NT=(q0+QB)/KVBLK;
  DMA_K(0,0);DMA_V(0,0);DMA_K(1,KSLOT);
  #pragma unroll
  for(int d0=0;d0<4;++d0)glds16(&Qw[(long)r32*PQ+d0*16+hi*8],(unsigned)__builtin_amdgcn_readfirstlane(qdst+d0*1024));
  float mhat=0.f,l_reg=0.f;f32x16 o[4];o[0]=f32x16{};o[1]=f32x16{};o[2]=f32x16{};o[3]=f32x16{};
  const f32x16 zero16=f32x16{};
  const int qrel=wid*QBLK+r32;
  #define CMASK(P0,P1,t) do{int jb_=(t)-(NT-4); if(jb_>=0)cmask(P0,P1,jb_,qrel,hi);}while(0)
  bool resc=false;
  #define START(P0,P1) do{ const float rm=rowmax(P0,P1); resc=false; \
    { const float dl=rm; mhat=fadd_s(mhat,dl); \
      _Pragma("unroll") for(int r=0;r<16;++r){P0[r]=fsub_s(P0[r],dl);P1[r]=fsub_s(P1[r],dl);} } \
    _Pragma("unroll") for(int r=0;r<16;++r)P0[r]=__builtin_amdgcn_exp2f(P0[r]); }while(0)
  #define RESC() do{ if(resc){ asm volatile("s_waitcnt lgkmcnt(0)":::"memory"); \
      _Pragma("unroll") for(int d_=0;d_<4;++d_) _Pragma("unroll") for(int r=0;r<16;++r)o[d_][r]*=wsf[crow(r,hi)]; } }while(0)
  f32x16 pA0,pA1,pB0,pB1;
  int sl_prev=0,sl_cur=0,sl_next=KSLOT;
  #define ROT() do{sl_prev=sl_cur;sl_cur=sl_next;sl_next=(sl_next==(NSLOT-1)*KSLOT)?0:sl_next+KSLOT;}while(0)
  DMA_K(2,2*KSLOT);
  WAIT_BAR(1);
  { bf16x8 q4[4];
    #pragma unroll
    for(int d0=0;d0<4;++d0)q4[d0]=QLD(d0);
    qkt(pA0,pA1,Kbase,q4,zero16,r32,hi); }
  asm volatile("s_nop 15\n\ts_nop 7":"+v"(pA0),"+v"(pA1));CMASK(pA0,pA1,0);
  START(pA0,pA1);
  _Pragma("unroll") for(int r=0;r<16;++r)pA1[r]=__builtin_amdgcn_exp2f(pA1[r]);
  WAIT_BAR(0);
  DMA_K(3,0);DMA_V(1,KSLOT);
  ROT();
  kload8(kf,kp0+sl_cur);
  WAIT_BAR(3);
  s16x4 vlo[16],vhi[16]; u32x4 pw0,pw1,pw2,pw3;
  #define PKW(P,B) cvtpk_s(P[B],P[B+1])
  #define PAF(k) __builtin_bit_cast(bf16x8,pw##k)
  #define VFR(i) (bf16x8){vlo[i][0],vlo[i][1],vlo[i][2],vlo[i][3],vhi[i][0],vhi[i][1],vhi[i][2],vhi[i][3]}
  #define PIN(x) asm volatile("":"+v"(x))
  #define MX3(a,b,c) __builtin_fmaxf(__builtin_fmaxf((a),(b)),(c))
  #define GAPA(MF,A0,A1,A2,A3,W0,W1,PW) do{ MF; sacc+=A0; sacc+=A1; sacc+=A2; sacc+=A3; PIN(sacc); W0; W1; PIN(PW); SBAR(); }while(0)
  #define EX(v) __builtin_amdgcn_exp2f((v)-mhat)
  #define GAPB(MF,X,B) do{ MF; X[B]=EX(X[B]); X[B+1]=EX(X[B+1]); PIN(X); SBAR(); }while(0)
  #define VRD(i) do{ vlo[i]=vtr(vp_+(((i)>>2)*4096+((i)&3)*1024)); vhi[i]=vtr(vp_+(((i)>>2)*4096+((i)&3)*1024+512)); }while(0)
  #define KRD(G,j) do{ if(G){ kload2(kf,kp0+sl_next,j); SBAR(); } }while(0)
  #define PVM(d,ks) o[d]=__builtin_amdgcn_mfma_f32_32x32x16_bf16(PAF(ks),VFR((d)*4+(ks)),o[d],0,0,0)
  #define STEP(C0,C1,P0,P1,t,GK,GV,GL) do{ SBAR(); \
    const lds_cptr vp_=vp0+2*sl_prev; \
    const bf16x8 q0_=QLD(0),q1_=QLD(1),q2_=QLD(2),q3_=QLD(3); \
    VRD(0); SBAR(); float sacc=(P0[0]+P0[1]); \
    GAPA(C0=__builtin_amdgcn_mfma_f32_32x32x16_bf16(kf[0],q0_,zero16,0,0,0), P0[2],P0[3],P0[4],P0[5],     pw0[0]=PKW(P0,0), pw0[1]=PKW(P0,2), pw0); \
    VRD(4); SBAR(); GAPA(C1=__builtin_amdgcn_mfma_f32_32x32x16_bf16(kf[1],q0_,zero16,0,0,0), P0[6],P0[7],P0[8],P0[9],     pw0[2]=PKW(P0,4), pw0[3]=PKW(P0,6), pw0); \
    VRD(8); SBAR(); GAPA(C0=__builtin_amdgcn_mfma_f32_32x32x16_bf16(kf[2],q1_,C0,0,0,0),   P0[10],P0[11],P0[12],P0[13], pw1[0]=PKW(P0,8), pw1[1]=PKW(P0,10), pw1); \
    VRD(12); SBAR(); GAPA(C1=__builtin_amdgcn_mfma_f32_32x32x16_bf16(kf[3],q1_,C1,0,0,0),   P0[14],P0[15],P1[0],P1[1],   pw1[2]=PKW(P0,12),pw1[3]=PKW(P0,14), pw1); \
    VRD(1); SBAR(); GAPA(C0=__builtin_amdgcn_mfma_f32_32x32x16_bf16(kf[4],q2_,C0,0,0,0),   P1[2],P1[3],P1[4],P1[5],     pw2[0]=PKW(P1,0), pw2[1]=PKW(P1,2), pw2); \
    VRD(5); SBAR(); GAPA(C1=__builtin_amdgcn_mfma_f32_32x32x16_bf16(kf[5],q2_,C1,0,0,0),   P1[6],P1[7],P1[8],P1[9],     pw2[2]=PKW(P1,4), pw2[3]=PKW(P1,6), pw2); \
    VRD(9); SBAR(); GAPA(C0=__builtin_amdgcn_mfma_f32_32x32x16_bf16(kf[6],q3_,C0,0,0,0),   P1[10],P1[11],P1[12],P1[13], pw3[0]=PKW(P1,8), pw3[1]=PKW(P1,10), pw3); \
    VRD(13); SBAR(); GAPA(C1=__builtin_amdgcn_mfma_f32_32x32x16_bf16(kf[7],q3_,C1,0,0,0),   P1[14],P1[15],0.f,0.f,       pw3[2]=PKW(P1,12),pw3[3]=PKW(P1,14), pw3); \
    l_reg+=sacc; \
    if(GK){DMA_K((t)+3,sl_cur);} if(GV){DMA_V((t)+1,sl_next);} \
    CMASK(C0,C1,t); \
    { float a=MX3(C0[0],C0[1],C1[0]),b=MX3(C0[2],C0[3],C1[1]); a=MX3(a,C1[2],C1[3]); \
      _Pragma("unroll") for(int r=4;r<16;r+=4){a=MX3(a,C0[r],C0[r+1]);b=MX3(b,C0[r+2],C0[r+3]);a=MX3(a,C1[r],C1[r+1]);b=MX3(b,C1[r+2],C1[r+3]);} \
      float rm=__builtin_fmaxf(a,b); { auto rr=__builtin_amdgcn_permlane32_swap(__float_as_uint(rm),__float_as_uint(rm),false,false); rm=__builtin_fmaxf(__uint_as_float(rr[0]),__uint_as_float(rr[1])); } \
      rm-=mhat; resc=false; \
      if(__builtin_expect(__any(rm>(float)THRL),0)){ const float dl=__builtin_fmaxf(rm,0.f); mhat+=dl; \
        const float f=__builtin_amdgcn_exp2f(-dl); l_reg*=f; if(hi==0)wsf[r32]=f; resc=true; } } \
    SBAR(); \
    GAPB(PVM(0,0), C0,0);  VRD(2);  SBAR(); \
    GAPB(PVM(1,0), C0,2);  VRD(6);  SBAR(); \
    GAPB(PVM(2,0), C0,4);  VRD(10); SBAR(); \
    GAPB(PVM(3,0), C0,6);  VRD(14); SBAR(); \
    GAPB(PVM(0,1), C0,8);  VRD(3);  SBAR(); \
    GAPB(PVM(1,1), C0,10); VRD(7);  SBAR(); \
    GAPB(PVM(2,1), C0,12); VRD(11); SBAR(); \
    GAPB(PVM(3,1), C0,14); VRD(15); SBAR(); \
    KRD(GL,0); GAPB(PVM(0,2), C1,0); \
    GAPB(PVM(1,2), C1,2); \
    KRD(GL,1); GAPB(PVM(2,2), C1,4); \
    GAPB(PVM(3,2), C1,6); \
    KRD(GL,2); GAPB(PVM(0,3), C1,8); \
    GAPB(PVM(1,3), C1,10); \
    KRD(GL,3); GAPB(PVM(2,3), C1,12); \
    GAPB(PVM(3,3), C1,14); \
    }while(0)
  int t=1;
  #undef CMASK
  #define CMASK(P0,P1,t) do{}while(0)
  for(;t+5<NT;t+=2){
    STEP(pB0,pB1,pA0,pA1,t,true,true,true);     WAIT_BAR(3); RESC(); ROT();
    STEP(pA0,pA1,pB0,pB1,t+1,true,true,true);   WAIT_BAR(3); RESC(); ROT();
  }
  #undef CMASK
  #define CMASK(P0,P1,t) do{int jb_=(t)-(NT-4); if(jb_>=0)cmask(P0,P1,jb_,qrel,hi);}while(0)
  #define ENDW(tt) do{ if((tt)+3<NT){WAIT_BAR(3);} else if((tt)+2<NT){WAIT_BAR(2);} else {WAIT_BAR(0);} }while(0)
  for(;t+1<NT;t+=2){
    STEP(pB0,pB1,pA0,pA1,t,(t+3<NT),(t+1<NT),(t+1<NT));       ENDW(t);   RESC(); ROT();
    STEP(pA0,pA1,pB0,pB1,t+1,(t+4<NT),(t+2<NT),(t+2<NT));     ENDW(t+1); RESC(); ROT();
  }
  STEP(pB0,pB1,pA0,pA1,NT-1,false,false,false); RESC();
  { float sacc=pB0[0]+pB0[1]; _Pragma("unroll") for(int r=2;r<16;++r)sacc+=pB0[r]; _Pragma("unroll") for(int r=0;r<16;++r)sacc+=pB1[r]; l_reg+=sacc;
    pw0=(u32x4){PKW(pB0,0),PKW(pB0,2),PKW(pB0,4),PKW(pB0,6)};pw1=(u32x4){PKW(pB0,8),PKW(pB0,10),PKW(pB0,12),PKW(pB0,14)};pw2=(u32x4){PKW(pB1,0),PKW(pB1,2),PKW(pB1,4),PKW(pB1,6)};pw3=(u32x4){PKW(pB1,8),PKW(pB1,10),PKW(pB1,12),PKW(pB1,14)};
    SBAR(); pv4(o,vb0+2*sl_cur,PAF(0),PAF(1),PAF(2),PAF(3)); }
  #undef PKW
  #undef PAF
  #undef VFR
  #undef PIN
  #undef MX3
  #undef GAPA
  #undef GAPB
  #undef EX
  #undef VRD
  #undef KRD
  #undef PVM
  #undef STEP
  #undef ENDW
  {auto rr=__builtin_amdgcn_permlane32_swap(__float_as_uint(l_reg),__float_as_uint(l_reg),false,false);l_reg=__uint_as_float(rr[0])+__uint_as_float(rr[1]);}
  if(hi==0)wsf[32+r32]=l_reg;asm volatile("s_waitcnt lgkmcnt(0)":::"memory");
  float rli[16];
  #pragma unroll
  for(int r=0;r<16;++r)rli[r]=__builtin_amdgcn_rcpf(wsf[32+crow(r,hi)]);
  bf16*Ow=Oh+(long)(q0+wid*QBLK)*PO;
  { bf16*stg=(bf16*)(shm+L_Q)+wid*2048;
    #pragma unroll
    for(int hf=0;hf<2;++hf){
      #pragma unroll
      for(int r=0;r<16;++r){const int orow=crow(r,hi);
        #pragma unroll
        for(int d0=0;d0<2;++d0)stg[orow*64+d0*32+r32]=__float2bfloat16(o[2*hf+d0][r]*rli[r]);}
      asm volatile("s_waitcnt lgkmcnt(0)":::"memory");
      #pragma unroll
      for(int i=0;i<4;++i){const int row=i*8+(lane>>3),ch=lane&7; const u32x4 v=*(const u32x4*)(stg+row*64+ch*8); ATTN_STORE16(Ow+(long)row*PO+hf*64+ch*8,v);}
      asm volatile("s_waitcnt lgkmcnt(0)":::"memory"); } }
  asm volatile("s_waitcnt lgkmcnt(0)\n\ts_barrier":::"memory");
  #undef DMA_K
  #undef DMA_V
  #undef QLD
  #undef CMASK
  #undef START
  #undef RESC
  #undef ROT
}
#undef SBAR
#undef WAIT_BAR
}
#include <hip/hip_cooperative_groups.h>
namespace cg = cooperative_groups;
constexpr int NWAVES = 8;
constexpr int BATCH = 16, SEQ = 2048, D = 1024, DEPTH = 4, FF = 4096, PLE = 256, INW = 2560, AW = 512, RW = 512;
constexpr int M = BATCH * SEQ;
constexpr size_t MiB = 1u << 20;
constexpr size_t WS_CS = 1 * MiB;
constexpr size_t WS_SSQ0 = 3 * MiB, WS_SSQ1 = 5 * MiB;
constexpr size_t WS_W = 8 * MiB, W_LAYER = 25 * MiB + 512 * 1024;
constexpr size_t WO_IN = 0, WO_OUT = 5 * MiB, WO_W1 = 7 * MiB, WO_W2 = 15 * MiB, WO_PG = 23 * MiB, WO_PP = 25 * MiB;
constexpr size_t WS_P16 = 110 * MiB;
constexpr size_t WS_XB0 = 126 * MiB;
constexpr size_t WS_R = 190 * MiB;
constexpr size_t WS_PROJ = WS_R;
constexpr size_t WS_OV = WS_R + 160 * MiB;
constexpr size_t WS_AO = WS_R + 224 * MiB;
constexpr size_t WS_HB = WS_R;
constexpr size_t WS_XBF = WS_R + 64 * MiB;
constexpr size_t WS_PP = WS_R;
constexpr size_t WS_END = WS_R + 288 * MiB;
static_assert(WS_W + DEPTH * W_LAYER <= WS_P16 && WS_P16 + (size_t)M * PLE * 2 <= WS_XB0 && WS_XB0 + (size_t)M * D * 2 <= WS_R && WS_HB + (size_t)M * FF * 2 <= WS_END, "d_ws map");
constexpr int RING_BYTES = 131072;
constexpr int LDS_BYTES = 147456;

#define GAS __attribute__((address_space(1)))
#define LAS __attribute__((address_space(3)))
typedef unsigned short bf16;
typedef unsigned v4u __attribute__((ext_vector_type(4)));
typedef float f32x4 __attribute__((ext_vector_type(4)));
typedef short bf16x8 __attribute__((ext_vector_type(8)));
#define LDS_WAIT() asm volatile("s_waitcnt lgkmcnt(0)" ::: "memory")
#define VM_WAIT() asm volatile("s_waitcnt vmcnt(0)" ::: "memory")
__device__ __forceinline__ unsigned f2bf(float f) { unsigned u = __builtin_bit_cast(unsigned, f); return (u + 0x7fffu + ((u >> 16) & 1u)) >> 16; }
__device__ __forceinline__ unsigned pk2(float lo, float hi) { unsigned r; asm("v_cvt_pk_bf16_f32 %0, %1, %2" : "=v"(r) : "v"(lo), "v"(hi)); return r; }
__device__ __forceinline__ float bf2f(unsigned short v) { return __uint_as_float((unsigned)v << 16); }
__device__ __forceinline__ float sigmoid_f(float x) { return __builtin_amdgcn_rcpf(1.f + __builtin_amdgcn_exp2f(-1.4426950408889634f * x)); }

typedef GAS unsigned gu32;
#define RLX_AGENT __ATOMIC_RELAXED, __HIP_MEMORY_SCOPE_AGENT
#define XB_TMO      128
#define XB_XCNT(j)  (256  + 64 * (j))
#define XB_XSUB(j)  (1280 + 64 * (j))
#define XB_XGEN(j)  (2304 + 64 * (j))
#define XB_TOP      3328
#define XB_TOPGEN   3392
#define XCD_BAR_WORDS 3456
#define XB_SPIN_CAP (1u << 18)

__device__ __forceinline__ unsigned xb_ld(unsigned* p)              { return __hip_atomic_load(p, __ATOMIC_RELAXED, __HIP_MEMORY_SCOPE_AGENT); }
__device__ __forceinline__ unsigned xb_add(unsigned* p, unsigned v) { return __hip_atomic_fetch_add(p, v, __ATOMIC_RELAXED, __HIP_MEMORY_SCOPE_AGENT); }
__device__ __forceinline__ unsigned xb_xcc_id() { return (unsigned)__builtin_amdgcn_s_getreg((3 << 11) | 20) & 0xFu; }
#define XB_SPIN(cond, bar) do { unsigned _sp = 0; while (cond) { __builtin_amdgcn_s_sleep(1); \
    if ((++_sp & 255u) == 0u) { if (xb_ld(&(bar)[XB_TMO])) break; if (_sp > XB_SPIN_CAP) { atomicAdd(&(bar)[XB_TMO], 1u); break; } } } } while (0)

struct XcdBarrier {
    unsigned* bar; unsigned x;
    volatile LAS unsigned* st;
};

__device__ __forceinline__ XcdBarrier xcd_barrier_post(unsigned* bar, volatile LAS unsigned* st) {
    XcdBarrier b; b.bar = bar; b.x = xb_xcc_id(); b.st = st;
    if (threadIdx.x == 0) st[4] = xb_add(&bar[XB_XCNT(b.x)], 1u);
    return b;
}
__device__ __forceinline__ void xcd_barrier_complete(unsigned* bar, unsigned x, unsigned& nloc, unsigned& nx) {
    const unsigned G = gridDim.x * gridDim.y * gridDim.z;
    unsigned sum, cnt, mine, sp = 0u;
    for (;;) {
        sum = 0u; cnt = 0u; mine = 0u;
#pragma unroll
        for (unsigned j = 0; j < 16; ++j) { const unsigned c = xb_ld(&bar[XB_XCNT(j)]); sum += c; cnt += (c > 0u) ? 1u : 0u; mine = (j == x) ? c : mine; }
        if (sum == G) break;
        __builtin_amdgcn_s_sleep(1);
        if ((++sp & 255u) == 0u) { if (xb_ld(&bar[XB_TMO])) break; if (sp > XB_SPIN_CAP) { atomicAdd(&bar[XB_TMO], 1u); break; } }
    }
    nloc = mine > 0u ? mine : 1u; nx = cnt > 0u ? cnt : 1u;
}

__device__ __forceinline__ void xcd_barrier(const XcdBarrier& b) {
    asm volatile("s_waitcnt vmcnt(0)" ::: "memory");
    __syncthreads();
    if (threadIdx.x == 0) {
        unsigned* bar = b.bar;
        __builtin_amdgcn_s_waitcnt(0);
        unsigned nloc = b.st[0], nx = b.st[1];
        if (nloc == 0u) { xcd_barrier_complete(bar, b.x, nloc, nx); b.st[0] = nloc; b.st[1] = nx; }
        const unsigned old = xb_add(&bar[XB_XSUB(b.x)], 1u);
        const unsigned gen = old / nloc;
        if (old + 1u == (gen + 1u) * nloc) {
            __builtin_amdgcn_fence(__ATOMIC_RELEASE, "agent");
            asm volatile("s_waitcnt vmcnt(0)" ::: "memory");
            const unsigned og = xb_add(&bar[XB_TOP], 1u);
            const unsigned tg = og / nx;
            if (og + 1u == (tg + 1u) * nx) xb_add(&bar[XB_TOPGEN], 1u);
            else XB_SPIN(xb_ld(&bar[XB_TOPGEN]) == tg, bar);
            __builtin_amdgcn_fence(__ATOMIC_ACQUIRE, "agent");
            xb_add(&bar[XB_XGEN(b.x)], 1u);
            asm volatile("s_waitcnt vmcnt(0)" ::: "memory");
        } else {
            XB_SPIN(xb_ld(&bar[XB_XGEN(b.x)]) == gen, bar);
            __builtin_amdgcn_fence(__ATOMIC_ACQUIRE, "agent");
            asm volatile("s_waitcnt vmcnt(0)" ::: "memory");
        }
    }
    __syncthreads();
}
template <class BG> __device__ __forceinline__ void xcd_barrier_bg(const XcdBarrier& b, const BG& bgwork) {
    asm volatile("s_waitcnt vmcnt(0)" ::: "memory");
    __syncthreads();
    if (threadIdx.x == 0) {
        unsigned* bar = b.bar;
        __builtin_amdgcn_s_waitcnt(0);
        unsigned nloc = b.st[0], nx = b.st[1];
        if (nloc == 0u) { xcd_barrier_complete(bar, b.x, nloc, nx); b.st[0] = nloc; b.st[1] = nx; }
        const unsigned old = xb_add(&bar[XB_XSUB(b.x)], 1u);
        const unsigned gen = old / nloc;
        if (old + 1u == (gen + 1u) * nloc) {
            __builtin_amdgcn_fence(__ATOMIC_RELEASE, "agent");
            asm volatile("s_waitcnt vmcnt(0)" ::: "memory");
            const unsigned og = xb_add(&bar[XB_TOP], 1u);
            const unsigned tg = og / nx;
            if (og + 1u == (tg + 1u) * nx) xb_add(&bar[XB_TOPGEN], 1u);
            else XB_SPIN(xb_ld(&bar[XB_TOPGEN]) == tg, bar);
            __builtin_amdgcn_fence(__ATOMIC_ACQUIRE, "agent");
            xb_add(&bar[XB_XGEN(b.x)], 1u);
            asm volatile("s_waitcnt vmcnt(0)" ::: "memory");
        } else {
            XB_SPIN(xb_ld(&bar[XB_XGEN(b.x)]) == gen, bar);
            __builtin_amdgcn_fence(__ATOMIC_ACQUIRE, "agent");
            asm volatile("s_waitcnt vmcnt(0)" ::: "memory");
        }
    }
    if (threadIdx.x >= 64) bgwork();
    __syncthreads();
}
template <class BG> __device__ __forceinline__ void xcd_barrier_local_bg(const XcdBarrier& b, const BG& bgwork, bool with_bg) {
    asm volatile("s_waitcnt vmcnt(0)" ::: "memory");
    __syncthreads();
    if (threadIdx.x == 0) {
        unsigned* bar = b.bar;
        __builtin_amdgcn_s_waitcnt(0);
        const unsigned nloc = b.st[0];
        const unsigned old = xb_add(&bar[XB_XSUB(b.x)], 1u);
        const unsigned gen = old / nloc;
        if (old + 1u == (gen + 1u) * nloc) xb_add(&bar[XB_XGEN(b.x)], 1u);
        else XB_SPIN(xb_ld(&bar[XB_XGEN(b.x)]) == gen, bar);
        __builtin_amdgcn_fence(__ATOMIC_ACQUIRE, "agent");
        asm volatile("s_waitcnt vmcnt(0)" ::: "memory");
    }
    if (with_bg && threadIdx.x >= 64) bgwork();
    __syncthreads();
}

struct Frame {
    LAS unsigned char* lds;
    LAS const unsigned long long* tab;
};
struct Who { int tid, lane, wave, vcu, G, bx, local; };
constexpr int LDSW_OFF = 131072 + 2048;
__device__ __forceinline__ Who who() { Who w; w.tid = tid_opaque(); w.lane = w.tid & 63; w.wave = __builtin_amdgcn_readfirstlane(w.tid >> 6);
    extern __shared__ __attribute__((aligned(16))) unsigned char lds_who_[];
    volatile LAS unsigned* cw = (volatile LAS unsigned*)((LAS unsigned char*)lds_who_ + LDSW_OFF);
    int bx = __builtin_amdgcn_readfirstlane((int)cw[2]), lc = __builtin_amdgcn_readfirstlane((int)cw[3]), G = gridDim.x; asm volatile("" : "+s"(bx), "+s"(G), "+s"(lc));
    w.G = G; w.bx = bx; w.local = lc; w.vcu = (G % 8 == 0) ? (bx % 8) * (G / 8) + bx / 8 : bx; return w; }
__device__ __forceinline__ int opaque_s(int v) { asm volatile("" : "+s"(v)); return v; }
__device__ __forceinline__ const void* ptab(LAS const unsigned long long* tab, int k) {
    const unsigned long long v = tab[k]; const unsigned lo = __builtin_amdgcn_readfirstlane((unsigned)v), hi = __builtin_amdgcn_readfirstlane((unsigned)(v >> 32));
    GAS const char* g = (GAS const char*)(((unsigned long long)hi << 32) | lo);
    return (const void*)g;
}
#define FIN(k) ((const float*)ptab(F.tab, (k)))
#define FOUT() ((float*)ptab(F.tab, 23))
#define FWS(off) ((unsigned char*)ptab(F.tab, 24) + (off))
enum { I_X = 0, I_P, I_POS, I_WIN, I_WOUT, I_GMIX, I_GSUBLN, I_LAMQ, I_LAMK, I_CONVW, I_CONVB, I_WGA, I_BGA, I_WGX, I_BGX, I_LRULAM, I_GMLP, I_WMLPIN, I_WMLPOUT, I_GPLE, I_WPLEGATE, I_WPLEPROJ, I_GFINAL };
enum { RB_PROJ, RB_OV, RB_AO, RB_HB, RB_PP, RB_XBF };
#define RBUF(which) ((bf16*)rbuf_(FWS(0), W.local, W.bx, (which)))
__device__ __forceinline__ unsigned char* rbuf_(unsigned char* ws, int local, int bx, int which) {
    const size_t pitchB = (which == RB_PROJ) ? (size_t)INW * 2 : (which == RB_HB) ? (size_t)FF * 2 : (size_t)D * 2;
    if (!local) return ws + (which == RB_PROJ ? WS_PROJ : which == RB_OV ? WS_OV : which == RB_AO ? WS_AO : which == RB_HB ? WS_HB : which == RB_PP ? WS_PP : WS_XBF);
    const size_t x = (size_t)(bx % 8), off = (which == RB_OV) ? 20 * MiB : (which == RB_AO) ? 28 * MiB : (which == RB_XBF) ? 8 * MiB : 0;
    return ws + WS_R + x * (36 * MiB) + off - x * (size_t)(M / 8) * pitchB;
}

__device__ __forceinline__ float wave_sum(float v) {
#pragma unroll
    for (int o = 1; o < 64; o <<= 1) v += __shfl_xor(v, o);
    return v;
}
__device__ __forceinline__ void p0_transpose_item(const float* W, const float* gain, int K, int N, bf16* WT, LAS float* scr, int item, int lane) {
    const int nblk = N / 32, kb = item / nblk, nb = item % nblk, k0 = 64 * kb, n0 = 32 * nb;
    const int c = lane & 7;
    float v[32];
#pragma unroll
    for (int i = 0; i < 32; ++i) v[i] = __builtin_nontemporal_load(&W[(size_t)(k0 + 2 * i + (lane >> 5)) * N + n0 + (lane & 31)]);
    f32x4 ga = {1.f, 1.f, 1.f, 1.f}, gb = ga;
    if (gain) { ga = *(const f32x4*)(gain + k0 + 8 * c); gb = *(const f32x4*)(gain + k0 + 8 * c + 4); }
#pragma unroll
    for (int i = 0; i < 32; ++i) scr[(2 * i + (lane >> 5)) * 33 + (lane & 31)] = v[i];
    LDS_WAIT(); asm volatile("" ::: "memory");
#pragma unroll
    for (int j = 0; j < 4; ++j) { const int n = (lane >> 3) + 8 * j; const LAS float* s = scr + (8 * c) * 33 + n;
        v4u o; o.x = pk2(s[0 * 33] * ga.x, s[1 * 33] * ga.y); o.y = pk2(s[2 * 33] * ga.z, s[3 * 33] * ga.w); o.z = pk2(s[4 * 33] * gb.x, s[5 * 33] * gb.y); o.w = pk2(s[6 * 33] * gb.z, s[7 * 33] * gb.w);
        *(GAS v4u*)(WT + (size_t)(n0 + n) * K + k0 + 8 * c) = o; }
    LDS_WAIT(); asm volatile("" ::: "memory");
}
__device__ __forceinline__ void p0_prologue(Frame& F) {
    const Who W = who();
    LAS float* scr = (LAS float*)(F.lds + W.wave * 16384);
    const int gw = W.vcu * NWAVES + W.wave, NGW = W.G * NWAVES;
    unsigned char* ws = FWS(0);
    const float *w_in = FIN(I_WIN), *w_out = FIN(I_WOUT), *w_mlp_in = FIN(I_WMLPIN), *w_mlp_out = FIN(I_WMLPOUT), *w_ple_gate = FIN(I_WPLEGATE), *w_ple_proj = FIN(I_WPLEPROJ), *g_mix = FIN(I_GMIX), *g_mlp = FIN(I_GMLP), *g_ple = FIN(I_GPLE);
    constexpr int I_IN = (D / 64) * (INW / 32), I_OUT = (D / 64) * (D / 32), I_1 = (D / 64) * (FF / 32), I_2 = (FF / 64) * (D / 32), I_PG = I_OUT, I_PP = (PLE / 64) * (D / 32);
    constexpr int PER_L = I_IN + I_OUT + I_1 + I_2 + I_PG + I_PP;
    for (int it = gw; it < DEPTH * PER_L; it += NGW) {
        const int l = it / PER_L; int r = it % PER_L; bf16* wl = (bf16*)(ws + WS_W + (size_t)l * W_LAYER);
        if (r < I_IN) { p0_transpose_item(w_in + (size_t)l * D * INW, g_mix + l * D, D, INW, (bf16*)((unsigned char*)wl + WO_IN), scr, r, W.lane); continue; } r -= I_IN;
        if (r < I_OUT) { p0_transpose_item(w_out + (size_t)l * D * D, nullptr, D, D, (bf16*)((unsigned char*)wl + WO_OUT), scr, r, W.lane); continue; } r -= I_OUT;
        if (r < I_1) { p0_transpose_item(w_mlp_in + (size_t)l * D * FF, g_mlp + l * D, D, FF, (bf16*)((unsigned char*)wl + WO_W1), scr, r, W.lane); continue; } r -= I_1;
        if (r < I_2) { p0_transpose_item(w_mlp_out + (size_t)l * FF * D, nullptr, FF, D, (bf16*)((unsigned char*)wl + WO_W2), scr, r, W.lane); continue; } r -= I_2;
        if (r < I_PG) { p0_transpose_item(w_ple_gate + (size_t)l * D * D, g_ple + l * D, D, D, (bf16*)((unsigned char*)wl + WO_PG), scr, r, W.lane); continue; } r -= I_PG;
        p0_transpose_item(w_ple_proj + (size_t)l * PLE * D, nullptr, PLE, D, (bf16*)((unsigned char*)wl + WO_PP), scr, r, W.lane);
    }
    const float* x_ = FIN(I_X); bf16* XB1_ = (bf16*)FOUT(); float* SSQ1_ = (float*)(ws + WS_SSQ1); float* CS_ = (float*)(ws + WS_CS); const int* pos_ = (const int*)FIN(I_POS);
#pragma unroll 4
    for (int m = gw; m < M; m += NGW) {
        const GAS f32x4* xr = (const GAS f32x4*)(x_ + (size_t)m * D) + W.lane;
        GAS unsigned long long* o8 = (GAS unsigned long long*)(XB1_ + (size_t)m * D) + W.lane; float s = 0.f;
#pragma unroll
        for (int j = 0; j < 4; ++j) { const f32x4 v = __builtin_nontemporal_load(&xr[64 * j]); s += (v.x * v.x + v.y * v.y) + (v.z * v.z + v.w * v.w);
            o8[64 * j] = (unsigned long long)pk2(v.x, v.y) | ((unsigned long long)pk2(v.z, v.w) << 32); }
        s = wave_sum(s);
        if (W.lane < 16) SSQ1_[(size_t)m * 16 + W.lane] = (W.lane == 0) ? s : 0.f;
    }
}
__device__ __forceinline__ void convert_p_slice(Frame& F, int l, int slice) {
    const Who W = who();
    const float* src = FIN(I_P) + (size_t)l * M * PLE; bf16* P16_ = (bf16*)FWS(WS_P16);
    const size_t NV = W.local ? (size_t)(M / 8) * PLE / 8 : (size_t)M * PLE / 8, base = W.local ? (size_t)(W.bx % 8) * NV : 0;
    const size_t PER = (NV + 2) / 3, lo = (size_t)slice * PER, hi = (lo + PER < NV) ? lo + PER : NV;
    const size_t nthr = (W.local ? (size_t)(W.G / 8) : (size_t)W.G) * (NWAVES - 1) * 64, me = (W.local ? (size_t)(W.bx / 8) : (size_t)W.bx) * (NWAVES - 1) * 64 + (W.tid - 64);
#pragma unroll 4
    for (size_t e = lo + me; e < hi; e += nthr) {
        const f32x4 a = __builtin_nontemporal_load((const GAS f32x4*)(src + (base + e) * 8)), b = __builtin_nontemporal_load((const GAS f32x4*)(src + (base + e) * 8 + 4));
        v4u o; o.x = pk2(a.x, a.y); o.y = pk2(a.z, a.w); o.z = pk2(b.x, b.y); o.w = pk2(b.z, b.w);
        *(GAS v4u*)(P16_ + (base + e) * 8) = o; }
}
struct BgConvert { Frame F; int l, slice; __device__ __forceinline__ void operator()() const { Frame f = F; convert_p_slice(f, l, slice); } };
__device__ __forceinline__ void final_norm(Frame& F) {
    const Who W = who();
    const int NGW = (W.local ? W.G / 8 : W.G) * NWAVES, gw = (W.local ? W.bx / 8 : W.bx) * NWAVES + W.wave, m0 = W.local ? (W.bx % 8) * (M / 8) : 0, m1 = W.local ? m0 + M / 8 : M;
    const float* SSQ1_ = (const float*)FWS(WS_SSQ1); float* O_ = FOUT(); const float* gf_ = FIN(I_GFINAL); const bf16* XBF_ = RBUF(RB_XBF);
#pragma unroll 4
    for (int m = m0 + gw; m < m1; m += NGW) {
        const float rs = pg8::row_rs(SSQ1_, m);
        const GAS unsigned long long* hr = (const GAS unsigned long long*)(XBF_ + (size_t)m * D) + W.lane; GAS f32x4* orow = (GAS f32x4*)(O_ + (size_t)m * D) + W.lane; const GAS f32x4* gr = (const GAS f32x4*)gf_ + W.lane;
#pragma unroll
        for (int j = 0; j < 4; ++j) { const unsigned long long w8 = __builtin_nontemporal_load(&hr[64 * j]); const unsigned lo = (unsigned)w8, hi = (unsigned)(w8 >> 32); const f32x4 g = gr[64 * j];
            const f32x4 v = {pg8::bf_lo(lo), pg8::bf_hi(lo), pg8::bf_lo(hi), pg8::bf_hi(hi)}; __builtin_nontemporal_store(v * rs * g, &orow[64 * j]); }
    }
}

__device__ __forceinline__ void lru_item(Frame& F, int l, int item) {
    const int b = item >> 4, g = (item >> 1) & 7, hf = item & 1;
    const int tid_ = tid_opaque(), lane = tid_ & 63, w = __builtin_amdgcn_readfirstlane(tid_ >> 6), r = lane & 15, q = lane >> 4;
    LAS float* xcs = (LAS float*)(F.lds + w * 4352);
    LAS float* car = (LAS float*)(F.lds + 36864);
    const Who W = who();
    const bf16* pj = RBUF(RB_PROJ) + (size_t)b * SEQ * INW;
    bf16* ao = RBUF(RB_AO) + (size_t)b * SEQ * D;
    v4u* lb = (v4u*)FWS(WS_XB0) + ((size_t)item * NWAVES + w) * (16 * 2 * 64) + lane;
    const int t0 = w * 256;
    const bf16* gcol = pj + 3 * AW + RW + g * 64 + hf * 32 + r;
    bf16* ycol = ao + AW + g * 64 + hf * 32 + r;
    float hin[2] = {0.f, 0.f};
    {
        const int cch = g * 64 + lane;
        const float* conv_w = FIN(I_CONVW);
        const float cw0 = conv_w[(l * 4 + 0) * RW + cch], cw1 = conv_w[(l * 4 + 1) * RW + cch], cw2 = conv_w[(l * 4 + 2) * RW + cch], cw3 = conv_w[(l * 4 + 3) * RW + cch], cb = FIN(I_CONVB)[l * RW + cch];
        bf16x8 Bf[2][2][2];
#pragma unroll
        for (int gate = 0; gate < 2; ++gate) { const float* W = (gate ? FIN(I_WGX) : FIN(I_WGA)) + (size_t)(l * 8 + g) * 64 * 64;
#pragma unroll
            for (int n = 0; n < 2; ++n)
#pragma unroll
                for (int kk = 0; kk < 2; ++kk) { const float* wp = W + (size_t)(32 * kk + 8 * q) * 64 + hf * 32 + 16 * n + r; v4u pw;
                    pw.x = pk2(wp[0 * 64], wp[1 * 64]); pw.y = pk2(wp[2 * 64], wp[3 * 64]); pw.z = pk2(wp[4 * 64], wp[5 * 64]); pw.w = pk2(wp[6 * 64], wp[7 * 64]);
                    Bf[gate][n][kk] = __builtin_bit_cast(bf16x8, pw); } }
        float ba[2], bx[2], sp8[2];
#pragma unroll
        for (int n = 0; n < 2; ++n) { const int ch = l * RW + g * 64 + hf * 32 + 16 * n + r; ba[n] = FIN(I_BGA)[ch]; bx[n] = FIN(I_BGX)[ch];
            const float z = -FIN(I_LRULAM)[ch]; sp8[n] = 8.f * (fmaxf(z, 0.f) + log1pf(__expf(-fabsf(z)))); }
        const bf16* xcol = pj + 3 * AW + cch;
        float h3 = 0.f, h2 = 0.f, h1 = 0.f;
        if (t0 != 0) { h3 = bf2f(xcol[(size_t)(t0 - 3) * INW]); h2 = bf2f(xcol[(size_t)(t0 - 2) * INW]); h1 = bf2f(xcol[(size_t)(t0 - 1) * INW]); }
        float hrun[2] = {0.f, 0.f}, Arun[2] = {1.f, 1.f};
        unsigned short xq[16], xn[16];
#pragma unroll
        for (int tt = 0; tt < 16; ++tt) { xq[tt] = xcol[(size_t)(t0 + tt) * INW]; xn[tt] = xcol[(size_t)(t0 + 16 + tt) * INW]; }
#pragma unroll 1
        for (int sc = 0; sc < 16; ++sc) {
            const int ts = t0 + sc * 16, tn = (sc < 14) ? ts + 32 : ts;
            unsigned short xnn[16];
#pragma unroll
            for (int tt = 0; tt < 16; ++tt) xnn[tt] = xcol[(size_t)(tn + tt) * INW];
#pragma unroll
            for (int tt = 0; tt < 16; ++tt) { const float xv = bf2f(xq[tt]); const float xc = cb + cw0 * h3 + cw1 * h2 + cw2 * h1 + cw3 * xv; h3 = h2; h2 = h1; h1 = xv; xcs[tt * 68 + lane] = xc; }
            asm volatile("s_waitcnt lgkmcnt(0)" ::: "memory");
            bf16x8 Af[2];
#pragma unroll
            for (int kk = 0; kk < 2; ++kk) { const LAS f32x4* ap = (const LAS f32x4*)(xcs + r * 68 + 32 * kk + 8 * q); const f32x4 a0 = ap[0], a1 = ap[1];
                v4u pw; pw.x = pk2(a0.x, a0.y); pw.y = pk2(a0.z, a0.w); pw.z = pk2(a1.x, a1.y); pw.w = pk2(a1.z, a1.w); Af[kk] = __builtin_bit_cast(bf16x8, pw); }
            f32x4 Da[2], Dx[2];
#pragma unroll
            for (int n = 0; n < 2; ++n) { Da[n] = (f32x4){0.f, 0.f, 0.f, 0.f}; Dx[n] = Da[n];
#pragma unroll
                for (int kk = 0; kk < 2; ++kk) { Da[n] = __builtin_amdgcn_mfma_f32_16x16x32_bf16(Af[kk], Bf[0][n][kk], Da[n], 0, 0, 0); Dx[n] = __builtin_amdgcn_mfma_f32_16x16x32_bf16(Af[kk], Bf[1][n][kk], Dx[n], 0, 0, 0); } }
#pragma unroll
            for (int n = 0; n < 2; ++n) {
                float a[4], bb[4]; v4u st;
#pragma unroll
                for (int i = 0; i < 4; ++i) { const float xcv = xcs[(4 * q + i) * 68 + hf * 32 + 16 * n + r];
                    const float ra = sigmoid_f(Da[n][i] + ba[n]), ix = sigmoid_f(Dx[n][i] + bx[n]);
                    const float la = -ra * sp8[n];
                    const float y2 = 2.f * la;
                    const float ser = -y2 * (1.f + y2 * (0.5f + y2 * (0.16666667f + y2 * (0.041666668f + y2 * 0.008333334f))));
                    const float av = __builtin_amdgcn_exp2f(1.4426950408889634f * la);
                    const float em = (y2 > -0.25f) ? ser : (1.f - av * av);
                    const float bv = __builtin_amdgcn_sqrtf(fmaxf(em, 0.f)) * (ix * xcv);
                    const unsigned pr = pk2(la * 1.4426950408889634f, bv); st[i] = pr;
                    a[i] = __builtin_amdgcn_exp2f(bf2f((unsigned short)(pr & 0xffffu))); bb[i] = __uint_as_float(pr & 0xffff0000u); }
                lb[(sc * 2 + n) * 64] = st;
                const float Al = (a[0] * a[1]) * (a[2] * a[3]);
                const float Hl = ((bb[0] * a[1] + bb[1]) * a[2] + bb[2]) * a[3] + bb[3];
                const float A0 = __shfl(Al, r), A1 = __shfl(Al, r + 16), A2 = __shfl(Al, r + 32), A3 = __shfl(Al, r + 48);
                const float H0 = __shfl(Hl, r), H1 = __shfl(Hl, r + 16), H2 = __shfl(Hl, r + 32), H3 = __shfl(Hl, r + 48);
                const float c0 = hrun[n], c1 = A0 * c0 + H0, c2 = A1 * c1 + H1, c3 = A2 * c2 + H2, c4 = A3 * c3 + H3;
                hrun[n] = c4; Arun[n] *= (A0 * A1) * (A2 * A3);
            }
#pragma unroll
            for (int tt = 0; tt < 16; ++tt) { xq[tt] = xn[tt]; xn[tt] = xnn[tt]; }
        }
        if (q == 0) {
#pragma unroll
            for (int n = 0; n < 2; ++n) { car[w * 64 + n * 16 + r] = Arun[n]; car[w * 64 + 32 + n * 16 + r] = hrun[n]; } }
        __syncthreads();
#pragma unroll
        for (int n = 0; n < 2; ++n) { float h = 0.f; for (int w2 = 0; w2 < w; ++w2) h = car[w2 * 64 + n * 16 + r] * h + car[w2 * 64 + 32 + n * 16 + r]; hin[n] = h; }
    }
    {
        VM_WAIT();
        float hrun[2] = {hin[0], hin[1]};
        v4u cur[2], nxt[2]; cur[0] = lb[0]; cur[1] = lb[64]; nxt[0] = lb[128]; nxt[1] = lb[192];
        unsigned short gq[2][4];
#pragma unroll
        for (int n = 0; n < 2; ++n)
#pragma unroll
            for (int i = 0; i < 4; ++i) gq[n][i] = gcol[(size_t)(t0 + 4 * q + i) * INW + 16 * n];
#pragma unroll 1
        for (int sc = 0; sc < 16; ++sc) {
            const int ts = t0 + sc * 16, scn = (sc < 14) ? sc + 2 : sc, tg = (sc < 15) ? ts + 16 : ts;
            v4u nn[2]; nn[0] = lb[(scn * 2 + 0) * 64]; nn[1] = lb[(scn * 2 + 1) * 64];
            unsigned short gn[2][4];
#pragma unroll
            for (int n = 0; n < 2; ++n)
#pragma unroll
                for (int i = 0; i < 4; ++i) gn[n][i] = gcol[(size_t)(tg + 4 * q + i) * INW + 16 * n];
#pragma unroll
            for (int n = 0; n < 2; ++n) {
                float a[4], bb[4];
#pragma unroll
                for (int i = 0; i < 4; ++i) { const unsigned pr = cur[n][i]; a[i] = __builtin_amdgcn_exp2f(__uint_as_float(pr << 16)); bb[i] = __uint_as_float(pr & 0xffff0000u); }
                const float Al = (a[0] * a[1]) * (a[2] * a[3]);
                const float Hl = ((bb[0] * a[1] + bb[1]) * a[2] + bb[2]) * a[3] + bb[3];
                const float A0 = __shfl(Al, r), A1 = __shfl(Al, r + 16), A2 = __shfl(Al, r + 32);
                const float H0 = __shfl(Hl, r), H1 = __shfl(Hl, r + 16), H2 = __shfl(Hl, r + 32), H3 = __shfl(Hl, r + 48), A3 = __shfl(Al, r + 48);
                const float c0 = hrun[n], c1 = A0 * c0 + H0, c2 = A1 * c1 + H1, c3 = A2 * c2 + H2, c4 = A3 * c3 + H3;
                hrun[n] = c4;
                float h = (q == 0) ? c0 : (q == 1) ? c1 : (q == 2) ? c2 : c3;
#pragma unroll
                for (int i = 0; i < 4; ++i) { h = a[i] * h + bb[i]; const float gv = bf2f(gq[n][i]);
                    const float ge = gv * sigmoid_f(1.5957691216057308f * (gv + 0.044715f * gv * gv * gv));
                    ycol[(size_t)(ts + 4 * q + i) * D + 16 * n] = (bf16)(pk2(h * ge, 0.f) & 0xffffu); }
            }
            cur[0] = nxt[0]; cur[1] = nxt[1]; nxt[0] = nn[0]; nxt[1] = nn[1];
#pragma unroll
            for (int n = 0; n < 2; ++n)
#pragma unroll
                for (int i = 0; i < 4; ++i) gq[n][i] = gn[n][i];
        }
    }
    __syncthreads();
}

__device__ __forceinline__ void attn_post(Frame& F, int l, int b, int h, int qb, float lam, float oscale) {
    const int tid_ = tid_opaque(), lane = tid_ & 63, wave_ = __builtin_amdgcn_readfirstlane(tid_ >> 6), rsub = lane >> 4, e8 = (lane & 15) * 8;
    const float* gs = FIN(I_GSUBLN) + l * 128 + e8; const Who W = who(); const bf16* OV_ = RBUF(RB_OV); bf16* AO_ = RBUF(RB_AO); const f32x4 g0 = *(const f32x4*)gs, g1 = *(const f32x4*)(gs + 4);
    const size_t rowbase = (size_t)b * SEQ + qb * 256 + wave_ * 32;
#pragma unroll
    for (int it = 0; it < 8; ++it) { const size_t row = rowbase + it * 4 + rsub;
        const v4u a = __builtin_nontemporal_load((const GAS v4u*)(OV_ + row * D + h * 256 + e8)), c = __builtin_nontemporal_load((const GAS v4u*)(OV_ + row * D + h * 256 + 128 + e8));
        f32x4 d0 = {pg8::bf_lo(a.x) - lam * pg8::bf_lo(c.x), pg8::bf_hi(a.x) - lam * pg8::bf_hi(c.x), pg8::bf_lo(a.y) - lam * pg8::bf_lo(c.y), pg8::bf_hi(a.y) - lam * pg8::bf_hi(c.y)};
        f32x4 d1 = {pg8::bf_lo(a.z) - lam * pg8::bf_lo(c.z), pg8::bf_hi(a.z) - lam * pg8::bf_hi(c.z), pg8::bf_lo(a.w) - lam * pg8::bf_lo(c.w), pg8::bf_hi(a.w) - lam * pg8::bf_hi(c.w)};
        float ss = pg8::sumsq8(d0, d1);
        ss += __shfl_xor(ss, 1); ss += __shfl_xor(ss, 2); ss += __shfl_xor(ss, 4); ss += __shfl_xor(ss, 8);
        const float rs = __builtin_amdgcn_rsqf(ss * (1.f / 128.f) + 1e-6f) * oscale;
        d0 = d0 * rs * g0; d1 = d1 * rs * g1;
        v4u o; o.x = pk2(d0.x, d0.y); o.y = pk2(d0.z, d0.w); o.z = pk2(d1.x, d1.y); o.w = pk2(d1.z, d1.w);
        *(GAS v4u*)(AO_ + row * D + h * 128 + e8) = o; }
}

struct Args { const void* in[23]; float* out; unsigned char* ws; int ph_lo, ph_hi; };
constexpr int N_PHASES = 2 + 6 * DEPTH;
__global__ void __launch_bounds__(NWAVES * 64, 2) hymba_fwd(Args args) {
    extern __shared__ __attribute__((aligned(16))) unsigned char lds[];
    cg::grid_group grid = cg::this_grid();
    Frame F;
    F.lds = (LAS unsigned char*)lds;
    { LAS unsigned long long* tabw = (LAS unsigned long long*)(F.lds + RING_BYTES + 1024);
      if (threadIdx.x == 0) {
#pragma unroll
          for (int k = 0; k < 23; ++k) tabw[k] = (unsigned long long)args.in[k];
          tabw[23] = (unsigned long long)args.out; tabw[24] = (unsigned long long)args.ws; }
      F.tab = tabw; }
    __syncthreads();
    const int lo = args.ph_lo, hi = args.ph_hi;
#define IN(k) (lo <= (k) && (k) < hi)
#define SEAM(k) do { if (IN(k) && IN((k) + 1)) { if (local_mode && (k) != N_PHASES - 2) {     const BgConvert bg{F, 0, 0}; xcd_barrier_local_bg(bar, bg, false); } else xcd_barrier(bar); } } while (0)
#define SEAM_BG(k, sl) do { const BgConvert bg{F, opaque_s(l_), (sl)}; if (IN(k) && IN((k) + 1)) { if (local_mode) xcd_barrier_local_bg(bar, bg, true); else xcd_barrier_bg(bar, bg); } else if (IN((k) + 1)) { if (threadIdx.x >= 64) bg(); __syncthreads(); } } while (0)

    if (blockIdx.x == 0) { unsigned* bw = (unsigned*)args.ws; for (int u = threadIdx.x; u < XCD_BAR_WORDS; u += NWAVES * 64) bw[u] = 0u; }
    if (threadIdx.x < 8) ((volatile LAS unsigned*)(F.lds + LDSW_OFF))[threadIdx.x] = (threadIdx.x == 2) ? blockIdx.x : 0u;
    __syncthreads();
    if (IN(0)) { p0_prologue(F); }
    grid.sync();
    XcdBarrier bar = xcd_barrier_post((unsigned*)args.ws, (volatile LAS unsigned*)(F.lds + LDSW_OFF));
    xcd_barrier(bar);
    if (threadIdx.x == 0) {
        volatile LAS unsigned* cw = (volatile LAS unsigned*)(F.lds + LDSW_OFF); const unsigned G = gridDim.x, nloc = cw[0], nx = cw[1], rank = cw[4];
        unsigned slot = 0u; bool uniform = true;
#pragma unroll
        for (unsigned j = 0; j < 16; ++j) { const unsigned c = xb_ld(&bar.bar[XB_XCNT(j)]); if (c > 0u) { if (j < bar.x) ++slot; if (c != nloc) uniform = false; } }
        const bool local = uniform && nx == 8u && nloc * 8u == G && slot < 8u && rank < nloc && xb_ld(&bar.bar[XB_TMO]) == 0u;
        cw[2] = local ? rank * 8u + slot : blockIdx.x; cw[3] = local ? 1u : 0u; }
    __syncthreads();
    const bool local_mode = __builtin_amdgcn_readfirstlane((int)((volatile LAS unsigned*)(F.lds + LDSW_OFF))[3]) != 0;

#pragma unroll 1
    for (int l_ = 0; l_ < DEPTH; ++l_) {
        const int pb = 1 + 6 * l_;
        if (IN(pb + 0)) {
            const Who W = who(); const int l = opaque_s(l_);
            unsigned char* ws = FWS(0); const unsigned char* wl = ws + WS_W + (size_t)l * W_LAYER;
            pg8::Gemm g{(const bf16*)FOUT(), (const bf16*)(wl + WO_IN), M, INW, D}; pg8::StaticOrder S; S.init(M, INW, W.G, W.bx);
            pg8::EpiIn E{RBUF(RB_PROJ), INW, (const float*)(ws + WS_SSQ1), (const int*)FIN(I_POS), attn_body::C2, (bf16*)FOUT() + (size_t)32 * 1024 * 1024, (bf16*)FOUT() + (size_t)48 * 1024 * 1024};
            pg8::gemm_phase<pg8::EpiIn, pg8::StaticOrder, true, true>(F.lds, g, S, E);
        }
        SEAM_BG(pb + 0, 0);
        if (IN(pb + 1)) {
            const Who W = who(); const int l = opaque_s(l_);
            float lam, oscale;
            { const float* lq = FIN(I_LAMQ) + l * 128; const float* lk = FIN(I_LAMK) + l * 128;
              const float d0 = wave_sum(lq[W.lane] * lk[W.lane]), d1 = wave_sum(lq[64 + W.lane] * lk[64 + W.lane]);
              const float li = 0.8f - 0.6f * __expf(-0.3f * (float)l); lam = __expf(d0) - __expf(d1) + li; oscale = 1.f - li; }
#if defined(PROBE_ATTN2)
            for (int rep_ = 0; rep_ < 2; ++rep_)
#endif
            for (int item = W.vcu; item < 256; item += W.G) {
                const int bh = item >> 2, s = item & 3, b = bh >> 2, h = bh & 3;
                const attn_body::bf16* kimg = (const attn_body::bf16*)((const bf16*)FOUT() + (size_t)32 * 1024 * 1024); const attn_body::bf16* vimg = (const attn_body::bf16*)((const bf16*)FOUT() + (size_t)48 * 1024 * 1024);
                const attn_body::bf16* pj = (const attn_body::bf16*)(RBUF(RB_PROJ) + (size_t)b * SEQ * INW); attn_body::bf16* ov = (attn_body::bf16*)(RBUF(RB_OV) + (size_t)b * SEQ * D);
#pragma unroll 1
                for (int k = 0; k < 2; ++k) { const int qb = k ? 7 - s : s;
#pragma unroll 1
                    for (int c = 0; c < 2; ++c)
                        attn2::attn_unit128<8>(qb, pj + (h * 2 + c) * 64, kimg + (size_t)((b * 8 + h * 2 + c) * 32) * 4096, vimg + (size_t)((b * 4 + h) * 32) * 8192, ov + h * 256 + c * 128, (char*)lds);
                    VM_WAIT(); __syncthreads(); __builtin_amdgcn_fence(__ATOMIC_ACQUIRE, "agent"); VM_WAIT();
                    attn_post(F, l, b, h, qb, lam, oscale);
                }
            }
            __syncthreads();
#if defined(PROBE_LRU2)
            for (int rep_ = 0; rep_ < 2; ++rep_)
#endif
            for (int item = W.vcu; item < 256; item += W.G) lru_item(F, l, item);
        }
        SEAM_BG(pb + 1, 1);
        if (IN(pb + 2)) {
            const Who W = who(); const int l = opaque_s(l_);
            unsigned char* ws = FWS(0); const unsigned char* wl = ws + WS_W + (size_t)l * W_LAYER;
            pg8::Gemm g{RBUF(RB_AO), (const bf16*)(wl + WO_OUT), M, D, D}; pg8::StaticOrder S; S.init(M, D, W.G, W.bx, 1);
            pg8::EpiRes E{(const bf16*)FOUT(), (bf16*)(ws + WS_XB0), (float*)(ws + WS_SSQ0)};
            pg8::gemm_phase<pg8::EpiRes, pg8::StaticOrder, true, true>(F.lds, g, S, E);
        }
        SEAM_BG(pb + 2, 2);
        if (IN(pb + 3)) {
            const Who W = who(); const int l = opaque_s(l_);
            unsigned char* ws = FWS(0); const unsigned char* wl = ws + WS_W + (size_t)l * W_LAYER;
            pg8::Gemm g{(const bf16*)(ws + WS_XB0), (const bf16*)(wl + WO_W1), M, FF, D}; pg8::StaticOrder S; S.init(M, FF, W.G, W.bx);
            pg8::EpiMlpIn E{RBUF(RB_HB), FF, (const float*)(ws + WS_SSQ0)};
            pg8::gemm_phase<pg8::EpiMlpIn, pg8::StaticOrder, true, true>(F.lds, g, S, E);
        }
        SEAM(pb + 3);
        if (IN(pb + 4)) {
            const Who W = who(); const int l = opaque_s(l_);
            unsigned char* ws = FWS(0); const unsigned char* wl = ws + WS_W + (size_t)l * W_LAYER;
            pg8::Gemm g{RBUF(RB_HB), (const bf16*)(wl + WO_W2), M, D, FF}; pg8::StaticOrder S; S.init(M, D, W.G, W.bx, 1);
            pg8::EpiRes E{(const bf16*)(ws + WS_XB0), (bf16*)(ws + WS_XB0), (float*)(ws + WS_SSQ0)};
            pg8::gemm_phase<pg8::EpiRes, pg8::StaticOrder, true, true>(F.lds, g, S, E);
        }
        SEAM(pb + 4);
        if (IN(pb + 5)) {
            const Who W = who(); const int l = opaque_s(l_);
            { unsigned char* ws = FWS(0); const unsigned char* wl = ws + WS_W + (size_t)l * W_LAYER;
              pg8::Gemm g{(const bf16*)(ws + WS_P16), (const bf16*)(wl + WO_PP), M, D, opaque_s(PLE)}; pg8::StaticOrder S; S.init(M, D, W.G, W.bx);
              pg8::EpiPlain E{RBUF(RB_PP), D};
              pg8::gemm_phase<pg8::EpiPlain, pg8::StaticOrder, true, true>(F.lds, g, S, E); }
            VM_WAIT(); __syncthreads();
            { unsigned char* ws = FWS(0); const unsigned char* wl = ws + WS_W + (size_t)l * W_LAYER;
              pg8::Gemm g{(const bf16*)(ws + WS_XB0), (const bf16*)(wl + WO_PG), M, D, D}; pg8::StaticOrder S; S.init(M, D, W.G, W.bx);
              pg8::EpiPle E{(const bf16*)(ws + WS_XB0), (l == DEPTH - 1) ? RBUF(RB_XBF) : (bf16*)FOUT(), (const float*)(ws + WS_SSQ0), (float*)(ws + WS_SSQ1), (const bf16*)RBUF(RB_PP)};
              pg8::gemm_phase<pg8::EpiPle, pg8::StaticOrder, true, true>(F.lds, g, S, E); }
        }
        SEAM(pb + 5);
    }
    if (IN(N_PHASES - 1)) final_norm(F);
#undef IN
#undef SEAM
#undef SEAM_BG
}

extern "C" void kernel_launch(void* const* d_in, const int* in_sizes, int n_in, void* d_out, int out_size, void* d_ws, size_t ws_size, hipStream_t stream) {
    static int grid = 0;
    if (grid == 0) {
        if (n_in != 23 || in_sizes[0] != M * D || out_size != M * D || ws_size < WS_END) { fprintf(stderr, "kernel_launch: unexpected shapes: n_in %d in0 %d out %d ws %zu (need %zu); nothing launched\n", n_in, n_in > 0 ? in_sizes[0] : -1, out_size, ws_size, (size_t)WS_END); grid = -1; return; }
        int dev = 0, cus = 0, per_cu = 0;
        if (hipGetDevice(&dev) != hipSuccess || hipDeviceGetAttribute(&cus, hipDeviceAttributeMultiprocessorCount, dev) != hipSuccess) { grid = -1; return; }
        if (hipFuncSetAttribute((const void*)hymba_fwd, hipFuncAttributeMaxDynamicSharedMemorySize, LDS_BYTES) != hipSuccess) { fprintf(stderr, "kernel_launch: hipFuncSetAttribute failed\n"); grid = -1; return; }
        if (hipOccupancyMaxActiveBlocksPerMultiprocessor(&per_cu, (const void*)hymba_fwd, NWAVES * 64, LDS_BYTES) != hipSuccess || per_cu < 1) { fprintf(stderr, "kernel_launch: occupancy query reports %d\n", per_cu); per_cu = 1; }
        (void)hipGetLastError();
        grid = cus * per_cu;
    }
    if (grid < 0) return;
    Args a{};
    for (int i = 0; i < 23; ++i) a.in[i] = d_in[i];
    a.out = (float*)d_out; a.ws = (unsigned char*)d_ws;
#ifndef MK_CUTS
    a.ph_lo = 0; a.ph_hi = N_PHASES;
    void* kargs[] = {&a};
    hipError_t e = hipLaunchCooperativeKernel((const void*)hymba_fwd, dim3(grid), dim3(NWAVES * 64), kargs, LDS_BYTES, stream);
    if (e != hipSuccess) fprintf(stderr, "kernel_launch: cooperative launch failed: %s (grid %d)\n", hipGetErrorString(e), grid);
#else
    for (int ph = 0; ph < N_PHASES; ++ph) { a.ph_lo = ph; a.ph_hi = ph + 1; void* kargs[] = {&a};
        hipError_t e = hipLaunchCooperativeKernel((const void*)hymba_fwd, dim3(grid), dim3(NWAVES * 64), kargs, LDS_BYTES, stream);
        if (e != hipSuccess) { fprintf(stderr, "kernel_launch: launch %d failed: %s\n", ph, hipGetErrorString(e)); break; } }
#endif
}
```
